# Optimizing an MI355X kernel written in HIP

```python
import jax, jax.numpy as jnp
from jax import lax
import numpy as np

D_MODEL = 1024
BATCH = 4
SEQ = 4096
DEPTH = 2

N_EVEN = (DEPTH + 1) // 2
N_ODD = DEPTH // 2
NORM_EPS = 1e-5

GLA_HEADS = 4
GLA_DK = 64
GLA_DV = 128
GLA_KEY = GLA_HEADS * GLA_DK
GLA_VAL = GLA_HEADS * GLA_DV
GLA_GATE_RANK = 16
GLA_GATE_NORMALIZER = 16.0
GLA_CHUNK = 64

RWKV_HEADS = 8
RWKV_HEAD = 64
RWKV_W = RWKV_HEADS * RWKV_HEAD
RWKV_DECAY_RANK = 64
RWKV_A_RANK = 64
RWKV_LN_EPS = 64e-5
RWKV_SHIFT = 3 * RWKV_W + RWKV_DECAY_RANK + RWKV_A_RANK

MIX0 = GLA_VAL + RWKV_W
SPLIT0 = [GLA_KEY, 2 * GLA_KEY, 2 * GLA_KEY + GLA_VAL,
          2 * GLA_KEY + GLA_VAL + GLA_GATE_RANK,
          2 * GLA_KEY + GLA_VAL + GLA_GATE_RANK + RWKV_SHIFT]
IN0 = 2 * GLA_KEY + GLA_VAL + GLA_GATE_RANK + RWKV_SHIFT + MIX0
SPLIT_RWKV = [RWKV_W, 2 * RWKV_W, 3 * RWKV_W, 3 * RWKV_W + RWKV_DECAY_RANK]

SWA_Q_HEADS = 16
SWA_KV_HEADS = 4
SWA_GROUP = SWA_Q_HEADS // SWA_KV_HEADS
SWA_HEAD = 64
WINDOW = 128
ROPE_DIMS = SWA_HEAD // 4
ROPE_THETA = 500000.0
MIX1 = SWA_Q_HEADS * SWA_HEAD
SWA_KV = SWA_KV_HEADS * SWA_HEAD
SWA_QKV = MIX1 + 2 * SWA_KV
IN1 = SWA_QKV + MIX1

kernel_name = "hybrid_gla_rwkv7_swa_sink_gated"


def rmsnorm(x, w, eps=NORM_EPS):
    xf = x.astype(jnp.float32)
    y = xf * lax.rsqrt(jnp.mean(xf * xf, axis=-1, keepdims=True) + eps)
    return (y * w.astype(jnp.float32)).astype(x.dtype)


def token_shift(t):
    return jnp.concatenate([jnp.zeros_like(t[:, :1]), t[:, :-1]], axis=1)


def gla_chunked(q, k, v, g):
    f32 = jnp.float32
    B, T, H, dk = q.shape
    dv = v.shape[-1]
    C = GLA_CHUNK
    NC = T // C
    q = (q.astype(f32) * (dk ** -0.5)).reshape(B, NC, C, H, dk)
    k = k.astype(f32).reshape(B, NC, C, H, dk)
    v = v.astype(f32).reshape(B, NC, C, H, dv)
    b = jnp.cumsum(g.astype(f32).reshape(B, NC, C, H, dk), axis=2)
    ref = b[:, :, C // 2:C // 2 + 1]
    att = jnp.einsum('bnihd,bnjhd->bnhij', q * jnp.exp(b - ref), k * jnp.exp(ref - b))
    causal = jnp.tril(jnp.ones((C, C), dtype=bool))
    att = jnp.where(causal, att, 0.0)
    o_intra = jnp.einsum('bnhij,bnjhv->bnihv', att, v)
    b_last = b[:, :, -1:]
    chunk_kv = jnp.einsum('bnjhd,bnjhv->nbhdv', k * jnp.exp(b_last - b), v)
    chunk_decay = jnp.exp(b_last[:, :, 0]).transpose(1, 0, 2, 3)

    def step(S, inp):
        kv, dec = inp
        return S * dec[..., None] + kv, S

    _, S_prev = lax.scan(step, jnp.zeros((B, H, dk, dv), f32), (chunk_kv, chunk_decay))
    o_inter = jnp.einsum('bnihd,nbhdv->bnihv', q * jnp.exp(b), S_prev)
    return (o_intra + o_inter).reshape(B, T, H, dv)


def rwkv7_scan(r, decay, k, v, a_vec, b_vec):
    B, T, H, N = r.shape

    def step(S, inp):
        r_t, w_t, k_t, v_t, a_t, b_t = inp
        sa = jnp.einsum('bhvk,bhk->bhv', S, a_t)
        S = S * w_t[:, :, None, :] + sa[..., None] * b_t[:, :, None, :] + v_t[..., None] * k_t[:, :, None, :]
        return S, jnp.einsum('bhvk,bhk->bhv', S, r_t)

    xs = (jnp.moveaxis(r, 1, 0), jnp.moveaxis(decay, 1, 0), jnp.moveaxis(k, 1, 0),
          jnp.moveaxis(v, 1, 0), jnp.moveaxis(a_vec, 1, 0), jnp.moveaxis(b_vec, 1, 0))
    _, out = lax.scan(step, jnp.zeros((B, H, N, N), jnp.float32), xs)
    return jnp.moveaxis(out, 0, 1)


def gla_rwkv_mixer(h, w_in, gk_up, gk_bias, gla_norm_w, mu, w0, w_up, a0, a_up,
                   k_k, k_a, r_k, ln_w, ln_b, w_out):
    f32 = jnp.float32
    B, T, _ = h.shape
    proj = h @ w_in
    gq, gk, gv, g_low, rw, gate = jnp.split(proj, SPLIT0, axis=-1)

    log_decay = jax.nn.log_sigmoid((g_low @ gk_up + gk_bias).astype(f32)) / GLA_GATE_NORMALIZER
    o_a = gla_chunked(gq.reshape(B, T, GLA_HEADS, GLA_DK), gk.reshape(B, T, GLA_HEADS, GLA_DK),
                      gv.reshape(B, T, GLA_HEADS, GLA_DV), log_decay.reshape(B, T, GLA_HEADS, GLA_DK))
    o_a = o_a * lax.rsqrt(jnp.mean(o_a * o_a, axis=-1, keepdims=True) + NORM_EPS) * gla_norm_w.astype(f32)
    o_a = o_a.reshape(B, T, GLA_VAL)

    rw = rw.astype(f32)
    rw = rw + (token_shift(rw) - rw) * mu.astype(f32)
    r, k, v, xw, xa = jnp.split(rw, SPLIT_RWKV, axis=-1)
    w = -jax.nn.softplus(-(w0.astype(f32) + jnp.tanh(xw) @ w_up.astype(f32))) - 0.5
    decay = jnp.exp(-jnp.exp(w))
    a = jax.nn.sigmoid(a0.astype(f32) + xa @ a_up.astype(f32))
    hs = (B, T, RWKV_HEADS, RWKV_HEAD)
    kk = (k * k_k.astype(f32)).reshape(hs)
    kk = kk / jnp.maximum(jnp.sqrt(jnp.sum(kk * kk, axis=-1, keepdims=True)), 1e-12)
    k = k * (1.0 + (a - 1.0) * k_a.astype(f32))
    r, k, v, decay, a = r.reshape(hs), k.reshape(hs), v.reshape(hs), decay.reshape(hs), a.reshape(hs)
    o_b = rwkv7_scan(r, decay, k, v, -kk, kk * a)
    mean = jnp.mean(o_b, axis=-1, keepdims=True)
    var = jnp.mean((o_b - mean) ** 2, axis=-1, keepdims=True)
    o_b = (o_b - mean) * lax.rsqrt(var + RWKV_LN_EPS) * ln_w.astype(f32).reshape(RWKV_HEADS, RWKV_HEAD) \
        + ln_b.astype(f32).reshape(RWKV_HEADS, RWKV_HEAD)
    o_b = o_b + jnp.sum(r * k * r_k.astype(f32), axis=-1, keepdims=True) * v
    o_b = o_b.reshape(B, T, RWKV_W)

    o = jnp.concatenate([o_a, o_b], axis=-1) * jax.nn.silu(gate.astype(f32))
    return (o.astype(h.dtype) @ w_out).astype(h.dtype)


def partial_rope(x, pos):
    f32 = jnp.float32
    half = ROPE_DIMS // 2
    inv_freq = ROPE_THETA ** (-jnp.arange(half, dtype=f32) / half)
    ang = pos.astype(f32)[:, None] * inv_freq
    cos = jnp.cos(ang)[None, :, None, :]
    sin = jnp.sin(ang)[None, :, None, :]
    xr = x[..., :ROPE_DIMS].astype(f32)
    x1, x2 = xr[..., :half], xr[..., half:]
    rot = jnp.concatenate([x1 * cos - x2 * sin, x2 * cos + x1 * sin], axis=-1)
    return jnp.concatenate([rot.astype(x.dtype), x[..., ROPE_DIMS:]], axis=-1)


def banded_sink_attention(q, k, v, sinks):
    f32 = jnp.float32
    B, T, _, hd = q.shape
    NB = T // WINDOW
    qb = q.astype(f32).reshape(B, NB, WINDOW, SWA_KV_HEADS, SWA_GROUP, hd) * (hd ** -0.5)

    def two_blocks(t):
        tb = t.astype(f32).reshape(B, NB, WINDOW, SWA_KV_HEADS, hd)
        prev = jnp.pad(tb[:, :-1], ((0, 0), (1, 0), (0, 0), (0, 0), (0, 0)))
        return jnp.concatenate([prev, tb], axis=2)

    kb, vb = two_blocks(k), two_blocks(v)
    s = jnp.einsum('bnqhgd,bnkhd->bnhgqk', qb, kb)
    qi = jnp.arange(WINDOW)[:, None]
    kj = jnp.arange(2 * WINDOW)[None, :]
    diff = qi + WINDOW - kj
    band = (diff >= 0) & (diff < WINDOW)
    valid = band[None] & ((jnp.arange(NB)[:, None, None] > 0) | (kj[None] >= WINDOW))
    s = jnp.where(valid[None, :, None, None], s, -jnp.inf)
    sink = sinks.astype(f32).reshape(SWA_KV_HEADS, SWA_GROUP)[None, None, :, :, None, None]
    m = jnp.maximum(jnp.max(s, axis=-1, keepdims=True), sink)
    p = jnp.exp(s - m)
    denom = jnp.sum(p, axis=-1, keepdims=True) + jnp.exp(sink - m)
    o = jnp.einsum('bnhgqk,bnkhd->bnqhgd', p / denom, vb)
    return o.reshape(B, T, SWA_Q_HEADS, hd)


def swa_mixer(h, w_in, b_in, sinks, w_out, b_out):
    f32 = jnp.float32
    B, T, _ = h.shape
    proj = h @ w_in
    qkv = proj[..., :SWA_QKV] + b_in
    gate = proj[..., SWA_QKV:]
    q, k, v = jnp.split(qkv, [MIX1, MIX1 + SWA_KV], axis=-1)
    pos = jnp.arange(T)
    q = partial_rope(q.reshape(B, T, SWA_Q_HEADS, SWA_HEAD), pos)
    k = partial_rope(k.reshape(B, T, SWA_KV_HEADS, SWA_HEAD), pos)
    v = v.reshape(B, T, SWA_KV_HEADS, SWA_HEAD)
    o = banded_sink_attention(q, k, v, sinks).reshape(B, T, MIX1)
    o = o * jax.nn.silu(gate.astype(f32))
    return (o.astype(h.dtype) @ w_out + b_out).astype(h.dtype)


def setup_inputs(seed: int = 0) -> dict:
    key = jax.random.key(seed)
    ks = jax.random.split(key, 24)
    f32 = jnp.float32
    nrm = lambda k, s: jax.random.normal(k, s, f32)
    return {
        "x": nrm(ks[0], (BATCH, SEQ, D_MODEL)),
        "norm_w": 1.0 + 0.02 * nrm(ks[1], (DEPTH, D_MODEL)),
        "w_in0": nrm(ks[2], (N_EVEN, D_MODEL, IN0)) * D_MODEL ** -0.5,
        "gla_gk_up": nrm(ks[3], (N_EVEN, GLA_GATE_RANK, GLA_KEY)) * GLA_GATE_RANK ** -0.5,
        "gla_gk_bias": 0.1 * nrm(ks[4], (N_EVEN, GLA_KEY)),
        "gla_norm_w": 1.0 + 0.02 * nrm(ks[5], (N_EVEN, GLA_DV)),
        "rwkv_mu": jax.random.uniform(ks[6], (N_EVEN, RWKV_SHIFT), f32),
        "rwkv_w0": jax.random.uniform(ks[7], (N_EVEN, RWKV_W), f32, -4.0, 1.0),
        "rwkv_w_up": nrm(ks[8], (N_EVEN, RWKV_DECAY_RANK, RWKV_W)) * 0.5 * RWKV_DECAY_RANK ** -0.5,
        "rwkv_a0": 0.2 * nrm(ks[9], (N_EVEN, RWKV_W)),
        "rwkv_a_up": nrm(ks[10], (N_EVEN, RWKV_A_RANK, RWKV_W)) * 0.5 * RWKV_A_RANK ** -0.5,
        "rwkv_k_k": 0.85 + 0.05 * nrm(ks[11], (N_EVEN, RWKV_W)),
        "rwkv_k_a": 1.0 + 0.05 * nrm(ks[12], (N_EVEN, RWKV_W)),
        "rwkv_r_k": 0.1 * nrm(ks[13], (N_EVEN, RWKV_HEADS, RWKV_HEAD)),
        "rwkv_ln_w": 1.0 + 0.02 * nrm(ks[14], (N_EVEN, RWKV_W)),
        "rwkv_ln_b": 0.02 * nrm(ks[15], (N_EVEN, RWKV_W)),
        "w_out0": nrm(ks[16], (N_EVEN, MIX0, D_MODEL)) * MIX0 ** -0.5,
        "w_in1": nrm(ks[17], (N_ODD, D_MODEL, IN1)) * D_MODEL ** -0.5,
        "b_in1": 0.02 * nrm(ks[18], (N_ODD, SWA_QKV)),
        "attn_sinks": 0.5 * nrm(ks[19], (N_ODD, SWA_Q_HEADS)),
        "w_out1": nrm(ks[20], (N_ODD, MIX1, D_MODEL)) * MIX1 ** -0.5,
        "b_out1": 0.02 * nrm(ks[21], (N_ODD, D_MODEL)),
        "final_norm_w": 1.0 + 0.02 * nrm(ks[22], (D_MODEL,)),
    }


def reference(x, norm_w, w_in0, gla_gk_up, gla_gk_bias, gla_norm_w, rwkv_mu, rwkv_w0, rwkv_w_up,
              rwkv_a0, rwkv_a_up, rwkv_k_k, rwkv_k_a, rwkv_r_k, rwkv_ln_w, rwkv_ln_b, w_out0,
              w_in1, b_in1, attn_sinks, w_out1, b_out1, final_norm_w):
    h = x
    for layer in range(DEPTH):
        i = layer // 2
        hn = rmsnorm(h, norm_w[layer])
        if layer % 2 == 0:
            h = h + gla_rwkv_mixer(hn, w_in0[i], gla_gk_up[i], gla_gk_bias[i], gla_norm_w[i],
                                   rwkv_mu[i], rwkv_w0[i], rwkv_w_up[i], rwkv_a0[i], rwkv_a_up[i],
                                   rwkv_k_k[i], rwkv_k_a[i], rwkv_r_k[i], rwkv_ln_w[i], rwkv_ln_b[i],
                                   w_out0[i])
        else:
            h = h + swa_mixer(hn, w_in1[i], b_in1[i], attn_sinks[i], w_out1[i], b_out1[i])
    return rmsnorm(h, final_norm_w)
```

```cpp
#include <hip/hip_runtime.h>
#include <hip/hip_cooperative_groups.h>
#include <cstdio>
#include <cstdint>
namespace cg = cooperative_groups;
#ifndef REP_P2R
#define REP_P2R 1
#endif
#ifndef REP_P2G
#define REP_P2G 1
#endif
#ifndef REP_S2
#define REP_S2 1
#endif
#ifndef REP_P3
#define REP_P3 1
#endif
namespace pg8 {
#define PG8_LAS __attribute__((address_space(3)))
typedef unsigned short bf16_t;
typedef short bf16x8 __attribute__((ext_vector_type(8)));
typedef float f32x4 __attribute__((ext_vector_type(4)));
typedef unsigned u32x4 __attribute__((ext_vector_type(4)));
constexpr int BM = 256, BK = 64, HALF = 128, HTB = HALF * BK * 2  , STAGE_BYTES = 8 * HTB, NXCD = 8, WGM = 8;

__host__ __device__ __forceinline__ int lds_byte(int r, int c) { const int st = (r >> 4) * 2 + (c >> 5), rr = r & 15, cc = c & 31, ob = rr * 64 + cc * 2; return st * 1024 + (ob ^ (((ob >> 9) & 1) << 5)); }
__host__ __device__ __forceinline__ void stage_rc(int b, int& R, int& C) { const int st = b / 1024, sb = b % 1024, swz = sb ^ (((sb >> 9) & 1) << 5); R = (st >> 1) * 16 + swz / 64; C = (st & 1) * 32 + (swz % 64) / 2; }
__host__ __device__ __forceinline__ int perm32(int rho) { const int n = rho >> 4, i = rho & 15; return 8 * (i >> 2) + 4 * n + (i & 3); }

struct Unit { int pm, pn; };
struct Gemm { const bf16_t* A; const bf16_t* Bt; int M, N, K; };

struct StaticOrder {
    int nM, nN, nwg, G, c;
    __host__ __device__ void init(int M, int N, int G_, int c_) { nM = M / BM; nN = N / BM; nwg = nM * nN; G = G_; c = c_; }
    __host__ __device__ bool next(int i, Unit& u) const {
        const long L = (long)i * G + c; if (L >= nwg) return false;
        int wgid = (int)L; { const int q = nwg / NXCD, r = nwg % NXCD, xcd = wgid % NXCD, off = wgid / NXCD; wgid = (xcd < r ? xcd * (q + 1) : r * (q + 1) + (xcd - r) * q) + off; }
        const int nig = WGM * nN, gid = wgid / nig, fm = gid * WGM, gsz = (nM - fm) < WGM ? (nM - fm) : WGM;
        u.pm = fm + ((wgid % nig) % gsz); u.pn = (wgid % nig) / gsz; return true;
    }
    __device__ __forceinline__ void a_ready(const Unit&) const {}
    __device__ __forceinline__ void done(const Unit&) const {}
};

template <class Epi, class Sched, bool ALIGN_EPI = false, bool SP2 = false>
__device__ __forceinline__ void gemm_phase(PG8_LAS unsigned char* lds, const Gemm g, const Sched& S, const Epi& E) {
    const int tid = threadIdx.x, wid = __builtin_amdgcn_readfirstlane(tid >> 6), lane = tid & 63, wr = wid >> 2, wc = wid & 3, fr = lane & 15, fq = lane >> 4;
    const int K = g.K, nt = K / BK;
    unsigned voffA[2], voffB[2];
#pragma unroll
    for (int i = 0; i < 2; ++i) { int R, C; stage_rc(tid * 16 + i * 8192, R, C); const int Rb = Epi::PERM ? ((R & ~31) + perm32(R & 31)) : R;
        voffA[i] = (unsigned)(R * K + C) * 2u; voffB[i] = (unsigned)(Rb * K + C) * 2u; }
    const size_t kstep = (size_t)(BK * 2);
    const size_t hstep = (size_t)HALF * K * 2;
    const size_t tstep = 2 * hstep;
    const unsigned ldsw = (unsigned)wid * 1024u;
    const int aoff = lds_byte(wr * 64 + fr, fq * 8), boff = lds_byte(wc * 32 + fr, fq * 8);
#define PG8_SA(b, h) (((b) * 2 + (h)) * HTB)
#define PG8_SB(b, h) ((4 + (b) * 2 + (h)) * HTB)
#define PG8_STAGE(bufoff, gbase, voff) do { _Pragma("unroll") for (int _i = 0; _i < 2; ++_i) \
        __builtin_amdgcn_global_load_lds((const unsigned*)((const char*)(gbase) + (voff)[_i]), (PG8_LAS unsigned*)(lds + (bufoff) + ldsw + _i * 8192), 16, 0, 0); } while (0)
#define PG8_LDA(dst, b, h) do { _Pragma("unroll") for (int m = 0; m < 4; ++m) _Pragma("unroll") for (int k = 0; k < 2; ++k) dst[m][k] = *(const PG8_LAS bf16x8*)(lds + PG8_SA(b, h) + aoff + m * 2048 + k * 1024); } while (0)
#define PG8_LDB(dst, b, h) do { _Pragma("unroll") for (int n = 0; n < 2; ++n) _Pragma("unroll") for (int k = 0; k < 2; ++k) dst[n][k] = *(const PG8_LAS bf16x8*)(lds + PG8_SB(b, h) + boff + n * 2048 + k * 1024); } while (0)
#define PG8_MMA(ai, bj, At, Bt) do { __builtin_amdgcn_s_setprio(1); _Pragma("unroll") for (int m = 0; m < 4; ++m) _Pragma("unroll") for (int n = 0; n < 2; ++n) _Pragma("unroll") for (int k = 0; k < 2; ++k) \
        acc[ai][bj][m][n] = __builtin_amdgcn_mfma_f32_16x16x32_bf16(Bt[n][k], At[m][k], acc[ai][bj][m][n], 0, 0, 0); __builtin_amdgcn_s_setprio(0); } while (0)
#define PG8_WAIT_V(n) asm volatile("s_waitcnt vmcnt(" #n ")" ::: "memory")
#define PG8_WAIT_L(n) asm volatile("s_waitcnt lgkmcnt(" #n ")" ::: "memory")
#define PG8_BAR __builtin_amdgcn_s_barrier()
#define PG8_SCHED __builtin_amdgcn_sched_barrier(0)
    Unit cur, nxt; int ui = 0;
    if (!S.next(0, cur)) return;
    f32x4 acc[2][2][4][2];
#pragma unroll
    for (int a = 0; a < 2; ++a)
#pragma unroll
        for (int b = 0; b < 2; ++b)
#pragma unroll
            for (int m = 0; m < 4; ++m)
#pragma unroll
                for (int n = 0; n < 2; ++n) acc[a][b][m][n] = (f32x4){0.f, 0.f, 0.f, 0.f};
    bf16x8 At[4][2], B0[2][2], B1[2][2];
    const char* cA = (const char*)g.A + (size_t)cur.pm * tstep; const char* cB = (const char*)g.Bt + (size_t)cur.pn * tstep;
    S.a_ready(cur);
    if constexpr (SP2) {
        PG8_STAGE(PG8_SB(0, 0), cB, voffB); PG8_STAGE(PG8_SB(0, 1), cB + hstep, voffB); PG8_STAGE(PG8_SA(0, 0), cA, voffA); PG8_STAGE(PG8_SA(0, 1), cA + hstep, voffA);
        if (wr == 1) PG8_BAR;
        PG8_WAIT_V(2); PG8_BAR;
        PG8_STAGE(PG8_SB(1, 0), cB + kstep, voffB); PG8_STAGE(PG8_SA(1, 0), cA + kstep, voffA); PG8_STAGE(PG8_SB(1, 1), cB + hstep + kstep, voffB);
        PG8_WAIT_V(6); PG8_BAR;
    } else {
        PG8_STAGE(PG8_SB(0, 0), cB, voffB); PG8_STAGE(PG8_SA(0, 0), cA, voffA); PG8_STAGE(PG8_SB(0, 1), cB + hstep, voffB); PG8_STAGE(PG8_SA(0, 1), cA + hstep, voffA);
        if (wr == 1) PG8_BAR;
        PG8_WAIT_V(4); PG8_BAR;
        PG8_STAGE(PG8_SB(1, 0), cB + kstep, voffB); PG8_STAGE(PG8_SA(1, 0), cA + kstep, voffA); PG8_STAGE(PG8_SB(1, 1), cB + hstep + kstep, voffB);
        PG8_WAIT_V(6); PG8_BAR;
    }
    for (;;) {
        const bool has_next = S.next(ui + 1, nxt);
        const char* nA = has_next ? (const char*)g.A + (size_t)nxt.pm * tstep : cA; const char* nB = has_next ? (const char*)g.Bt + (size_t)nxt.pn * tstep : cB;
        for (int t = 0; t < nt; t += 2) {
            const bool last = (t == nt - 2);
            const char* a1 = cA + (size_t)(t + 1) * kstep;
            const char* a2 = last ? nA : cA + (size_t)(t + 2) * kstep; const char* b2 = last ? nB : cB + (size_t)(t + 2) * kstep;
            const char* a3 = a2 + kstep; const char* b3 = b2 + kstep;
            if (last && has_next) S.a_ready(nxt);
            if constexpr (SP2) {
            PG8_LDB(B0, 0, 0); PG8_LDB(B1, 0, 1); PG8_SCHED; PG8_LDA(At, 0, 0); PG8_STAGE(PG8_SA(1, 1), a1 + hstep, voffA);
            PG8_WAIT_V(8); PG8_WAIT_L(0); PG8_BAR; PG8_MMA(0, 0, At, B0); PG8_MMA(0, 1, At, B1); PG8_BAR; PG8_SCHED;
            PG8_LDA(At, 0, 1); PG8_STAGE(PG8_SB(0, 0), b2, voffB); PG8_STAGE(PG8_SB(0, 1), b2 + hstep, voffB); PG8_STAGE(PG8_SA(0, 0), a2, voffA);
            PG8_WAIT_V(8); PG8_WAIT_L(0); PG8_BAR; PG8_MMA(1, 0, At, B0); PG8_MMA(1, 1, At, B1); PG8_BAR; PG8_SCHED;
            PG8_LDB(B0, 1, 0); PG8_LDB(B1, 1, 1); PG8_SCHED; PG8_LDA(At, 1, 0); PG8_STAGE(PG8_SA(0, 1), a2 + hstep, voffA);
            PG8_WAIT_V(8); PG8_WAIT_L(0); PG8_BAR; PG8_MMA(0, 0, At, B0); PG8_MMA(0, 1, At, B1); PG8_BAR; PG8_SCHED;
            PG8_LDA(At, 1, 1); PG8_STAGE(PG8_SB(1, 0), b3, voffB); PG8_STAGE(PG8_SB(1, 1), b3 + hstep, voffB); PG8_STAGE(PG8_SA(1, 0), a3, voffA);
            PG8_WAIT_V(8); PG8_WAIT_L(0); PG8_BAR; PG8_MMA(1, 0, At, B0); PG8_MMA(1, 1, At, B1); PG8_BAR; PG8_SCHED;
            } else {
            PG8_LDB(B0, 0, 0); PG8_SCHED; PG8_LDA(At, 0, 0); PG8_STAGE(PG8_SA(1, 1), a1 + hstep, voffA);
            PG8_WAIT_L(8); PG8_BAR; PG8_WAIT_L(0); PG8_MMA(0, 0, At, B0); PG8_BAR; PG8_SCHED;
            PG8_LDB(B1, 0, 1); PG8_STAGE(PG8_SB(0, 0), b2, voffB);
            PG8_BAR; PG8_WAIT_L(0); PG8_MMA(0, 1, At, B1); PG8_BAR;
            PG8_LDA(At, 0, 1); PG8_STAGE(PG8_SA(0, 0), a2, voffA);
            PG8_BAR; PG8_WAIT_L(0); PG8_MMA(1, 0, At, B0); PG8_BAR; PG8_SCHED;
            PG8_STAGE(PG8_SB(0, 1), b2 + hstep, voffB);
            PG8_WAIT_V(6); PG8_BAR; PG8_MMA(1, 1, At, B1); PG8_BAR;
            PG8_LDB(B0, 1, 0); PG8_SCHED; PG8_LDA(At, 1, 0); PG8_STAGE(PG8_SA(0, 1), a2 + hstep, voffA);
            PG8_WAIT_L(8); PG8_BAR; PG8_WAIT_L(0); PG8_MMA(0, 0, At, B0); PG8_BAR; PG8_SCHED;
            PG8_LDB(B1, 1, 1); PG8_STAGE(PG8_SB(1, 0), b3, voffB);
            PG8_BAR; PG8_WAIT_L(0); PG8_MMA(0, 1, At, B1); PG8_BAR;
            PG8_LDA(At, 1, 1); PG8_STAGE(PG8_SA(1, 0), a3, voffA);
            PG8_BAR; PG8_WAIT_L(0); PG8_MMA(1, 0, At, B0); PG8_BAR; PG8_SCHED;
            PG8_STAGE(PG8_SB(1, 1), b3 + hstep, voffB);
            PG8_WAIT_V(6); PG8_BAR; PG8_MMA(1, 1, At, B1); PG8_BAR;
            }
        }
        if constexpr (ALIGN_EPI) { if (wr == 0) PG8_BAR; }
        if constexpr (!Epi::AFTER_DRAIN) { E(acc, cur, wr, wc, fr, fq); S.done(cur); }
        if (!has_next) break;
#pragma unroll
        for (int a = 0; a < 2; ++a)
#pragma unroll
            for (int b = 0; b < 2; ++b)
#pragma unroll
                for (int m = 0; m < 4; ++m)
#pragma unroll
                    for (int n = 0; n < 2; ++n) acc[a][b][m][n] = (f32x4){0.f, 0.f, 0.f, 0.f};
        cur = nxt; cA = nA; cB = nB; ++ui;
        if constexpr (ALIGN_EPI) { if (wr == 1) PG8_BAR; }
    }
    PG8_WAIT_V(0);
    if constexpr (!ALIGN_EPI) { if (wr == 0) PG8_BAR; }
    PG8_BAR;
    if constexpr (Epi::AFTER_DRAIN) { E.fused(acc, cur, wr, wc, fr, fq, lds, wid, lane); S.done(cur); }
#undef PG8_SA
#undef PG8_SB
#undef PG8_STAGE
#undef PG8_LDA
#undef PG8_LDB
#undef PG8_MMA
#undef PG8_WAIT_V
#undef PG8_WAIT_L
#undef PG8_BAR
#undef PG8_SCHED
}
}
#define GAS __attribute__((address_space(1)))
#define LAS __attribute__((address_space(3)))
#define AS4 __attribute__((address_space(4)))
#define DI __device__ __forceinline__
typedef unsigned short bf16;
typedef float f32x4 __attribute__((ext_vector_type(4)));
typedef float f32x16 __attribute__((ext_vector_type(16)));
typedef short bf16x8 __attribute__((ext_vector_type(8)));
typedef short s16x4 __attribute__((ext_vector_type(4)));
typedef unsigned u32x4 __attribute__((ext_vector_type(4)));
typedef unsigned u32x2 __attribute__((ext_vector_type(2)));
typedef __bf16 bf2v __attribute__((ext_vector_type(2)));

constexpr int NB = 4, T = 4096, M = NB * T, D = 1024;
constexpr int IN0 = 3728, N0P = 3840, IN1 = 2560;
constexpr int C_GQ = 0, C_GK = 256, C_GV = 512, C_GLOW = 1024, C_RW = 1040, C_GATE0 = 2704;
constexpr int C_RR = C_RW, C_RK = C_RW + 512, C_RV = C_RW + 1024, C_XW = C_RW + 1536, C_XA = C_RW + 1600;
constexpr float NORM_EPS = 1e-5f, RWKV_LN_EPS = 64e-5f;
constexpr size_t MiB = 1u << 20;
constexpr size_t WS_W0T = 0, WS_WO0T = 8 * MiB, WS_W1T = 10 * MiB, WS_WO1T = 15 * MiB;
constexpr size_t WS_SLOT1 = 17 * MiB, WS_SLOT2 = 18 * MiB, WS_BONUS = 19 * MiB, WS_GDEC = 19 * MiB + 512 * 1024;
constexpr size_t WS_CTL = 19 * MiB + 768 * 1024, CTL_BYTES = 40960, WS_PCNT = WS_CTL + 16384;
constexpr size_t WS_XCCTAB = WS_CTL + 32768, WS_PROG = WS_CTL + 33792;
constexpr int LDS_BAR_OFF = 147456 - 64;
constexpr size_t WS_ROPE = 18 * MiB + 512 * 1024;
constexpr size_t WS_WLT = 18 * MiB + 768 * 1024;
constexpr size_t WS_XN = 20 * MiB;
constexpr size_t WS_PROJ0 = 52 * MiB;
constexpr size_t WS_H1B = 116 * MiB;
constexpr size_t WS_SCR = 172 * MiB;
constexpr size_t WS_OARAW = 204 * MiB;
constexpr size_t WS_VP = 236 * MiB;
constexpr size_t WS_END = 252 * MiB;
constexpr int LDS_BYTES = 147456;

struct Params {
    const float *x, *norm_w, *w_in0, *gk_up, *gk_bias, *gla_norm_w, *mu, *w0, *w_up, *a0, *a_up, *k_k, *k_a, *r_k, *ln_w, *ln_b, *w_out0, *w_in1, *b_in1, *sinks, *w_out1, *b_out1, *final_w;
    float* out; unsigned char* ws;
};

typedef float f32x2v __attribute__((ext_vector_type(2)));
DI unsigned pk2(float lo, float hi) { const f32x2v f = {lo, hi}; return __builtin_bit_cast(unsigned, __builtin_convertvector(f, bf2v)); }
DI unsigned f2bf(float f) { return pk2(f, 0.f) & 0xffffu; }
DI float bf2f(unsigned h) { return __builtin_bit_cast(float, h << 16); }
DI float bflo(unsigned w) { return __builtin_bit_cast(float, w << 16); }
DI float bfhi(unsigned w) { return __builtin_bit_cast(float, w & 0xffff0000u); }
DI float wave_sum(float v) {
#pragma unroll
    for (int o = 1; o < 64; o <<= 1) v += __shfl_xor(v, o);
    return v;
}
DI float dpp_sum16(float v) {
    v += __builtin_bit_cast(float, __builtin_amdgcn_update_dpp(0, __builtin_bit_cast(int, v), 0xB1, 0xf, 0xf, true));
    v += __builtin_bit_cast(float, __builtin_amdgcn_update_dpp(0, __builtin_bit_cast(int, v), 0x4E, 0xf, 0xf, true));
    v += __builtin_bit_cast(float, __builtin_amdgcn_update_dpp(0, __builtin_bit_cast(int, v), 0x141, 0xf, 0xf, true));
    v += __builtin_bit_cast(float, __builtin_amdgcn_update_dpp(0, __builtin_bit_cast(int, v), 0x140, 0xf, 0xf, true));
    return v;
}
DI float half_sum32(float v) { v = dpp_sum16(v); return v + __shfl_xor(v, 16); }
DI void unpack8(const u32x4 w, float (&f)[8]) {
#pragma unroll
    for (int e = 0; e < 4; ++e) { f[2 * e] = bflo(w[e]); f[2 * e + 1] = bfhi(w[e]); }
}
DI int crow(int r, int hi) { return (r & 3) + 8 * (r >> 2) + 4 * hi; }
DI int kpos(int k) { const int o16 = k & 15; return (k & ~15) + 8 * ((o16 >> 2) & 1) + 4 * (o16 >> 3) + (o16 & 3); }
#define MFMA32(a, b, c) __builtin_amdgcn_mfma_f32_32x32x16_bf16((a), (b), (c), 0, 0, 0)
#define LDS_WAIT() asm volatile("s_waitcnt lgkmcnt(0)" ::: "memory")
DI void lds_barrier() { asm volatile("s_waitcnt lgkmcnt(0)" ::: "memory"); __builtin_amdgcn_s_barrier(); asm volatile("" ::: "memory"); }

#define XB_TMO      128
#define XB_XCNT(j)  (256  + 64 * (j))
#define XB_XSUB(j)  (1280 + 64 * (j))
#define XB_XGEN(j)  (2304 + 64 * (j))
#define XB_TOP      3328
#define XB_TOPGEN   3392
#define XCD_BAR_WORDS 3456
#define XB_SPIN_CAP (1u << 18)

__device__ __forceinline__ unsigned xb_ld(unsigned* p)              { return __hip_atomic_load(p, __ATOMIC_RELAXED, __HIP_MEMORY_SCOPE_AGENT); }
__device__ __forceinline__ unsigned xb_add(unsigned* p, unsigned v) { return __hip_atomic_fetch_add(p, v, __ATOMIC_RELAXED, __HIP_MEMORY_SCOPE_AGENT); }
__device__ __forceinline__ unsigned xb_xcc_id() { return (unsigned)__builtin_amdgcn_s_getreg((3 << 11) | 20) & 0xFu; }
#define XB_SPIN(cond, bar) do { unsigned _sp = 0; while (cond) { __builtin_amdgcn_s_sleep(1); \
    if ((++_sp & 255u) == 0u) { if (xb_ld(&(bar)[XB_TMO])) break; if (_sp > XB_SPIN_CAP) { atomicAdd(&(bar)[XB_TMO], 1u); break; } } } } while (0)

struct XcdBarrier {
    unsigned* bar; unsigned x;
    volatile LAS unsigned* st;
};

__device__ __forceinline__ XcdBarrier xcd_barrier_post(unsigned* bar, volatile LAS unsigned* st) {
    XcdBarrier b; b.bar = bar; b.x = xb_xcc_id(); b.st = st;
    if (threadIdx.x == 0) (void)xb_add(&bar[XB_XCNT(b.x)], 1u);
    return b;
}
__device__ __forceinline__ void xcd_barrier_complete(unsigned* bar, unsigned x, unsigned& nloc, unsigned& nx) {
    const unsigned G = gridDim.x * gridDim.y * gridDim.z;
    unsigned sum, cnt, mine, sp = 0u;
    for (;;) {
        sum = 0u; cnt = 0u; mine = 0u;
#pragma unroll
        for (unsigned j = 0; j < 16; ++j) { const unsigned c = xb_ld(&bar[XB_XCNT(j)]); sum += c; cnt += (c > 0u) ? 1u : 0u; mine = (j == x) ? c : mine; }
        if (sum == G) break;
        __builtin_amdgcn_s_sleep(1);
        if ((++sp & 255u) == 0u) { if (xb_ld(&bar[XB_TMO])) break; if (sp > XB_SPIN_CAP) { atomicAdd(&bar[XB_TMO], 1u); break; } }
    }
    nloc = mine > 0u ? mine : 1u; nx = cnt > 0u ? cnt : 1u;
}

__device__ __forceinline__ void xcd_barrier(const XcdBarrier& b) {
    asm volatile("s_waitcnt vmcnt(0)" ::: "memory");
    __syncthreads();
    if (threadIdx.x == 0) {
        unsigned* bar = b.bar;
        __builtin_amdgcn_s_waitcnt(0);
        unsigned nloc = b.st[0], nx = b.st[1];
        if (nloc == 0u) { xcd_barrier_complete(bar, b.x, nloc, nx); b.st[0] = nloc; b.st[1] = nx; }
        const unsigned old = xb_add(&bar[XB_XSUB(b.x)], 1u);
        const unsigned gen = old / nloc;
        if (old + 1u == (gen + 1u) * nloc) {
            __builtin_amdgcn_fence(__ATOMIC_RELEASE, "agent");
            asm volatile("s_waitcnt vmcnt(0)" ::: "memory");
            const unsigned og = xb_add(&bar[XB_TOP], 1u);
            const unsigned tg = og / nx;
            if (og + 1u == (tg + 1u) * nx) xb_add(&bar[XB_TOPGEN], 1u);
            else XB_SPIN(xb_ld(&bar[XB_TOPGEN]) == tg, bar);
            __builtin_amdgcn_fence(__ATOMIC_ACQUIRE, "agent");
            xb_add(&bar[XB_XGEN(b.x)], 1u);
            asm volatile("s_waitcnt vmcnt(0)" ::: "memory");
        } else {
            XB_SPIN(xb_ld(&bar[XB_XGEN(b.x)]) == gen, bar);
            __builtin_amdgcn_fence(__ATOMIC_ACQUIRE, "agent");
            asm volatile("s_waitcnt vmcnt(0)" ::: "memory");
        }
    }
    __syncthreads();
}

struct EpiScaleBf16 {
    static constexpr bool PERM = true, AFTER_DRAIN = false;
    bf16* O; int ldc; const float* slots; const float* bias; int bias_n;
    DI void operator()(const pg8::f32x4 (&acc)[2][2][4][2], const pg8::Unit& u, int wr, int wc, int fr, int fq) const {
        const int row0 = u.pm * 256 + wr * 64 + fr, col0 = u.pn * 256 + wc * 32 + 8 * fq;
        const bool hb = bias && (u.pn * 256 < bias_n);
        f32x4 bv[2][2];
#pragma unroll
        for (int bj = 0; bj < 2; ++bj)
#pragma unroll
            for (int n = 0; n < 2; ++n) bv[bj][n] = hb ? *(const f32x4*)(bias + col0 + bj * 128 + 4 * n) : (f32x4){0.f, 0.f, 0.f, 0.f};
#pragma unroll
        for (int ai = 0; ai < 2; ++ai)
#pragma unroll
            for (int m = 0; m < 4; ++m) {
                const int row = row0 + ai * 128 + m * 16; float rs = 1.f;
                if (slots) { const f32x4* sp = (const f32x4*)(slots + (size_t)row * 16); const f32x4 a = sp[0], b = sp[1], c = sp[2], d = sp[3];
                    const float ss = ((a[0] + a[1]) + (a[2] + a[3])) + ((b[0] + b[1]) + (b[2] + b[3])) + ((c[0] + c[1]) + (c[2] + c[3])) + ((d[0] + d[1]) + (d[2] + d[3]));
                    rs = 1.0f / sqrtf(ss * (1.0f / 1024.0f) + NORM_EPS); }
                bf16* rowp = O + (size_t)row * ldc + col0;
#pragma unroll
                for (int bj = 0; bj < 2; ++bj) { const f32x4 v0 = acc[ai][bj][m][0] * rs + bv[bj][0], v1 = acc[ai][bj][m][1] * rs + bv[bj][1];
                    u32x4 w; w.x = pk2(v0[0], v0[1]); w.y = pk2(v0[2], v0[3]); w.z = pk2(v1[0], v1[1]); w.w = pk2(v1[2], v1[3]);
                    *(u32x4*)(rowp + bj * 128) = w; }
            }
    }
};
struct EpiResid {
    static constexpr bool PERM = false, AFTER_DRAIN = false;
    const float* base; bf16* outB; float* slots;
    DI void operator()(const pg8::f32x4 (&acc)[2][2][4][2], const pg8::Unit& u, int wr, int wc, int fr, int fq) const {
        const int col0 = u.pn * 256 + wc * 32 + 4 * fq;
#pragma unroll
        for (int ai = 0; ai < 2; ++ai)
#pragma unroll
            for (int m = 0; m < 4; ++m) {
                const int row = u.pm * 256 + ai * 128 + wr * 64 + m * 16 + fr; const size_t off = (size_t)row * 1024 + col0; float ss = 0.f;
#pragma unroll
                for (int bj = 0; bj < 2; ++bj)
#pragma unroll
                    for (int n = 0; n < 2; ++n) { const f32x4 bs = *(const f32x4*)(base + off + bj * 128 + n * 16); const f32x4 v = bs + acc[ai][bj][m][n];
                        u32x2 w; w.x = pk2(v[0], v[1]); w.y = pk2(v[2], v[3]); *(u32x2*)(outB + off + bj * 128 + n * 16) = w;
                        ss += (v[0] * v[0] + v[1] * v[1]) + (v[2] * v[2] + v[3] * v[3]); }
                ss += __shfl_xor(ss, 16); ss += __shfl_xor(ss, 32);
                if (fq == 0) slots[(size_t)row * 16 + u.pn * 4 + wc] = ss;
            }
    }
};

struct EpiResidNorm {
    static constexpr bool PERM = false, AFTER_DRAIN = true;
    const bf16* base; float* out; const float* bias; const float* w; float* xbuf; unsigned* cnt;
    DI void fused(pg8::f32x4 (&acc)[2][2][4][2], const pg8::Unit& u, int wr, int wc, int fr, int fq, PG8_LAS unsigned char* lds, int wid, int lane) const {
        PG8_LAS float* Pt = (PG8_LAS float*)lds;
        PG8_LAS float* S = (PG8_LAS float*)(lds + 4096);
        const int col0 = u.pn * 256 + wc * 32 + 4 * fq;
#pragma unroll
        for (int ai = 0; ai < 2; ++ai)
#pragma unroll
            for (int m = 0; m < 4; ++m) {
                const int r = ai * 128 + wr * 64 + m * 16 + fr; const size_t off = (size_t)(u.pm * 256 + r) * 1024 + col0; float ss = 0.f;
#pragma unroll
                for (int bj = 0; bj < 2; ++bj)
#pragma unroll
                    for (int n = 0; n < 2; ++n) { const u32x2 bw = *(const u32x2*)(base + off + bj * 128 + n * 16); const f32x4 bs = (f32x4){bflo(bw.x), bfhi(bw.x), bflo(bw.y), bfhi(bw.y)}; const f32x4 bv = *(const f32x4*)(bias + col0 + bj * 128 + n * 16);
                        const f32x4 v = bs + acc[ai][bj][m][n] + bv; acc[ai][bj][m][n] = v; ss += (v[0] * v[0] + v[1] * v[1]) + (v[2] * v[2] + v[3] * v[3]); }
                ss += __shfl_xor(ss, 16); ss += __shfl_xor(ss, 32);
                if (fq == 0) Pt[r * 4 + wc] = ss;
                if (m & 1) asm volatile("" ::: "memory");
            }
        asm volatile("s_waitcnt lgkmcnt(0)" ::: "memory"); __builtin_amdgcn_s_barrier(); asm volatile("" ::: "memory");
        const int row = wid * 32 + (lane & 31);
        if (lane < 32) { const float tot = (Pt[row * 4 + 0] + Pt[row * 4 + 1]) + (Pt[row * 4 + 2] + Pt[row * 4 + 3]);
            __hip_atomic_store(xbuf + (size_t)(u.pm * 256 + row) * 4 + u.pn, tot, __ATOMIC_RELAXED, __HIP_MEMORY_SCOPE_AGENT); }
        asm volatile("s_waitcnt vmcnt(0)" ::: "memory");
        if (lane == 0) __hip_atomic_fetch_add(cnt + 64 * u.pm, 1u, __ATOMIC_RELAXED, __HIP_MEMORY_SCOPE_AGENT);
        if (wid == 0) {
            unsigned spins = 0;
            while ((unsigned)__builtin_amdgcn_readfirstlane(__hip_atomic_load(cnt + 64 * u.pm, __ATOMIC_RELAXED, __HIP_MEMORY_SCOPE_AGENT)) < 32u) { __builtin_amdgcn_s_sleep(2); if (++spins > (1u << 22)) break; }
            __builtin_amdgcn_fence(__ATOMIC_ACQUIRE, "agent");
        }
        asm volatile("s_waitcnt vmcnt(0) lgkmcnt(0)" ::: "memory"); __builtin_amdgcn_s_barrier(); asm volatile("" ::: "memory");
        if (lane < 32) { const float* sl = xbuf + (size_t)(u.pm * 256 + row) * 4; float t = 0.f;
#pragma unroll
            for (int k = 0; k < 4; ++k) t += __hip_atomic_load(sl + k, __ATOMIC_RELAXED, __HIP_MEMORY_SCOPE_AGENT);
            S[row] = 1.0f / sqrtf(t * (1.f / 1024.f) + NORM_EPS); }
        asm volatile("s_waitcnt lgkmcnt(0)" ::: "memory"); __builtin_amdgcn_s_barrier(); asm volatile("" ::: "memory");
        f32x4 wv[2][2];
#pragma unroll
        for (int bj = 0; bj < 2; ++bj)
#pragma unroll
            for (int n = 0; n < 2; ++n) wv[bj][n] = *(const f32x4*)(w + col0 + bj * 128 + n * 16);
#pragma unroll
        for (int ai = 0; ai < 2; ++ai)
#pragma unroll
            for (int m = 0; m < 4; ++m) { const int r = ai * 128 + wr * 64 + m * 16 + fr; const float rs = S[r]; const size_t off = (size_t)(u.pm * 256 + r) * 1024 + col0;
#pragma unroll
                for (int bj = 0; bj < 2; ++bj)
#pragma unroll
                    for (int n = 0; n < 2; ++n) *(f32x4*)(out + off + bj * 128 + n * 16) = acc[ai][bj][m][n] * rs * wv[bj][n]; }
    }
};

DI void transpose_item(const float* W, int N, int Npad, bf16* WT, const float* kscale, LAS float* scr, int item, int lane) {
    const int nblk = Npad / 32, kb = item / nblk, nb = item % nblk, k0 = 64 * kb, n0 = 32 * nb;
    const int n = n0 + (lane & 31);
#pragma unroll 8
    for (int i = 0; i < 32; ++i) { const int kk = 2 * i + (lane >> 5); float v = (n < N) ? W[(size_t)(k0 + kk) * N + n] : 0.f; if (kscale) v *= kscale[k0 + kk]; scr[kk * 33 + (lane & 31)] = v; }
    LDS_WAIT(); asm volatile("" ::: "memory");
    const int c = lane & 7;
#pragma unroll
    for (int j = 0; j < 4; ++j) { const int nn = (lane >> 3) + 8 * j; const LAS float* s = scr + (8 * c) * 33 + nn;
        u32x4 o; o.x = pk2(s[0 * 33], s[1 * 33]); o.y = pk2(s[2 * 33], s[3 * 33]); o.z = pk2(s[4 * 33], s[5 * 33]); o.w = pk2(s[6 * 33], s[7 * 33]);
        *(u32x4*)(WT + (size_t)(n0 + nn) * 1024 + k0 + 8 * c) = o; }
    LDS_WAIT(); asm volatile("" ::: "memory");
}
DI void p0_prologue(const Params& P, LAS unsigned char* lds, int wave, int lane) {
    LAS float* scr = (LAS float*)(lds + wave * 16384);
    const int gw = blockIdx.x * 8 + wave, NGW = gridDim.x * 8;
    bf16* W0T = (bf16*)(P.ws + WS_W0T); bf16* WO0T = (bf16*)(P.ws + WS_WO0T); bf16* W1T = (bf16*)(P.ws + WS_W1T); bf16* WO1T = (bf16*)(P.ws + WS_WO1T);
    constexpr int I0 = 16 * (N0P / 32), I1 = 16 * 32, I2 = 16 * (IN1 / 32), I3 = 16 * 32;
    for (int it = gw; it < I0 + I1 + I2 + I3; it += NGW) {
        int r = it;
        if (r < I0) { transpose_item(P.w_in0, IN0, N0P, W0T, nullptr, scr, r, lane); continue; } r -= I0;
        if (r < I1) { transpose_item(P.w_out0, 1024, 1024, WO0T, nullptr, scr, r, lane); continue; } r -= I1;
        if (r < I2) { transpose_item(P.w_in1, IN1, IN1, W1T, P.norm_w + 1024, scr, r, lane); continue; } r -= I2;
        transpose_item(P.w_out1, 1024, 1024, WO1T, nullptr, scr, r, lane);
    }
    {
        float* RT = (float*)(P.ws + WS_ROPE);
        for (int e = gw * 64 + lane; e < T * 8; e += NGW * 64) { const int pos = e >> 3, j = e & 7;
            const float invf = __expf(-(float)j * 0.125f * 13.122363377404328f); const float ang = (float)pos * invf; const float nrev = rintf(ang * 0.15915494309189535f);
            float r = fmaf(-nrev, 6.2831854820251465f, ang); r = fmaf(-nrev, -1.7484555e-07f, r);
            RT[2 * e] = __cosf(r); RT[2 * e + 1] = __sinf(r); }
    }
    {
        u32x4* WLT = (u32x4*)(P.ws + WS_WLT);
        for (int e = gw * 64 + lane; e < 8 * 2 * 4 * 2 * 64; e += NGW * 64) { const int ln = e & 63, db = (e >> 6) & 1, s = (e >> 7) & 3, lo = (e >> 9) & 1, h = e >> 10;
            const float* wp = (lo ? P.a_up : P.w_up) + (size_t)(16 * s + 8 * (ln >> 5)) * 512 + h * 64 + 2 * (ln & 31) + db;
            u32x4 o; o.x = pk2(wp[0], wp[512]); o.y = pk2(wp[2 * 512], wp[3 * 512]); o.z = pk2(wp[4 * 512], wp[5 * 512]); o.w = pk2(wp[6 * 512], wp[7 * 512]); WLT[e] = o; }
    }
    bf16* XN = (bf16*)(P.ws + WS_XN);
    {
        const f32x4* wr = (const f32x4*)P.norm_w + lane; const f32x4 w0 = wr[0], w1 = wr[64], w2 = wr[128], w3 = wr[192];
        f32x4 nx[4];
        { const f32x4* xr = (const f32x4*)(P.x + (size_t)(gw < M ? gw : 0) * D) + lane;
#pragma unroll
          for (int j = 0; j < 4; ++j) nx[j] = xr[64 * j]; }
        for (int m = gw; m < M; m += NGW) {
            f32x4 v[4]; float s = 0.f;
#pragma unroll
            for (int j = 0; j < 4; ++j) { v[j] = nx[j]; s += (v[j][0] * v[j][0] + v[j][1] * v[j][1]) + (v[j][2] * v[j][2] + v[j][3] * v[j][3]); }
            if (m + NGW < M) { const f32x4* xr = (const f32x4*)(P.x + (size_t)(m + NGW) * D) + lane;
#pragma unroll
                for (int j = 0; j < 4; ++j) nx[j] = xr[64 * j]; }
            const float rstd = 1.0f / sqrtf(wave_sum(s) * (1.f / D) + NORM_EPS);
            u32x2* o8 = (u32x2*)(XN + (size_t)m * D) + lane;
            { u32x2 o; o.x = pk2(v[0][0] * rstd * w0[0], v[0][1] * rstd * w0[1]); o.y = pk2(v[0][2] * rstd * w0[2], v[0][3] * rstd * w0[3]); o8[0] = o; }
            { u32x2 o; o.x = pk2(v[1][0] * rstd * w1[0], v[1][1] * rstd * w1[1]); o.y = pk2(v[1][2] * rstd * w1[2], v[1][3] * rstd * w1[3]); o8[64] = o; }
            { u32x2 o; o.x = pk2(v[2][0] * rstd * w2[0], v[2][1] * rstd * w2[1]); o.y = pk2(v[2][2] * rstd * w2[2], v[2][3] * rstd * w2[3]); o8[128] = o; }
            { u32x2 o; o.x = pk2(v[3][0] * rstd * w3[0], v[3][1] * rstd * w3[1]); o.y = pk2(v[3][2] * rstd * w3[2], v[3][3] * rstd * w3[3]); o8[192] = o; }
        }
    }
}
DI float softplus_f(float z) { return fmaxf(z, 0.f) + __logf(1.f + __expf(-fabsf(z))); }
DI float tanh_f(float x) { return 1.f - 2.f * __builtin_amdgcn_rcpf(__expf(2.f * x) + 1.f); }

template <int N> DI void dpp_fmac(float& acc, float src, float y) { asm("v_fmac_f32_dpp %0, %1, %2 row_newbcast:%3 row_mask:0xf bank_mask:0xf" : "+v"(acc) : "v"(src), "v"(y), "n"(N)); }
template <int N> DI void dpp_mul_ip(float& y, float src) { asm("v_mul_f32_dpp %0, %1, %0 row_newbcast:%2 row_mask:0xf bank_mask:0xf" : "+v"(y) : "v"(src), "n"(N)); }
template <int N> DI float dpp_mul(float src, float s) { float r; asm("v_mul_f32_dpp %0, %1, %2 row_newbcast:%3 row_mask:0xf bank_mask:0xf" : "=v"(r) : "v"(src), "v"(s), "n"(N)); return r; }
template <int D> struct RStep {
    static DI void dot(const float (&y)[64], const f32x4& X, float& s0, float& s1, float& s2, float& s3) {
        if constexpr (D < 16) { dpp_fmac<D>(s0, X[0], y[D]); dpp_fmac<D>(s1, X[1], y[16 + D]); dpp_fmac<D>(s2, X[2], y[32 + D]); dpp_fmac<D>(s3, X[3], y[48 + D]); RStep<D + 1>::dot(y, X, s0, s1, s2, s3); } }
    static DI void upd(float (&y)[64], const f32x4& Bv, float sa) {
        if constexpr (D < 16) {
            dpp_fmac<D>(y[D], Bv[0], sa); dpp_fmac<D>(y[16 + D], Bv[1], sa); dpp_fmac<D>(y[32 + D], Bv[2], sa); dpp_fmac<D>(y[48 + D], Bv[3], sa);
            RStep<D + 1>::upd(y, Bv, sa); } }
    static DI void scale(float (&y)[64], const f32x4& W) {
        if constexpr (D < 16) {
            dpp_mul_ip<D>(y[D], W[0]); dpp_mul_ip<D>(y[16 + D], W[1]); dpp_mul_ip<D>(y[32 + D], W[2]); dpp_mul_ip<D>(y[48 + D], W[3]);
            RStep<D + 1>::scale(y, W); } }
};
DI void rwkv_rstep(float (&y)[64], const f32x4 (&X)[4], int t, int role, int lane, const LAS float* ksw, bf16* mstep) {
    float s0 = 0.f, s1 = 0.f, s2 = 0.f, s3 = 0.f;
    RStep<0>::dot(y, X[0], s0, s1, s2, s3);
    RStep<0>::upd(y, X[2], (s0 + s1) + (s2 + s3));
    if (role == 1) {
        if (lane == t) {
#pragma unroll
            for (int d = 0; d < 64; ++d) y[d] = ksw[t * 65 + d];
        }
        asm volatile("s_nop 4" ::: "memory");
    }
    float o0 = 0.f, o1 = 0.f, o2 = 0.f, o3 = 0.f;
    RStep<0>::dot(y, X[3], o0, o1, o2, o3);
    mstep[t * 64] = (bf16)f2bf((o0 + o1) + (o2 + o3));
}
DI void rwkv_prep_item(const Params& P, int item, LAS unsigned char* lds, int wave, int lane) {
    const int bh = item >> 4, quad = item & 15, b = bh >> 3, h = bh & 7;
    const int tok0 = b * T + quad * 256;
    const bf16* PROJ0 = (const bf16*)(P.ws + WS_PROJ0);
    float* scr = (float*)(P.ws + WS_SCR + (size_t)blockIdx.x * 262144);
    LAS float* KS = (LAS float*)lds;
    LAS float* TOT = (LAS float*)(lds + 8 * 64 * 65 * 4);
    bf16* VP = (bf16*)(P.ws + WS_VP); float* BON = (float*)(P.ws + WS_BONUS);
    const int hd = h * 64 + lane;
    {
        const int m = lane & 31, hi = lane >> 5;
        const int c = wave >> 1, tb = (wave & 1) * 32;
        const int tokw = tok0 + wave * 32, posw = quad * 256 + wave * 32;
        f32x16 accw[2], acca[2];
#pragma unroll
        for (int i = 0; i < 16; ++i) { accw[0][i] = 0.f; accw[1][i] = 0.f; acca[0][i] = 0.f; acca[1][i] = 0.f; }
        {
            const bf16* rowc = PROJ0 + (size_t)(tokw + m) * N0P; const bool hasprev = (posw + m) > 0;
            const u32x4* WLT = (const u32x4*)(P.ws + WS_WLT) + (size_t)h * 1024 + lane;
            u32x4 cwv[4], cav[4], pwv[4], pav[4], bwv[4][2], bav[4][2];
#pragma unroll
            for (int s = 0; s < 4; ++s) { const int j0 = 16 * s + 8 * hi;
                cwv[s] = *(const u32x4*)(rowc + C_XW + j0); cav[s] = *(const u32x4*)(rowc + C_XA + j0);
                pwv[s] = (u32x4){0u, 0u, 0u, 0u}; pav[s] = (u32x4){0u, 0u, 0u, 0u};
                if (hasprev) { pwv[s] = *(const u32x4*)(rowc - N0P + C_XW + j0); pav[s] = *(const u32x4*)(rowc - N0P + C_XA + j0); }
#pragma unroll
                for (int db = 0; db < 2; ++db) { bwv[s][db] = WLT[((0 * 4 + s) * 2 + db) * 64]; bav[s][db] = WLT[((1 * 4 + s) * 2 + db) * 64]; } }
#pragma unroll
            for (int s = 0; s < 4; ++s) {
                const int j0 = 16 * s + 8 * hi;
                float fcw[8], fpw[8], fca[8], fpa[8]; unpack8(cwv[s], fcw); unpack8(pwv[s], fpw); unpack8(cav[s], fca); unpack8(pav[s], fpa);
                const f32x4 mw0 = *(const f32x4*)(P.mu + 1536 + j0), mw1 = *(const f32x4*)(P.mu + 1536 + j0 + 4), ma0 = *(const f32x4*)(P.mu + 1600 + j0), ma1 = *(const f32x4*)(P.mu + 1600 + j0 + 4);
                float xw[8], xa[8];
#pragma unroll
                for (int e = 0; e < 8; ++e) { const float muw = e < 4 ? mw0[e & 3] : mw1[e & 3], mua = e < 4 ? ma0[e & 3] : ma1[e & 3];
                    xw[e] = tanh_f(fcw[e] + (fpw[e] - fcw[e]) * muw); xa[e] = fca[e] + (fpa[e] - fca[e]) * mua; }
                u32x4 aw, aa;
#pragma unroll
                for (int e = 0; e < 4; ++e) { aw[e] = pk2(xw[2 * e], xw[2 * e + 1]); aa[e] = pk2(xa[2 * e], xa[2 * e + 1]); }
#pragma unroll
                for (int db = 0; db < 2; ++db) {
                    accw[db] = MFMA32(__builtin_bit_cast(bf16x8, aw), __builtin_bit_cast(bf16x8, bwv[s][db]), accw[db]);
                    acca[db] = MFMA32(__builtin_bit_cast(bf16x8, aa), __builtin_bit_cast(bf16x8, bav[s][db]), acca[db]);
                }
            }
        }
        float kkd[2], kad[2], rkd[2], w0d[2], a0d[2], mur[2], muk[2], muv[2];
#pragma unroll
        for (int db = 0; db < 2; ++db) { const int hd = h * 64 + 2 * m + db; kkd[db] = P.k_k[hd]; kad[db] = P.k_a[hd]; rkd[db] = P.r_k[hd]; w0d[db] = P.w0[hd]; a0d[db] = P.a0[hd];
            mur[db] = P.mu[hd]; muk[db] = P.mu[512 + hd]; muv[db] = P.mu[1024 + hd]; }
        unsigned qr[16], qk[16], qv[16], qpr[4], qpk[4], qpv[4];
#pragma unroll
        for (int i = 0; i < 16; ++i) {
            int io = i; asm volatile("" : "+v"(io));
            const bf16* row = PROJ0 + (size_t)(tokw + crow(io, hi)) * N0P + h * 64 + 2 * m;
            qr[i] = *(const unsigned*)(row + C_RR); qk[i] = *(const unsigned*)(row + C_RK); qv[i] = *(const unsigned*)(row + C_RV);
            if ((i & 3) == 0) {
                qpr[i >> 2] = 0u; qpk[i >> 2] = 0u; qpv[i >> 2] = 0u;
                if (posw + crow(i, hi) > 0) { qpr[i >> 2] = *(const unsigned*)(row - N0P + C_RR); qpk[i >> 2] = *(const unsigned*)(row - N0P + C_RK); qpv[i >> 2] = *(const unsigned*)(row - N0P + C_RV); }
            }
        }
        float ee[2][16], Lc[2][16];
#pragma unroll
        for (int db = 0; db < 2; ++db) {
#pragma unroll
            for (int i = 0; i < 16; ++i) { const float wl = w0d[db] + accw[db][i]; ee[db][i] = __expf(-softplus_f(-wl) - 0.5f); }
            float gt[4], go[4];
#pragma unroll
            for (int g = 0; g < 4; ++g) { Lc[db][4 * g] = ee[db][4 * g]; Lc[db][4 * g + 1] = Lc[db][4 * g] + ee[db][4 * g + 1]; Lc[db][4 * g + 2] = Lc[db][4 * g + 1] + ee[db][4 * g + 2]; Lc[db][4 * g + 3] = Lc[db][4 * g + 2] + ee[db][4 * g + 3];
                gt[g] = Lc[db][4 * g + 3]; go[g] = __shfl_xor(gt[g], 32); }
            float run = 0.f;
#pragma unroll
            for (int g = 0; g < 4; ++g) { const float base = run + (hi ? go[g] : 0.f);
#pragma unroll
                for (int q = 0; q < 4; ++q) Lc[db][4 * g + q] += base;
                run += gt[g] + go[g]; }
            if (!(wave & 1) && hi == 0) TOT[c * 64 + 2 * m + db] = run;
        }
        __syncthreads();
        if (wave & 1) {
#pragma unroll
            for (int db = 0; db < 2; ++db) { const float tp = TOT[c * 64 + 2 * m + db];
#pragma unroll
                for (int i = 0; i < 16; ++i) Lc[db][i] += tp; }
        }
        float Lb[2][4];
#pragma unroll
        for (int db = 0; db < 2; ++db)
#pragma unroll
            for (int g = 0; g < 4; ++g) { Lb[db][g] = Lc[db][4 * g] - ee[db][4 * g]; asm volatile("" : "+v"(Lb[db][g])); }
        {
            float pv0 = 0.f, pv1 = 0.f;
#pragma unroll
            for (int i = 0; i < 16; ++i) {
                int io = i; asm volatile("" : "+v"(io));
                if ((i & 3) == 0) { pv0 = bflo(qpv[i >> 2]); pv1 = bfhi(qpv[i >> 2]); }
                const float c0 = bflo(qv[i]), c1 = bfhi(qv[i]);
                *(unsigned*)(VP + (size_t)(tokw + crow(io, hi)) * 512 + h * 64 + 2 * m) = pk2(c0 + (pv0 - c0) * muv[0], c1 + (pv1 - c1) * muv[1]);
                pv0 = c0; pv1 = c1;
            }
        }
        float pr[2] = {0.f, 0.f}, pk[2] = {0.f, 0.f}, pemL[2] = {1.f, 1.f};
#pragma unroll
        for (int i = 0; i < 16; ++i) {
            int io = i; asm volatile("" : "+v"(io));
            const int tau = crow(io, hi), tok = tokw + tau, t = tb + tau;
            if ((i & 3) == 0) { pr[0] = bflo(qpr[i >> 2]); pr[1] = bfhi(qpr[i >> 2]); pk[0] = bflo(qpk[i >> 2]); pk[1] = bfhi(qpk[i >> 2]); }
            float r[2], k[2], a[2], kk[2];
#pragma unroll
            for (int db = 0; db < 2; ++db) {
                const float cr = db ? bfhi(qr[i]) : bflo(qr[i]), ck = db ? bfhi(qk[i]) : bflo(qk[i]);
                r[db] = cr + (pr[db] - cr) * mur[db]; k[db] = ck + (pk[db] - ck) * muk[db];
                pr[db] = cr; pk[db] = ck;
                const float al = a0d[db] + acca[db][i];
                a[db] = __builtin_amdgcn_rcpf(1.f + __expf(-al));
                kk[db] = k[db] * kkd[db];
            }
            const float nrm = sqrtf(half_sum32(kk[0] * kk[0] + kk[1] * kk[1]));
            const float inv = __builtin_amdgcn_rcpf(fmaxf(nrm, 1e-12f));
            float k2[2];
#pragma unroll
            for (int db = 0; db < 2; ++db) k2[db] = k[db] * (1.f + (a[db] - 1.f) * kad[db]);
            const float bon = half_sum32(r[0] * k2[0] * rkd[0] + r[1] * k2[1] * rkd[1]);
#pragma unroll
            for (int db = 0; db < 2; ++db) {
                const int d = 2 * m + db; const float kkn = kk[db] * inv;
                float* o = scr + (size_t)((c * 64 + t) * 4) * 64 + (d & 15) * 4 + (d >> 4);
                const float eL = __expf(Lc[db][i]), emL = __builtin_amdgcn_rcpf(eL);
                const float wprev = (i & 3) ? pemL[db] : __expf(-Lb[db][i >> 2]); pemL[db] = emL;
                o[0] = -kkn * wprev;
                if (i == 15 && t == 63) o[64] = emL;
                o[128] = kkn * a[db] * eL;
                o[192] = r[db] * emL;
                KS[((2 * c + 1 - (c >> 1)) * 64 + t) * 65 + d] = k2[db] * eL;
            }
            if (m == 0) BON[(size_t)tok * 8 + h] = bon;
        }
    }
    __syncthreads();
    {
        const int c = wave >> 1, role = (wave ^ (wave >> 2)) & 1;
        const f32x4* xb = (const f32x4*)(scr + (size_t)c * 64 * 256) + (lane & 15);
        const LAS float* ksw = KS + wave * 64 * 65;
        float y[64];
        const int n = quad * 4 + c;
        bf16* mats = (bf16*)P.out + (size_t)(bh * 64 + n) * 4 * 4096;
        bf16* mstep = mats + role * 4096 + (role ? lane : kpos(lane));
#pragma unroll 1
        for (int rep2 = 0; rep2 < REP_S2; ++rep2) {
            int ln = lane; asm volatile("" : "+v"(ln));
#pragma unroll
            for (int d = 0; d < 64; ++d) y[d] = (role == 0 && d == ln) ? 1.f : 0.f;
            f32x4 XA[4], XB[4];
#pragma unroll
            for (int v = 0; v < 4; ++v) XA[v] = xb[v * 16];
            for (int t = 0; t < 64; t += 2) {
#pragma unroll
                for (int v = 0; v < 4; ++v) XB[v] = xb[(t + 1) * 64 + v * 16];
                rwkv_rstep(y, XA, t, role, lane, ksw, mstep);
                if (t + 2 < 64) {
#pragma unroll
                    for (int v = 0; v < 4; ++v) XA[v] = xb[(t + 2) * 64 + v * 16];
                }
                rwkv_rstep(y, XB, t + 1, role, lane, ksw, mstep);
            }
            RStep<0>::scale(y, XB[1]);
        }
        bf16* mend = mats + (role ? 2 : 3) * 4096 + (role ? lane : kpos(lane));
        LAS float* myr = KS + (wave * 64 + lane) * 65;
#pragma unroll
        for (int d = 0; d < 64; ++d) myr[d] = y[d];
#pragma unroll 1
        for (int d = 0; d < 64; ++d) mend[d * 64] = (bf16)f2bf(myr[d]);
    }
    __syncthreads();
}

DI void gla_prep_item(const Params& P, int item, LAS unsigned char* lds, int wave, int lane) {
    const int bh = item >> 6, n = item & 63, b = bh >> 2, h = bh & 3;
    const int tok0 = b * T + n * 64, hd = h * 64 + lane;
    const bf16* PROJ0 = (const bf16*)(P.ws + WS_PROJ0);
    LAS float* WT = (LAS float*)lds;
    LAS bf16* QEb = (LAS bf16*)(WT + 1024);
    LAS bf16* KEb = QEb + 64 * 72;
    LAS float* KL = (LAS float*)(KEb + 64 * 72);
    bf16* mats = (bf16*)(P.ws + WS_XN) + (size_t)(bh * 64 + n) * 3 * 4096;
    float* GDEC = (float*)(P.ws + WS_GDEC) + (size_t)(bh * 64 + n) * 64;
    float q8[8], k8[8]; u32x4 gl0[8], gl1[8];
#pragma unroll
    for (int i = 0; i < 8; ++i) { const bf16* row = PROJ0 + (size_t)(tok0 + wave * 8 + i) * N0P; q8[i] = bf2f(row[C_GQ + hd]) * 0.125f; k8[i] = bf2f(row[C_GK + hd]);
        gl0[i] = *(const u32x4*)(row + C_GLOW); gl1[i] = *(const u32x4*)(row + C_GLOW + 8); }
    float up[16];
#pragma unroll
    for (int r = 0; r < 16; ++r) up[r] = P.gk_up[r * 256 + hd];
    const float bias = P.gk_bias[hd];
    float bt[8]; float acc = 0.f;
#pragma unroll
    for (int i = 0; i < 8; ++i) { float xg = bias;
#pragma unroll
        for (int r = 0; r < 4; ++r) { xg = fmaf(bflo(gl0[i][r]), up[2 * r], xg); xg = fmaf(bfhi(gl0[i][r]), up[2 * r + 1], xg); }
#pragma unroll
        for (int r = 0; r < 4; ++r) { xg = fmaf(bflo(gl1[i][r]), up[8 + 2 * r], xg); xg = fmaf(bfhi(gl1[i][r]), up[8 + 2 * r + 1], xg); }
        acc += -softplus_f(-xg) * (1.f / 16.f); bt[i] = acc; }
    WT[wave * 64 + lane] = acc;
    if (wave == 4) WT[512 + lane] = bt[0];
    __syncthreads();
    float off = 0.f, off4 = 0.f, total = 0.f;
#pragma unroll
    for (int w2 = 0; w2 < 8; ++w2) { const float tv = WT[w2 * 64 + lane]; if (w2 < wave) off += tv; if (w2 < 4) off4 += tv; total += tv; }
    const float bref = off4 + WT[512 + lane], blast = total;
#pragma unroll
    for (int i = 0; i < 8; ++i) { const int t = wave * 8 + i; const float b_t = bt[i] + off;
        QEb[t * 72 + lane] = (bf16)f2bf(q8[i] * __expf(b_t - bref)); KEb[t * 72 + lane] = (bf16)f2bf(k8[i] * __expf(bref - b_t)); KL[t * 65 + lane] = k8[i] * __expf(blast - b_t);
        mats[t * 64 + kpos(lane)] = (bf16)f2bf(q8[i] * __expf(b_t)); }
    if (wave == 0) GDEC[lane] = __expf(blast);
    __syncthreads();
    if (wave < 4) {
        const int m = lane & 31, hi = lane >> 5, tb = wave >> 1, jb = wave & 1;
        f32x16 c;
#pragma unroll
        for (int r = 0; r < 16; ++r) c[r] = 0.f;
#pragma unroll
        for (int s = 0; s < 4; ++s) { const bf16x8 A = *(const LAS bf16x8*)(KEb + (32 * jb + m) * 72 + 16 * s + 8 * hi), Bq = *(const LAS bf16x8*)(QEb + (32 * tb + m) * 72 + 16 * s + 8 * hi); c = MFMA32(A, Bq, c); }
        const int t = 32 * tb + m;
#pragma unroll
        for (int g = 0; g < 4; ++g) { const int j0 = 32 * jb + 8 * g + 4 * hi; u32x2 w;
            w.x = pk2(j0 <= t ? c[4 * g] : 0.f, j0 + 1 <= t ? c[4 * g + 1] : 0.f); w.y = pk2(j0 + 2 <= t ? c[4 * g + 2] : 0.f, j0 + 3 <= t ? c[4 * g + 3] : 0.f);
            *(u32x2*)(mats + 4096 + t * 64 + j0) = w; }
    } else {
#pragma unroll
        for (int r = 0; r < 16; ++r) { const int d = (wave - 4) * 16 + r; mats[8192 + d * 64 + lane] = (bf16)f2bf(KL[lane * 65 + d]); }
    }
    __syncthreads();
}

constexpr int SQ_PITCH = 144, SQ_MAT = 64 * SQ_PITCH, SQ_VT = 4 * SQ_MAT, SQ_DEC = SQ_VT + 128 * SQ_PITCH, SQ_BUF = 57344;
template <bool DIAG>
DI void seq_pass(unsigned* prog, const bf16* mats, int nmat, const bf16* vsrc, int vpitch, const float* dec, bf16* outp, LAS unsigned char* lds, int tid, int wave, int lane) {
    const int m = lane & 31, hi = lane >> 5;
    f32x16 sacc[2];
#pragma unroll
    for (int i = 0; i < 16; ++i) { sacc[0][i] = 0.f; sacc[1][i] = 0.f; }
    const int st = tid - 256;
    struct StSet { u32x4 rm[8]; u32x4 rv[2]; float rdec; };
    const int v8 = st & 7, par = (st >> 3) & 1;
    constexpr int NMAT = DIAG ? 3 : 4;
    auto gload = [&](int n, StSet& S) {
        const bf16* mp = mats + (size_t)n * NMAT * 4096;
#pragma unroll
        for (int q = 0; q < 2 * NMAT; ++q) S.rm[q] = *(const u32x4*)(mp + (size_t)(st + 256 * q) * 8);
#pragma unroll
        for (int q = 0; q < 2; ++q) S.rv[q] = *(const u32x4*)(vsrc + (size_t)(n * 64 + (st >> 3) + 32 * q) * vpitch + 8 * v8);
        if (DIAG) S.rdec = dec[n * 64 + (st & 63)];
    };
    auto lstore = [&](int n, const StSet& S) {
        LAS unsigned char* B = lds + (n & 1) * SQ_BUF;
#pragma unroll
        for (int q = 0; q < 2 * NMAT; ++q) { const int idx = (st + 256 * q) & 511; *(LAS u32x4*)(B + (q >> 1) * SQ_MAT + (idx >> 3) * SQ_PITCH + (idx & 7) * 16) = S.rm[q]; }
#pragma unroll
        for (int q = 0; q < 2; ++q) {
            const int vt = (st >> 3) + 32 * q;
            const unsigned k0 = par ? S.rv[q][2] : S.rv[q][0], k1 = par ? S.rv[q][3] : S.rv[q][1], s0 = par ? S.rv[q][0] : S.rv[q][2], s1 = par ? S.rv[q][1] : S.rv[q][3];
            const unsigned r0 = (unsigned)__builtin_amdgcn_update_dpp(0, (int)s0, 0x128, 0xf, 0xf, true), r1 = (unsigned)__builtin_amdgcn_update_dpp(0, (int)s1, 0x128, 0xf, 0xf, true);
            unsigned o[4];
            if (par == 0) { o[0] = (k0 & 0xffffu) | (r0 << 16); o[1] = (k0 >> 16) | (r0 & 0xffff0000u); o[2] = (k1 & 0xffffu) | (r1 << 16); o[3] = (k1 >> 16) | (r1 & 0xffff0000u); }
            else          { o[0] = (r0 & 0xffffu) | (k0 << 16); o[1] = (r0 >> 16) | (k0 & 0xffff0000u); o[2] = (r1 & 0xffffu) | (k1 << 16); o[3] = (r1 >> 16) | (k1 & 0xffff0000u); }
            const int tp = vt >> 1, gsw = ((tp >> 2) ^ v8) & 7;
#pragma unroll
            for (int jj = 0; jj < 4; ++jj) *(LAS unsigned*)(B + SQ_VT + (8 * v8 + 4 * par + jj) * SQ_PITCH + (4 * gsw + (tp & 3)) * 4) = o[jj];
        }
        if (DIAG && st < 64) *(LAS float*)(B + SQ_DEC + st * 4) = S.rdec;
    };
    f32x16 o0, o1;
    bf16x8 sBp[2][2];
#pragma unroll
    for (int kb = 0; kb < 2; ++kb)
#pragma unroll
        for (int s = 0; s < 2; ++s) sBp[kb][s] = (bf16x8){0, 0, 0, 0, 0, 0, 0, 0};
    LAS unsigned char* SBX = lds + 2 * SQ_BUF;
    if (wave >= 2 && wave < 4) {
#pragma unroll
        for (int q = 0; q < 4; ++q) *(LAS bf16x8*)(SBX + (0 * 2 + (wave & 1)) * 4096 + lane * 64 + 16 * q) = sBp[q >> 1][q & 1];
    }
    auto compute = [&](int n, int bufi) {
        if (wave < 4) {
            const int vb = wave & 1; const bool upd = wave >= 2;
            const LAS unsigned char* B = lds + bufi * SQ_BUF;
            const int vrow = 32 * vb + m;
            const LAS unsigned char* Vr = B + SQ_VT + vrow * SQ_PITCH;
            const LAS unsigned char* Ar = B + m * SQ_PITCH + 16 * hi;
            bf16x8 Fa[2], Fb[2], Va, Vb;
#define SQ_LD(F, VB, k, MS, MV) do { if ((k) < 4) { const int co_ = (32 * ((k) >> 1) + 16 * ((k) & 1)) * 2; \
            F[0] = *(const LAS bf16x8*)(Ar + (MS) * SQ_MAT + co_); F[1] = *(const LAS bf16x8*)(Ar + (MS) * SQ_MAT + 32 * SQ_PITCH + co_); } \
        else { const int S4_ = (k) - 4, co_ = 32 * S4_; VB = *(const LAS bf16x8*)(Vr + (((2 * S4_ + hi) ^ (vrow >> 3)) & 7) * 16); \
            F[0] = *(const LAS bf16x8*)(Ar + (MV) * SQ_MAT + co_); F[1] = *(const LAS bf16x8*)(Ar + (MV) * SQ_MAT + 32 * SQ_PITCH + co_); } } while (0)
            if (!upd) {
                bf16x8 sB[2][2];
#pragma unroll
                for (int q = 0; q < 4; ++q) sB[q >> 1][q & 1] = *(const LAS bf16x8*)(SBX + ((n & 1) * 2 + vb) * 4096 + lane * 64 + 16 * q);
#pragma unroll
                for (int i = 0; i < 16; ++i) { o0[i] = 0.f; o1[i] = 0.f; }
#define SQ_MM(F, VB, k) do { const bf16x8 Bq_ = ((k) < 4) ? sB[(k) >> 1][(k) & 1] : VB; o0 = MFMA32(Bq_, F[0], o0); o1 = MFMA32(Bq_, F[1], o1); } while (0)
                SQ_LD(Fa, Va, 0, 0, 1); SQ_LD(Fb, Vb, 1, 0, 1);
                __builtin_amdgcn_sched_barrier(0);
                SQ_MM(Fa, Va, 0); SQ_LD(Fa, Va, 2, 0, 1); __builtin_amdgcn_sched_barrier(0);
                SQ_MM(Fb, Vb, 1); SQ_LD(Fb, Vb, 3, 0, 1); __builtin_amdgcn_sched_barrier(0);
                SQ_MM(Fa, Va, 2); SQ_LD(Fa, Va, 4, 0, 1); __builtin_amdgcn_sched_barrier(0);
                SQ_MM(Fb, Vb, 3); SQ_LD(Fb, Vb, 5, 0, 1); __builtin_amdgcn_sched_barrier(0);
                SQ_MM(Fa, Va, 4); SQ_LD(Fa, Va, 6, 0, 1); __builtin_amdgcn_sched_barrier(0);
                SQ_MM(Fb, Vb, 5); SQ_LD(Fb, Vb, 7, 0, 1); __builtin_amdgcn_sched_barrier(0);
                SQ_MM(Fa, Va, 6); SQ_MM(Fb, Vb, 7);
#undef SQ_MM
            } else {
                f32x16 n0, n1;
#pragma unroll
                for (int i = 0; i < 16; ++i) {
                    if (DIAG) { n0[i] = sacc[0][i] * *(const LAS float*)(B + SQ_DEC + crow(i, hi) * 4); n1[i] = sacc[1][i] * *(const LAS float*)(B + SQ_DEC + (32 + crow(i, hi)) * 4); }
                    else { n0[i] = 0.f; n1[i] = 0.f; } }
#define SQ_MM(F, VB, k) do { const bf16x8 Bq_ = ((k) < 4) ? sBp[(k) >> 1][(k) & 1] : VB; n0 = MFMA32(F[0], Bq_, n0); n1 = MFMA32(F[1], Bq_, n1); } while (0)
                if (!DIAG) {
                    SQ_LD(Fa, Va, 0, 3, 2); SQ_LD(Fb, Vb, 1, 3, 2);
                    __builtin_amdgcn_sched_barrier(0);
                    SQ_MM(Fa, Va, 0); SQ_LD(Fa, Va, 2, 3, 2); __builtin_amdgcn_sched_barrier(0);
                    SQ_MM(Fb, Vb, 1); SQ_LD(Fb, Vb, 3, 3, 2); __builtin_amdgcn_sched_barrier(0);
                    SQ_MM(Fa, Va, 2); SQ_LD(Fa, Va, 4, 3, 2); __builtin_amdgcn_sched_barrier(0);
                    SQ_MM(Fb, Vb, 3); SQ_LD(Fb, Vb, 5, 3, 2); __builtin_amdgcn_sched_barrier(0);
                } else {
                    SQ_LD(Fa, Va, 4, 3, 2); SQ_LD(Fb, Vb, 5, 3, 2);
                    __builtin_amdgcn_sched_barrier(0);
                }
                SQ_MM(Fa, Va, 4); SQ_LD(Fa, Va, 6, 3, 2); __builtin_amdgcn_sched_barrier(0);
                SQ_MM(Fb, Vb, 5); SQ_LD(Fb, Vb, 7, 3, 2); __builtin_amdgcn_sched_barrier(0);
                SQ_MM(Fa, Va, 6); SQ_MM(Fb, Vb, 7);
#undef SQ_MM
                sacc[0] = n0; sacc[1] = n1;
#pragma unroll
                for (int kb = 0; kb < 2; ++kb)
#pragma unroll
                    for (int s = 0; s < 2; ++s) { u32x4 w;
#pragma unroll
                        for (int e = 0; e < 4; ++e) w[e] = pk2(sacc[kb][8 * s + 2 * e], sacc[kb][8 * s + 2 * e + 1]);
                        sBp[kb][s] = __builtin_bit_cast(bf16x8, w);
                        *(LAS bf16x8*)(SBX + (((n + 1) & 1) * 2 + vb) * 4096 + lane * 64 + 16 * (2 * kb + s)) = sBp[kb][s]; }
            }
#undef SQ_LD
        }
    };
    auto store_out = [&](int n) {
        if (wave < 2) {
#pragma unroll
            for (int g = 0; g < 4; ++g) { bf16* op_ = outp + (size_t)(n * 64 + m) * 512 + 32 * wave + 8 * g + 4 * hi;
                u32x2 w0, w1; w0.x = pk2(o0[4 * g], o0[4 * g + 1]); w0.y = pk2(o0[4 * g + 2], o0[4 * g + 3]); w1.x = pk2(o1[4 * g], o1[4 * g + 1]); w1.y = pk2(o1[4 * g + 2], o1[4 * g + 3]);
                *(u32x2*)op_ = w0; *(u32x2*)(op_ + 32 * 512) = w1; }
        }
    };
    if (wave < 4) {
        lds_barrier();
#pragma unroll 1
        for (int n = 0; n < 64; ++n) { compute(n, n & 1); store_out(n); lds_barrier(); }
    } else {
        StSet A, Bs, C;
        gload(0, A); gload(1, Bs); gload(2, C);
        lstore(0, A); gload(3, A);
        lds_barrier();
#pragma unroll 1
        for (int k = 0; k < 60; k += 3) {
            if (st == 0) __hip_atomic_store(prog, (unsigned)(k + 4), __ATOMIC_RELAXED, __HIP_MEMORY_SCOPE_AGENT);
            lstore(k + 1, Bs); gload(k + 4, Bs); lds_barrier();
            lstore(k + 2, C); gload(k + 5, C); lds_barrier();
            lstore(k + 3, A); gload(k + 6, A); lds_barrier();
        }
        lstore(61, Bs); lds_barrier();
        lstore(62, C); lds_barrier();
        lstore(63, A); lds_barrier();
        lds_barrier();
    }
}
struct P3Src { const bf16* mats; int nmat; const bf16* vsrc; int vpitch; const float* dec; bf16* outp; };
DI P3Src p3_src(const Params& P, int bx) {
    P3Src s;
    if (bx < 32) { const int b = bx >> 3, h = bx & 7;
        s.mats = (const bf16*)P.out + (size_t)bx * 64 * 4 * 4096; s.nmat = 4; s.vsrc = (const bf16*)(P.ws + WS_VP) + (size_t)b * T * 512 + h * 64; s.vpitch = 512; s.dec = nullptr;
        s.outp = (bf16*)(P.ws + WS_SCR) + (size_t)b * T * 512 + h * 64; }
    else { const int g = bx - 32, bh = (g & 7) | ((g >> 4) << 3), vh = (g >> 3) & 1, b = bh >> 2, h = bh & 3;
        s.mats = (const bf16*)(P.ws + WS_XN) + (size_t)bh * 64 * 3 * 4096; s.nmat = 3; s.vsrc = (const bf16*)(P.ws + WS_PROJ0) + (size_t)b * T * N0P + C_GV + h * 128 + 64 * vh; s.vpitch = N0P;
        s.dec = (const float*)(P.ws + WS_GDEC) + (size_t)bh * 64 * 64; s.outp = (bf16*)(P.ws + WS_OARAW) + (size_t)b * T * 512 + h * 128 + 64 * vh; }
    return s;
}
DI void p3_seq(const Params& P, LAS unsigned char* lds, int tid, int wave, int lane) {
    const int bx = blockIdx.x;
    unsigned* progw = (unsigned*)(P.ws + WS_PROG);
    if (bx < 64) {
        const P3Src s = p3_src(P, bx);
        if (bx < 32) seq_pass<false>(progw + 16 * bx, s.mats, 4, s.vsrc, s.vpitch, nullptr, s.outp, lds, tid, wave, lane);
        else         seq_pass<true>(progw + 16 * bx, s.mats, 3, s.vsrc, s.vpitch, s.dec, s.outp, lds, tid, wave, lane);
    } else {
        const unsigned* xt = (const unsigned*)(P.ws + WS_XCCTAB);
        LAS unsigned* hs = (LAS unsigned*)lds;
        if (tid < 4) hs[tid] = 0u;
        __syncthreads();
        const unsigned myx = xt[bx];
        if (tid < 192) { const unsigned o = xt[64 + tid]; if (o == myx) { __hip_atomic_fetch_add(&hs[2], 1u, __ATOMIC_RELAXED, __HIP_MEMORY_SCOPE_WORKGROUP); if (64 + tid < bx) __hip_atomic_fetch_add(&hs[0], 1u, __ATOMIC_RELAXED, __HIP_MEMORY_SCOPE_WORKGROUP); } }
        if (tid >= 192 && tid < 256) { if (xt[tid - 192] == myx) { const unsigned slot = __hip_atomic_fetch_add(&hs[1], 1u, __ATOMIC_RELAXED, __HIP_MEMORY_SCOPE_WORKGROUP); hs[8 + slot] = (unsigned)(tid - 192); } }
        __syncthreads();
        const int rank = (int)hs[0], np = (int)hs[1], nh = (int)hs[2];
        unsigned pf0 = 0u;
        if (np > 0) {
            const int tgt = (int)hs[8 + (rank % np)];
            const int sub = rank / np, cnt = (nh - (rank % np) + np - 1) / np;
            const P3Src s = p3_src(P, tgt);
            const unsigned* pw = progw + 16 * tgt;
            const int nlm = s.nmat * 64;
            int pc = sub; unsigned spins = 0;
            while (pc < 64) {
                const int p = (int)__builtin_amdgcn_readfirstlane((int)__hip_atomic_load(pw, __ATOMIC_RELAXED, __HIP_MEMORY_SCOPE_AGENT));
                if (pc <= p + 8) {
                    const char* a = nullptr;
                    if (tid < nlm) a = (const char*)(s.mats + (size_t)pc * s.nmat * 4096) + (size_t)tid * 128;
                    else if (tid < nlm + 64) a = (const char*)(s.vsrc + (size_t)(pc * 64 + (tid - nlm)) * s.vpitch);
                    if (a) asm volatile("global_load_dword %0, %1, off" : "+v"(pf0) : "v"(a) : "memory");
                    pc += cnt;
                } else { __builtin_amdgcn_s_sleep(8); if (++spins > (1u << 16)) break; }
            }
        }
        asm volatile("s_waitcnt vmcnt(0)" : "+v"(pf0) :: "memory");
        __syncthreads();
    }
}

DI float silu_f(float g) { return g / (1.f + __expf(-g)); }
DI void p4_finalize(const Params& P, int wave, int lane) {
    const int gw = blockIdx.x * 8 + wave, NGW = gridDim.x * 8;
    const bf16* OB = (const bf16*)(P.ws + WS_SCR); const bf16* OA = (const bf16*)(P.ws + WS_OARAW);
    const bf16* PROJ0 = (const bf16*)(P.ws + WS_PROJ0); const bf16* VP = (const bf16*)(P.ws + WS_VP); const float* BON = (const float*)(P.ws + WS_BONUS);
    bf16* O0 = (bf16*)(P.ws + WS_XN);
    const int cv = (8 * lane) & 127;
    const f32x4 gw0 = *(const f32x4*)(P.gla_norm_w + cv), gw1 = *(const f32x4*)(P.gla_norm_w + cv + 4);
    const f32x4 lw0 = *(const f32x4*)(P.ln_w + 8 * lane), lw1 = *(const f32x4*)(P.ln_w + 8 * lane + 4), lb0 = *(const f32x4*)(P.ln_b + 8 * lane), lb1 = *(const f32x4*)(P.ln_b + 8 * lane + 4);
    struct Ld { f32x4 a0, a1, b0, b1; u32x4 ga, gb, vv; float bon; };
    auto load = [&](int tok) { Ld L; const bf16* row = PROJ0 + (size_t)tok * N0P + C_GATE0;
        { const u32x4 wa = *(const u32x4*)(OA + (size_t)tok * 512 + 8 * lane), wb = *(const u32x4*)(OB + (size_t)tok * 512 + 8 * lane);
          L.a0 = (f32x4){bflo(wa.x), bfhi(wa.x), bflo(wa.y), bfhi(wa.y)}; L.a1 = (f32x4){bflo(wa.z), bfhi(wa.z), bflo(wa.w), bfhi(wa.w)};
          L.b0 = (f32x4){bflo(wb.x), bfhi(wb.x), bflo(wb.y), bfhi(wb.y)}; L.b1 = (f32x4){bflo(wb.z), bfhi(wb.z), bflo(wb.w), bfhi(wb.w)}; }
        L.ga = *(const u32x4*)(row + 8 * lane); L.gb = *(const u32x4*)(row + 512 + 8 * lane); L.vv = *(const u32x4*)(VP + (size_t)tok * 512 + 8 * lane); L.bon = BON[(size_t)tok * 8 + (lane >> 3)]; return L; };
    Ld nx = load(gw < M ? gw : 0);
    for (int tok = gw; tok < M; tok += NGW) {
        const Ld L = nx;
        if (tok + NGW < M) nx = load(tok + NGW);
        {
            const f32x4 a0 = L.a0, a1 = L.a1;
            float ss = (a0[0] * a0[0] + a0[1] * a0[1]) + (a0[2] * a0[2] + a0[3] * a0[3]) + (a1[0] * a1[0] + a1[1] * a1[1]) + (a1[2] * a1[2] + a1[3] * a1[3]);
            ss += __shfl_xor(ss, 1); ss += __shfl_xor(ss, 2); ss += __shfl_xor(ss, 4); ss += __shfl_xor(ss, 8);
            const float rstd = 1.0f / sqrtf(ss * (1.f / 128.f) + NORM_EPS);
            const u32x4 g = L.ga;
            u32x4 o;
            o.x = pk2(a0[0] * rstd * gw0[0] * silu_f(bflo(g.x)), a0[1] * rstd * gw0[1] * silu_f(bfhi(g.x)));
            o.y = pk2(a0[2] * rstd * gw0[2] * silu_f(bflo(g.y)), a0[3] * rstd * gw0[3] * silu_f(bfhi(g.y)));
            o.z = pk2(a1[0] * rstd * gw1[0] * silu_f(bflo(g.z)), a1[1] * rstd * gw1[1] * silu_f(bfhi(g.z)));
            o.w = pk2(a1[2] * rstd * gw1[2] * silu_f(bflo(g.w)), a1[3] * rstd * gw1[3] * silu_f(bfhi(g.w)));
            *(u32x4*)(O0 + (size_t)tok * 1024 + 8 * lane) = o;
        }
        {
            const f32x4 a0 = L.b0, a1 = L.b1;
            float s = (a0[0] + a0[1]) + (a0[2] + a0[3]) + (a1[0] + a1[1]) + (a1[2] + a1[3]);
            s += __shfl_xor(s, 1); s += __shfl_xor(s, 2); s += __shfl_xor(s, 4);
            const float mean = s * (1.f / 64.f);
            const f32x4 d0 = a0 - mean, d1 = a1 - mean;
            float q = (d0[0] * d0[0] + d0[1] * d0[1]) + (d0[2] * d0[2] + d0[3] * d0[3]) + (d1[0] * d1[0] + d1[1] * d1[1]) + (d1[2] * d1[2] + d1[3] * d1[3]);
            q += __shfl_xor(q, 1); q += __shfl_xor(q, 2); q += __shfl_xor(q, 4);
            const float rstd = 1.0f / sqrtf(q * (1.f / 64.f) + RWKV_LN_EPS);
            const float bon = L.bon; const u32x4 vv = L.vv, g = L.gb;
            u32x4 o;
            o.x = pk2((d0[0] * rstd * lw0[0] + lb0[0] + bon * bflo(vv.x)) * silu_f(bflo(g.x)), (d0[1] * rstd * lw0[1] + lb0[1] + bon * bfhi(vv.x)) * silu_f(bfhi(g.x)));
            o.y = pk2((d0[2] * rstd * lw0[2] + lb0[2] + bon * bflo(vv.y)) * silu_f(bflo(g.y)), (d0[3] * rstd * lw0[3] + lb0[3] + bon * bfhi(vv.y)) * silu_f(bfhi(g.y)));
            o.z = pk2((d1[0] * rstd * lw1[0] + lb1[0] + bon * bflo(vv.z)) * silu_f(bflo(g.z)), (d1[1] * rstd * lw1[1] + lb1[1] + bon * bfhi(vv.z)) * silu_f(bfhi(g.z)));
            o.w = pk2((d1[2] * rstd * lw1[2] + lb1[2] + bon * bflo(vv.w)) * silu_f(bflo(g.w)), (d1[3] * rstd * lw1[3] + lb1[3] + bon * bfhi(vv.w)) * silu_f(bfhi(g.w)));
            *(u32x4*)(O0 + (size_t)tok * 1024 + 512 + 8 * lane) = o;
        }
    }
}
constexpr int AT_KP = 144, AT_VP = 528, AT_VOFF = 256 * AT_KP;
DI void rope_cs(const float* RT, int pos, float (&cs)[8], float (&sn)[8]) {
    const f32x4* tp = (const f32x4*)(RT + (size_t)pos * 16);
#pragma unroll
    for (int q = 0; q < 4; ++q) { const f32x4 v = tp[q]; cs[2 * q] = v[0]; sn[2 * q] = v[1]; cs[2 * q + 1] = v[2]; sn[2 * q + 1] = v[3]; }
}
DI void p7_attn(const Params& P, LAS unsigned char* lds, int tid, int wave, int lane) {
    const bf16* PROJ1 = (const bf16*)(P.ws + WS_SCR); bf16* O1 = (bf16*)(P.ws + WS_XN); const float* RT = (const float*)(P.ws + WS_ROPE);
    const int m = lane & 31, hi = lane >> 5;
    const int c8 = tid & 7, kpar = (tid >> 3) & 1;
    u32x4 kw[4], vw[4];
    auto uload = [&](int unit) {
        const int qb = unit & 31, kvh = (unit >> 5) & 3, b = unit >> 7;
#pragma unroll
        for (int q = 0; q < 4; ++q) { const int key = (tid >> 3) + 64 * q; const int pos = qb * 128 - 128 + key;
            kw[q] = (u32x4){0u, 0u, 0u, 0u}; vw[q] = (u32x4){0u, 0u, 0u, 0u};
            if (pos >= 0) { const bf16* row = PROJ1 + (size_t)(b * T + pos) * IN1; kw[q] = *(const u32x4*)(row + 1024 + kvh * 64 + 8 * c8); vw[q] = *(const u32x4*)(row + 1280 + kvh * 64 + 8 * c8); } }
    };
    if ((int)blockIdx.x < 512) uload(blockIdx.x);
    struct QG { u32x4 q[4], qo; u32x2 g[8]; };
    auto qgload = [&](int unit, int qq) { QG r; const int qb = unit & 31, kvh = (unit >> 5) & 3, b = unit >> 7; const int h = kvh * 4 + (wave >> 1);
        const int pos = qb * 128 + (wave & 1) * 64 + 32 * qq + m; const bf16* row = PROJ1 + ((size_t)b * T + pos) * IN1;
#pragma unroll
        for (int s = 0; s < 4; ++s) r.q[s] = *(const u32x4*)(row + h * 64 + 16 * s + 8 * hi);
        r.qo = *(const u32x4*)(row + h * 64 + 8 * (hi ^ 1));
#pragma unroll
        for (int db = 0; db < 2; ++db)
#pragma unroll
            for (int gq = 0; gq < 4; ++gq) r.g[4 * db + gq] = *(const u32x2*)(row + 1536 + h * 64 + 32 * db + 8 * gq + 4 * hi);
        return r; };
    QG nxq = qgload((int)blockIdx.x < 512 ? blockIdx.x : 0, 0);
    for (int unit = blockIdx.x; unit < 512; unit += gridDim.x) {
        const int qb = unit & 31, kvh = (unit >> 5) & 3, b = unit >> 7;
#pragma unroll
        for (int q = 0; q < 4; ++q) {
            const int key = (tid >> 3) + 64 * q; const int pos = qb * 128 - 128 + key;
            u32x4 kq = kw[q];
            if (c8 < 2 && pos >= 0) { const bf16* row = PROJ1 + (size_t)(b * T + pos) * IN1;
                const u32x4 ow = *(const u32x4*)(row + 1024 + kvh * 64 + 8 * (c8 ^ 1)); float a[8], o[8], cs[8], sn[8]; unpack8(kq, a); unpack8(ow, o); rope_cs(RT, pos, cs, sn);
                float r[8];
#pragma unroll
                for (int j = 0; j < 8; ++j) r[j] = (c8 == 0) ? (a[j] * cs[j] - o[j] * sn[j]) : (a[j] * cs[j] + o[j] * sn[j]);
                kq.x = pk2(r[0], r[1]); kq.y = pk2(r[2], r[3]); kq.z = pk2(r[4], r[5]); kq.w = pk2(r[6], r[7]); }
            *(LAS u32x4*)(lds + key * AT_KP + c8 * 16) = kq;
            const u32x4 rv = vw[q];
            const unsigned k0 = kpar ? rv[2] : rv[0], k1 = kpar ? rv[3] : rv[1], s0 = kpar ? rv[0] : rv[2], s1 = kpar ? rv[1] : rv[3];
            const unsigned r0 = (unsigned)__builtin_amdgcn_update_dpp(0, (int)s0, 0x128, 0xf, 0xf, true), r1 = (unsigned)__builtin_amdgcn_update_dpp(0, (int)s1, 0x128, 0xf, 0xf, true);
            unsigned o4[4];
            if (kpar == 0) { o4[0] = (k0 & 0xffffu) | (r0 << 16); o4[1] = (k0 >> 16) | (r0 & 0xffff0000u); o4[2] = (k1 & 0xffffu) | (r1 << 16); o4[3] = (k1 >> 16) | (r1 & 0xffff0000u); }
            else           { o4[0] = (r0 & 0xffffu) | (k0 << 16); o4[1] = (r0 >> 16) | (k0 & 0xffff0000u); o4[2] = (r1 & 0xffffu) | (k1 << 16); o4[3] = (r1 >> 16) | (k1 & 0xffff0000u); }
            const int tp = key >> 1, gsw = (tp >> 2) ^ c8;
#pragma unroll
            for (int jj = 0; jj < 4; ++jj) *(LAS unsigned*)(lds + AT_VOFF + (8 * c8 + 4 * kpar + jj) * AT_VP + (4 * gsw + (tp & 3)) * 4) = o4[jj];
        }
        lds_barrier();
        if (unit + (int)gridDim.x < 512) uload(unit + gridDim.x);
        const int g = wave >> 1, h = kvh * 4 + g; const float sink = P.sinks[h];
        for (int qq = 0; qq < 2; ++qq) {
            const int qs = (wave & 1) * 64 + 32 * qq, qi = qs + m, pos = qb * 128 + qi; const size_t tok = (size_t)b * T + pos;
            const QG cq = nxq;
            { const int nu = (qq == 0) ? unit : unit + (int)gridDim.x; if (nu < 512) nxq = qgload(nu, qq ^ 1); }
            bf16x8 Q[4];
#pragma unroll
            for (int s = 0; s < 4; ++s) { const u32x4 w = cq.q[s]; float a[8]; unpack8(w, a);
                if (s == 0) { const u32x4 ow = cq.qo; float o[8], cs[8], sn[8]; unpack8(ow, o); rope_cs(RT, pos, cs, sn);
#pragma unroll
                    for (int j = 0; j < 8; ++j) a[j] = (hi == 0) ? (a[j] * cs[j] - o[j] * sn[j]) : (a[j] * cs[j] + o[j] * sn[j]); }
                u32x4 qw;
#pragma unroll
                for (int e = 0; e < 4; ++e) qw[e] = pk2(a[2 * e] * 0.125f, a[2 * e + 1] * 0.125f);
                Q[s] = __builtin_bit_cast(bf16x8, qw); }
            const int kb0 = qs >> 5;
            f32x16 sc[5];
#pragma unroll
            for (int kbi = 0; kbi < 5; ++kbi) {
#pragma unroll
                for (int i = 0; i < 16; ++i) sc[kbi][i] = 0.f;
#pragma unroll
                for (int s = 0; s < 4; ++s) { const bf16x8 A = *(const LAS bf16x8*)(lds + (32 * (kb0 + kbi) + m) * AT_KP + (16 * s + 8 * hi) * 2); sc[kbi] = MFMA32(A, Q[s], sc[kbi]); }
            }
            float mx = sink;
#pragma unroll
            for (int kbi = 0; kbi < 5; ++kbi)
#pragma unroll
                for (int i = 0; i < 16; ++i) { const int kj = 32 * (kb0 + kbi) + crow(i, hi);
                    const bool band = (kbi == 0) ? (kj >= qi + 1) : ((kbi == 4) ? (kj <= qi + 128) : true); const bool vis = band && (qb > 0 || kj >= 128);
                    sc[kbi][i] = vis ? sc[kbi][i] : -1e30f; mx = fmaxf(mx, sc[kbi][i]); }
            mx = fmaxf(mx, __shfl_xor(mx, 32));
            float sum = 0.f;
#pragma unroll
            for (int kbi = 0; kbi < 5; ++kbi)
#pragma unroll
                for (int i = 0; i < 16; ++i) { const float pv = __expf(sc[kbi][i] - mx); sc[kbi][i] = pv; sum += pv; }
            sum += __shfl_xor(sum, 32);
            const float inv = 1.f / (sum + __expf(sink - mx));
            f32x16 oacc[2];
#pragma unroll
            for (int db = 0; db < 2; ++db) {
#pragma unroll
                for (int i = 0; i < 16; ++i) oacc[db][i] = 0.f;
                const int vrow = 32 * db + m, rsw = (vrow >> 3) & 7;
#pragma unroll
                for (int kbi = 0; kbi < 5; ++kbi)
#pragma unroll
                    for (int s2 = 0; s2 < 2; ++s2) { u32x4 pw;
#pragma unroll
                        for (int e = 0; e < 4; ++e) pw[e] = pk2(sc[kbi][8 * s2 + 2 * e], sc[kbi][8 * s2 + 2 * e + 1]);
                        const int ga = 4 * (kb0 + kbi) + 2 * s2;
                        const LAS unsigned char* vp = lds + AT_VOFF + vrow * AT_VP + 8 * hi;
                        const u32x2 lo = *(const LAS u32x2*)(vp + (ga ^ rsw) * 16), hi2 = *(const LAS u32x2*)(vp + ((ga + 1) ^ rsw) * 16);
                        const u32x4 aw = (u32x4){lo.x, lo.y, hi2.x, hi2.y};
                        oacc[db] = MFMA32(__builtin_bit_cast(bf16x8, aw), __builtin_bit_cast(bf16x8, pw), oacc[db]); }
            }
#pragma unroll
            for (int db = 0; db < 2; ++db)
#pragma unroll
                for (int gq = 0; gq < 4; ++gq) { const int d0 = 32 * db + 8 * gq + 4 * hi; const u32x2 gw = cq.g[4 * db + gq];
                    u32x2 o; o.x = pk2(oacc[db][4 * gq] * inv * silu_f(bflo(gw.x)), oacc[db][4 * gq + 1] * inv * silu_f(bfhi(gw.x)));
                    o.y = pk2(oacc[db][4 * gq + 2] * inv * silu_f(bflo(gw.y)), oacc[db][4 * gq + 3] * inv * silu_f(bfhi(gw.y)));
                    *(u32x2*)(O1 + tok * 1024 + h * 64 + d0) = o; }
        }
        lds_barrier();
    }
}
DI void p9_final(const Params& P, int wave, int lane) {
    const int gw = blockIdx.x * 8 + wave, NGW = gridDim.x * 8;
    const float* slots = (const float*)(P.ws + WS_SLOT2);
    for (int mrow = gw; mrow < M; mrow += NGW) {
        float s = (lane < 16) ? slots[(size_t)mrow * 16 + lane] : 0.f;
        s += __shfl_xor(s, 1); s += __shfl_xor(s, 2); s += __shfl_xor(s, 4); s += __shfl_xor(s, 8);
        s = __shfl(s, 0);
        const float rstd = 1.0f / sqrtf(s * (1.f / 1024.f) + NORM_EPS);
        f32x4* o = (f32x4*)(P.out + (size_t)mrow * D) + lane; const f32x4* w = (const f32x4*)P.final_w + lane;
#pragma unroll
        for (int j = 0; j < 4; ++j) { const f32x4 v = o[64 * j]; o[64 * j] = v * rstd * w[64 * j]; }
    }
}

__global__ void __launch_bounds__(512) fwd_megakernel(Params P) {
    extern __shared__ __attribute__((aligned(16))) unsigned char lds_raw[];
    LAS unsigned char* lds = (LAS unsigned char*)lds_raw;
    cg::grid_group grid = cg::this_grid();
    const int tid = threadIdx.x, lane = tid & 63, wave = __builtin_amdgcn_readfirstlane(tid >> 6);
    const int G = gridDim.x;
    if (tid < 2) ((LAS unsigned*)(lds + LDS_BAR_OFF))[tid] = 0u;
    __syncthreads();
    if (tid == 0) ((unsigned*)(P.ws + WS_XCCTAB))[blockIdx.x] = xb_xcc_id() + 1u;
    const XcdBarrier xbar = xcd_barrier_post((unsigned*)(P.ws + WS_CTL), (volatile LAS unsigned*)(lds + LDS_BAR_OFF));
    bf16* XN = (bf16*)(P.ws + WS_XN);
    p0_prologue(P, lds, wave, lane);
    if (P.ws == nullptr) grid.sync();
    xcd_barrier(xbar);
    { pg8::Gemm g{XN, (const bf16*)(P.ws + WS_W0T), M, N0P, D}; pg8::StaticOrder S; S.init(M, N0P, G, (int)blockIdx.x);
      EpiScaleBf16 E{(bf16*)(P.ws + WS_PROJ0), N0P, nullptr, nullptr, 0};
      pg8::gemm_phase<EpiScaleBf16, pg8::StaticOrder, true, true>(lds, g, S, E); }
    xcd_barrier(xbar);
#pragma unroll 1
    for (int rep = 0; rep < REP_P2R; ++rep) { for (int it = blockIdx.x; it < 512; it += G) rwkv_prep_item(P, it, lds, wave, lane); }
#pragma unroll 1
    for (int rep = 0; rep < REP_P2G; ++rep) { for (int it = blockIdx.x; it < 1024; it += G) gla_prep_item(P, it, lds, wave, lane); }
    xcd_barrier(xbar);
#pragma unroll 1
    for (int rep = 0; rep < REP_P3; ++rep) { p3_seq(P, lds, tid, wave, lane); __syncthreads(); }
    xcd_barrier(xbar);
    p4_finalize(P, wave, lane);
    xcd_barrier(xbar);
    { pg8::Gemm g{XN, (const bf16*)(P.ws + WS_WO0T), M, D, D}; pg8::StaticOrder S; S.init(M, D, G, (int)blockIdx.x);
      EpiResid E{P.x, (bf16*)(P.ws + WS_H1B), (float*)(P.ws + WS_SLOT1)};
      pg8::gemm_phase<EpiResid, pg8::StaticOrder, true, true>(lds, g, S, E); }
    xcd_barrier(xbar);
    { pg8::Gemm g{(const bf16*)(P.ws + WS_H1B), (const bf16*)(P.ws + WS_W1T), M, IN1, D}; pg8::StaticOrder S; S.init(M, IN1, G, (int)blockIdx.x);
      EpiScaleBf16 E{(bf16*)(P.ws + WS_SCR), IN1, (const float*)(P.ws + WS_SLOT1), P.b_in1, 1536};
      pg8::gemm_phase<EpiScaleBf16, pg8::StaticOrder, true, true>(lds, g, S, E); }
    xcd_barrier(xbar);
    p7_attn(P, lds, tid, wave, lane);
    xcd_barrier(xbar);
    { pg8::Gemm g{XN, (const bf16*)(P.ws + WS_WO1T), M, D, D}; pg8::StaticOrder S; S.init(M, D, G, (int)blockIdx.x);
      EpiResidNorm E{(const bf16*)(P.ws + WS_H1B), P.out, P.b_out1, P.final_w, (float*)(P.ws + WS_SLOT2), (unsigned*)(P.ws + WS_PCNT)};
      pg8::gemm_phase<EpiResidNorm, pg8::StaticOrder, false, true>(lds, g, S, E); }
}

extern "C" void kernel_launch(void* const* d_in, const int* in_sizes, int n_in, void* d_out, int out_size, void* d_ws, size_t ws_size, hipStream_t stream) {
    static int grid = 0;
    if (grid == 0) {
        if (n_in != 23 || out_size != M * D || ws_size < WS_END) { fprintf(stderr, "kernel_launch: unexpected sizes n_in %d out %d ws %zu\n", n_in, out_size, ws_size); grid = -1; return; }
        int dev = 0, cus = 0, per_cu = 0;
        hipGetDevice(&dev); hipDeviceGetAttribute(&cus, hipDeviceAttributeMultiprocessorCount, dev);
        hipFuncSetAttribute((const void*)fwd_megakernel, hipFuncAttributeMaxDynamicSharedMemorySize, LDS_BYTES);
        hipOccupancyMaxActiveBlocksPerMultiprocessor(&per_cu, (const void*)fwd_megakernel, 512, LDS_BYTES);
        if (per_cu < 1) { fprintf(stderr, "kernel_launch: occupancy query says %d blocks/CU\n", per_cu); per_cu = 1; }
        grid = cus * 1;
        if (grid != 256) { fprintf(stderr, "kernel_launch: built for a 256-CU device (got %d)\n", cus); grid = -1; return; }
        (void)hipGetLastError();
    }
    if (grid < 0) return;
    Params p{};
    const float** pp = (const float**)&p;
    for (int i = 0; i < 23; ++i) pp[i] = (const float*)d_in[i];
    p.out = (float*)d_out; p.ws = (unsigned char*)d_ws;
    if (hipMemsetAsync((char*)d_ws + WS_CTL, 0, CTL_BYTES, stream) != hipSuccess) { fprintf(stderr, "memset failed\n"); return; }
    void* args[] = {&p};
    hipError_t e = hipLaunchCooperativeKernel((const void*)fwd_megakernel, dim3(grid), dim3(512), args, LDS_BYTES, stream);
    if (e != hipSuccess) fprintf(stderr, "cooperative launch failed: %s (grid %d)\n", hipGetErrorString(e), grid);
}
```

```cpp
#include <hip/hip_runtime.h>
#include <hip/hip_cooperative_groups.h>
#include <cstdio>
#include <cstdint>
namespace cg = cooperative_groups;
#ifndef REP_P2R
#define REP_P2R 1
#endif
#ifndef REP_P2G
#define REP_P2G 1
#endif
#ifndef REP_S2
#define REP_S2 1
#endif
#ifndef REP_P3
#define REP_P3 1
#endif
namespace pg8 {
#define PG8_LAS __attribute__((address_space(3)))
typedef unsigned short bf16_t;
typedef short bf16x8 __attribute__((ext_vector_type(8)));
typedef float f32x4 __attribute__((ext_vector_type(4)));
typedef unsigned u32x4 __attribute__((ext_vector_type(4)));
constexpr int BM = 256, BK = 64, HALF = 128, HTB = HALF * BK * 2  , STAGE_BYTES = 8 * HTB, NXCD = 8, WGM = 8;

__host__ __device__ __forceinline__ int lds_byte(int r, int c) { const int st = (r >> 4) * 2 + (c >> 5), rr = r & 15, cc = c & 31, ob = rr * 64 + cc * 2; return st * 1024 + (ob ^ (((ob >> 9) & 1) << 5)); }
__host__ __device__ __forceinline__ void stage_rc(int b, int& R, int& C) { const int st = b / 1024, sb = b % 1024, swz = sb ^ (((sb >> 9) & 1) << 5); R = (st >> 1) * 16 + swz / 64; C = (st & 1) * 32 + (swz % 64) / 2; }
__host__ __device__ __forceinline__ int perm32(int rho) { const int n = rho >> 4, i = rho & 15; return 8 * (i >> 2) + 4 * n + (i & 3); }

struct Unit { int pm, pn; };
struct Gemm { const bf16_t* A; const bf16_t* Bt; int M, N, K; };

struct StaticOrder {
    int nM, nN, nwg, G, c;
    __host__ __device__ void init(int M, int N, int G_, int c_) { nM = M / BM; nN = N / BM; nwg = nM * nN; G = G_; c = c_; }
    __host__ __device__ bool next(int i, Unit& u) const {
        const long L = (long)i * G + c; if (L >= nwg) return false;
        int wgid = (int)L; { const int q = nwg / NXCD, r = nwg % NXCD, xcd = wgid % NXCD, off = wgid / NXCD; wgid = (xcd < r ? xcd * (q + 1) : r * (q + 1) + (xcd - r) * q) + off; }
        const int nig = WGM * nN, gid = wgid / nig, fm = gid * WGM, gsz = (nM - fm) < WGM ? (nM - fm) : WGM;
        u.pm = fm + ((wgid % nig) % gsz); u.pn = (wgid % nig) / gsz; return true;
    }
    __device__ __forceinline__ void a_ready(const Unit&) const {}
    __device__ __forceinline__ void done(const Unit&) const {}
};

template <class Epi, class Sched, bool ALIGN_EPI = false, bool SP2 = false>
__device__ __forceinline__ void gemm_phase(PG8_LAS unsigned char* lds, const Gemm g, const Sched& S, const Epi& E) {
    const int tid = threadIdx.x, wid = __builtin_amdgcn_readfirstlane(tid >> 6), lane = tid & 63, wr = wid >> 2, wc = wid & 3, fr = lane & 15, fq = lane >> 4;
    const int K = g.K, nt = K / BK;
    unsigned voffA[2], voffB[2];
#pragma unroll
    for (int i = 0; i < 2; ++i) { int R, C; stage_rc(tid * 16 + i * 8192, R, C); const int Rb = Epi::PERM ? ((R & ~31) + perm32(R & 31)) : R;
        voffA[i] = (unsigned)(R * K + C) * 2u; voffB[i] = (unsigned)(Rb * K + C) * 2u; }
    const size_t kstep = (size_t)(BK * 2);
    const size_t hstep = (size_t)HALF * K * 2;
    const size_t tstep = 2 * hstep;
    const unsigned ldsw = (unsigned)wid * 1024u;
    const int aoff = lds_byte(wr * 64 + fr, fq * 8), boff = lds_byte(wc * 32 + fr, fq * 8);
#define PG8_SA(b, h) (((b) * 2 + (h)) * HTB)
#define PG8_SB(b, h) ((4 + (b) * 2 + (h)) * HTB)
#define PG8_STAGE(bufoff, gbase, voff) do { _Pragma("unroll") for (int _i = 0; _i < 2; ++_i) \
        __builtin_amdgcn_global_load_lds((const unsigned*)((const char*)(gbase) + (voff)[_i]), (PG8_LAS unsigned*)(lds + (bufoff) + ldsw + _i * 8192), 16, 0, 0); } while (0)
#define PG8_LDA(dst, b, h) do { _Pragma("unroll") for (int m = 0; m < 4; ++m) _Pragma("unroll") for (int k = 0; k < 2; ++k) dst[m][k] = *(const PG8_LAS bf16x8*)(lds + PG8_SA(b, h) + aoff + m * 2048 + k * 1024); } while (0)
#define PG8_LDB(dst, b, h) do { _Pragma("unroll") for (int n = 0; n < 2; ++n) _Pragma("unroll") for (int k = 0; k < 2; ++k) dst[n][k] = *(const PG8_LAS bf16x8*)(lds + PG8_SB(b, h) + boff + n * 2048 + k * 1024); } while (0)
#define PG8_MMA(ai, bj, At, Bt) do { __builtin_amdgcn_s_setprio(1); _Pragma("unroll") for (int m = 0; m < 4; ++m) _Pragma("unroll") for (int n = 0; n < 2; ++n) _Pragma("unroll") for (int k = 0; k < 2; ++k) \
        acc[ai][bj][m][n] = __builtin_amdgcn_mfma_f32_16x16x32_bf16(Bt[n][k], At[m][k], acc[ai][bj][m][n], 0, 0, 0); __builtin_amdgcn_s_setprio(0); } while (0)
#define PG8_WAIT_V(n) asm volatile("s_waitcnt vmcnt(" #n ")" ::: "memory")
#define PG8_WAIT_L(n) asm volatile("s_waitcnt lgkmcnt(" #n ")" ::: "memory")
#define PG8_BAR __builtin_amdgcn_s_barrier()
#define PG8_SCHED __builtin_amdgcn_sched_barrier(0)
    Unit cur, nxt; int ui = 0;
    if (!S.next(0, cur)) return;
    f32x4 acc[2][2][4][2];
#pragma unroll
    for (int a = 0; a < 2; ++a)
#pragma unroll
        for (int b = 0; b < 2; ++b)
#pragma unroll
            for (int m = 0; m < 4; ++m)
#pragma unroll
                for (int n = 0; n < 2; ++n) acc[a][b][m][n] = (f32x4){0.f, 0.f, 0.f, 0.f};
    bf16x8 At[4][2], B0[2][2], B1[2][2];
    const char* cA = (const char*)g.A + (size_t)cur.pm * tstep; const char* cB = (const char*)g.Bt + (size_t)cur.pn * tstep;
    S.a_ready(cur);
    if constexpr (SP2) {
        PG8_STAGE(PG8_SB(0, 0), cB, voffB); PG8_STAGE(PG8_SB(0, 1), cB + hstep, voffB); PG8_STAGE(PG8_SA(0, 0), cA, voffA); PG8_STAGE(PG8_SA(0, 1), cA + hstep, voffA);
        if (wr == 1) PG8_BAR;
        PG8_WAIT_V(2); PG8_BAR;
        PG8_STAGE(PG8_SB(1, 0), cB + kstep, voffB); PG8_STAGE(PG8_SA(1, 0), cA + kstep, voffA); PG8_STAGE(PG8_SB(1, 1), cB + hstep + kstep, voffB);
        PG8_WAIT_V(6); PG8_BAR;
    } else {
        PG8_STAGE(PG8_SB(0, 0), cB, voffB); PG8_STAGE(PG8_SA(0, 0), cA, voffA); PG8_STAGE(PG8_SB(0, 1), cB + hstep, voffB); PG8_STAGE(PG8_SA(0, 1), cA + hstep, voffA);
        if (wr == 1) PG8_BAR;
        PG8_WAIT_V(4); PG8_BAR;
        PG8_STAGE(PG8_SB(1, 0), cB + kstep, voffB); PG8_STAGE(PG8_SA(1, 0), cA + kstep, voffA); PG8_STAGE(PG8_SB(1, 1), cB + hstep + kstep, voffB);
        PG8_WAIT_V(6); PG8_BAR;
    }
    for (;;) {
        const bool has_next = S.next(ui + 1, nxt);
        const char* nA = has_next ? (const char*)g.A + (size_t)nxt.pm * tstep : cA; const char* nB = has_next ? (const char*)g.Bt + (size_t)nxt.pn * tstep : cB;
        for (int t = 0; t < nt; t += 2) {
            const bool last = (t == nt - 2);
            const char* a1 = cA + (size_t)(t + 1) * kstep;
            const char* a2 = last ? nA : cA + (size_t)(t + 2) * kstep; const char* b2 = last ? nB : cB + (size_t)(t + 2) * kstep;
            const char* a3 = a2 + kstep; const char* b3 = b2 + kstep;
            if (last && has_next) S.a_ready(nxt);
            if constexpr (SP2) {
            PG8_LDB(B0, 0, 0); PG8_LDB(B1, 0, 1); PG8_SCHED; PG8_LDA(At, 0, 0); PG8_STAGE(PG8_SA(1, 1), a1 + hstep, voffA);
            PG8_WAIT_V(8); PG8_WAIT_L(0); PG8_BAR; PG8_MMA(0, 0, At, B0); PG8_MMA(0, 1, At, B1); PG8_BAR; PG8_SCHED;
            PG8_LDA(At, 0, 1); PG8_STAGE(PG8_SB(0, 0), b2, voffB); PG8_STAGE(PG8_SB(0, 1), b2 + hstep, voffB); PG8_STAGE(PG8_SA(0, 0), a2, voffA);
            PG8_WAIT_V(8); PG8_WAIT_L(0); PG8_BAR; PG8_MMA(1, 0, At, B0); PG8_MMA(1, 1, At, B1); PG8_BAR; PG8_SCHED;
            PG8_LDB(B0, 1, 0); PG8_LDB(B1, 1, 1); PG8_SCHED; PG8_LDA(At, 1, 0); PG8_STAGE(PG8_SA(0, 1), a2 + hstep, voffA);
            PG8_WAIT_V(8); PG8_WAIT_L(0); PG8_BAR; PG8_MMA(0, 0, At, B0); PG8_MMA(0, 1, At, B1); PG8_BAR; PG8_SCHED;
            PG8_LDA(At, 1, 1); PG8_STAGE(PG8_SB(1, 0), b3, voffB); PG8_STAGE(PG8_SB(1, 1), b3 + hstep, voffB); PG8_STAGE(PG8_SA(1, 0), a3, voffA);
            PG8_WAIT_V(8); PG8_WAIT_L(0); PG8_BAR; PG8_MMA(1, 0, At, B0); PG8_MMA(1, 1, At, B1); PG8_BAR; PG8_SCHED;
            } else {
            PG8_LDB(B0, 0, 0); PG8_SCHED; PG8_LDA(At, 0, 0); PG8_STAGE(PG8_SA(1, 1), a1 + hstep, voffA);
            PG8_WAIT_L(8); PG8_BAR; PG8_WAIT_L(0); PG8_MMA(0, 0, At, B0); PG8_BAR; PG8_SCHED;
            PG8_LDB(B1, 0, 1); PG8_STAGE(PG8_SB(0, 0), b2, voffB);
            PG8_BAR; PG8_WAIT_L(0); PG8_MMA(0, 1, At, B1); PG8_BAR;
            PG8_LDA(At, 0, 1); PG8_STAGE(PG8_SA(0, 0), a2, voffA);
            PG8_BAR; PG8_WAIT_L(0); PG8_MMA(1, 0, At, B0); PG8_BAR; PG8_SCHED;
            PG8_STAGE(PG8_SB(0, 1), b2 + hstep, voffB);
            PG8_WAIT_V(6); PG8_BAR; PG8_MMA(1, 1, At, B1); PG8_BAR;
            PG8_LDB(B0, 1, 0); PG8_SCHED; PG8_LDA(At, 1, 0); PG8_STAGE(PG8_SA(0, 1), a2 + hstep, voffA);
            PG8_WAIT_L(8); PG8_BAR; PG8_WAIT_L(0); PG8_MMA(0, 0, At, B0); PG8_BAR; PG8_SCHED;
            PG8_LDB(B1, 1, 1); PG8_STAGE(PG8_SB(1, 0), b3, voffB);
            PG8_BAR; PG8_WAIT_L(0); PG8_MMA(0, 1, At, B1); PG8_BAR;
            PG8_LDA(At, 1, 1); PG8_STAGE(PG8_SA(1, 0), a3, voffA);
            PG8_BAR; PG8_WAIT_L(0); PG8_MMA(1, 0, At, B0); PG8_BAR; PG8_SCHED;
            PG8_STAGE(PG8_SB(1, 1), b3 + hstep, voffB);
            PG8_WAIT_V(6); PG8_BAR; PG8_MMA(1, 1, At, B1); PG8_BAR;
            }
        }
        if constexpr (ALIGN_EPI) { if (wr == 0) PG8_BAR; }
        if constexpr (!Epi::AFTER_DRAIN) { E(acc, cur, wr, wc, fr, fq); S.done(cur); }
        if (!has_next) break;
#pragma unroll
        for (int a = 0; a < 2; ++a)
#pragma unroll
            for (int b = 0; b < 2; ++b)
#pragma unroll
                for (int m = 0; m < 4; ++m)
#pragma unroll
                    for (int n = 0; n < 2; ++n) acc[a][b][m][n] = (f32x4){0.f, 0.f, 0.f, 0.f};
        cur = nxt; cA = nA; cB = nB; ++ui;
        if constexpr (ALIGN_EPI) { if (wr == 1) PG8_BAR; }
    }
    PG8_WAIT_V(0);
    if constexpr (!ALIGN_EPI) { if (wr == 0) PG8_BAR; }
    PG8_BAR;
    if constexpr (Epi::AFTER_DRAIN) { E.fused(acc, cur, wr, wc, fr, fq, lds, wid, lane); S.done(cur); }
#undef PG8_SA
#undef PG8_SB
#undef PG8_STAGE
#undef PG8_LDA
#undef PG8_LDB
#undef PG8_MMA
#undef PG8_WAIT_V
#undef PG8_WAIT_L
#undef PG8_BAR
#undef PG8_SCHED
}
}
#define GAS __attribute__((address_space(1)))
#define LAS __attribute__((address_space(3)))
#define AS4 __attribute__((address_space(4)))
#define DI __device__ __forceinline__
typedef unsigned short bf16;
typedef float f32x4 __attribute__((ext_vector_type(4)));
typedef float f32x16 __attribute__((ext_vector_type(16)));
typedef short bf16x8 __attribute__((ext_vector_type(8)));
typedef short s16x4 __attribute__((ext_vector_type(4)));
typedef unsigned u32x4 __attribute__((ext_vector_type(4)));
typedef unsigned u32x2 __attribute__((ext_vector_type(2)));
typedef __bf16 bf2v __attribute__((ext_vector_type(2)));

constexpr int NB = 4, T = 4096, M = NB * T, D = 1024;
constexpr int IN0 = 3728, N0P = 3840, IN1 = 2560;
constexpr int C_GQ = 0, C_GK = 256, C_GV = 512, C_GLOW = 1024, C_RW = 1040, C_GATE0 = 2704;
constexpr int C_RR = C_RW, C_RK = C_RW + 512, C_RV = C_RW + 1024, C_XW = C_RW + 1536, C_XA = C_RW + 1600;
constexpr float NORM_EPS = 1e-5f, RWKV_LN_EPS = 64e-5f;
constexpr size_t MiB = 1u << 20;
constexpr size_t WS_W0T = 0, WS_WO0T = 8 * MiB, WS_W1T = 10 * MiB, WS_WO1T = 15 * MiB;
constexpr size_t WS_SLOT1 = 17 * MiB, WS_SLOT2 = 18 * MiB, WS_BONUS = 19 * MiB, WS_GDEC = 19 * MiB + 512 * 1024;
constexpr size_t WS_CTL = 19 * MiB + 768 * 1024, CTL_BYTES = 40960, WS_PCNT = WS_CTL + 16384;
constexpr size_t WS_XCCTAB = WS_CTL + 32768, WS_PROG = WS_CTL + 33792;
constexpr int LDS_BAR_OFF = 147456 - 64;
constexpr size_t WS_ROPE = 18 * MiB + 512 * 1024;
constexpr size_t WS_WLT = 18 * MiB + 768 * 1024;
constexpr size_t WS_XN = 20 * MiB;
constexpr size_t WS_PROJ0 = 52 * MiB;
constexpr size_t WS_H1B = 116 * MiB;
constexpr size_t WS_SCR = 172 * MiB;
constexpr size_t WS_OARAW = 204 * MiB;
constexpr size_t WS_VP = 236 * MiB;
constexpr size_t WS_END = 252 * MiB;
constexpr int LDS_BYTES = 147456;

struct Params {
    const float *x, *norm_w, *w_in0, *gk_up, *gk_bias, *gla_norm_w, *mu, *w0, *w_up, *a0, *a_up, *k_k, *k_a, *r_k, *ln_w, *ln_b, *w_out0, *w_in1, *b_in1, *sinks, *w_out1, *b_out1, *final_w;
    float* out; unsigned char* ws;
};

typedef float f32x2v __attribute__((ext_vector_type(2)));
DI unsigned pk2(float lo, float hi) { const f32x2v f = {lo, hi}; return __builtin_bit_cast(unsigned, __builtin_convertvector(f, bf2v)); }
DI unsigned f2bf(float f) { return pk2(f, 0.f) & 0xffffu; }
DI float bf2f(unsigned h) { return __builtin_bit_cast(float, h << 16); }
DI float bflo(unsigned w) { return __builtin_bit_cast(float, w << 16); }
DI float bfhi(unsigned w) { return __builtin_bit_cast(float, w & 0xffff0000u); }
DI float wave_sum(float v) {
#pragma unroll
    for (int o = 1; o < 64; o <<= 1) v += __shfl_xor(v, o);
    return v;
}
DI float dpp_sum16(float v) {
    v += __builtin_bit_cast(float, __builtin_amdgcn_update_dpp(0, __builtin_bit_cast(int, v), 0xB1, 0xf, 0xf, true));
    v += __builtin_bit_cast(float, __builtin_amdgcn_update_dpp(0, __builtin_bit_cast(int, v), 0x4E, 0xf, 0xf, true));
    v += __builtin_bit_cast(float, __builtin_amdgcn_update_dpp(0, __builtin_bit_cast(int, v), 0x141, 0xf, 0xf, true));
    v += __builtin_bit_cast(float, __builtin_amdgcn_update_dpp(0, __builtin_bit_cast(int, v), 0x140, 0xf, 0xf, true));
    return v;
}
DI float half_sum32(float v) { v = dpp_sum16(v); return v + __shfl_xor(v, 16); }
DI void unpack8(const u32x4 w, float (&f)[8]) {
#pragma unroll
    for (int e = 0; e < 4; ++e) { f[2 * e] = bflo(w[e]); f[2 * e + 1] = bfhi(w[e]); }
}
DI int crow(int r, int hi) { return (r & 3) + 8 * (r >> 2) + 4 * hi; }
DI int kpos(int k) { const int o16 = k & 15; return (k & ~15) + 8 * ((o16 >> 2) & 1) + 4 * (o16 >> 3) + (o16 & 3); }
#define MFMA32(a, b, c) __builtin_amdgcn_mfma_f32_32x32x16_bf16((a), (b), (c), 0, 0, 0)
#define LDS_WAIT() asm volatile("s_waitcnt lgkmcnt(0)" ::: "memory")
DI void lds_barrier() { asm volatile("s_waitcnt lgkmcnt(0)" ::: "memory"); __builtin_amdgcn_s_barrier(); asm volatile("" ::: "memory"); }

#define XB_TMO      128
#define XB_XCNT(j)  (256  + 64 * (j))
#define XB_XSUB(j)  (1280 + 64 * (j))
#define XB_XGEN(j)  (2304 + 64 * (j))
#define XB_TOP      3328
#define XB_TOPGEN   3392
#define XCD_BAR_WORDS 3456
#define XB_SPIN_CAP (1u << 18)

__device__ __forceinline__ unsigned xb_ld(unsigned* p)              { return __hip_atomic_load(p, __ATOMIC_RELAXED, __HIP_MEMORY_SCOPE_AGENT); }
__device__ __forceinline__ unsigned xb_add(unsigned* p, unsigned v) { return __hip_atomic_fetch_add(p, v, __ATOMIC_RELAXED, __HIP_MEMORY_SCOPE_AGENT); }
__device__ __forceinline__ unsigned xb_xcc_id() { return (unsigned)__builtin_amdgcn_s_getreg((3 << 11) | 20) & 0xFu; }
#define XB_SPIN(cond, bar) do { unsigned _sp = 0; while (cond) { __builtin_amdgcn_s_sleep(1); \
    if ((++_sp & 255u) == 0u) { if (xb_ld(&(bar)[XB_TMO])) break; if (_sp > XB_SPIN_CAP) { atomicAdd(&(bar)[XB_TMO], 1u); break; } } } } while (0)

struct XcdBarrier {
    unsigned* bar; unsigned x;
    volatile LAS unsigned* st;
};

__device__ __forceinline__ XcdBarrier xcd_barrier_post(unsigned* bar, volatile LAS unsigned* st) {
    XcdBarrier b; b.bar = bar; b.x = xb_xcc_id(); b.st = st;
    if (threadIdx.x == 0) (void)xb_add(&bar[XB_XCNT(b.x)], 1u);
    return b;
}
__device__ __forceinline__ void xcd_barrier_complete(unsigned* bar, unsigned x, unsigned& nloc, unsigned& nx) {
    const unsigned G = gridDim.x * gridDim.y * gridDim.z;
    unsigned sum, cnt, mine, sp = 0u;
    for (;;) {
        sum = 0u; cnt = 0u; mine = 0u;
#pragma unroll
        for (unsigned j = 0; j < 16; ++j) { const unsigned c = xb_ld(&bar[XB_XCNT(j)]); sum += c; cnt += (c > 0u) ? 1u : 0u; mine = (j == x) ? c : mine; }
        if (sum == G) break;
        __builtin_amdgcn_s_sleep(1);
        if ((++sp & 255u) == 0u) { if (xb_ld(&bar[XB_TMO])) break; if (sp > XB_SPIN_CAP) { atomicAdd(&bar[XB_TMO], 1u); break; } }
    }
    nloc = mine > 0u ? mine : 1u; nx = cnt > 0u ? cnt : 1u;
}

__device__ __forceinline__ void xcd_barrier(const XcdBarrier& b) {
    asm volatile("s_waitcnt vmcnt(0)" ::: "memory");
    __syncthreads();
    if (threadIdx.x == 0) {
        unsigned* bar = b.bar;
        __builtin_amdgcn_s_waitcnt(0);
        unsigned nloc = b.st[0], nx = b.st[1];
        if (nloc == 0u) { xcd_barrier_complete(bar, b.x, nloc, nx); b.st[0] = nloc; b.st[1] = nx; }
        const unsigned old = xb_add(&bar[XB_XSUB(b.x)], 1u);
        const unsigned gen = old / nloc;
        if (old + 1u == (gen + 1u) * nloc) {
            __builtin_amdgcn_fence(__ATOMIC_RELEASE, "agent");
            asm volatile("s_waitcnt vmcnt(0)" ::: "memory");
            const unsigned og = xb_add(&bar[XB_TOP], 1u);
            const unsigned tg = og / nx;
            if (og + 1u == (tg + 1u) * nx) xb_add(&bar[XB_TOPGEN], 1u);
            else XB_SPIN(xb_ld(&bar[XB_TOPGEN]) == tg, bar);
            __builtin_amdgcn_fence(__ATOMIC_ACQUIRE, "agent");
            xb_add(&bar[XB_XGEN(b.x)], 1u);
            asm volatile("s_waitcnt vmcnt(0)" ::: "memory");
        } else {
            XB_SPIN(xb_ld(&bar[XB_XGEN(b.x)]) == gen, bar);
            __builtin_amdgcn_fence(__ATOMIC_ACQUIRE, "agent");
            asm volatile("s_waitcnt vmcnt(0)" ::: "memory");
        }
    }
    __syncthreads();
}

struct EpiScaleBf16 {
    static constexpr bool PERM = true, AFTER_DRAIN = false;
    bf16* O; int ldc; const float* slots; const float* bias; int bias_n;
    DI void operator()(const pg8::f32x4 (&acc)[2][2][4][2], const pg8::Unit& u, int wr, int wc, int fr, int fq) const {
        const int row0 = u.pm * 256 + wr * 64 + fr, col0 = u.pn * 256 + wc * 32 + 8 * fq;
        const bool hb = bias && (u.pn * 256 < bias_n);
        f32x4 bv[2][2];
#pragma unroll
        for (int bj = 0; bj < 2; ++bj)
#pragma unroll
            for (int n = 0; n < 2; ++n) bv[bj][n] = hb ? *(const f32x4*)(bias + col0 + bj * 128 + 4 * n) : (f32x4){0.f, 0.f, 0.f, 0.f};
#pragma unroll
        for (int ai = 0; ai < 2; ++ai)
#pragma unroll
            for (int m = 0; m < 4; ++m) {
                const int row = row0 + ai * 128 + m * 16; float rs = 1.f;
                if (slots) { const f32x4* sp = (const f32x4*)(slots + (size_t)row * 16); const f32x4 a = sp[0], b = sp[1], c = sp[2], d = sp[3];
                    const float ss = ((a[0] + a[1]) + (a[2] + a[3])) + ((b[0] + b[1]) + (b[2] + b[3])) + ((c[0] + c[1]) + (c[2] + c[3])) + ((d[0] + d[1]) + (d[2] + d[3]));
                    rs = 1.0f / sqrtf(ss * (1.0f / 1024.0f) + NORM_EPS); }
                bf16* rowp = O + (size_t)row * ldc + col0;
#pragma unroll
                for (int bj = 0; bj < 2; ++bj) { const f32x4 v0 = acc[ai][bj][m][0] * rs + bv[bj][0], v1 = acc[ai][bj][m][1] * rs + bv[bj][1];
                    u32x4 w; w.x = pk2(v0[0], v0[1]); w.y = pk2(v0[2], v0[3]); w.z = pk2(v1[0], v1[1]); w.w = pk2(v1[2], v1[3]);
                    *(u32x4*)(rowp + bj * 128) = w; }
            }
    }
};
struct EpiResid {
    static constexpr bool PERM = false, AFTER_DRAIN = false;
    const float* base; bf16* outB; float* slots;
    DI void operator()(const pg8::f32x4 (&acc)[2][2][4][2], const pg8::Unit& u, int wr, int wc, int fr, int fq) const {
        const int col0 = u.pn * 256 + wc * 32 + 4 * fq;
#pragma unroll
        for (int ai = 0; ai < 2; ++ai)
#pragma unroll
            for (int m = 0; m < 4; ++m) {
                const int row = u.pm * 256 + ai * 128 + wr * 64 + m * 16 + fr; const size_t off = (size_t)row * 1024 + col0; float ss = 0.f;
#pragma unroll
                for (int bj = 0; bj < 2; ++bj)
#pragma unroll
                    for (int n = 0; n < 2; ++n) { const f32x4 bs = *(const f32x4*)(base + off + bj * 128 + n * 16); const f32x4 v = bs + acc[ai][bj][m][n];
                        u32x2 w; w.x = pk2(v[0], v[1]); w.y = pk2(v[2], v[3]); *(u32x2*)(outB + off + bj * 128 + n * 16) = w;
                        ss += (v[0] * v[0] + v[1] * v[1]) + (v[2] * v[2] + v[3] * v[3]); }
                ss += __shfl_xor(ss, 16); ss += __shfl_xor(ss, 32);
                if (fq == 0) slots[(size_t)row * 16 + u.pn * 4 + wc] = ss;
            }
    }
};

struct EpiResidNorm {
    static constexpr bool PERM = false, AFTER_DRAIN = true;
    const bf16* base; float* out; const float* bias; const float* w; float* xbuf; unsigned* cnt;
    DI void fused(pg8::f32x4 (&acc)[2][2][4][2], const pg8::Unit& u, int wr, int wc, int fr, int fq, PG8_LAS unsigned char* lds, int wid, int lane) const {
        PG8_LAS float* Pt = (PG8_LAS float*)lds;
        PG8_LAS float* S = (PG8_LAS float*)(lds + 4096);
        const int col0 = u.pn * 256 + wc * 32 + 4 * fq;
#pragma unroll
        for (int ai = 0; ai < 2; ++ai)
#pragma unroll
            for (int m = 0; m < 4; ++m) {
                const int r = ai * 128 + wr * 64 + m * 16 + fr; const size_t off = (size_t)(u.pm * 256 + r) * 1024 + col0; float ss = 0.f;
#pragma unroll
                for (int bj = 0; bj < 2; ++bj)
#pragma unroll
                    for (int n = 0; n < 2; ++n) { const u32x2 bw = *(const u32x2*)(base + off + bj * 128 + n * 16); const f32x4 bs = (f32x4){bflo(bw.x), bfhi(bw.x), bflo(bw.y), bfhi(bw.y)}; const f32x4 bv = *(const f32x4*)(bias + col0 + bj * 128 + n * 16);
                        const f32x4 v = bs + acc[ai][bj][m][n] + bv; acc[ai][bj][m][n] = v; ss += (v[0] * v[0] + v[1] * v[1]) + (v[2] * v[2] + v[3] * v[3]); }
                ss += __shfl_xor(ss, 16); ss += __shfl_xor(ss, 32);
                if (fq == 0) Pt[r * 4 + wc] = ss;
                if (m & 1) asm volatile("" ::: "memory");
            }
        asm volatile("s_waitcnt lgkmcnt(0)" ::: "memory"); __builtin_amdgcn_s_barrier(); asm volatile("" ::: "memory");
        const int row = wid * 32 + (lane & 31);
        if (lane < 32) { const float tot = (Pt[row * 4 + 0] + Pt[row * 4 + 1]) + (Pt[row * 4 + 2] + Pt[row * 4 + 3]);
            __hip_atomic_store(xbuf + (size_t)(u.pm * 256 + row) * 4 + u.pn, tot, __ATOMIC_RELAXED, __HIP_MEMORY_SCOPE_AGENT); }
        asm volatile("s_waitcnt vmcnt(0)" ::: "memory");
        if (lane == 0) __hip_atomic_fetch_add(cnt + 64 * u.pm, 1u, __ATOMIC_RELAXED, __HIP_MEMORY_SCOPE_AGENT);
        if (wid == 0) {
            unsigned spins = 0;
            while ((unsigned)__builtin_amdgcn_readfirstlane(__hip_atomic_load(cnt + 64 * u.pm, __ATOMIC_RELAXED, __HIP_MEMORY_SCOPE_AGENT)) < 32u) { __builtin_amdgcn_s_sleep(2); if (++spins > (1u << 22)) break; }
            __builtin_amdgcn_fence(__ATOMIC_ACQUIRE, "agent");
        }
        asm volatile("s_waitcnt vmcnt(0) lgkmcnt(0)" ::: "memory"); __builtin_amdgcn_s_barrier(); asm volatile("" ::: "memory");
        if (lane < 32) { const float* sl = xbuf + (size_t)(u.pm * 256 + row) * 4; float t = 0.f;
#pragma unroll
            for (int k = 0; k < 4; ++k) t += __hip_atomic_load(sl + k, __ATOMIC_RELAXED, __HIP_MEMORY_SCOPE_AGENT);
            S[row] = 1.0f / sqrtf(t * (1.f / 1024.f) + NORM_EPS); }
        asm volatile("s_waitcnt lgkmcnt(0)" ::: "memory"); __builtin_amdgcn_s_barrier(); asm volatile("" ::: "memory");
        f32x4 wv[2][2];
#pragma unroll
        for (int bj = 0; bj < 2; ++bj)
#pragma unroll
            for (int n = 0; n < 2; ++n) wv[bj][n] = *(const f32x4*)(w + col0 + bj * 128 + n * 16);
#pragma unroll
        for (int ai = 0; ai < 2; ++ai)
#pragma unroll
            for (int m = 0; m < 4; ++m) { const int r = ai * 128 + wr * 64 + m * 16 + fr; const float rs = S[r]; const size_t off = (size_t)(u.pm * 256 + r) * 1024 + col0;
#pragma unroll
                for (int bj = 0; bj < 2; ++bj)
#pragma unroll
                    for (int n = 0; n < 2; ++n) *(f32x4*)(out + off + bj * 128 + n * 16) = acc[ai][bj][m][n] * rs * wv[bj][n]; }
    }
};

DI void transpose_item(const float* W, int N, int Npad, bf16* WT, const float* kscale, LAS float* scr, int item, int lane) {
    const int nblk = Npad / 32, kb = item / nblk, nb = item % nblk, k0 = 64 * kb, n0 = 32 * nb;
    const int n = n0 + (lane & 31);
#pragma unroll 8
    for (int i = 0; i < 32; ++i) { const int kk = 2 * i + (lane >> 5); float v = (n < N) ? W[(size_t)(k0 + kk) * N + n] : 0.f; if (kscale) v *= kscale[k0 + kk]; scr[kk * 33 + (lane & 31)] = v; }
    LDS_WAIT(); asm volatile("" ::: "memory");
    const int c = lane & 7;
#pragma unroll
    for (int j = 0; j < 4; ++j) { const int nn = (lane >> 3) + 8 * j; const LAS float* s = scr + (8 * c) * 33 + nn;
        u32x4 o; o.x = pk2(s[0 * 33], s[1 * 33]); o.y = pk2(s[2 * 33], s[3 * 33]); o.z = pk2(s[4 * 33], s[5 * 33]); o.w = pk2(s[6 * 33], s[7 * 33]);
        *(u32x4*)(WT + (size_t)(n0 + nn) * 1024 + k0 + 8 * c) = o; }
    LDS_WAIT(); asm volatile("" ::: "memory");
}
DI void p0_prologue(const Params& P, LAS unsigned char* lds, int wave, int lane) {
    LAS float* scr = (LAS float*)(lds + wave * 16384);
    const int gw = blockIdx.x * 8 + wave, NGW = gridDim.x * 8;
    bf16* W0T = (bf16*)(P.ws + WS_W0T); bf16* WO0T = (bf16*)(P.ws + WS_WO0T); bf16* W1T = (bf16*)(P.ws + WS_W1T); bf16* WO1T = (bf16*)(P.ws + WS_WO1T);
    constexpr int I0 = 16 * (N0P / 32), I1 = 16 * 32, I2 = 16 * (IN1 / 32), I3 = 16 * 32;
    for (int it = gw; it < I0 + I1 + I2 + I3; it += NGW) {
        int r = it;
        if (r < I0) { transpose_item(P.w_in0, IN0, N0P, W0T, nullptr, scr, r, lane); continue; } r -= I0;
        if (r < I1) { transpose_item(P.w_out0, 1024, 1024, WO0T, nullptr, scr, r, lane); continue; } r -= I1;
        if (r < I2) { transpose_item(P.w_in1, IN1, IN1, W1T, P.norm_w + 1024, scr, r, lane); continue; } r -= I2;
        transpose_item(P.w_out1, 1024, 1024, WO1T, nullptr, scr, r, lane);
    }
    {
        float* RT = (float*)(P.ws + WS_ROPE);
        for (int e = gw * 64 + lane; e < T * 8; e += NGW * 64) { const int pos = e >> 3, j = e & 7;
            const float invf = __expf(-(float)j * 0.125f * 13.122363377404328f); const float ang = (float)pos * invf; const float nrev = rintf(ang * 0.15915494309189535f);
            float r = fmaf(-nrev, 6.2831854820251465f, ang); r = fmaf(-nrev, -1.7484555e-07f, r);
            RT[2 * e] = __cosf(r); RT[2 * e + 1] = __sinf(r); }
    }
    {
        u32x4* WLT = (u32x4*)(P.ws + WS_WLT);
        for (int e = gw * 64 + lane; e < 8 * 2 * 4 * 2 * 64; e += NGW * 64) { const int ln = e & 63, db = (e >> 6) & 1, s = (e >> 7) & 3, lo = (e >> 9) & 1, h = e >> 10;
            const float* wp = (lo ? P.a_up : P.w_up) + (size_t)(16 * s + 8 * (ln >> 5)) * 512 + h * 64 + 2 * (ln & 31) + db;
            u32x4 o; o.x = pk2(wp[0], wp[512]); o.y = pk2(wp[2 * 512], wp[3 * 512]); o.z = pk2(wp[4 * 512], wp[5 * 512]); o.w = pk2(wp[6 * 512], wp[7 * 512]); WLT[e] = o; }
    }
    bf16* XN = (bf16*)(P.ws + WS_XN);
    {
        const f32x4* wr = (const f32x4*)P.norm_w + lane; const f32x4 w0 = wr[0], w1 = wr[64], w2 = wr[128], w3 = wr[192];
        f32x4 nx[4];
        { const f32x4* xr = (const f32x4*)(P.x + (size_t)(gw < M ? gw : 0) * D) + lane;
#pragma unroll
          for (int j = 0; j < 4; ++j) nx[j] = xr[64 * j]; }
        for (int m = gw; m < M; m += NGW) {
            f32x4 v[4]; float s = 0.f;
#pragma unroll
            for (int j = 0; j < 4; ++j) { v[j] = nx[j]; s += (v[j][0] * v[j][0] + v[j][1] * v[j][1]) + (v[j][2] * v[j][2] + v[j][3] * v[j][3]); }
            if (m + NGW < M) { const f32x4* xr = (const f32x4*)(P.x + (size_t)(m + NGW) * D) + lane;
#pragma unroll
                for (int j = 0; j < 4; ++j) nx[j] = xr[64 * j]; }
            const float rstd = 1.0f / sqrtf(wave_sum(s) * (1.f / D) + NORM_EPS);
            u32x2* o8 = (u32x2*)(XN + (size_t)m * D) + lane;
            { u32x2 o; o.x = pk2(v[0][0] * rstd * w0[0], v[0][1] * rstd * w0[1]); o.y = pk2(v[0][2] * rstd * w0[2], v[0][3] * rstd * w0[3]); o8[0] = o; }
            { u32x2 o; o.x = pk2(v[1][0] * rstd * w1[0], v[1][1] * rstd * w1[1]); o.y = pk2(v[1][2] * rstd * w1[2], v[1][3] * rstd * w1[3]); o8[64] = o; }
            { u32x2 o; o.x = pk2(v[2][0] * rstd * w2[0], v[2][1] * rstd * w2[1]); o.y = pk2(v[2][2] * rstd * w2[2], v[2][3] * rstd * w2[3]); o8[128] = o; }
            { u32x2 o; o.x = pk2(v[3][0] * rstd * w3[0], v[3][1] * rstd * w3[1]); o.y = pk2(v[3][2] * rstd * w3[2], v[3][3] * rstd * w3[3]); o8[192] = o; }
        }
    }
}
DI float softplus_f(float z) { return fmaxf(z, 0.f) + __logf(1.f + __expf(-fabsf(z))); }
DI float tanh_f(float x) { return 1.f - 2.f * __builtin_amdgcn_rcpf(__expf(2.f * x) + 1.f); }

template <int N> DI void dpp_fmac(float& acc, float src, float y) { asm("v_fmac_f32_dpp %0, %1, %2 row_newbcast:%3 row_mask:0xf bank_mask:0xf" : "+v"(acc) : "v"(src), "v"(y), "n"(N)); }
template <int N> DI void dpp_mul_ip(float& y, float src) { asm("v_mul_f32_dpp %0, %1, %0 row_newbcast:%2 row_mask:0xf bank_mask:0xf" : "+v"(y) : "v"(src), "n"(N)); }
template <int N> DI float dpp_mul(float src, float s) { float r; asm("v_mul_f32_dpp %0, %1, %2 row_newbcast:%3 row_mask:0xf bank_mask:0xf" : "=v"(r) : "v"(src), "v"(s), "n"(N)); return r; }
template <int D> struct RStep {
    static DI void dot(const float (&y)[64], const f32x4& X, float& s0, float& s1, float& s2, float& s3) {
        if constexpr (D < 16) { dpp_fmac<D>(s0, X[0], y[D]); dpp_fmac<D>(s1, X[1], y[16 + D]); dpp_fmac<D>(s2, X[2], y[32 + D]); dpp_fmac<D>(s3, X[3], y[48 + D]); RStep<D + 1>::dot(y, X, s0, s1, s2, s3); } }
    static DI void upd(float (&y)[64], const f32x4& Bv, float sa) {
        if constexpr (D < 16) {
            dpp_fmac<D>(y[D], Bv[0], sa); dpp_fmac<D>(y[16 + D], Bv[1], sa); dpp_fmac<D>(y[32 + D], Bv[2], sa); dpp_fmac<D>(y[48 + D], Bv[3], sa);
            RStep<D + 1>::upd(y, Bv, sa); } }
    static DI void scale(float (&y)[64], const f32x4& W) {
        if constexpr (D < 16) {
            dpp_mul_ip<D>(y[D], W[0]); dpp_mul_ip<D>(y[16 + D], W[1]); dpp_mul_ip<D>(y[32 + D], W[2]); dpp_mul_ip<D>(y[48 + D], W[3]);
            RStep<D + 1>::scale(y, W); } }
};
DI void rwkv_rstep(float (&y)[64], const f32x4 (&X)[4], int t, int role, int lane, bf16* mstep) {
    float s0 = 0.f, s1 = 0.f, s2 = 0.f, s3 = 0.f;
    RStep<0>::dot(y, X[0], s0, s1, s2, s3);
    float sa = (s0 + s1) + (s2 + s3);
    if (role == 1) sa = (lane < t) ? sa : 0.f;
    RStep<0>::upd(y, X[2], sa);
    float o0 = 0.f, o1 = 0.f, o2 = 0.f, o3 = 0.f;
    RStep<0>::dot(y, X[3], o0, o1, o2, o3);
    float o = (o0 + o1) + (o2 + o3);
    if (role == 1) o = (lane <= t) ? o : 0.f;
    mstep[t * 64] = (bf16)f2bf(o);
}
DI void rwkv_prep_item(const Params& P, int item, LAS unsigned char* lds, int wave, int lane) {
    const int bh = item >> 4, quad = item & 15, b = bh >> 3, h = bh & 7;
    const int tok0 = b * T + quad * 256;
    const bf16* PROJ0 = (const bf16*)(P.ws + WS_PROJ0);
    float* scr = (float*)(P.ws + WS_SCR + (size_t)blockIdx.x * 262144);
    LAS float* KS = (LAS float*)lds;
    LAS float* TOT = (LAS float*)(lds + 8 * 64 * 65 * 4);
    bf16* VP = (bf16*)(P.ws + WS_VP); float* BON = (float*)(P.ws + WS_BONUS);
    const int hd = h * 64 + lane;
    {
        const int m = lane & 31, hi = lane >> 5;
        const int c = wave >> 1, tb = (wave & 1) * 32;
        const int tokw = tok0 + wave * 32, posw = quad * 256 + wave * 32;
        f32x16 accw[2], acca[2];
#pragma unroll
        for (int i = 0; i < 16; ++i) { accw[0][i] = 0.f; accw[1][i] = 0.f; acca[0][i] = 0.f; acca[1][i] = 0.f; }
        {
            const bf16* rowc = PROJ0 + (size_t)(tokw + m) * N0P; const bool hasprev = (posw + m) > 0;
            const u32x4* WLT = (const u32x4*)(P.ws + WS_WLT) + (size_t)h * 1024 + lane;
            u32x4 cwv[4], cav[4], pwv[4], pav[4], bwv[4][2], bav[4][2];
#pragma unroll
            for (int s = 0; s < 4; ++s) { const int j0 = 16 * s + 8 * hi;
                cwv[s] = *(const u32x4*)(rowc + C_XW + j0); cav[s] = *(const u32x4*)(rowc + C_XA + j0);
                pwv[s] = (u32x4){0u, 0u, 0u, 0u}; pav[s] = (u32x4){0u, 0u, 0u, 0u};
                if (hasprev) { pwv[s] = *(const u32x4*)(rowc - N0P + C_XW + j0); pav[s] = *(const u32x4*)(rowc - N0P + C_XA + j0); }
#pragma unroll
                for (int db = 0; db < 2; ++db) { bwv[s][db] = WLT[((0 * 4 + s) * 2 + db) * 64]; bav[s][db] = WLT[((1 * 4 + s) * 2 + db) * 64]; } }
#pragma unroll
            for (int s = 0; s < 4; ++s) {
                const int j0 = 16 * s + 8 * hi;
                float fcw[8], fpw[8], fca[8], fpa[8]; unpack8(cwv[s], fcw); unpack8(pwv[s], fpw); unpack8(cav[s], fca); unpack8(pav[s], fpa);
                const f32x4 mw0 = *(const f32x4*)(P.mu + 1536 + j0), mw1 = *(const f32x4*)(P.mu + 1536 + j0 + 4), ma0 = *(const f32x4*)(P.mu + 1600 + j0), ma1 = *(const f32x4*)(P.mu + 1600 + j0 + 4);
                float xw[8], xa[8];
#pragma unroll
                for (int e = 0; e < 8; ++e) { const float muw = e < 4 ? mw0[e & 3] : mw1[e & 3], mua = e < 4 ? ma0[e & 3] : ma1[e & 3];
                    xw[e] = tanh_f(fcw[e] + (fpw[e] - fcw[e]) * muw); xa[e] = fca[e] + (fpa[e] - fca[e]) * mua; }
                u32x4 aw, aa;
#pragma unroll
                for (int e = 0; e < 4; ++e) { aw[e] = pk2(xw[2 * e], xw[2 * e + 1]); aa[e] = pk2(xa[2 * e], xa[2 * e + 1]); }
#pragma unroll
                for (int db = 0; db < 2; ++db) {
                    accw[db] = MFMA32(__builtin_bit_cast(bf16x8, aw), __builtin_bit_cast(bf16x8, bwv[s][db]), accw[db]);
                    acca[db] = MFMA32(__builtin_bit_cast(bf16x8, aa), __builtin_bit_cast(bf16x8, bav[s][db]), acca[db]);
                }
            }
        }
        float kkd[2], kad[2], rkd[2], w0d[2], a0d[2], mur[2], muk[2], muv[2];
#pragma unroll
        for (int db = 0; db < 2; ++db) { const int hd = h * 64 + 2 * m + db; kkd[db] = P.k_k[hd]; kad[db] = P.k_a[hd]; rkd[db] = P.r_k[hd]; w0d[db] = P.w0[hd]; a0d[db] = P.a0[hd];
            mur[db] = P.mu[hd]; muk[db] = P.mu[512 + hd]; muv[db] = P.mu[1024 + hd]; }
        unsigned qr[16], qk[16], qv[16], qpr[4], qpk[4], qpv[4];
#pragma unroll
        for (int i = 0; i < 16; ++i) {
            int io = i; asm volatile("" : "+v"(io));
            const bf16* row = PROJ0 + (size_t)(tokw + crow(io, hi)) * N0P + h * 64 + 2 * m;
            qr[i] = *(const unsigned*)(row + C_RR); qk[i] = *(const unsigned*)(row + C_RK); qv[i] = *(const unsigned*)(row + C_RV);
            if ((i & 3) == 0) {
                qpr[i >> 2] = 0u; qpk[i >> 2] = 0u; qpv[i >> 2] = 0u;
                if (posw + crow(i, hi) > 0) { qpr[i >> 2] = *(const unsigned*)(row - N0P + C_RR); qpk[i >> 2] = *(const unsigned*)(row - N0P + C_RK); qpv[i >> 2] = *(const unsigned*)(row - N0P + C_RV); }
            }
        }
        float ee[2][16], Lc[2][16];
#pragma unroll
        for (int db = 0; db < 2; ++db) {
#pragma unroll
            for (int i = 0; i < 16; ++i) { const float wl = w0d[db] + accw[db][i]; ee[db][i] = __expf(-softplus_f(-wl) - 0.5f); }
            float gt[4], go[4];
#pragma unroll
            for (int g = 0; g < 4; ++g) { Lc[db][4 * g] = ee[db][4 * g]; Lc[db][4 * g + 1] = Lc[db][4 * g] + ee[db][4 * g + 1]; Lc[db][4 * g + 2] = Lc[db][4 * g + 1] + ee[db][4 * g + 2]; Lc[db][4 * g + 3] = Lc[db][4 * g + 2] + ee[db][4 * g + 3];
                gt[g] = Lc[db][4 * g + 3]; go[g] = __shfl_xor(gt[g], 32); }
            float run = 0.f;
#pragma unroll
            for (int g = 0; g < 4; ++g) { const float base = run + (hi ? go[g] : 0.f);
#pragma unroll
                for (int q = 0; q < 4; ++q) Lc[db][4 * g + q] += base;
                run += gt[g] + go[g]; }
            if (!(wave & 1) && hi == 0) TOT[c * 64 + 2 * m + db] = run;
        }
        __syncthreads();
        if (wave & 1) {
#pragma unroll
            for (int db = 0; db < 2; ++db) { const float tp = TOT[c * 64 + 2 * m + db];
#pragma unroll
                for (int i = 0; i < 16; ++i) Lc[db][i] += tp; }
        }
        float Lb[2][4];
#pragma unroll
        for (int db = 0; db < 2; ++db)
#pragma unroll
            for (int g = 0; g < 4; ++g) { Lb[db][g] = Lc[db][4 * g] - ee[db][4 * g]; asm volatile("" : "+v"(Lb[db][g])); }
        {
            float pv0 = 0.f, pv1 = 0.f;
#pragma unroll
            for (int i = 0; i < 16; ++i) {
                int io = i; asm volatile("" : "+v"(io));
                if ((i & 3) == 0) { pv0 = bflo(qpv[i >> 2]); pv1 = bfhi(qpv[i >> 2]); }
                const float c0 = bflo(qv[i]), c1 = bfhi(qv[i]);
                *(unsigned*)(VP + (size_t)(tokw + crow(io, hi)) * 512 + h * 64 + 2 * m) = pk2(c0 + (pv0 - c0) * muv[0], c1 + (pv1 - c1) * muv[1]);
                pv0 = c0; pv1 = c1;
            }
        }
        float pr[2] = {0.f, 0.f}, pk[2] = {0.f, 0.f}, pemL[2] = {1.f, 1.f};
#pragma unroll
        for (int i = 0; i < 16; ++i) {
            int io = i; asm volatile("" : "+v"(io));
            const int tau = crow(io, hi), tok = tokw + tau, t = tb + tau;
            if ((i & 3) == 0) { pr[0] = bflo(qpr[i >> 2]); pr[1] = bfhi(qpr[i >> 2]); pk[0] = bflo(qpk[i >> 2]); pk[1] = bfhi(qpk[i >> 2]); }
            float r[2], k[2], a[2], kk[2];
#pragma unroll
            for (int db = 0; db < 2; ++db) {
                const float cr = db ? bfhi(qr[i]) : bflo(qr[i]), ck = db ? bfhi(qk[i]) : bflo(qk[i]);
                r[db] = cr + (pr[db] - cr) * mur[db]; k[db] = ck + (pk[db] - ck) * muk[db];
                pr[db] = cr; pk[db] = ck;
                const float al = a0d[db] + acca[db][i];
                a[db] = __builtin_amdgcn_rcpf(1.f + __expf(-al));
                kk[db] = k[db] * kkd[db];
            }
            const float nrm = sqrtf(half_sum32(kk[0] * kk[0] + kk[1] * kk[1]));
            const float inv = __builtin_amdgcn_rcpf(fmaxf(nrm, 1e-12f));
            float k2[2];
#pragma unroll
            for (int db = 0; db < 2; ++db) k2[db] = k[db] * (1.f + (a[db] - 1.f) * kad[db]);
            const float bon = half_sum32(r[0] * k2[0] * rkd[0] + r[1] * k2[1] * rkd[1]);
#pragma unroll
            for (int db = 0; db < 2; ++db) {
                const int d = 2 * m + db; const float kkn = kk[db] * inv;
                float* o = scr + (size_t)((c * 64 + t) * 4) * 64 + (d & 15) * 4 + (d >> 4);
                const float eL = __expf(Lc[db][i]), emL = __builtin_amdgcn_rcpf(eL);
                const float wprev = (i & 3) ? pemL[db] : __expf(-Lb[db][i >> 2]); pemL[db] = emL;
                o[0] = -kkn * wprev;
                if (i == 15 && t == 63) o[64] = emL;
                o[128] = kkn * a[db] * eL;
                o[192] = r[db] * emL;
                KS[((2 * c + 1 - (c >> 1)) * 64 + t) * 65 + d] = k2[db] * eL;
            }
            if (m == 0) BON[(size_t)tok * 8 + h] = bon;
        }
    }
    __syncthreads();
    {
        const int c = wave >> 1, role = (wave ^ (wave >> 2)) & 1;
        const f32x4* xb = (const f32x4*)(scr + (size_t)c * 64 * 256) + (lane & 15);
        const LAS float* ksw = KS + wave * 64 * 65;
        float y[64];
        const int n = quad * 4 + c;
        bf16* mats = (bf16*)P.out + (size_t)(bh * 64 + n) * 4 * 4096;
        bf16* mstep = mats + role * 4096 + (role ? lane : kpos(lane));
#pragma unroll 1
        for (int rep2 = 0; rep2 < REP_S2; ++rep2) {
            int ln = lane; asm volatile("" : "+v"(ln));
#pragma unroll
            for (int d = 0; d < 64; ++d) y[d] = (role == 0) ? ((d == ln) ? 1.f : 0.f) : ksw[ln * 65 + d];
            f32x4 XA[4], XB[4];
#pragma unroll
            for (int v = 0; v < 4; ++v) XA[v] = xb[v * 16];
            for (int t = 0; t < 64; t += 2) {
#pragma unroll
                for (int v = 0; v < 4; ++v) XB[v] = xb[(t + 1) * 64 + v * 16];
                rwkv_rstep(y, XA, t, role, lane, mstep);
                if (t + 2 < 64) {
#pragma unroll
                    for (int v = 0; v < 4; ++v) XA[v] = xb[(t + 2) * 64 + v * 16];
                }
                rwkv_rstep(y, XB, t + 1, role, lane, mstep);
            }
            RStep<0>::scale(y, XB[1]);
        }
        bf16* mend = mats + (role ? 2 : 3) * 4096 + (role ? lane : kpos(lane));
        LAS float* myr = KS + (wave * 64 + lane) * 65;
#pragma unroll
        for (int d = 0; d < 64; ++d) myr[d] = y[d];
#pragma unroll 1
        for (int d = 0; d < 64; ++d) mend[d * 64] = (bf16)f2bf(myr[d]);
    }
    __syncthreads();
}

DI void gla_prep_item(const Params& P, int item, LAS unsigned char* lds, int wave, int lane) {
    const int bh = item >> 6, n = item & 63, b = bh >> 2, h = bh & 3;
    const int tok0 = b * T + n * 64, hd = h * 64 + lane;
    const bf16* PROJ0 = (const bf16*)(P.ws + WS_PROJ0);
    LAS float* WT = (LAS float*)lds;
    LAS bf16* QEb = (LAS bf16*)(WT + 1024);
    LAS bf16* KEb = QEb + 64 * 72;
    LAS float* KL = (LAS float*)(KEb + 64 * 72);
    bf16* mats = (bf16*)(P.ws + WS_XN) + (size_t)(bh * 64 + n) * 3 * 4096;
    float* GDEC = (float*)(P.ws + WS_GDEC) + (size_t)(bh * 64 + n) * 64;
    float q8[8], k8[8]; u32x4 gl0[8], gl1[8];
#pragma unroll
    for (int i = 0; i < 8; ++i) { const bf16* row = PROJ0 + (size_t)(tok0 + wave * 8 + i) * N0P; q8[i] = bf2f(row[C_GQ + hd]) * 0.125f; k8[i] = bf2f(row[C_GK + hd]);
        gl0[i] = *(const u32x4*)(row + C_GLOW); gl1[i] = *(const u32x4*)(row + C_GLOW + 8); }
    float up[16];
#pragma unroll
    for (int r = 0; r < 16; ++r) up[r] = P.gk_up[r * 256 + hd];
    const float bias = P.gk_bias[hd];
    float bt[8]; float acc = 0.f;
#pragma unroll
    for (int i = 0; i < 8; ++i) { float xg = bias;
#pragma unroll
        for (int r = 0; r < 4; ++r) { xg = fmaf(bflo(gl0[i][r]), up[2 * r], xg); xg = fmaf(bfhi(gl0[i][r]), up[2 * r + 1], xg); }
#pragma unroll
        for (int r = 0; r < 4; ++r) { xg = fmaf(bflo(gl1[i][r]), up[8 + 2 * r], xg); xg = fmaf(bfhi(gl1[i][r]), up[8 + 2 * r + 1], xg); }
        acc += -softplus_f(-xg) * (1.f / 16.f); bt[i] = acc; }
    WT[wave * 64 + lane] = acc;
    if (wave == 4) WT[512 + lane] = bt[0];
    __syncthreads();
    float off = 0.f, off4 = 0.f, total = 0.f;
#pragma unroll
    for (int w2 = 0; w2 < 8; ++w2) { const float tv = WT[w2 * 64 + lane]; if (w2 < wave) off += tv; if (w2 < 4) off4 += tv; total += tv; }
    const float bref = off4 + WT[512 + lane], blast = total;
#pragma unroll
    for (int i = 0; i < 8; ++i) { const int t = wave * 8 + i; const float b_t = bt[i] + off;
        QEb[t * 72 + lane] = (bf16)f2bf(q8[i] * __expf(b_t - bref)); KEb[t * 72 + lane] = (bf16)f2bf(k8[i] * __expf(bref - b_t)); KL[t * 65 + lane] = k8[i] * __expf(blast - b_t);
        mats[t * 64 + kpos(lane)] = (bf16)f2bf(q8[i] * __expf(b_t)); }
    if (wave == 0) GDEC[lane] = __expf(blast);
    __syncthreads();
    if (wave < 4) {
        const int m = lane & 31, hi = lane >> 5, tb = wave >> 1, jb = wave & 1;
        f32x16 c;
#pragma unroll
        for (int r = 0; r < 16; ++r) c[r] = 0.f;
#pragma unroll
        for (int s = 0; s < 4; ++s) { const bf16x8 A = *(const LAS bf16x8*)(KEb + (32 * jb + m) * 72 + 16 * s + 8 * hi), Bq = *(const LAS bf16x8*)(QEb + (32 * tb + m) * 72 + 16 * s + 8 * hi); c = MFMA32(A, Bq, c); }
        const int t = 32 * tb + m;
#pragma unroll
        for (int g = 0; g < 4; ++g) { const int j0 = 32 * jb + 8 * g + 4 * hi; u32x2 w;
            w.x = pk2(j0 <= t ? c[4 * g] : 0.f, j0 + 1 <= t ? c[4 * g + 1] : 0.f); w.y = pk2(j0 + 2 <= t ? c[4 * g + 2] : 0.f, j0 + 3 <= t ? c[4 * g + 3] : 0.f);
            *(u32x2*)(mats + 4096 + t * 64 + j0) = w; }
    } else {
#pragma unroll
        for (int r = 0; r < 16; ++r) { const int d = (wave - 4) * 16 + r; mats[8192 + d * 64 + lane] = (bf16)f2bf(KL[lane * 65 + d]); }
    }
    __syncthreads();
}

constexpr int SQ_PITCH = 144, SQ_MAT = 64 * SQ_PITCH, SQ_VT = 4 * SQ_MAT, SQ_DEC = SQ_VT + 128 * SQ_PITCH, SQ_BUF = 57344;
template <bool DIAG>
DI void seq_pass(unsigned* prog, const bf16* mats, int nmat, const bf16* vsrc, int vpitch, const float* dec, bf16* outp, LAS unsigned char* lds, int tid, int wave, int lane) {
    const int m = lane & 31, hi = lane >> 5;
    f32x16 sacc[2];
#pragma unroll
    for (int i = 0; i < 16; ++i) { sacc[0][i] = 0.f; sacc[1][i] = 0.f; }
    const int st = tid - 256;
    struct StSet { u32x4 rm[8]; u32x4 rv[2]; float rdec; };
    const int v8 = st & 7, par = (st >> 3) & 1;
    constexpr int NMAT = DIAG ? 3 : 4;
    auto gload = [&](int n, StSet& S) {
        const bf16* mp = mats + (size_t)n * NMAT * 4096;
#pragma unroll
        for (int q = 0; q < 2 * NMAT; ++q) S.rm[q] = *(const u32x4*)(mp + (size_t)(st + 256 * q) * 8);
#pragma unroll
        for (int q = 0; q < 2; ++q) S.rv[q] = *(const u32x4*)(vsrc + (size_t)(n * 64 + (st >> 3) + 32 * q) * vpitch + 8 * v8);
        if (DIAG) S.rdec = dec[n * 64 + (st & 63)];
    };
    auto lstore = [&](int n, const StSet& S) {
        LAS unsigned char* B = lds + (n & 1) * SQ_BUF;
#pragma unroll
        for (int q = 0; q < 2 * NMAT; ++q) { const int idx = (st + 256 * q) & 511; *(LAS u32x4*)(B + (q >> 1) * SQ_MAT + (idx >> 3) * SQ_PITCH + (idx & 7) * 16) = S.rm[q]; }
#pragma unroll
        for (int q = 0; q < 2; ++q) {
            const int vt = (st >> 3) + 32 * q;
            const unsigned k0 = par ? S.rv[q][2] : S.rv[q][0], k1 = par ? S.rv[q][3] : S.rv[q][1], s0 = par ? S.rv[q][0] : S.rv[q][2], s1 = par ? S.rv[q][1] : S.rv[q][3];
            const unsigned r0 = (unsigned)__builtin_amdgcn_update_dpp(0, (int)s0, 0x128, 0xf, 0xf, true), r1 = (unsigned)__builtin_amdgcn_update_dpp(0, (int)s1, 0x128, 0xf, 0xf, true);
            unsigned o[4];
            if (par == 0) { o[0] = (k0 & 0xffffu) | (r0 << 16); o[1] = (k0 >> 16) | (r0 & 0xffff0000u); o[2] = (k1 & 0xffffu) | (r1 << 16); o[3] = (k1 >> 16) | (r1 & 0xffff0000u); }
            else          { o[0] = (r0 & 0xffffu) | (k0 << 16); o[1] = (r0 >> 16) | (k0 & 0xffff0000u); o[2] = (r1 & 0xffffu) | (k1 << 16); o[3] = (r1 >> 16) | (k1 & 0xffff0000u); }
            const int tp = vt >> 1, gsw = ((tp >> 2) ^ v8) & 7;
#pragma unroll
            for (int jj = 0; jj < 4; ++jj) *(LAS unsigned*)(B + SQ_VT + (8 * v8 + 4 * par + jj) * SQ_PITCH + (4 * gsw + (tp & 3)) * 4) = o[jj];
        }
        if (DIAG && st < 64) *(LAS float*)(B + SQ_DEC + st * 4) = S.rdec;
    };
    f32x16 o0, o1;
    bf16x8 sBp[2][2];
#pragma unroll
    for (int kb = 0; kb < 2; ++kb)
#pragma unroll
        for (int s = 0; s < 2; ++s) sBp[kb][s] = (bf16x8){0, 0, 0, 0, 0, 0, 0, 0};
    LAS unsigned char* SBX = lds + 2 * SQ_BUF;
    if (wave >= 2 && wave < 4) {
#pragma unroll
        for (int q = 0; q < 4; ++q) *(LAS bf16x8*)(SBX + (0 * 2 + (wave & 1)) * 4096 + lane * 64 + 16 * q) = sBp[q >> 1][q & 1];
    }
    auto compute = [&](int n, int bufi) {
        if (wave < 4) {
            const int vb = wave & 1; const bool upd = wave >= 2;
            const LAS unsigned char* B = lds + bufi * SQ_BUF;
            const int vrow = 32 * vb + m;
            const LAS unsigned char* Vr = B + SQ_VT + vrow * SQ_PITCH;
            const LAS unsigned char* Ar = B + m * SQ_PITCH + 16 * hi;
            bf16x8 Fa[2], Fb[2], Va, Vb;
#define SQ_LD(F, VB, k, MS, MV) do { if ((k) < 4) { const int co_ = (32 * ((k) >> 1) + 16 * ((k) & 1)) * 2; \
            F[0] = *(const LAS bf16x8*)(Ar + (MS) * SQ_MAT + co_); F[1] = *(const LAS bf16x8*)(Ar + (MS) * SQ_MAT + 32 * SQ_PITCH + co_); } \
        else { const int S4_ = (k) - 4, co_ = 32 * S4_; VB = *(const LAS bf16x8*)(Vr + (((2 * S4_ + hi) ^ (vrow >> 3)) & 7) * 16); \
            F[0] = *(const LAS bf16x8*)(Ar + (MV) * SQ_MAT + co_); F[1] = *(const LAS bf16x8*)(Ar + (MV) * SQ_MAT + 32 * SQ_PITCH + co_); } } while (0)
            if (!upd) {
                bf16x8 sB[2][2];
#pragma unroll
                for (int q = 0; q < 4; ++q) sB[q >> 1][q & 1] = *(const LAS bf16x8*)(SBX + ((n & 1) * 2 + vb) * 4096 + lane * 64 + 16 * q);
#pragma unroll
                for (int i = 0; i < 16; ++i) { o0[i] = 0.f; o1[i] = 0.f; }
#define SQ_MM(F, VB, k) do { const bf16x8 Bq_ = ((k) < 4) ? sB[(k) >> 1][(k) & 1] : VB; o0 = MFMA32(Bq_, F[0], o0); o1 = MFMA32(Bq_, F[1], o1); } while (0)
                SQ_LD(Fa, Va, 0, 0, 1); SQ_LD(Fb, Vb, 1, 0, 1);
                __builtin_amdgcn_sched_barrier(0);
                SQ_MM(Fa, Va, 0); SQ_LD(Fa, Va, 2, 0, 1); __builtin_amdgcn_sched_barrier(0);
                SQ_MM(Fb, Vb, 1); SQ_LD(Fb, Vb, 3, 0, 1); __builtin_amdgcn_sched_barrier(0);
                SQ_MM(Fa, Va, 2); SQ_LD(Fa, Va, 4, 0, 1); __builtin_amdgcn_sched_barrier(0);
                SQ_MM(Fb, Vb, 3); SQ_LD(Fb, Vb, 5, 0, 1); __builtin_amdgcn_sched_barrier(0);
                SQ_MM(Fa, Va, 4); SQ_LD(Fa, Va, 6, 0, 1); __builtin_amdgcn_sched_barrier(0);
                SQ_MM(Fb, Vb, 5); SQ_LD(Fb, Vb, 7, 0, 1); __builtin_amdgcn_sched_barrier(0);
                SQ_MM(Fa, Va, 6); SQ_MM(Fb, Vb, 7);
#undef SQ_MM
            } else {
                f32x16 n0, n1;
#pragma unroll
                for (int i = 0; i < 16; ++i) {
                    if (DIAG) { n0[i] = sacc[0][i] * *(const LAS float*)(B + SQ_DEC + crow(i, hi) * 4); n1[i] = sacc[1][i] * *(const LAS float*)(B + SQ_DEC + (32 + crow(i, hi)) * 4); }
                    else { n0[i] = 0.f; n1[i] = 0.f; } }
#define SQ_MM(F, VB, k) do { const bf16x8 Bq_ = ((k) < 4) ? sBp[(k) >> 1][(k) & 1] : VB; n0 = MFMA32(F[0], Bq_, n0); n1 = MFMA32(F[1], Bq_, n1); } while (0)
                if (!DIAG) {
                    SQ_LD(Fa, Va, 0, 3, 2); SQ_LD(Fb, Vb, 1, 3, 2);
                    __builtin_amdgcn_sched_barrier(0);
                    SQ_MM(Fa, Va, 0); SQ_LD(Fa, Va, 2, 3, 2); __builtin_amdgcn_sched_barrier(0);
                    SQ_MM(Fb, Vb, 1); SQ_LD(Fb, Vb, 3, 3, 2); __builtin_amdgcn_sched_barrier(0);
                    SQ_MM(Fa, Va, 2); SQ_LD(Fa, Va, 4, 3, 2); __builtin_amdgcn_sched_barrier(0);
                    SQ_MM(Fb, Vb, 3); SQ_LD(Fb, Vb, 5, 3, 2); __builtin_amdgcn_sched_barrier(0);
                } else {
                    SQ_LD(Fa, Va, 4, 3, 2); SQ_LD(Fb, Vb, 5, 3, 2);
                    __builtin_amdgcn_sched_barrier(0);
                }
                SQ_MM(Fa, Va, 4); SQ_LD(Fa, Va, 6, 3, 2); __builtin_amdgcn_sched_barrier(0);
                SQ_MM(Fb, Vb, 5); SQ_LD(Fb, Vb, 7, 3, 2); __builtin_amdgcn_sched_barrier(0);
                SQ_MM(Fa, Va, 6); SQ_MM(Fb, Vb, 7);
#undef SQ_MM
                sacc[0] = n0; sacc[1] = n1;
#pragma unroll
                for (int kb = 0; kb < 2; ++kb)
#pragma unroll
                    for (int s = 0; s < 2; ++s) { u32x4 w;
#pragma unroll
                        for (int e = 0; e < 4; ++e) w[e] = pk2(sacc[kb][8 * s + 2 * e], sacc[kb][8 * s + 2 * e + 1]);
                        sBp[kb][s] = __builtin_bit_cast(bf16x8, w);
                        *(LAS bf16x8*)(SBX + (((n + 1) & 1) * 2 + vb) * 4096 + lane * 64 + 16 * (2 * kb + s)) = sBp[kb][s]; }
            }
#undef SQ_LD
        }
    };
    auto store_out = [&](int n) {
        if (wave < 2) {
#pragma unroll
            for (int g = 0; g < 4; ++g) { bf16* op_ = outp + (size_t)(n * 64 + m) * 512 + 32 * wave + 8 * g + 4 * hi;
                u32x2 w0, w1; w0.x = pk2(o0[4 * g], o0[4 * g + 1]); w0.y = pk2(o0[4 * g + 2], o0[4 * g + 3]); w1.x = pk2(o1[4 * g], o1[4 * g + 1]); w1.y = pk2(o1[4 * g + 2], o1[4 * g + 3]);
                *(u32x2*)op_ = w0; *(u32x2*)(op_ + 32 * 512) = w1; }
        }
    };
    if (wave < 4) {
        lds_barrier();
#pragma unroll 1
        for (int n = 0; n < 64; ++n) { compute(n, n & 1); store_out(n); lds_barrier(); }
    } else {
        StSet A, Bs, C;
        gload(0, A); gload(1, Bs); gload(2, C);
        lstore(0, A); gload(3, A);
        lds_barrier();
#pragma unroll 1
        for (int k = 0; k < 60; k += 3) {
            if (st == 0) __hip_atomic_store(prog, (unsigned)(k + 4), __ATOMIC_RELAXED, __HIP_MEMORY_SCOPE_AGENT);
            lstore(k + 1, Bs); gload(k + 4, Bs); lds_barrier();
            lstore(k + 2, C); gload(k + 5, C); lds_barrier();
            lstore(k + 3, A); gload(k + 6, A); lds_barrier();
        }
        lstore(61, Bs); lds_barrier();
        lstore(62, C); lds_barrier();
        lstore(63, A); lds_barrier();
        lds_barrier();
    }
}
struct P3Src { const bf16* mats; int nmat; const bf16* vsrc; int vpitch; const float* dec; bf16* outp; };
DI P3Src p3_src(const Params& P, int bx) {
    P3Src s;
    if (bx < 32) { const int b = bx >> 3, h = bx & 7;
        s.mats = (const bf16*)P.out + (size_t)bx * 64 * 4 * 4096; s.nmat = 4; s.vsrc = (const bf16*)(P.ws + WS_VP) + (size_t)b * T * 512 + h * 64; s.vpitch = 512; s.dec = nullptr;
        s.outp = (bf16*)(P.ws + WS_SCR) + (size_t)b * T * 512 + h * 64; }
    else { const int g = bx - 32, bh = (g & 7) | ((g >> 4) << 3), vh = (g >> 3) & 1, b = bh >> 2, h = bh & 3;
        s.mats = (const bf16*)(P.ws + WS_XN) + (size_t)bh * 64 * 3 * 4096; s.nmat = 3; s.vsrc = (const bf16*)(P.ws + WS_PROJ0) + (size_t)b * T * N0P + C_GV + h * 128 + 64 * vh; s.vpitch = N0P;
        s.dec = (const float*)(P.ws + WS_GDEC) + (size_t)bh * 64 * 64; s.outp = (bf16*)(P.ws + WS_OARAW) + (size_t)b * T * 512 + h * 128 + 64 * vh; }
    return s;
}
DI void p3_seq(const Params& P, LAS unsigned char* lds, int tid, int wave, int lane) {
    const int bx = blockIdx.x;
    unsigned* progw = (unsigned*)(P.ws + WS_PROG);
    if (bx < 64) {
        const P3Src s = p3_src(P, bx);
        if (bx < 32) seq_pass<false>(progw + 16 * bx, s.mats, 4, s.vsrc, s.vpitch, nullptr, s.outp, lds, tid, wave, lane);
        else         seq_pass<true>(progw + 16 * bx, s.mats, 3, s.vsrc, s.vpitch, s.dec, s.outp, lds, tid, wave, lane);
    } else {
        const unsigned* xt = (const unsigned*)(P.ws + WS_XCCTAB);
        LAS unsigned* hs = (LAS unsigned*)lds;
        if (tid < 4) hs[tid] = 0u;
        __syncthreads();
        const unsigned myx = xt[bx];
        if (tid < 192) { const unsigned o = xt[64 + tid]; if (o == myx) { __hip_atomic_fetch_add(&hs[2], 1u, __ATOMIC_RELAXED, __HIP_MEMORY_SCOPE_WORKGROUP); if (64 + tid < bx) __hip_atomic_fetch_add(&hs[0], 1u, __ATOMIC_RELAXED, __HIP_MEMORY_SCOPE_WORKGROUP); } }
        if (tid >= 192 && tid < 256) { if (xt[tid - 192] == myx) { const unsigned slot = __hip_atomic_fetch_add(&hs[1], 1u, __ATOMIC_RELAXED, __HIP_MEMORY_SCOPE_WORKGROUP); hs[8 + slot] = (unsigned)(tid - 192); } }
        __syncthreads();
        const int rank = (int)hs[0], np = (int)hs[1], nh = (int)hs[2];
        unsigned pf0 = 0u;
        if (np > 0) {
            const int tgt = (int)hs[8 + (rank % np)];
            const int sub = rank / np, cnt = (nh - (rank % np) + np - 1) / np;
            const P3Src s = p3_src(P, tgt);
            const unsigned* pw = progw + 16 * tgt;
            const int nlm = s.nmat * 64;
            int pc = sub; unsigned spins = 0;
            while (pc < 64) {
                const int p = (int)__builtin_amdgcn_readfirstlane((int)__hip_atomic_load(pw, __ATOMIC_RELAXED, __HIP_MEMORY_SCOPE_AGENT));
                if (pc <= p + 8) {
                    const char* a = nullptr;
                    if (tid < nlm) a = (const char*)(s.mats + (size_t)pc * s.nmat * 4096) + (size_t)tid * 128;
                    else if (tid < nlm + 64) a = (const char*)(s.vsrc + (size_t)(pc * 64 + (tid - nlm)) * s.vpitch);
                    if (a) asm volatile("global_load_dword %0, %1, off" : "+v"(pf0) : "v"(a) : "memory");
                    pc += cnt;
                } else { __builtin_amdgcn_s_sleep(8); if (++spins > (1u << 16)) break; }
            }
        }
        asm volatile("s_waitcnt vmcnt(0)" : "+v"(pf0) :: "memory");
        __syncthreads();
    }
}

DI float silu_f(float g) { return g / (1.f + __expf(-g)); }
DI void p4_finalize(const Params& P, int wave, int lane) {
    const int gw = blockIdx.x * 8 + wave, NGW = gridDim.x * 8;
    const bf16* OB = (const bf16*)(P.ws + WS_SCR); const bf16* OA = (const bf16*)(P.ws + WS_OARAW);
    const bf16* PROJ0 = (const bf16*)(P.ws + WS_PROJ0); const bf16* VP = (const bf16*)(P.ws + WS_VP); const float* BON = (const float*)(P.ws + WS_BONUS);
    bf16* O0 = (bf16*)(P.ws + WS_XN);
    const int cv = (8 * lane) & 127;
    const f32x4 gw0 = *(const f32x4*)(P.gla_norm_w + cv), gw1 = *(const f32x4*)(P.gla_norm_w + cv + 4);
    const f32x4 lw0 = *(const f32x4*)(P.ln_w + 8 * lane), lw1 = *(const f32x4*)(P.ln_w + 8 * lane + 4), lb0 = *(const f32x4*)(P.ln_b + 8 * lane), lb1 = *(const f32x4*)(P.ln_b + 8 * lane + 4);
    struct Ld { f32x4 a0, a1, b0, b1; u32x4 ga, gb, vv; float bon; };
    auto load = [&](int tok) { Ld L; const bf16* row = PROJ0 + (size_t)tok * N0P + C_GATE0;
        { const u32x4 wa = *(const u32x4*)(OA + (size_t)tok * 512 + 8 * lane), wb = *(const u32x4*)(OB + (size_t)tok * 512 + 8 * lane);
          L.a0 = (f32x4){bflo(wa.x), bfhi(wa.x), bflo(wa.y), bfhi(wa.y)}; L.a1 = (f32x4){bflo(wa.z), bfhi(wa.z), bflo(wa.w), bfhi(wa.w)};
          L.b0 = (f32x4){bflo(wb.x), bfhi(wb.x), bflo(wb.y), bfhi(wb.y)}; L.b1 = (f32x4){bflo(wb.z), bfhi(wb.z), bflo(wb.w), bfhi(wb.w)}; }
        L.ga = *(const u32x4*)(row + 8 * lane); L.gb = *(const u32x4*)(row + 512 + 8 * lane); L.vv = *(const u32x4*)(VP + (size_t)tok * 512 + 8 * lane); L.bon = BON[(size_t)tok * 8 + (lane >> 3)]; return L; };
    Ld nx = load(gw < M ? gw : 0);
    for (int tok = gw; tok < M; tok += NGW) {
        const Ld L = nx;
        if (tok + NGW < M) nx = load(tok + NGW);
        {
            const f32x4 a0 = L.a0, a1 = L.a1;
            float ss = (a0[0] * a0[0] + a0[1] * a0[1]) + (a0[2] * a0[2] + a0[3] * a0[3]) + (a1[0] * a1[0] + a1[1] * a1[1]) + (a1[2] * a1[2] + a1[3] * a1[3]);
            ss += __shfl_xor(ss, 1); ss += __shfl_xor(ss, 2); ss += __shfl_xor(ss, 4); ss += __shfl_xor(ss, 8);
            const float rstd = 1.0f / sqrtf(ss * (1.f / 128.f) + NORM_EPS);
            const u32x4 g = L.ga;
            u32x4 o;
            o.x = pk2(a0[0] * rstd * gw0[0] * silu_f(bflo(g.x)), a0[1] * rstd * gw0[1] * silu_f(bfhi(g.x)));
            o.y = pk2(a0[2] * rstd * gw0[2] * silu_f(bflo(g.y)), a0[3] * rstd * gw0[3] * silu_f(bfhi(g.y)));
            o.z = pk2(a1[0] * rstd * gw1[0] * silu_f(bflo(g.z)), a1[1] * rstd * gw1[1] * silu_f(bfhi(g.z)));
            o.w = pk2(a1[2] * rstd * gw1[2] * silu_f(bflo(g.w)), a1[3] * rstd * gw1[3] * silu_f(bfhi(g.w)));
            *(u32x4*)(O0 + (size_t)tok * 1024 + 8 * lane) = o;
        }
        {
            const f32x4 a0 = L.b0, a1 = L.b1;
            float s = (a0[0] + a0[1]) + (a0[2] + a0[3]) + (a1[0] + a1[1]) + (a1[2] + a1[3]);
            s += __shfl_xor(s, 1); s += __shfl_xor(s, 2); s += __shfl_xor(s, 4);
            const float mean = s * (1.f / 64.f);
            const f32x4 d0 = a0 - mean, d1 = a1 - mean;
            float q = (d0[0] * d0[0] + d0[1] * d0[1]) + (d0[2] * d0[2] + d0[3] * d0[3]) + (d1[0] * d1[0] + d1[1] * d1[1]) + (d1[2] * d1[2] + d1[3] * d1[3]);
            q += __shfl_xor(q, 1); q += __shfl_xor(q, 2); q += __shfl_xor(q, 4);
            const float rstd = 1.0f / sqrtf(q * (1.f / 64.f) + RWKV_LN_EPS);
            const float bon = L.bon; const u32x4 vv = L.vv, g = L.gb;
            u32x4 o;
            o.x = pk2((d0[0] * rstd * lw0[0] + lb0[0] + bon * bflo(vv.x)) * silu_f(bflo(g.x)), (d0[1] * rstd * lw0[1] + lb0[1] + bon * bfhi(vv.x)) * silu_f(bfhi(g.x)));
            o.y = pk2((d0[2] * rstd * lw0[2] + lb0[2] + bon * bflo(vv.y)) * silu_f(bflo(g.y)), (d0[3] * rstd * lw0[3] + lb0[3] + bon * bfhi(vv.y)) * silu_f(bfhi(g.y)));
            o.z = pk2((d1[0] * rstd * lw1[0] + lb1[0] + bon * bflo(vv.z)) * silu_f(bflo(g.z)), (d1[1] * rstd * lw1[1] + lb1[1] + bon * bfhi(vv.z)) * silu_f(bfhi(g.z)));
            o.w = pk2((d1[2] * rstd * lw1[2] + lb1[2] + bon * bflo(vv.w)) * silu_f(bflo(g.w)), (d1[3] * rstd * lw1[3] + lb1[3] + bon * bfhi(vv.w)) * silu_f(bfhi(g.w)));
            *(u32x4*)(O0 + (size_t)tok * 1024 + 512 + 8 * lane) = o;
        }
    }
}
constexpr int AT_KP = 144, AT_VP = 528, AT_VOFF = 256 * AT_KP;
DI void rope_cs(const float* RT, int pos, float (&cs)[8], float (&sn)[8]) {
    const f32x4* tp = (const f32x4*)(RT + (size_t)pos * 16);
#pragma unroll
    for (int q = 0; q < 4; ++q) { const f32x4 v = tp[q]; cs[2 * q] = v[0]; sn[2 * q] = v[1]; cs[2 * q + 1] = v[2]; sn[2 * q + 1] = v[3]; }
}
DI void p7_attn(const Params& P, LAS unsigned char* lds, int tid, int wave, int lane) {
    const bf16* PROJ1 = (const bf16*)(P.ws + WS_SCR); bf16* O1 = (bf16*)(P.ws + WS_XN); const float* RT = (const float*)(P.ws + WS_ROPE);
    const int m = lane & 31, hi = lane >> 5;
    const int c8 = tid & 7, kpar = (tid >> 3) & 1;
    u32x4 kw[4], vw[4];
    auto uload = [&](int unit) {
        const int qb = unit & 31, kvh = (unit >> 5) & 3, b = unit >> 7;
#pragma unroll
        for (int q = 0; q < 4; ++q) { const int key = (tid >> 3) + 64 * q; const int pos = qb * 128 - 128 + key;
            kw[q] = (u32x4){0u, 0u, 0u, 0u}; vw[q] = (u32x4){0u, 0u, 0u, 0u};
            if (pos >= 0) { const bf16* row = PROJ1 + (size_t)(b * T + pos) * IN1; kw[q] = *(const u32x4*)(row + 1024 + kvh * 64 + 8 * c8); vw[q] = *(const u32x4*)(row + 1280 + kvh * 64 + 8 * c8); } }
    };
    if ((int)blockIdx.x < 512) uload(blockIdx.x);
    struct QG { u32x4 q[4], qo; u32x2 g[8]; };
    auto qgload = [&](int unit, int qq) { QG r; const int qb = unit & 31, kvh = (unit >> 5) & 3, b = unit >> 7; const int h = kvh * 4 + (wave >> 1);
        const int pos = qb * 128 + (wave & 1) * 64 + 32 * qq + m; const bf16* row = PROJ1 + ((size_t)b * T + pos) * IN1;
#pragma unroll
        for (int s = 0; s < 4; ++s) r.q[s] = *(const u32x4*)(row + h * 64 + 16 * s + 8 * hi);
        r.qo = *(const u32x4*)(row + h * 64 + 8 * (hi ^ 1));
#pragma unroll
        for (int db = 0; db < 2; ++db)
#pragma unroll
            for (int gq = 0; gq < 4; ++gq) r.g[4 * db + gq] = *(const u32x2*)(row + 1536 + h * 64 + 32 * db + 8 * gq + 4 * hi);
        return r; };
    QG nxq = qgload((int)blockIdx.x < 512 ? blockIdx.x : 0, 0);
    for (int unit = blockIdx.x; unit < 512; unit += gridDim.x) {
        const int qb = unit & 31, kvh = (unit >> 5) & 3, b = unit >> 7;
#pragma unroll
        for (int q = 0; q < 4; ++q) {
            const int key = (tid >> 3) + 64 * q; const int pos = qb * 128 - 128 + key;
            u32x4 kq = kw[q];
            if (c8 < 2 && pos >= 0) { const bf16* row = PROJ1 + (size_t)(b * T + pos) * IN1;
                const u32x4 ow = *(const u32x4*)(row + 1024 + kvh * 64 + 8 * (c8 ^ 1)); float a[8], o[8], cs[8], sn[8]; unpack8(kq, a); unpack8(ow, o); rope_cs(RT, pos, cs, sn);
                float r[8];
#pragma unroll
                for (int j = 0; j < 8; ++j) r[j] = (c8 == 0) ? (a[j] * cs[j] - o[j] * sn[j]) : (a[j] * cs[j] + o[j] * sn[j]);
                kq.x = pk2(r[0], r[1]); kq.y = pk2(r[2], r[3]); kq.z = pk2(r[4], r[5]); kq.w = pk2(r[6], r[7]); }
            *(LAS u32x4*)(lds + key * AT_KP + c8 * 16) = kq;
            const u32x4 rv = vw[q];
            const unsigned k0 = kpar ? rv[2] : rv[0], k1 = kpar ? rv[3] : rv[1], s0 = kpar ? rv[0] : rv[2], s1 = kpar ? rv[1] : rv[3];
            const unsigned r0 = (unsigned)__builtin_amdgcn_update_dpp(0, (int)s0, 0x128, 0xf, 0xf, true), r1 = (unsigned)__builtin_amdgcn_update_dpp(0, (int)s1, 0x128, 0xf, 0xf, true);
            unsigned o4[4];
            if (kpar == 0) { o4[0] = (k0 & 0xffffu) | (r0 << 16); o4[1] = (k0 >> 16) | (r0 & 0xffff0000u); o4[2] = (k1 & 0xffffu) | (r1 << 16); o4[3] = (k1 >> 16) | (r1 & 0xffff0000u); }
            else           { o4[0] = (r0 & 0xffffu) | (k0 << 16); o4[1] = (r0 >> 16) | (k0 & 0xffff0000u); o4[2] = (r1 & 0xffffu) | (k1 << 16); o4[3] = (r1 >> 16) | (k1 & 0xffff0000u); }
            const int tp = key >> 1, gsw = (tp >> 2) ^ c8;
#pragma unroll
            for (int jj = 0; jj < 4; ++jj) *(LAS unsigned*)(lds + AT_VOFF + (8 * c8 + 4 * kpar + jj) * AT_VP + (4 * gsw + (tp & 3)) * 4) = o4[jj];
        }
        lds_barrier();
        if (unit + (int)gridDim.x < 512) uload(unit + gridDim.x);
        const int g = wave >> 1, h = kvh * 4 + g; const float sink = P.sinks[h];
        for (int qq = 0; qq < 2; ++qq) {
            const int qs = (wave & 1) * 64 + 32 * qq, qi = qs + m, pos = qb * 128 + qi; const size_t tok = (size_t)b * T + pos;
            const QG cq = nxq;
            { const int nu = (qq == 0) ? unit : unit + (int)gridDim.x; if (nu < 512) nxq = qgload(nu, qq ^ 1); }
            bf16x8 Q[4];
#pragma unroll
            for (int s = 0; s < 4; ++s) { const u32x4 w = cq.q[s]; float a[8]; unpack8(w, a);
                if (s == 0) { const u32x4 ow = cq.qo; float o[8], cs[8], sn[8]; unpack8(ow, o); rope_cs(RT, pos, cs, sn);
#pragma unroll
                    for (int j = 0; j < 8; ++j) a[j] = (hi == 0) ? (a[j] * cs[j] - o[j] * sn[j]) : (a[j] * cs[j] + o[j] * sn[j]); }
                u32x4 qw;
#pragma unroll
                for (int e = 0; e < 4; ++e) qw[e] = pk2(a[2 * e] * 0.125f, a[2 * e + 1] * 0.125f);
                Q[s] = __builtin_bit_cast(bf16x8, qw); }
            const int kb0 = qs >> 5;
            f32x16 sc[5];
#pragma unroll
            for (int kbi = 0; kbi < 5; ++kbi) {
#pragma unroll
                for (int i = 0; i < 16; ++i) sc[kbi][i] = 0.f;
#pragma unroll
                for (int s = 0; s < 4; ++s) { const bf16x8 A = *(const LAS bf16x8*)(lds + (32 * (kb0 + kbi) + m) * AT_KP + (16 * s + 8 * hi) * 2); sc[kbi] = MFMA32(A, Q[s], sc[kbi]); }
            }
            float mx = sink;
#pragma unroll
            for (int kbi = 0; kbi < 5; ++kbi)
#pragma unroll
                for (int i = 0; i < 16; ++i) { const int kj = 32 * (kb0 + kbi) + crow(i, hi);
                    const bool band = (kbi == 0) ? (kj >= qi + 1) : ((kbi == 4) ? (kj <= qi + 128) : true); const bool vis = band && (qb > 0 || kj >= 128);
                    sc[kbi][i] = vis ? sc[kbi][i] : -1e30f; mx = fmaxf(mx, sc[kbi][i]); }
            mx = fmaxf(mx, __shfl_xor(mx, 32));
            float sum = 0.f;
#pragma unroll
            for (int kbi = 0; kbi < 5; ++kbi)
#pragma unroll
                for (int i = 0; i < 16; ++i) { const float pv = __expf(sc[kbi][i] - mx); sc[kbi][i] = pv; sum += pv; }
            sum += __shfl_xor(sum, 32);
            const float inv = 1.f / (sum + __expf(sink - mx));
            f32x16 oacc[2];
#pragma unroll
            for (int db = 0; db < 2; ++db) {
#pragma unroll
                for (int i = 0; i < 16; ++i) oacc[db][i] = 0.f;
                const int vrow = 32 * db + m, rsw = (vrow >> 3) & 7;
#pragma unroll
                for (int kbi = 0; kbi < 5; ++kbi)
#pragma unroll
                    for (int s2 = 0; s2 < 2; ++s2) { u32x4 pw;
#pragma unroll
                        for (int e = 0; e < 4; ++e) pw[e] = pk2(sc[kbi][8 * s2 + 2 * e], sc[kbi][8 * s2 + 2 * e + 1]);
                        const int ga = 4 * (kb0 + kbi) + 2 * s2;
                        const LAS unsigned char* vp = lds + AT_VOFF + vrow * AT_VP + 8 * hi;
                        const u32x2 lo = *(const LAS u32x2*)(vp + (ga ^ rsw) * 16), hi2 = *(const LAS u32x2*)(vp + ((ga + 1) ^ rsw) * 16);
                        const u32x4 aw = (u32x4){lo.x, lo.y, hi2.x, hi2.y};
                        oacc[db] = MFMA32(__builtin_bit_cast(bf16x8, aw), __builtin_bit_cast(bf16x8, pw), oacc[db]); }
            }
#pragma unroll
            for (int db = 0; db < 2; ++db)
#pragma unroll
                for (int gq = 0; gq < 4; ++gq) { const int d0 = 32 * db + 8 * gq + 4 * hi; const u32x2 gw = cq.g[4 * db + gq];
                    u32x2 o; o.x = pk2(oacc[db][4 * gq] * inv * silu_f(bflo(gw.x)), oacc[db][4 * gq + 1] * inv * silu_f(bfhi(gw.x)));
                    o.y = pk2(oacc[db][4 * gq + 2] * inv * silu_f(bflo(gw.y)), oacc[db][4 * gq + 3] * inv * silu_f(bfhi(gw.y)));
                    *(u32x2*)(O1 + tok * 1024 + h * 64 + d0) = o; }
        }
        lds_barrier();
    }
}
DI void p9_final(const Params& P, int wave, int lane) {
    const int gw = blockIdx.x * 8 + wave, NGW = gridDim.x * 8;
    const float* slots = (const float*)(P.ws + WS_SLOT2);
    for (int mrow = gw; mrow < M; mrow += NGW) {
        float s = (lane < 16) ? slots[(size_t)mrow * 16 + lane] : 0.f;
        s += __shfl_xor(s, 1); s += __shfl_xor(s, 2); s += __shfl_xor(s, 4); s += __shfl_xor(s, 8);
        s = __shfl(s, 0);
        const float rstd = 1.0f / sqrtf(s * (1.f / 1024.f) + NORM_EPS);
        f32x4* o = (f32x4*)(P.out + (size_t)mrow * D) + lane; const f32x4* w = (const f32x4*)P.final_w + lane;
#pragma unroll
        for (int j = 0; j < 4; ++j) { const f32x4 v = o[64 * j]; o[64 * j] = v * rstd * w[64 * j]; }
    }
}

__global__ void __launch_bounds__(512) fwd_megakernel(Params P) {
    extern __shared__ __attribute__((aligned(16))) unsigned char lds_raw[];
    LAS unsigned char* lds = (LAS unsigned char*)lds_raw;
    cg::grid_group grid = cg::this_grid();
    const int tid = threadIdx.x, lane = tid & 63, wave = __builtin_amdgcn_readfirstlane(tid >> 6);
    const int G = gridDim.x;
    if (tid < 2) ((LAS unsigned*)(lds + LDS_BAR_OFF))[tid] = 0u;
    __syncthreads();
    if (tid == 0) ((unsigned*)(P.ws + WS_XCCTAB))[blockIdx.x] = xb_xcc_id() + 1u;
    const XcdBarrier xbar = xcd_barrier_post((unsigned*)(P.ws + WS_CTL), (volatile LAS unsigned*)(lds + LDS_BAR_OFF));
    bf16* XN = (bf16*)(P.ws + WS_XN);
    p0_prologue(P, lds, wave, lane);
    if (P.ws == nullptr) grid.sync();
    xcd_barrier(xbar);
    { pg8::Gemm g{XN, (const bf16*)(P.ws + WS_W0T), M, N0P, D}; pg8::StaticOrder S; S.init(M, N0P, G, (int)blockIdx.x);
      EpiScaleBf16 E{(bf16*)(P.ws + WS_PROJ0), N0P, nullptr, nullptr, 0};
      pg8::gemm_phase<EpiScaleBf16, pg8::StaticOrder, true, true>(lds, g, S, E); }
    xcd_barrier(xbar);
#pragma unroll 1
    for (int rep = 0; rep < REP_P2R; ++rep) { for (int it = blockIdx.x; it < 512; it += G) rwkv_prep_item(P, it, lds, wave, lane); }
#pragma unroll 1
    for (int rep = 0; rep < REP_P2G; ++rep) { for (int it = blockIdx.x; it < 1024; it += G) gla_prep_item(P, it, lds, wave, lane); }
    xcd_barrier(xbar);
#pragma unroll 1
    for (int rep = 0; rep < REP_P3; ++rep) { p3_seq(P, lds, tid, wave, lane); __syncthreads(); }
    xcd_barrier(xbar);
    p4_finalize(P, wave, lane);
    xcd_barrier(xbar);
    { pg8::Gemm g{XN, (const bf16*)(P.ws + WS_WO0T), M, D, D}; pg8::StaticOrder S; S.init(M, D, G, (int)blockIdx.x);
      EpiResid E{P.x, (bf16*)(P.ws + WS_H1B), (float*)(P.ws + WS_SLOT1)};
      pg8::gemm_phase<EpiResid, pg8::StaticOrder, true, true>(lds, g, S, E); }
    xcd_barrier(xbar);
    { pg8::Gemm g{(const bf16*)(P.ws + WS_H1B), (const bf16*)(P.ws + WS_W1T), M, IN1, D}; pg8::StaticOrder S; S.init(M, IN1, G, (int)blockIdx.x);
      EpiScaleBf16 E{(bf16*)(P.ws + WS_SCR), IN1, (const float*)(P.ws + WS_SLOT1), P.b_in1, 1536};
      pg8::gemm_phase<EpiScaleBf16, pg8::StaticOrder, true, true>(lds, g, S, E); }
    xcd_barrier(xbar);
    p7_attn(P, lds, tid, wave, lane);
    xcd_barrier(xbar);
    { pg8::Gemm g{XN, (const bf16*)(P.ws + WS_WO1T), M, D, D}; pg8::StaticOrder S; S.init(M, D, G, (int)blockIdx.x);
      EpiResidNorm E{(const bf16*)(P.ws + WS_H1B), P.out, P.b_out1, P.final_w, (float*)(P.ws + WS_SLOT2), (unsigned*)(P.ws + WS_PCNT)};
      pg8::gemm_phase<EpiResidNorm, pg8::StaticOrder, false, true>(lds, g, S, E); }
}

extern "C" void kernel_launch(void* const* d_in, const int* in_sizes, int n_in, void* d_out, int out_size, void* d_ws, size_t ws_size, hipStream_t stream) {
    static int grid = 0;
    if (grid == 0) {
        if (n_in != 23 || out_size != M * D || ws_size < WS_END) { fprintf(stderr, "kernel_launch: unexpected sizes n_in %d out %d ws %zu\n", n_in, out_size, ws_size); grid = -1; return; }
        int dev = 0, cus = 0, per_cu = 0;
        hipGetDevice(&dev); hipDeviceGetAttribute(&cus, hipDeviceAttributeMultiprocessorCount, dev);
        hipFuncSetAttribute((const void*)fwd_megakernel, hipFuncAttributeMaxDynamicSharedMemorySize, LDS_BYTES);
        hipOccupancyMaxActiveBlocksPerMultiprocessor(&per_cu, (const void*)fwd_megakernel, 512, LDS_BYTES);
        if (per_cu < 1) { fprintf(stderr, "kernel_launch: occupancy query says %d blocks/CU\n", per_cu); per_cu = 1; }
        grid = cus * 1;
        if (grid != 256) { fprintf(stderr, "kernel_launch: built for a 256-CU device (got %d)\n", cus); grid = -1; return; }
        (void)hipGetLastError();
    }
    if (grid < 0) return;
    Params p{};
    const float** pp = (const float**)&p;
    for (int i = 0; i < 23; ++i) pp[i] = (const float*)d_in[i];
    p.out = (float*)d_out; p.ws = (unsigned char*)d_ws;
    if (hipMemsetAsync((char*)d_ws + WS_CTL, 0, CTL_BYTES, stream) != hipSuccess) { fprintf(stderr, "memset failed\n"); return; }
    void* args[] = {&p};
    hipError_t e = hipLaunchCooperativeKernel((const void*)fwd_megakernel, dim3(grid), dim3(512), args, LDS_BYTES, stream);
    if (e != hipSuccess) fprintf(stderr, "cooperative launch failed: %s (grid %d)\n", hipGetErrorString(e), grid);
}
```

```cpp
#include <hip/hip_runtime.h>
#include <hip/hip_cooperative_groups.h>
#include <cstdio>
#include <cstdint>
namespace cg = cooperative_groups;
#ifndef REP_P2R
#define REP_P2R 1
#endif
#ifndef REP_P2G
#define REP_P2G 1
#endif
#ifndef REP_S2
#define REP_S2 1
#endif
#ifndef REP_P3
#define REP_P3 1
#endif
namespace pg8 {
#define PG8_LAS __attribute__((address_space(3)))
typedef unsigned short bf16_t;
typedef short bf16x8 __attribute__((ext_vector_type(8)));
typedef float f32x4 __attribute__((ext_vector_type(4)));
typedef unsigned u32x4 __attribute__((ext_vector_type(4)));
constexpr int BM = 256, BK = 64, HALF = 128, HTB = HALF * BK * 2  , STAGE_BYTES = 8 * HTB, NXCD = 8, WGM = 8;

__host__ __device__ __forceinline__ int lds_byte(int r, int c) { const int st = (r >> 4) * 2 + (c >> 5), rr = r & 15, cc = c & 31, ob = rr * 64 + cc * 2; return st * 1024 + (ob ^ (((ob >> 9) & 1) << 5)); }
__host__ __device__ __forceinline__ void stage_rc(int b, int& R, int& C) { const int st = b / 1024, sb = b % 1024, swz = sb ^ (((sb >> 9) & 1) << 5); R = (st >> 1) * 16 + swz / 64; C = (st & 1) * 32 + (swz % 64) / 2; }
__host__ __device__ __forceinline__ int perm32(int rho) { const int n = rho >> 4, i = rho & 15; return 8 * (i >> 2) + 4 * n + (i & 3); }

struct Unit { int pm, pn; };
struct Gemm { const bf16_t* A; const bf16_t* Bt; int M, N, K; };

struct StaticOrder {
    int nM, nN, nwg, G, c;
    __host__ __device__ void init(int M, int N, int G_, int c_) { nM = M / BM; nN = N / BM; nwg = nM * nN; G = G_; c = c_; }
    __host__ __device__ bool next(int i, Unit& u) const {
        const long L = (long)i * G + c; if (L >= nwg) return false;
        int wgid = (int)L; { const int q = nwg / NXCD, r = nwg % NXCD, xcd = wgid % NXCD, off = wgid / NXCD; wgid = (xcd < r ? xcd * (q + 1) : r * (q + 1) + (xcd - r) * q) + off; }
        const int nig = WGM * nN, gid = wgid / nig, fm = gid * WGM, gsz = (nM - fm) < WGM ? (nM - fm) : WGM;
        u.pm = fm + ((wgid % nig) % gsz); u.pn = (wgid % nig) / gsz; return true;
    }
    __device__ __forceinline__ void a_ready(const Unit&) const {}
    __device__ __forceinline__ void done(const Unit&) const {}
};

template <class Epi, class Sched, bool ALIGN_EPI = false, bool SP2 = false>
__device__ __forceinline__ void gemm_phase(PG8_LAS unsigned char* lds, const Gemm g, const Sched& S, const Epi& E) {
    const int tid = threadIdx.x, wid = __builtin_amdgcn_readfirstlane(tid >> 6), lane = tid & 63, wr = wid >> 2, wc = wid & 3, fr = lane & 15, fq = lane >> 4;
    const int K = g.K, nt = K / BK;
    unsigned voffA[2], voffB[2];
#pragma unroll
    for (int i = 0; i < 2; ++i) { int R, C; stage_rc(tid * 16 + i * 8192, R, C); const int Rb = Epi::PERM ? ((R & ~31) + perm32(R & 31)) : R;
        voffA[i] = (unsigned)(R * K + C) * 2u; voffB[i] = (unsigned)(Rb * K + C) * 2u; }
    const size_t kstep = (size_t)(BK * 2);
    const size_t hstep = (size_t)HALF * K * 2;
    const size_t tstep = 2 * hstep;
    const unsigned ldsw = (unsigned)wid * 1024u;
    const int aoff = lds_byte(wr * 64 + fr, fq * 8), boff = lds_byte(wc * 32 + fr, fq * 8);
#define PG8_SA(b, h) (((b) * 2 + (h)) * HTB)
#define PG8_SB(b, h) ((4 + (b) * 2 + (h)) * HTB)
#define PG8_STAGE(bufoff, gbase, voff) do { _Pragma("unroll") for (int _i = 0; _i < 2; ++_i) \
        __builtin_amdgcn_global_load_lds((const unsigned*)((const char*)(gbase) + (voff)[_i]), (PG8_LAS unsigned*)(lds + (bufoff) + ldsw + _i * 8192), 16, 0, 0); } while (0)
#define PG8_LDA(dst, b, h) do { _Pragma("unroll") for (int m = 0; m < 4; ++m) _Pragma("unroll") for (int k = 0; k < 2; ++k) dst[m][k] = *(const PG8_LAS bf16x8*)(lds + PG8_SA(b, h) + aoff + m * 2048 + k * 1024); } while (0)
#define PG8_LDB(dst, b, h) do { _Pragma("unroll") for (int n = 0; n < 2; ++n) _Pragma("unroll") for (int k = 0; k < 2; ++k) dst[n][k] = *(const PG8_LAS bf16x8*)(lds + PG8_SB(b, h) + boff + n * 2048 + k * 1024); } while (0)
#define PG8_MMA(ai, bj, At, Bt) do { __builtin_amdgcn_s_setprio(1); _Pragma("unroll") for (int m = 0; m < 4; ++m) _Pragma("unroll") for (int n = 0; n < 2; ++n) _Pragma("unroll") for (int k = 0; k < 2; ++k) \
        acc[ai][bj][m][n] = __builtin_amdgcn_mfma_f32_16x16x32_bf16(Bt[n][k], At[m][k], acc[ai][bj][m][n], 0, 0, 0); __builtin_amdgcn_s_setprio(0); } while (0)
#define PG8_WAIT_V(n) asm volatile("s_waitcnt vmcnt(" #n ")" ::: "memory")
#define PG8_WAIT_L(n) asm volatile("s_waitcnt lgkmcnt(" #n ")" ::: "memory")
#define PG8_BAR __builtin_amdgcn_s_barrier()
#define PG8_SCHED __builtin_amdgcn_sched_barrier(0)
    Unit cur, nxt; int ui = 0;
    if (!S.next(0, cur)) return;
    f32x4 acc[2][2][4][2];
#pragma unroll
    for (int a = 0; a < 2; ++a)
#pragma unroll
        for (int b = 0; b < 2; ++b)
#pragma unroll
            for (int m = 0; m < 4; ++m)
#pragma unroll
                for (int n = 0; n < 2; ++n) acc[a][b][m][n] = (f32x4){0.f, 0.f, 0.f, 0.f};
    bf16x8 At[4][2], B0[2][2], B1[2][2];
    const char* cA = (const char*)g.A + (size_t)cur.pm * tstep; const char* cB = (const char*)g.Bt + (size_t)cur.pn * tstep;
    S.a_ready(cur);
    if constexpr (SP2) {
        PG8_STAGE(PG8_SB(0, 0), cB, voffB); PG8_STAGE(PG8_SB(0, 1), cB + hstep, voffB); PG8_STAGE(PG8_SA(0, 0), cA, voffA); PG8_STAGE(PG8_SA(0, 1), cA + hstep, voffA);
        if (wr == 1) PG8_BAR;
        PG8_WAIT_V(2); PG8_BAR;
        PG8_STAGE(PG8_SB(1, 0), cB + kstep, voffB); PG8_STAGE(PG8_SA(1, 0), cA + kstep, voffA); PG8_STAGE(PG8_SB(1, 1), cB + hstep + kstep, voffB);
        PG8_WAIT_V(6); PG8_BAR;
    } else {
        PG8_STAGE(PG8_SB(0, 0), cB, voffB); PG8_STAGE(PG8_SA(0, 0), cA, voffA); PG8_STAGE(PG8_SB(0, 1), cB + hstep, voffB); PG8_STAGE(PG8_SA(0, 1), cA + hstep, voffA);
        if (wr == 1) PG8_BAR;
        PG8_WAIT_V(4); PG8_BAR;
        PG8_STAGE(PG8_SB(1, 0), cB + kstep, voffB); PG8_STAGE(PG8_SA(1, 0), cA + kstep, voffA); PG8_STAGE(PG8_SB(1, 1), cB + hstep + kstep, voffB);
        PG8_WAIT_V(6); PG8_BAR;
    }
    for (;;) {
        const bool has_next = S.next(ui + 1, nxt);
        const char* nA = has_next ? (const char*)g.A + (size_t)nxt.pm * tstep : cA; const char* nB = has_next ? (const char*)g.Bt + (size_t)nxt.pn * tstep : cB;
        for (int t = 0; t < nt; t += 2) {
            const bool last = (t == nt - 2);
            const char* a1 = cA + (size_t)(t + 1) * kstep;
            const char* a2 = last ? nA : cA + (size_t)(t + 2) * kstep; const char* b2 = last ? nB : cB + (size_t)(t + 2) * kstep;
            const char* a3 = a2 + kstep; const char* b3 = b2 + kstep;
            if (last && has_next) S.a_ready(nxt);
            if constexpr (SP2) {
            PG8_LDB(B0, 0, 0); PG8_LDB(B1, 0, 1); PG8_SCHED; PG8_LDA(At, 0, 0); PG8_STAGE(PG8_SA(1, 1), a1 + hstep, voffA);
            PG8_WAIT_V(8); PG8_WAIT_L(0); PG8_BAR; PG8_MMA(0, 0, At, B0); PG8_MMA(0, 1, At, B1); PG8_BAR; PG8_SCHED;
            PG8_LDA(At, 0, 1); PG8_STAGE(PG8_SB(0, 0), b2, voffB); PG8_STAGE(PG8_SB(0, 1), b2 + hstep, voffB); PG8_STAGE(PG8_SA(0, 0), a2, voffA);
            PG8_WAIT_V(8); PG8_WAIT_L(0); PG8_BAR; PG8_MMA(1, 0, At, B0); PG8_MMA(1, 1, At, B1); PG8_BAR; PG8_SCHED;
            PG8_LDB(B0, 1, 0); PG8_LDB(B1, 1, 1); PG8_SCHED; PG8_LDA(At, 1, 0); PG8_STAGE(PG8_SA(0, 1), a2 + hstep, voffA);
            PG8_WAIT_V(8); PG8_WAIT_L(0); PG8_BAR; PG8_MMA(0, 0, At, B0); PG8_MMA(0, 1, At, B1); PG8_BAR; PG8_SCHED;
            PG8_LDA(At, 1, 1); PG8_STAGE(PG8_SB(1, 0), b3, voffB); PG8_STAGE(PG8_SB(1, 1), b3 + hstep, voffB); PG8_STAGE(PG8_SA(1, 0), a3, voffA);
            PG8_WAIT_V(8); PG8_WAIT_L(0); PG8_BAR; PG8_MMA(1, 0, At, B0); PG8_MMA(1, 1, At, B1); PG8_BAR; PG8_SCHED;
            } else {
            PG8_LDB(B0, 0, 0); PG8_SCHED; PG8_LDA(At, 0, 0); PG8_STAGE(PG8_SA(1, 1), a1 + hstep, voffA);
            PG8_WAIT_L(8); PG8_BAR; PG8_WAIT_L(0); PG8_MMA(0, 0, At, B0); PG8_BAR; PG8_SCHED;
            PG8_LDB(B1, 0, 1); PG8_STAGE(PG8_SB(0, 0), b2, voffB);
            PG8_BAR; PG8_WAIT_L(0); PG8_MMA(0, 1, At, B1); PG8_BAR;
            PG8_LDA(At, 0, 1); PG8_STAGE(PG8_SA(0, 0), a2, voffA);
            PG8_BAR; PG8_WAIT_L(0); PG8_MMA(1, 0, At, B0); PG8_BAR; PG8_SCHED;
            PG8_STAGE(PG8_SB(0, 1), b2 + hstep, voffB);
            PG8_WAIT_V(6); PG8_BAR; PG8_MMA(1, 1, At, B1); PG8_BAR;
            PG8_LDB(B0, 1, 0); PG8_SCHED; PG8_LDA(At, 1, 0); PG8_STAGE(PG8_SA(0, 1), a2 + hstep, voffA);
            PG8_WAIT_L(8); PG8_BAR; PG8_WAIT_L(0); PG8_MMA(0, 0, At, B0); PG8_BAR; PG8_SCHED;
            PG8_LDB(B1, 1, 1); PG8_STAGE(PG8_SB(1, 0), b3, voffB);
            PG8_BAR; PG8_WAIT_L(0); PG8_MMA(0, 1, At, B1); PG8_BAR;
            PG8_LDA(At, 1, 1); PG8_STAGE(PG8_SA(1, 0), a3, voffA);
            PG8_BAR; PG8_WAIT_L(0); PG8_MMA(1, 0, At, B0); PG8_BAR; PG8_SCHED;
            PG8_STAGE(PG8_SB(1, 1), b3 + hstep, voffB);
            PG8_WAIT_V(6); PG8_BAR; PG8_MMA(1, 1, At, B1); PG8_BAR;
            }
        }
        if constexpr (ALIGN_EPI) { if (wr == 0) PG8_BAR; }
        if constexpr (!Epi::AFTER_DRAIN) { E(acc, cur, wr, wc, fr, fq); S.done(cur); }
        if (!has_next) break;
#pragma unroll
        for (int a = 0; a < 2; ++a)
#pragma unroll
            for (int b = 0; b < 2; ++b)
#pragma unroll
                for (int m = 0; m < 4; ++m)
#pragma unroll
                    for (int n = 0; n < 2; ++n) acc[a][b][m][n] = (f32x4){0.f, 0.f, 0.f, 0.f};
        cur = nxt; cA = nA; cB = nB; ++ui;
        if constexpr (ALIGN_EPI) { if (wr == 1) PG8_BAR; }
    }
    PG8_WAIT_V(0);
    if constexpr (!ALIGN_EPI) { if (wr == 0) PG8_BAR; }
    PG8_BAR;
    if constexpr (Epi::AFTER_DRAIN) { E.fused(acc, cur, wr, wc, fr, fq, lds, wid, lane); S.done(cur); }
#undef PG8_SA
#undef PG8_SB
#undef PG8_STAGE
#undef PG8_LDA
#undef PG8_LDB
#undef PG8_MMA
#undef PG8_WAIT_V
#undef PG8_WAIT_L
#undef PG8_BAR
#undef PG8_SCHED
}
}
#define GAS __attribute__((address_space(1)))
#define LAS __attribute__((address_space(3)))
#define AS4 __attribute__((address_space(4)))
#define DI __device__ __forceinline__
typedef unsigned short bf16;
typedef float f32x4 __attribute__((ext_vector_type(4)));
typedef float f32x16 __attribute__((ext_vector_type(16)));
typedef short bf16x8 __attribute__((ext_vector_type(8)));
typedef short s16x4 __attribute__((ext_vector_type(4)));
typedef unsigned u32x4 __attribute__((ext_vector_type(4)));
typedef unsigned u32x2 __attribute__((ext_vector_type(2)));
typedef __bf16 bf2v __attribute__((ext_vector_type(2)));

constexpr int NB = 4, T = 4096, M = NB * T, D = 1024;
constexpr int IN0 = 3728, N0P = 3840, IN1 = 2560;
constexpr int C_GQ = 0, C_GK = 256, C_GV = 512, C_GLOW = 1024, C_RW = 1040, C_GATE0 = 2704;
constexpr int C_RR = C_RW, C_RK = C_RW + 512, C_RV = C_RW + 1024, C_XW = C_RW + 1536, C_XA = C_RW + 1600;
constexpr float NORM_EPS = 1e-5f, RWKV_LN_EPS = 64e-5f;
constexpr size_t MiB = 1u << 20;
constexpr size_t WS_W0T = 0, WS_WO0T = 8 * MiB, WS_W1T = 10 * MiB, WS_WO1T = 15 * MiB;
constexpr size_t WS_SLOT1 = 17 * MiB, WS_SLOT2 = 18 * MiB, WS_BONUS = 19 * MiB, WS_GDEC = 19 * MiB + 512 * 1024;
constexpr size_t WS_CTL = 19 * MiB + 768 * 1024, CTL_BYTES = 40960, WS_PCNT = WS_CTL + 16384;
constexpr size_t WS_XCCTAB = WS_CTL + 32768, WS_PROG = WS_CTL + 33792;
constexpr int LDS_BAR_OFF = 147456 - 64;
constexpr size_t WS_ROPE = 18 * MiB + 512 * 1024;
constexpr size_t WS_WLT = 18 * MiB + 768 * 1024;
constexpr size_t WS_XN = 20 * MiB;
constexpr size_t WS_PROJ0 = 52 * MiB;
constexpr size_t WS_H1B = 116 * MiB;
constexpr size_t WS_SCR = 172 * MiB;
constexpr size_t WS_OARAW = 204 * MiB;
constexpr size_t WS_VP = 236 * MiB;
constexpr size_t WS_END = 252 * MiB;
constexpr int LDS_BYTES = 147456;

struct Params {
    const float *x, *norm_w, *w_in0, *gk_up, *gk_bias, *gla_norm_w, *mu, *w0, *w_up, *a0, *a_up, *k_k, *k_a, *r_k, *ln_w, *ln_b, *w_out0, *w_in1, *b_in1, *sinks, *w_out1, *b_out1, *final_w;
    float* out; unsigned char* ws;
};

typedef float f32x2v __attribute__((ext_vector_type(2)));
DI unsigned pk2(float lo, float hi) { const f32x2v f = {lo, hi}; return __builtin_bit_cast(unsigned, __builtin_convertvector(f, bf2v)); }
DI unsigned f2bf(float f) { return pk2(f, 0.f) & 0xffffu; }
DI float bf2f(unsigned h) { return __builtin_bit_cast(float, h << 16); }
DI float bflo(unsigned w) { return __builtin_bit_cast(float, w << 16); }
DI float bfhi(unsigned w) { return __builtin_bit_cast(float, w & 0xffff0000u); }
DI float wave_sum(float v) {
#pragma unroll
    for (int o = 1; o < 64; o <<= 1) v += __shfl_xor(v, o);
    return v;
}
DI float dpp_sum16(float v) {
    v += __builtin_bit_cast(float, __builtin_amdgcn_update_dpp(0, __builtin_bit_cast(int, v), 0xB1, 0xf, 0xf, true));
    v += __builtin_bit_cast(float, __builtin_amdgcn_update_dpp(0, __builtin_bit_cast(int, v), 0x4E, 0xf, 0xf, true));
    v += __builtin_bit_cast(float, __builtin_amdgcn_update_dpp(0, __builtin_bit_cast(int, v), 0x141, 0xf, 0xf, true));
    v += __builtin_bit_cast(float, __builtin_amdgcn_update_dpp(0, __builtin_bit_cast(int, v), 0x140, 0xf, 0xf, true));
    return v;
}
DI float half_sum32(float v) { v = dpp_sum16(v); return v + __shfl_xor(v, 16); }
DI void unpack8(const u32x4 w, float (&f)[8]) {
#pragma unroll
    for (int e = 0; e < 4; ++e) { f[2 * e] = bflo(w[e]); f[2 * e + 1] = bfhi(w[e]); }
}
DI int crow(int r, int hi) { return (r & 3) + 8 * (r >> 2) + 4 * hi; }
DI int kpos(int k) { const int o16 = k & 15; return (k & ~15) + 8 * ((o16 >> 2) & 1) + 4 * (o16 >> 3) + (o16 & 3); }
#define MFMA32(a, b, c) __builtin_amdgcn_mfma_f32_32x32x16_bf16((a), (b), (c), 0, 0, 0)
#define LDS_WAIT() asm volatile("s_waitcnt lgkmcnt(0)" ::: "memory")
DI void lds_barrier() { asm volatile("s_waitcnt lgkmcnt(0)" ::: "memory"); __builtin_amdgcn_s_barrier(); asm volatile("" ::: "memory"); }

#define XB_TMO      128
#define XB_XCNT(j)  (256  + 64 * (j))
#define XB_XSUB(j)  (1280 + 64 * (j))
#define XB_XGEN(j)  (2304 + 64 * (j))
#define XB_TOP      3328
#define XB_TOPGEN   3392
#define XCD_BAR_WORDS 3456
#define XB_SPIN_CAP (1u << 18)

__device__ __forceinline__ unsigned xb_ld(unsigned* p)              { return __hip_atomic_load(p, __ATOMIC_RELAXED, __HIP_MEMORY_SCOPE_AGENT); }
__device__ __forceinline__ unsigned xb_add(unsigned* p, unsigned v) { return __hip_atomic_fetch_add(p, v, __ATOMIC_RELAXED, __HIP_MEMORY_SCOPE_AGENT); }
__device__ __forceinline__ unsigned xb_xcc_id() { return (unsigned)__builtin_amdgcn_s_getreg((3 << 11) | 20) & 0xFu; }
#define XB_SPIN(cond, bar) do { unsigned _sp = 0; while (cond) { __builtin_amdgcn_s_sleep(1); \
    if ((++_sp & 255u) == 0u) { if (xb_ld(&(bar)[XB_TMO])) break; if (_sp > XB_SPIN_CAP) { atomicAdd(&(bar)[XB_TMO], 1u); break; } } } } while (0)

struct XcdBarrier {
    unsigned* bar; unsigned x;
    volatile LAS unsigned* st;
};

__device__ __forceinline__ XcdBarrier xcd_barrier_post(unsigned* bar, volatile LAS unsigned* st) {
    XcdBarrier b; b.bar = bar; b.x = xb_xcc_id(); b.st = st;
    if (threadIdx.x == 0) (void)xb_add(&bar[XB_XCNT(b.x)], 1u);
    return b;
}
__device__ __forceinline__ void xcd_barrier_complete(unsigned* bar, unsigned x, unsigned& nloc, unsigned& nx) {
    const unsigned G = gridDim.x * gridDim.y * gridDim.z;
    unsigned sum, cnt, mine, sp = 0u;
    for (;;) {
        sum = 0u; cnt = 0u; mine = 0u;
#pragma unroll
        for (unsigned j = 0; j < 16; ++j) { const unsigned c = xb_ld(&bar[XB_XCNT(j)]); sum += c; cnt += (c > 0u) ? 1u : 0u; mine = (j == x) ? c : mine; }
        if (sum == G) break;
        __builtin_amdgcn_s_sleep(1);
        if ((++sp & 255u) == 0u) { if (xb_ld(&bar[XB_TMO])) break; if (sp > XB_SPIN_CAP) { atomicAdd(&bar[XB_TMO], 1u); break; } }
    }
    nloc = mine > 0u ? mine : 1u; nx = cnt > 0u ? cnt : 1u;
}

__device__ __forceinline__ void xcd_barrier(const XcdBarrier& b) {
    asm volatile("s_waitcnt vmcnt(0)" ::: "memory");
    __syncthreads();
    if (threadIdx.x == 0) {
        unsigned* bar = b.bar;
        __builtin_amdgcn_s_waitcnt(0);
        unsigned nloc = b.st[0], nx = b.st[1];
        if (nloc == 0u) { xcd_barrier_complete(bar, b.x, nloc, nx); b.st[0] = nloc; b.st[1] = nx; }
        const unsigned old = xb_add(&bar[XB_XSUB(b.x)], 1u);
        const unsigned gen = old / nloc;
        if (old + 1u == (gen + 1u) * nloc) {
            __builtin_amdgcn_fence(__ATOMIC_RELEASE, "agent");
            asm volatile("s_waitcnt vmcnt(0)" ::: "memory");
            const unsigned og = xb_add(&bar[XB_TOP], 1u);
            const unsigned tg = og / nx;
            if (og + 1u == (tg + 1u) * nx) xb_add(&bar[XB_TOPGEN], 1u);
            else XB_SPIN(xb_ld(&bar[XB_TOPGEN]) == tg, bar);
            __builtin_amdgcn_fence(__ATOMIC_ACQUIRE, "agent");
            xb_add(&bar[XB_XGEN(b.x)], 1u);
            asm volatile("s_waitcnt vmcnt(0)" ::: "memory");
        } else {
            XB_SPIN(xb_ld(&bar[XB_XGEN(b.x)]) == gen, bar);
            __builtin_amdgcn_fence(__ATOMIC_ACQUIRE, "agent");
            asm volatile("s_waitcnt vmcnt(0)" ::: "memory");
        }
    }
    __syncthreads();
}

struct EpiScaleBf16 {
    static constexpr bool PERM = true, AFTER_DRAIN = false;
    bf16* O; int ldc; const float* slots; const float* bias; int bias_n;
    DI void operator()(const pg8::f32x4 (&acc)[2][2][4][2], const pg8::Unit& u, int wr, int wc, int fr, int fq) const {
        const int row0 = u.pm * 256 + wr * 64 + fr, col0 = u.pn * 256 + wc * 32 + 8 * fq;
        const bool hb = bias && (u.pn * 256 < bias_n);
        f32x4 bv[2][2];
#pragma unroll
        for (int bj = 0; bj < 2; ++bj)
#pragma unroll
            for (int n = 0; n < 2; ++n) bv[bj][n] = hb ? *(const f32x4*)(bias + col0 + bj * 128 + 4 * n) : (f32x4){0.f, 0.f, 0.f, 0.f};
#pragma unroll
        for (int ai = 0; ai < 2; ++ai)
#pragma unroll
            for (int m = 0; m < 4; ++m) {
                const int row = row0 + ai * 128 + m * 16; float rs = 1.f;
                if (slots) { const f32x4* sp = (const f32x4*)(slots + (size_t)row * 16); const f32x4 a = sp[0], b = sp[1], c = sp[2], d = sp[3];
                    const float ss = ((a[0] + a[1]) + (a[2] + a[3])) + ((b[0] + b[1]) + (b[2] + b[3])) + ((c[0] + c[1]) + (c[2] + c[3])) + ((d[0] + d[1]) + (d[2] + d[3]));
                    rs = 1.0f / sqrtf(ss * (1.0f / 1024.0f) + NORM_EPS); }
                bf16* rowp = O + (size_t)row * ldc + col0;
#pragma unroll
                for (int bj = 0; bj < 2; ++bj) { const f32x4 v0 = acc[ai][bj][m][0] * rs + bv[bj][0], v1 = acc[ai][bj][m][1] * rs + bv[bj][1];
                    u32x4 w; w.x = pk2(v0[0], v0[1]); w.y = pk2(v0[2], v0[3]); w.z = pk2(v1[0], v1[1]); w.w = pk2(v1[2], v1[3]);
                    *(u32x4*)(rowp + bj * 128) = w; }
            }
    }
};
struct EpiResid {
    static constexpr bool PERM = false, AFTER_DRAIN = false;
    const float* base; bf16* outB; float* slots;
    DI void operator()(const pg8::f32x4 (&acc)[2][2][4][2], const pg8::Unit& u, int wr, int wc, int fr, int fq) const {
        const int col0 = u.pn * 256 + wc * 32 + 4 * fq;
#pragma unroll
        for (int ai = 0; ai < 2; ++ai)
#pragma unroll
            for (int m = 0; m < 4; ++m) {
                const int row = u.pm * 256 + ai * 128 + wr * 64 + m * 16 + fr; const size_t off = (size_t)row * 1024 + col0; float ss = 0.f;
#pragma unroll
                for (int bj = 0; bj < 2; ++bj)
#pragma unroll
                    for (int n = 0; n < 2; ++n) { const f32x4 bs = *(const f32x4*)(base + off + bj * 128 + n * 16); const f32x4 v = bs + acc[ai][bj][m][n];
                        u32x2 w; w.x = pk2(v[0], v[1]); w.y = pk2(v[2], v[3]); *(u32x2*)(outB + off + bj * 128 + n * 16) = w;
                        ss += (v[0] * v[0] + v[1] * v[1]) + (v[2] * v[2] + v[3] * v[3]); }
                ss += __shfl_xor(ss, 16); ss += __shfl_xor(ss, 32);
                if (fq == 0) slots[(size_t)row * 16 + u.pn * 4 + wc] = ss;
            }
    }
};

struct EpiResidNorm {
    static constexpr bool PERM = false, AFTER_DRAIN = true;
    const bf16* base; float* out; const float* bias; const float* w; float* xbuf; unsigned* cnt;
    DI void fused(pg8::f32x4 (&acc)[2][2][4][2], const pg8::Unit& u, int wr, int wc, int fr, int fq, PG8_LAS unsigned char* lds, int wid, int lane) const {
        PG8_LAS float* Pt = (PG8_LAS float*)lds;
        PG8_LAS float* S = (PG8_LAS float*)(lds + 4096);
        const int col0 = u.pn * 256 + wc * 32 + 4 * fq;
#pragma unroll
        for (int ai = 0; ai < 2; ++ai)
#pragma unroll
            for (int m = 0; m < 4; ++m) {
                const int r = ai * 128 + wr * 64 + m * 16 + fr; const size_t off = (size_t)(u.pm * 256 + r) * 1024 + col0; float ss = 0.f;
#pragma unroll
                for (int bj = 0; bj < 2; ++bj)
#pragma unroll
                    for (int n = 0; n < 2; ++n) { const u32x2 bw = *(const u32x2*)(base + off + bj * 128 + n * 16); const f32x4 bs = (f32x4){bflo(bw.x), bfhi(bw.x), bflo(bw.y), bfhi(bw.y)}; const f32x4 bv = *(const f32x4*)(bias + col0 + bj * 128 + n * 16);
                        const f32x4 v = bs + acc[ai][bj][m][n] + bv; acc[ai][bj][m][n] = v; ss += (v[0] * v[0] + v[1] * v[1]) + (v[2] * v[2] + v[3] * v[3]); }
                ss += __shfl_xor(ss, 16); ss += __shfl_xor(ss, 32);
                if (fq == 0) Pt[r * 4 + wc] = ss;
                if (m & 1) asm volatile("" ::: "memory");
            }
        asm volatile("s_waitcnt lgkmcnt(0)" ::: "memory"); __builtin_amdgcn_s_barrier(); asm volatile("" ::: "memory");
        const int row = wid * 32 + (lane & 31);
        if (lane < 32) { const float tot = (Pt[row * 4 + 0] + Pt[row * 4 + 1]) + (Pt[row * 4 + 2] + Pt[row * 4 + 3]);
            __hip_atomic_store(xbuf + (size_t)(u.pm * 256 + row) * 4 + u.pn, tot, __ATOMIC_RELAXED, __HIP_MEMORY_SCOPE_AGENT); }
        asm volatile("s_waitcnt vmcnt(0)" ::: "memory");
        if (lane == 0) __hip_atomic_fetch_add(cnt + 64 * u.pm, 1u, __ATOMIC_RELAXED, __HIP_MEMORY_SCOPE_AGENT);
        if (wid == 0) {
            unsigned spins = 0;
            while ((unsigned)__builtin_amdgcn_readfirstlane(__hip_atomic_load(cnt + 64 * u.pm, __ATOMIC_RELAXED, __HIP_MEMORY_SCOPE_AGENT)) < 32u) { __builtin_amdgcn_s_sleep(2); if (++spins > (1u << 22)) break; }
            __builtin_amdgcn_fence(__ATOMIC_ACQUIRE, "agent");
        }
        asm volatile("s_waitcnt vmcnt(0) lgkmcnt(0)" ::: "memory"); __builtin_amdgcn_s_barrier(); asm volatile("" ::: "memory");
        if (lane < 32) { const float* sl = xbuf + (size_t)(u.pm * 256 + row) * 4; float t = 0.f;
#pragma unroll
            for (int k = 0; k < 4; ++k) t += __hip_atomic_load(sl + k, __ATOMIC_RELAXED, __HIP_MEMORY_SCOPE_AGENT);
            S[row] = 1.0f / sqrtf(t * (1.f / 1024.f) + NORM_EPS); }
        asm volatile("s_waitcnt lgkmcnt(0)" ::: "memory"); __builtin_amdgcn_s_barrier(); asm volatile("" ::: "memory");
        f32x4 wv[2][2];
#pragma unroll
        for (int bj = 0; bj < 2; ++bj)
#pragma unroll
            for (int n = 0; n < 2; ++n) wv[bj][n] = *(const f32x4*)(w + col0 + bj * 128 + n * 16);
#pragma unroll
        for (int ai = 0; ai < 2; ++ai)
#pragma unroll
            for (int m = 0; m < 4; ++m) { const int r = ai * 128 + wr * 64 + m * 16 + fr; const float rs = S[r]; const size_t off = (size_t)(u.pm * 256 + r) * 1024 + col0;
#pragma unroll
                for (int bj = 0; bj < 2; ++bj)
#pragma unroll
                    for (int n = 0; n < 2; ++n) *(f32x4*)(out + off + bj * 128 + n * 16) = acc[ai][bj][m][n] * rs * wv[bj][n]; }
    }
};

DI void transpose_item(const float* W, int N, int Npad, bf16* WT, const float* kscale, LAS float* scr, int item, int lane) {
    const int nblk = Npad / 32, kb = item / nblk, nb = item % nblk, k0 = 64 * kb, n0 = 32 * nb;
    const int n = n0 + (lane & 31);
#pragma unroll 8
    for (int i = 0; i < 32; ++i) { const int kk = 2 * i + (lane >> 5); float v = (n < N) ? W[(size_t)(k0 + kk) * N + n] : 0.f; if (kscale) v *= kscale[k0 + kk]; scr[kk * 33 + (lane & 31)] = v; }
    LDS_WAIT(); asm volatile("" ::: "memory");
    const int c = lane & 7;
#pragma unroll
    for (int j = 0; j < 4; ++j) { const int nn = (lane >> 3) + 8 * j; const LAS float* s = scr + (8 * c) * 33 + nn;
        u32x4 o; o.x = pk2(s[0 * 33], s[1 * 33]); o.y = pk2(s[2 * 33], s[3 * 33]); o.z = pk2(s[4 * 33], s[5 * 33]); o.w = pk2(s[6 * 33], s[7 * 33]);
        *(u32x4*)(WT + (size_t)(n0 + nn) * 1024 + k0 + 8 * c) = o; }
    LDS_WAIT(); asm volatile("" ::: "memory");
}
DI void p0_prologue(const Params& P, LAS unsigned char* lds, int wave, int lane) {
    LAS float* scr = (LAS float*)(lds + wave * 16384);
    const int gw = blockIdx.x * 8 + wave, NGW = gridDim.x * 8;
    bf16* W0T = (bf16*)(P.ws + WS_W0T); bf16* WO0T = (bf16*)(P.ws + WS_WO0T); bf16* W1T = (bf16*)(P.ws + WS_W1T); bf16* WO1T = (bf16*)(P.ws + WS_WO1T);
    constexpr int I0 = 16 * (N0P / 32), I1 = 16 * 32, I2 = 16 * (IN1 / 32), I3 = 16 * 32;
    for (int it = gw; it < I0 + I1 + I2 + I3; it += NGW) {
        int r = it;
        if (r < I0) { transpose_item(P.w_in0, IN0, N0P, W0T, nullptr, scr, r, lane); continue; } r -= I0;
        if (r < I1) { transpose_item(P.w_out0, 1024, 1024, WO0T, nullptr, scr, r, lane); continue; } r -= I1;
        if (r < I2) { transpose_item(P.w_in1, IN1, IN1, W1T, P.norm_w + 1024, scr, r, lane); continue; } r -= I2;
        transpose_item(P.w_out1, 1024, 1024, WO1T, nullptr, scr, r, lane);
    }
    {
        float* RT = (float*)(P.ws + WS_ROPE);
        for (int e = gw * 64 + lane; e < T * 8; e += NGW * 64) { const int pos = e >> 3, j = e & 7;
            const float invf = __expf(-(float)j * 0.125f * 13.122363377404328f); const float ang = (float)pos * invf; const float nrev = rintf(ang * 0.15915494309189535f);
            float r = fmaf(-nrev, 6.2831854820251465f, ang); r = fmaf(-nrev, -1.7484555e-07f, r);
            RT[2 * e] = __cosf(r); RT[2 * e + 1] = __sinf(r); }
    }
    {
        u32x4* WLT = (u32x4*)(P.ws + WS_WLT);
        for (int e = gw * 64 + lane; e < 8 * 2 * 4 * 2 * 64; e += NGW * 64) { const int ln = e & 63, db = (e >> 6) & 1, s = (e >> 7) & 3, lo = (e >> 9) & 1, h = e >> 10;
            const float* wp = (lo ? P.a_up : P.w_up) + (size_t)(16 * s + 8 * (ln >> 5)) * 512 + h * 64 + 2 * (ln & 31) + db;
            u32x4 o; o.x = pk2(wp[0], wp[512]); o.y = pk2(wp[2 * 512], wp[3 * 512]); o.z = pk2(wp[4 * 512], wp[5 * 512]); o.w = pk2(wp[6 * 512], wp[7 * 512]); WLT[e] = o; }
    }
    bf16* XN = (bf16*)(P.ws + WS_XN);
    {
        const f32x4* wr = (const f32x4*)P.norm_w + lane; const f32x4 w0 = wr[0], w1 = wr[64], w2 = wr[128], w3 = wr[192];
        f32x4 nx[4];
        { const f32x4* xr = (const f32x4*)(P.x + (size_t)(gw < M ? gw : 0) * D) + lane;
#pragma unroll
          for (int j = 0; j < 4; ++j) nx[j] = xr[64 * j]; }
        for (int m = gw; m < M; m += NGW) {
            f32x4 v[4]; float s = 0.f;
#pragma unroll
            for (int j = 0; j < 4; ++j) { v[j] = nx[j]; s += (v[j][0] * v[j][0] + v[j][1] * v[j][1]) + (v[j][2] * v[j][2] + v[j][3] * v[j][3]); }
            if (m + NGW < M) { const f32x4* xr = (const f32x4*)(P.x + (size_t)(m + NGW) * D) + lane;
#pragma unroll
                for (int j = 0; j < 4; ++j) nx[j] = xr[64 * j]; }
            const float rstd = 1.0f / sqrtf(wave_sum(s) * (1.f / D) + NORM_EPS);
            u32x2* o8 = (u32x2*)(XN + (size_t)m * D) + lane;
            { u32x2 o; o.x = pk2(v[0][0] * rstd * w0[0], v[0][1] * rstd * w0[1]); o.y = pk2(v[0][2] * rstd * w0[2], v[0][3] * rstd * w0[3]); o8[0] = o; }
            { u32x2 o; o.x = pk2(v[1][0] * rstd * w1[0], v[1][1] * rstd * w1[1]); o.y = pk2(v[1][2] * rstd * w1[2], v[1][3] * rstd * w1[3]); o8[64] = o; }
            { u32x2 o; o.x = pk2(v[2][0] * rstd * w2[0], v[2][1] * rstd * w2[1]); o.y = pk2(v[2][2] * rstd * w2[2], v[2][3] * rstd * w2[3]); o8[128] = o; }
            { u32x2 o; o.x = pk2(v[3][0] * rstd * w3[0], v[3][1] * rstd * w3[1]); o.y = pk2(v[3][2] * rstd * w3[2], v[3][3] * rstd * w3[3]); o8[192] = o; }
        }
    }
}
DI float softplus_f(float z) { return fmaxf(z, 0.f) + __logf(1.f + __expf(-fabsf(z))); }
DI float tanh_f(float x) { return 1.f - 2.f * __builtin_amdgcn_rcpf(__expf(2.f * x) + 1.f); }

template <int N> DI void dpp_fmac(float& acc, float src, float y) { asm("v_fmac_f32_dpp %0, %1, %2 row_newbcast:%3 row_mask:0xf bank_mask:0xf" : "+v"(acc) : "v"(src), "v"(y), "n"(N)); }
template <int N> DI void dpp_mul_ip(float& y, float src) { asm("v_mul_f32_dpp %0, %1, %0 row_newbcast:%2 row_mask:0xf bank_mask:0xf" : "+v"(y) : "v"(src), "n"(N)); }
template <int N> DI float dpp_mul(float src, float s) { float r; asm("v_mul_f32_dpp %0, %1, %2 row_newbcast:%3 row_mask:0xf bank_mask:0xf" : "=v"(r) : "v"(src), "v"(s), "n"(N)); return r; }
template <int D> struct RStep {
    static DI void dot(const float (&y)[64], const f32x4& X, float& s0, float& s1, float& s2, float& s3) {
        if constexpr (D < 16) { dpp_fmac<D>(s0, X[0], y[D]); dpp_fmac<D>(s1, X[1], y[16 + D]); dpp_fmac<D>(s2, X[2], y[32 + D]); dpp_fmac<D>(s3, X[3], y[48 + D]); RStep<D + 1>::dot(y, X, s0, s1, s2, s3); } }
    static DI void upd(float (&y)[64], const f32x4& Bv, float sa) {
        if constexpr (D < 16) {
            dpp_fmac<D>(y[D], Bv[0], sa); dpp_fmac<D>(y[16 + D], Bv[1], sa); dpp_fmac<D>(y[32 + D], Bv[2], sa); dpp_fmac<D>(y[48 + D], Bv[3], sa);
            RStep<D + 1>::upd(y, Bv, sa); } }
    static DI void scale(float (&y)[64], const f32x4& W) {
        if constexpr (D < 16) {
            dpp_mul_ip<D>(y[D], W[0]); dpp_mul_ip<D>(y[16 + D], W[1]); dpp_mul_ip<D>(y[32 + D], W[2]); dpp_mul_ip<D>(y[48 + D], W[3]);
            RStep<D + 1>::scale(y, W); } }
};
DI void rwkv_rstep(float (&y)[64], const f32x4 (&X)[4], int t, int role, int lane, bf16* mstep) {
    float s0 = 0.f, s1 = 0.f, s2 = 0.f, s3 = 0.f;
    RStep<0>::dot(y, X[0], s0, s1, s2, s3);
    float sa = (s0 + s1) + (s2 + s3);
    if (role == 1) sa = (lane < t) ? sa : 0.f;
    RStep<0>::upd(y, X[2], sa);
    float o0 = 0.f, o1 = 0.f, o2 = 0.f, o3 = 0.f;
    RStep<0>::dot(y, X[3], o0, o1, o2, o3);
    float o = (o0 + o1) + (o2 + o3);
    if (role == 1) o = (lane <= t) ? o : 0.f;
    mstep[t * 64] = (bf16)f2bf(o);
}
DI void rwkv_prep_item(const Params& P, int item, LAS unsigned char* lds, int wave, int lane) {
    const int bh = item >> 4, quad = item & 15, b = bh >> 3, h = bh & 7;
    const int tok0 = b * T + quad * 256;
    const bf16* PROJ0 = (const bf16*)(P.ws + WS_PROJ0);
    float* scr = (float*)(P.ws + WS_SCR + (size_t)blockIdx.x * 262144);
    LAS float* KS = (LAS float*)lds;
    LAS float* TOT = (LAS float*)(lds + 8 * 64 * 65 * 4);
    bf16* VP = (bf16*)(P.ws + WS_VP); float* BON = (float*)(P.ws + WS_BONUS);
    const int hd = h * 64 + lane;
    {
        const int m = lane & 31, hi = lane >> 5;
        const int c = wave >> 1, tb = (wave & 1) * 32;
        const int tokw = tok0 + wave * 32, posw = quad * 256 + wave * 32;
        f32x16 accw[2], acca[2];
#pragma unroll
        for (int i = 0; i < 16; ++i) { accw[0][i] = 0.f; accw[1][i] = 0.f; acca[0][i] = 0.f; acca[1][i] = 0.f; }
        {
            const bf16* rowc = PROJ0 + (size_t)(tokw + m) * N0P; const bool hasprev = (posw + m) > 0;
            const u32x4* WLT = (const u32x4*)(P.ws + WS_WLT) + (size_t)h * 1024 + lane;
            u32x4 cwv[4], cav[4], pwv[4], pav[4], bwv[4][2], bav[4][2];
#pragma unroll
            for (int s = 0; s < 4; ++s) { const int j0 = 16 * s + 8 * hi;
                cwv[s] = *(const u32x4*)(rowc + C_XW + j0); cav[s] = *(const u32x4*)(rowc + C_XA + j0);
                pwv[s] = (u32x4){0u, 0u, 0u, 0u}; pav[s] = (u32x4){0u, 0u, 0u, 0u};
                if (hasprev) { pwv[s] = *(const u32x4*)(rowc - N0P + C_XW + j0); pav[s] = *(const u32x4*)(rowc - N0P + C_XA + j0); }
#pragma unroll
                for (int db = 0; db < 2; ++db) { bwv[s][db] = WLT[((0 * 4 + s) * 2 + db) * 64]; bav[s][db] = WLT[((1 * 4 + s) * 2 + db) * 64]; } }
#pragma unroll
            for (int s = 0; s < 4; ++s) {
                const int j0 = 16 * s + 8 * hi;
                float fcw[8], fpw[8], fca[8], fpa[8]; unpack8(cwv[s], fcw); unpack8(pwv[s], fpw); unpack8(cav[s], fca); unpack8(pav[s], fpa);
                const f32x4 mw0 = *(const f32x4*)(P.mu + 1536 + j0), mw1 = *(const f32x4*)(P.mu + 1536 + j0 + 4), ma0 = *(const f32x4*)(P.mu + 1600 + j0), ma1 = *(const f32x4*)(P.mu + 1600 + j0 + 4);
                float xw[8], xa[8];
#pragma unroll
                for (int e = 0; e < 8; ++e) { const float muw = e < 4 ? mw0[e & 3] : mw1[e & 3], mua = e < 4 ? ma0[e & 3] : ma1[e & 3];
                    xw[e] = tanh_f(fcw[e] + (fpw[e] - fcw[e]) * muw); xa[e] = fca[e] + (fpa[e] - fca[e]) * mua; }
                u32x4 aw, aa;
#pragma unroll
                for (int e = 0; e < 4; ++e) { aw[e] = pk2(xw[2 * e], xw[2 * e + 1]); aa[e] = pk2(xa[2 * e], xa[2 * e + 1]); }
#pragma unroll
                for (int db = 0; db < 2; ++db) {
                    accw[db] = MFMA32(__builtin_bit_cast(bf16x8, aw), __builtin_bit_cast(bf16x8, bwv[s][db]), accw[db]);
                    acca[db] = MFMA32(__builtin_bit_cast(bf16x8, aa), __builtin_bit_cast(bf16x8, bav[s][db]), acca[db]);
                }
            }
        }
        float kkd[2], kad[2], rkd[2], w0d[2], a0d[2], mur[2], muk[2], muv[2];
#pragma unroll
        for (int db = 0; db < 2; ++db) { const int hd = h * 64 + 2 * m + db; kkd[db] = P.k_k[hd]; kad[db] = P.k_a[hd]; rkd[db] = P.r_k[hd]; w0d[db] = P.w0[hd]; a0d[db] = P.a0[hd];
            mur[db] = P.mu[hd]; muk[db] = P.mu[512 + hd]; muv[db] = P.mu[1024 + hd]; }
        unsigned qr[16], qk[16], qv[16], qpr[4], qpk[4], qpv[4];
#pragma unroll
        for (int i = 0; i < 16; ++i) {
            int io = i; asm volatile("" : "+v"(io));
            const bf16* row = PROJ0 + (size_t)(tokw + crow(io, hi)) * N0P + h * 64 + 2 * m;
            qr[i] = *(const unsigned*)(row + C_RR); qk[i] = *(const unsigned*)(row + C_RK); qv[i] = *(const unsigned*)(row + C_RV);
            if ((i & 3) == 0) {
                qpr[i >> 2] = 0u; qpk[i >> 2] = 0u; qpv[i >> 2] = 0u;
                if (posw + crow(i, hi) > 0) { qpr[i >> 2] = *(const unsigned*)(row - N0P + C_RR); qpk[i >> 2] = *(const unsigned*)(row - N0P + C_RK); qpv[i >> 2] = *(const unsigned*)(row - N0P + C_RV); }
            }
        }
        float ee[2][16], Lc[2][16];
#pragma unroll
        for (int db = 0; db < 2; ++db) {
#pragma unroll
            for (int i = 0; i < 16; ++i) { const float wl = w0d[db] + accw[db][i]; ee[db][i] = __expf(-softplus_f(-wl) - 0.5f); }
            float gt[4], go[4];
#pragma unroll
            for (int g = 0; g < 4; ++g) { Lc[db][4 * g] = ee[db][4 * g]; Lc[db][4 * g + 1] = Lc[db][4 * g] + ee[db][4 * g + 1]; Lc[db][4 * g + 2] = Lc[db][4 * g + 1] + ee[db][4 * g + 2]; Lc[db][4 * g + 3] = Lc[db][4 * g + 2] + ee[db][4 * g + 3];
                gt[g] = Lc[db][4 * g + 3]; go[g] = __shfl_xor(gt[g], 32); }
            float run = 0.f;
#pragma unroll
            for (int g = 0; g < 4; ++g) { const float base = run + (hi ? go[g] : 0.f);
#pragma unroll
                for (int q = 0; q < 4; ++q) Lc[db][4 * g + q] += base;
                run += gt[g] + go[g]; }
            if (!(wave & 1) && hi == 0) TOT[c * 64 + 2 * m + db] = run;
        }
        __syncthreads();
        if (wave & 1) {
#pragma unroll
            for (int db = 0; db < 2; ++db) { const float tp = TOT[c * 64 + 2 * m + db];
#pragma unroll
                for (int i = 0; i < 16; ++i) Lc[db][i] += tp; }
        }
        float Lb[2][4];
#pragma unroll
        for (int db = 0; db < 2; ++db)
#pragma unroll
            for (int g = 0; g < 4; ++g) { Lb[db][g] = Lc[db][4 * g] - ee[db][4 * g]; asm volatile("" : "+v"(Lb[db][g])); }
        {
            float pv0 = 0.f, pv1 = 0.f;
#pragma unroll
            for (int i = 0; i < 16; ++i) {
                int io = i; asm volatile("" : "+v"(io));
                if ((i & 3) == 0) { pv0 = bflo(qpv[i >> 2]); pv1 = bfhi(qpv[i >> 2]); }
                const float c0 = bflo(qv[i]), c1 = bfhi(qv[i]);
                *(unsigned*)(VP + (size_t)(tokw + crow(io, hi)) * 512 + h * 64 + 2 * m) = pk2(c0 + (pv0 - c0) * muv[0], c1 + (pv1 - c1) * muv[1]);
                pv0 = c0; pv1 = c1;
            }
        }
        float pr[2] = {0.f, 0.f}, pk[2] = {0.f, 0.f}, pemL[2] = {1.f, 1.f};
#pragma unroll
        for (int i = 0; i < 16; ++i) {
            int io = i; asm volatile("" : "+v"(io));
            const int tau = crow(io, hi), tok = tokw + tau, t = tb + tau;
            if ((i & 3) == 0) { pr[0] = bflo(qpr[i >> 2]); pr[1] = bfhi(qpr[i >> 2]); pk[0] = bflo(qpk[i >> 2]); pk[1] = bfhi(qpk[i >> 2]); }
            float r[2], k[2], a[2], kk[2];
#pragma unroll
            for (int db = 0; db < 2; ++db) {
                const float cr = db ? bfhi(qr[i]) : bflo(qr[i]), ck = db ? bfhi(qk[i]) : bflo(qk[i]);
                r[db] = cr + (pr[db] - cr) * mur[db]; k[db] = ck + (pk[db] - ck) * muk[db];
                pr[db] = cr; pk[db] = ck;
                const float al = a0d[db] + acca[db][i];
                a[db] = __builtin_amdgcn_rcpf(1.f + __expf(-al));
                kk[db] = k[db] * kkd[db];
            }
            const float nrm = sqrtf(half_sum32(kk[0] * kk[0] + kk[1] * kk[1]));
            const float inv = __builtin_amdgcn_rcpf(fmaxf(nrm, 1e-12f));
            float k2[2];
#pragma unroll
            for (int db = 0; db < 2; ++db) k2[db] = k[db] * (1.f + (a[db] - 1.f) * kad[db]);
            const float bon = half_sum32(r[0] * k2[0] * rkd[0] + r[1] * k2[1] * rkd[1]);
#pragma unroll
            for (int db = 0; db < 2; ++db) {
                const int d = 2 * m + db; const float kkn = kk[db] * inv;
                float* o = scr + (size_t)((c * 64 + t) * 4) * 64 + (d & 15) * 4 + (d >> 4);
                const float eL = __expf(Lc[db][i]), emL = __builtin_amdgcn_rcpf(eL);
                const float wprev = (i & 3) ? pemL[db] : __expf(-Lb[db][i >> 2]); pemL[db] = emL;
                o[0] = -kkn * wprev;
                if (i == 15 && t == 63) o[64] = emL;
                o[128] = kkn * a[db] * eL;
                o[192] = r[db] * emL;
                KS[((2 * c + 1 - (c >> 1)) * 64 + t) * 65 + d] = k2[db] * eL;
            }
            if (m == 0) BON[(size_t)tok * 8 + h] = bon;
        }
    }
    __syncthreads();
    {
        const int c = wave >> 1, role = (wave ^ (wave >> 2)) & 1;
        const f32x4* xb = (const f32x4*)(scr + (size_t)c * 64 * 256) + (lane & 15);
        const LAS float* ksw = KS + wave * 64 * 65;
        float y[64];
        const int n = quad * 4 + c;
        bf16* mats = (bf16*)P.out + (size_t)(bh * 64 + n) * 4 * 4096;
        bf16* mstep = mats + role * 4096 + (role ? lane : kpos(lane));
#pragma unroll 1
        for (int rep2 = 0; rep2 < REP_S2; ++rep2) {
            int ln = lane; asm volatile("" : "+v"(ln));
#pragma unroll
            for (int d = 0; d < 64; ++d) y[d] = (role == 0) ? ((d == ln) ? 1.f : 0.f) : ksw[ln * 65 + d];
            f32x4 XA[4], XB[4];
#pragma unroll
            for (int v = 0; v < 4; ++v) XA[v] = xb[v * 16];
            for (int t = 0; t < 64; t += 2) {
#pragma unroll
                for (int v = 0; v < 4; ++v) XB[v] = xb[(t + 1) * 64 + v * 16];
                rwkv_rstep(y, XA, t, role, lane, mstep);
                if (t + 2 < 64) {
#pragma unroll
                    for (int v = 0; v < 4; ++v) XA[v] = xb[(t + 2) * 64 + v * 16];
                }
                rwkv_rstep(y, XB, t + 1, role, lane, mstep);
            }
            RStep<0>::scale(y, XB[1]);
        }
        bf16* mend = mats + (role ? 2 : 3) * 4096 + (role ? lane : kpos(lane));
        LAS float* myr = KS + (wave * 64 + lane) * 65;
#pragma unroll
        for (int d = 0; d < 64; ++d) myr[d] = y[d];
#pragma unroll 1
        for (int d = 0; d < 64; ++d) mend[d * 64] = (bf16)f2bf(myr[d]);
    }
    __syncthreads();
}

DI void gla_prep_item(const Params& P, int item, LAS unsigned char* lds, int wave, int lane) {
    const int bh = item >> 6, n = item & 63, b = bh >> 2, h = bh & 3;
    const int tok0 = b * T + n * 64, hd = h * 64 + lane;
    const bf16* PROJ0 = (const bf16*)(P.ws + WS_PROJ0);
    LAS float* WT = (LAS float*)lds;
    LAS bf16* QEb = (LAS bf16*)(WT + 1024);
    LAS bf16* KEb = QEb + 64 * 72;
    LAS float* KL = (LAS float*)(KEb + 64 * 72);
    bf16* mats = (bf16*)(P.ws + WS_XN) + (size_t)(bh * 64 + n) * 3 * 4096;
    float* GDEC = (float*)(P.ws + WS_GDEC) + (size_t)(bh * 64 + n) * 64;
    float q8[8], k8[8]; u32x4 gl0[8], gl1[8];
#pragma unroll
    for (int i = 0; i < 8; ++i) { const bf16* row = PROJ0 + (size_t)(tok0 + wave * 8 + i) * N0P; q8[i] = bf2f(row[C_GQ + hd]) * 0.125f; k8[i] = bf2f(row[C_GK + hd]);
        gl0[i] = *(const u32x4*)(row + C_GLOW); gl1[i] = *(const u32x4*)(row + C_GLOW + 8); }
    float up[16];
#pragma unroll
    for (int r = 0; r < 16; ++r) up[r] = P.gk_up[r * 256 + hd];
    const float bias = P.gk_bias[hd];
    float bt[8]; float acc = 0.f;
#pragma unroll
    for (int i = 0; i < 8; ++i) { float xg = bias;
#pragma unroll
        for (int r = 0; r < 4; ++r) { xg = fmaf(bflo(gl0[i][r]), up[2 * r], xg); xg = fmaf(bfhi(gl0[i][r]), up[2 * r + 1], xg); }
#pragma unroll
        for (int r = 0; r < 4; ++r) { xg = fmaf(bflo(gl1[i][r]), up[8 + 2 * r], xg); xg = fmaf(bfhi(gl1[i][r]), up[8 + 2 * r + 1], xg); }
        acc += -softplus_f(-xg) * (1.f / 16.f); bt[i] = acc; }
    WT[wave * 64 + lane] = acc;
    if (wave == 4) WT[512 + lane] = bt[0];
    __syncthreads();
    float off = 0.f, off4 = 0.f, total = 0.f;
#pragma unroll
    for (int w2 = 0; w2 < 8; ++w2) { const float tv = WT[w2 * 64 + lane]; if (w2 < wave) off += tv; if (w2 < 4) off4 += tv; total += tv; }
    const float bref = off4 + WT[512 + lane], blast = total;
#pragma unroll
    for (int i = 0; i < 8; ++i) { const int t = wave * 8 + i; const float b_t = bt[i] + off;
        QEb[t * 72 + lane] = (bf16)f2bf(q8[i] * __expf(b_t - bref)); KEb[t * 72 + lane] = (bf16)f2bf(k8[i] * __expf(bref - b_t)); KL[t * 65 + lane] = k8[i] * __expf(blast - b_t);
        mats[t * 64 + kpos(lane)] = (bf16)f2bf(q8[i] * __expf(b_t)); }
    if (wave == 0) GDEC[lane] = __expf(blast);
    __syncthreads();
    if (wave < 4) {
        const int m = lane & 31, hi = lane >> 5, tb = wave >> 1, jb = wave & 1;
        f32x16 c;
#pragma unroll
        for (int r = 0; r < 16; ++r) c[r] = 0.f;
#pragma unroll
        for (int s = 0; s < 4; ++s) { const bf16x8 A = *(const LAS bf16x8*)(KEb + (32 * jb + m) * 72 + 16 * s + 8 * hi), Bq = *(const LAS bf16x8*)(QEb + (32 * tb + m) * 72 + 16 * s + 8 * hi); c = MFMA32(A, Bq, c); }
        const int t = 32 * tb + m;
#pragma unroll
        for (int g = 0; g < 4; ++g) { const int j0 = 32 * jb + 8 * g + 4 * hi; u32x2 w;
            w.x = pk2(j0 <= t ? c[4 * g] : 0.f, j0 + 1 <= t ? c[4 * g + 1] : 0.f); w.y = pk2(j0 + 2 <= t ? c[4 * g + 2] : 0.f, j0 + 3 <= t ? c[4 * g + 3] : 0.f);
            *(u32x2*)(mats + 4096 + t * 64 + j0) = w; }
    } else {
#pragma unroll
        for (int r = 0; r < 16; ++r) { const int d = (wave - 4) * 16 + r; mats[8192 + d * 64 + lane] = (bf16)f2bf(KL[lane * 65 + d]); }
    }
    __syncthreads();
}

constexpr int SQ_PITCH = 144, SQ_MAT = 64 * SQ_PITCH, SQ_VT = 4 * SQ_MAT, SQ_DEC = SQ_VT + 128 * SQ_PITCH, SQ_BUF = 57344;
template <bool DIAG>
DI void seq_pass(unsigned* prog, const bf16* mats, int nmat, const bf16* vsrc, int vpitch, const float* dec, bf16* outp, LAS unsigned char* lds, int tid, int wave, int lane) {
    const int m = lane & 31, hi = lane >> 5;
    f32x16 sacc[2];
#pragma unroll
    for (int i = 0; i < 16; ++i) { sacc[0][i] = 0.f; sacc[1][i] = 0.f; }
    const int st = tid - 256;
    struct StSet { u32x4 rm[8]; u32x4 rv[2]; float rdec; };
    const int v8 = st & 7, par = (st >> 3) & 1;
    constexpr int NMAT = DIAG ? 3 : 4;
    auto gload = [&](int n, StSet& S) {
        const bf16* mp = mats + (size_t)n * NMAT * 4096;
#pragma unroll
        for (int q = 0; q < 2 * NMAT; ++q) S.rm[q] = *(const u32x4*)(mp + (size_t)(st + 256 * q) * 8);
#pragma unroll
        for (int q = 0; q < 2; ++q) S.rv[q] = *(const u32x4*)(vsrc + (size_t)(n * 64 + (st >> 3) + 32 * q) * vpitch + 8 * v8);
        if (DIAG) S.rdec = dec[n * 64 + (st & 63)];
    };
    auto lstore = [&](int n, const StSet& S) {
        LAS unsigned char* B = lds + (n & 1) * SQ_BUF;
#pragma unroll
        for (int q = 0; q < 2 * NMAT; ++q) { const int idx = (st + 256 * q) & 511; *(LAS u32x4*)(B + (q >> 1) * SQ_MAT + (idx >> 3) * SQ_PITCH + (idx & 7) * 16) = S.rm[q]; }
#pragma unroll
        for (int q = 0; q < 2; ++q) {
            const int vt = (st >> 3) + 32 * q;
            const unsigned k0 = par ? S.rv[q][2] : S.rv[q][0], k1 = par ? S.rv[q][3] : S.rv[q][1], s0 = par ? S.rv[q][0] : S.rv[q][2], s1 = par ? S.rv[q][1] : S.rv[q][3];
            const unsigned r0 = (unsigned)__builtin_amdgcn_update_dpp(0, (int)s0, 0x128, 0xf, 0xf, true), r1 = (unsigned)__builtin_amdgcn_update_dpp(0, (int)s1, 0x128, 0xf, 0xf, true);
            unsigned o[4];
            if (par == 0) { o[0] = (k0 & 0xffffu) | (r0 << 16); o[1] = (k0 >> 16) | (r0 & 0xffff0000u); o[2] = (k1 & 0xffffu) | (r1 << 16); o[3] = (k1 >> 16) | (r1 & 0xffff0000u); }
            else          { o[0] = (r0 & 0xffffu) | (k0 << 16); o[1] = (r0 >> 16) | (k0 & 0xffff0000u); o[2] = (r1 & 0xffffu) | (k1 << 16); o[3] = (r1 >> 16) | (k1 & 0xffff0000u); }
            const int tp = vt >> 1, gsw = ((tp >> 2) ^ v8) & 7;
#pragma unroll
            for (int jj = 0; jj < 4; ++jj) *(LAS unsigned*)(B + SQ_VT + (8 * v8 + 4 * par + jj) * SQ_PITCH + (4 * gsw + (tp & 3)) * 4) = o[jj];
        }
        if (DIAG && st < 64) *(LAS float*)(B + SQ_DEC + st * 4) = S.rdec;
    };
    f32x16 o0, o1;
    bf16x8 sBp[2][2];
#pragma unroll
    for (int kb = 0; kb < 2; ++kb)
#pragma unroll
        for (int s = 0; s < 2; ++s) sBp[kb][s] = (bf16x8){0, 0, 0, 0, 0, 0, 0, 0};
    LAS unsigned char* SBX = lds + 2 * SQ_BUF;
    if (wave >= 2 && wave < 4) {
#pragma unroll
        for (int q = 0; q < 4; ++q) *(LAS bf16x8*)(SBX + (0 * 2 + (wave & 1)) * 4096 + lane * 64 + 16 * q) = sBp[q >> 1][q & 1];
    }
    auto compute = [&](int n, int bufi) {
        if (wave < 4) {
            const int vb = wave & 1; const bool upd = wave >= 2;
            const LAS unsigned char* B = lds + bufi * SQ_BUF;
            const int vrow = 32 * vb + m;
            const LAS unsigned char* Vr = B + SQ_VT + vrow * SQ_PITCH;
            const LAS unsigned char* Ar = B + m * SQ_PITCH + 16 * hi;
            bf16x8 Fa[2], Fb[2], Va, Vb;
#define SQ_LD(F, VB, k, MS, MV) do { if ((k) < 4) { const int co_ = (32 * ((k) >> 1) + 16 * ((k) & 1)) * 2; \
            F[0] = *(const LAS bf16x8*)(Ar + (MS) * SQ_MAT + co_); F[1] = *(const LAS bf16x8*)(Ar + (MS) * SQ_MAT + 32 * SQ_PITCH + co_); } \
        else { const int S4_ = (k) - 4, co_ = 32 * S4_; VB = *(const LAS bf16x8*)(Vr + (((2 * S4_ + hi) ^ (vrow >> 3)) & 7) * 16); \
            F[0] = *(const LAS bf16x8*)(Ar + (MV) * SQ_MAT + co_); F[1] = *(const LAS bf16x8*)(Ar + (MV) * SQ_MAT + 32 * SQ_PITCH + co_); } } while (0)
            if (!upd) {
                bf16x8 sB[2][2];
#pragma unroll
                for (int q = 0; q < 4; ++q) sB[q >> 1][q & 1] = *(const LAS bf16x8*)(SBX + ((n & 1) * 2 + vb) * 4096 + lane * 64 + 16 * q);
#pragma unroll
                for (int i = 0; i < 16; ++i) { o0[i] = 0.f; o1[i] = 0.f; }
#define SQ_MM(F, VB, k) do { const bf16x8 Bq_ = ((k) < 4) ? sB[(k) >> 1][(k) & 1] : VB; o0 = MFMA32(Bq_, F[0], o0); o1 = MFMA32(Bq_, F[1], o1); } while (0)
                SQ_LD(Fa, Va, 0, 0, 1); SQ_LD(Fb, Vb, 1, 0, 1);
                __builtin_amdgcn_sched_barrier(0);
                SQ_MM(Fa, Va, 0); SQ_LD(Fa, Va, 2, 0, 1); __builtin_amdgcn_sched_barrier(0);
                SQ_MM(Fb, Vb, 1); SQ_LD(Fb, Vb, 3, 0, 1); __builtin_amdgcn_sched_barrier(0);
                SQ_MM(Fa, Va, 2); SQ_LD(Fa, Va, 4, 0, 1); __builtin_amdgcn_sched_barrier(0);
                SQ_MM(Fb, Vb, 3); SQ_LD(Fb, Vb, 5, 0, 1); __builtin_amdgcn_sched_barrier(0);
                SQ_MM(Fa, Va, 4); SQ_LD(Fa, Va, 6, 0, 1); __builtin_amdgcn_sched_barrier(0);
                SQ_MM(Fb, Vb, 5); SQ_LD(Fb, Vb, 7, 0, 1); __builtin_amdgcn_sched_barrier(0);
                SQ_MM(Fa, Va, 6); SQ_MM(Fb, Vb, 7);
#undef SQ_MM
            } else {
                f32x16 n0, n1;
#pragma unroll
                for (int i = 0; i < 16; ++i) {
                    if (DIAG) { n0[i] = sacc[0][i] * *(const LAS float*)(B + SQ_DEC + crow(i, hi) * 4); n1[i] = sacc[1][i] * *(const LAS float*)(B + SQ_DEC + (32 + crow(i, hi)) * 4); }
                    else { n0[i] = 0.f; n1[i] = 0.f; } }
#define SQ_MM(F, VB, k) do { const bf16x8 Bq_ = ((k) < 4) ? sBp[(k) >> 1][(k) & 1] : VB; n0 = MFMA32(F[0], Bq_, n0); n1 = MFMA32(F[1], Bq_, n1); } while (0)
                if (!DIAG) {
                    SQ_LD(Fa, Va, 0, 3, 2); SQ_LD(Fb, Vb, 1, 3, 2);
                    __builtin_amdgcn_sched_barrier(0);
                    SQ_MM(Fa, Va, 0); SQ_LD(Fa, Va, 2, 3, 2); __builtin_amdgcn_sched_barrier(0);
                    SQ_MM(Fb, Vb, 1); SQ_LD(Fb, Vb, 3, 3, 2); __builtin_amdgcn_sched_barrier(0);
                    SQ_MM(Fa, Va, 2); SQ_LD(Fa, Va, 4, 3, 2); __builtin_amdgcn_sched_barrier(0);
                    SQ_MM(Fb, Vb, 3); SQ_LD(Fb, Vb, 5, 3, 2); __builtin_amdgcn_sched_barrier(0);
                } else {
                    SQ_LD(Fa, Va, 4, 3, 2); SQ_LD(Fb, Vb, 5, 3, 2);
                    __builtin_amdgcn_sched_barrier(0);
                }
                SQ_MM(Fa, Va, 4); SQ_LD(Fa, Va, 6, 3, 2); __builtin_amdgcn_sched_barrier(0);
                SQ_MM(Fb, Vb, 5); SQ_LD(Fb, Vb, 7, 3, 2); __builtin_amdgcn_sched_barrier(0);
                SQ_MM(Fa, Va, 6); SQ_MM(Fb, Vb, 7);
#undef SQ_MM
                sacc[0] = n0; sacc[1] = n1;
#pragma unroll
                for (int kb = 0; kb < 2; ++kb)
#pragma unroll
                    for (int s = 0; s < 2; ++s) { u32x4 w;
#pragma unroll
                        for (int e = 0; e < 4; ++e) w[e] = pk2(sacc[kb][8 * s + 2 * e], sacc[kb][8 * s + 2 * e + 1]);
                        sBp[kb][s] = __builtin_bit_cast(bf16x8, w);
                        *(LAS bf16x8*)(SBX + (((n + 1) & 1) * 2 + vb) * 4096 + lane * 64 + 16 * (2 * kb + s)) = sBp[kb][s]; }
            }
#undef SQ_LD
        }
    };
    auto store_out = [&](int n) {
        if (wave < 2) {
#pragma unroll
            for (int g = 0; g < 4; ++g) { bf16* op_ = outp + (size_t)(n * 64 + m) * 512 + 32 * wave + 8 * g + 4 * hi;
                u32x2 w0, w1; w0.x = pk2(o0[4 * g], o0[4 * g + 1]); w0.y = pk2(o0[4 * g + 2], o0[4 * g + 3]); w1.x = pk2(o1[4 * g], o1[4 * g + 1]); w1.y = pk2(o1[4 * g + 2], o1[4 * g + 3]);
                *(u32x2*)op_ = w0; *(u32x2*)(op_ + 32 * 512) = w1; }
        }
    };
    if (wave < 4) {
        lds_barrier();
#pragma unroll 1
        for (int n = 0; n < 64; ++n) { compute(n, n & 1); store_out(n); lds_barrier(); }
    } else {
        StSet A, Bs, C;
        gload(0, A); gload(1, Bs); gload(2, C);
        lstore(0, A); gload(3, A);
        lds_barrier();
#pragma unroll 1
        for (int k = 0; k < 60; k += 3) {
            if (st == 0) __hip_atomic_store(prog, (unsigned)(k + 4), __ATOMIC_RELAXED, __HIP_MEMORY_SCOPE_AGENT);
            lstore(k + 1, Bs); gload(k + 4, Bs); lds_barrier();
            lstore(k + 2, C); gload(k + 5, C); lds_barrier();
            lstore(k + 3, A); gload(k + 6, A); lds_barrier();
        }
        lstore(61, Bs); lds_barrier();
        lstore(62, C); lds_barrier();
        lstore(63, A); lds_barrier();
        lds_barrier();
    }
}
struct P3Src { const bf16* mats; int nmat; const bf16* vsrc; int vpitch; const float* dec; bf16* outp; };
DI P3Src p3_src(const Params& P, int bx) {
    P3Src s;
    if (bx < 32) { const int b = bx >> 3, h = bx & 7;
        s.mats = (const bf16*)P.out + (size_t)bx * 64 * 4 * 4096; s.nmat = 4; s.vsrc = (const bf16*)(P.ws + WS_VP) + (size_t)b * T * 512 + h * 64; s.vpitch = 512; s.dec = nullptr;
        s.outp = (bf16*)(P.ws + WS_SCR) + (size_t)b * T * 512 + h * 64; }
    else { const int g = bx - 32, bh = (g & 7) | ((g >> 4) << 3), vh = (g >> 3) & 1, b = bh >> 2, h = bh & 3;
        s.mats = (const bf16*)(P.ws + WS_XN) + (size_t)bh * 64 * 3 * 4096; s.nmat = 3; s.vsrc = (const bf16*)(P.ws + WS_PROJ0) + (size_t)b * T * N0P + C_GV + h * 128 + 64 * vh; s.vpitch = N0P;
        s.dec = (const float*)(P.ws + WS_GDEC) + (size_t)bh * 64 * 64; s.outp = (bf16*)(P.ws + WS_OARAW) + (size_t)b * T * 512 + h * 128 + 64 * vh; }
    return s;
}
DI void p3_seq(const Params& P, LAS unsigned char* lds, int tid, int wave, int lane) {
    const int bx = blockIdx.x;
    unsigned* progw = (unsigned*)(P.ws + WS_PROG);
    if (bx < 64) {
        const P3Src s = p3_src(P, bx);
        if (bx < 32) seq_pass<false>(progw + 16 * bx, s.mats, 4, s.vsrc, s.vpitch, nullptr, s.outp, lds, tid, wave, lane);
        else         seq_pass<true>(progw + 16 * bx, s.mats, 3, s.vsrc, s.vpitch, s.dec, s.outp, lds, tid, wave, lane);
    } else {
        const unsigned* xt = (const unsigned*)(P.ws + WS_XCCTAB);
        LAS unsigned* hs = (LAS unsigned*)lds;
        if (tid < 4) hs[tid] = 0u;
        __syncthreads();
        const unsigned myx = xt[bx];
        if (tid < 192) { const unsigned o = xt[64 + tid]; if (o == myx) { __hip_atomic_fetch_add(&hs[2], 1u, __ATOMIC_RELAXED, __HIP_MEMORY_SCOPE_WORKGROUP); if (64 + tid < bx) __hip_atomic_fetch_add(&hs[0], 1u, __ATOMIC_RELAXED, __HIP_MEMORY_SCOPE_WORKGROUP); } }
        if (tid >= 192 && tid < 256) { if (xt[tid - 192] == myx) { const unsigned slot = __hip_atomic_fetch_add(&hs[1], 1u, __ATOMIC_RELAXED, __HIP_MEMORY_SCOPE_WORKGROUP); hs[8 + slot] = (unsigned)(tid - 192); } }
        __syncthreads();
        const int rank = (int)hs[0], np = (int)hs[1], nh = (int)hs[2];
        unsigned pf0 = 0u;
        if (np > 0) {
            const int tgt = (int)hs[8 + (rank % np)];
            const int sub = rank / np, cnt = (nh - (rank % np) + np - 1) / np;
            const P3Src s = p3_src(P, tgt);
            const unsigned* pw = progw + 16 * tgt;
            const int nlm = s.nmat * 64;
            int pc = sub; unsigned spins = 0;
            while (pc < 64) {
                const int p = (int)__builtin_amdgcn_readfirstlane((int)__hip_atomic_load(pw, __ATOMIC_RELAXED, __HIP_MEMORY_SCOPE_AGENT));
                if (pc <= p + 8) {
                    const char* a = nullptr;
                    if (tid < nlm) a = (const char*)(s.mats + (size_t)pc * s.nmat * 4096) + (size_t)tid * 128;
                    else if (tid < nlm + 64) a = (const char*)(s.vsrc + (size_t)(pc * 64 + (tid - nlm)) * s.vpitch);
                    if (a) asm volatile("global_load_dword %0, %1, off" : "+v"(pf0) : "v"(a) : "memory");
                    pc += cnt;
                } else { __builtin_amdgcn_s_sleep(8); if (++spins > (1u << 16)) break; }
            }
        }
        asm volatile("s_waitcnt vmcnt(0)" : "+v"(pf0) :: "memory");
        __syncthreads();
    }
}

DI float silu_f(float g) { return g * __builtin_amdgcn_rcpf(1.f + __expf(-g)); }
DI void p4_finalize(const Params& P, int wave, int lane) {
    const int gw = blockIdx.x * 8 + wave, NGW = gridDim.x * 8;
    const bf16* OB = (const bf16*)(P.ws + WS_SCR); const bf16* OA = (const bf16*)(P.ws + WS_OARAW);
    const bf16* PROJ0 = (const bf16*)(P.ws + WS_PROJ0); const bf16* VP = (const bf16*)(P.ws + WS_VP); const float* BON = (const float*)(P.ws + WS_BONUS);
    bf16* O0 = (bf16*)(P.ws + WS_XN);
    const int cv = (8 * lane) & 127;
    const f32x4 gw0 = *(const f32x4*)(P.gla_norm_w + cv), gw1 = *(const f32x4*)(P.gla_norm_w + cv + 4);
    const f32x4 lw0 = *(const f32x4*)(P.ln_w + 8 * lane), lw1 = *(const f32x4*)(P.ln_w + 8 * lane + 4), lb0 = *(const f32x4*)(P.ln_b + 8 * lane), lb1 = *(const f32x4*)(P.ln_b + 8 * lane + 4);
    struct Ld { f32x4 a0, a1, b0, b1; u32x4 ga, gb, vv; float bon; };
    auto load = [&](int tok) { Ld L; const bf16* row = PROJ0 + (size_t)tok * N0P + C_GATE0;
        { const u32x4 wa = *(const u32x4*)(OA + (size_t)tok * 512 + 8 * lane), wb = *(const u32x4*)(OB + (size_t)tok * 512 + 8 * lane);
          L.a0 = (f32x4){bflo(wa.x), bfhi(wa.x), bflo(wa.y), bfhi(wa.y)}; L.a1 = (f32x4){bflo(wa.z), bfhi(wa.z), bflo(wa.w), bfhi(wa.w)};
          L.b0 = (f32x4){bflo(wb.x), bfhi(wb.x), bflo(wb.y), bfhi(wb.y)}; L.b1 = (f32x4){bflo(wb.z), bfhi(wb.z), bflo(wb.w), bfhi(wb.w)}; }
        L.ga = *(const u32x4*)(row + 8 * lane); L.gb = *(const u32x4*)(row + 512 + 8 * lane); L.vv = *(const u32x4*)(VP + (size_t)tok * 512 + 8 * lane); L.bon = BON[(size_t)tok * 8 + (lane >> 3)]; return L; };
    Ld nx = load(gw < M ? gw : 0);
    for (int tok = gw; tok < M; tok += NGW) {
        const Ld L = nx;
        if (tok + NGW < M) nx = load(tok + NGW);
        {
            const f32x4 a0 = L.a0, a1 = L.a1;
            float ss = (a0[0] * a0[0] + a0[1] * a0[1]) + (a0[2] * a0[2] + a0[3] * a0[3]) + (a1[0] * a1[0] + a1[1] * a1[1]) + (a1[2] * a1[2] + a1[3] * a1[3]);
            ss += __shfl_xor(ss, 1); ss += __shfl_xor(ss, 2); ss += __shfl_xor(ss, 4); ss += __shfl_xor(ss, 8);
            const float rstd = 1.0f / sqrtf(ss * (1.f / 128.f) + NORM_EPS);
            const u32x4 g = L.ga;
            u32x4 o;
            o.x = pk2(a0[0] * rstd * gw0[0] * silu_f(bflo(g.x)), a0[1] * rstd * gw0[1] * silu_f(bfhi(g.x)));
            o.y = pk2(a0[2] * rstd * gw0[2] * silu_f(bflo(g.y)), a0[3] * rstd * gw0[3] * silu_f(bfhi(g.y)));
            o.z = pk2(a1[0] * rstd * gw1[0] * silu_f(bflo(g.z)), a1[1] * rstd * gw1[1] * silu_f(bfhi(g.z)));
            o.w = pk2(a1[2] * rstd * gw1[2] * silu_f(bflo(g.w)), a1[3] * rstd * gw1[3] * silu_f(bfhi(g.w)));
            *(u32x4*)(O0 + (size_t)tok * 1024 + 8 * lane) = o;
        }
        {
            const f32x4 a0 = L.b0, a1 = L.b1;
            float s = (a0[0] + a0[1]) + (a0[2] + a0[3]) + (a1[0] + a1[1]) + (a1[2] + a1[3]);
            s += __shfl_xor(s, 1); s += __shfl_xor(s, 2); s += __shfl_xor(s, 4);
            const float mean = s * (1.f / 64.f);
            const f32x4 d0 = a0 - mean, d1 = a1 - mean;
            float q = (d0[0] * d0[0] + d0[1] * d0[1]) + (d0[2] * d0[2] + d0[3] * d0[3]) + (d1[0] * d1[0] + d1[1] * d1[1]) + (d1[2] * d1[2] + d1[3] * d1[3]);
            q += __shfl_xor(q, 1); q += __shfl_xor(q, 2); q += __shfl_xor(q, 4);
            const float rstd = 1.0f / sqrtf(q * (1.f / 64.f) + RWKV_LN_EPS);
            const float bon = L.bon; const u32x4 vv = L.vv, g = L.gb;
            u32x4 o;
            o.x = pk2((d0[0] * rstd * lw0[0] + lb0[0] + bon * bflo(vv.x)) * silu_f(bflo(g.x)), (d0[1] * rstd * lw0[1] + lb0[1] + bon * bfhi(vv.x)) * silu_f(bfhi(g.x)));
            o.y = pk2((d0[2] * rstd * lw0[2] + lb0[2] + bon * bflo(vv.y)) * silu_f(bflo(g.y)), (d0[3] * rstd * lw0[3] + lb0[3] + bon * bfhi(vv.y)) * silu_f(bfhi(g.y)));
            o.z = pk2((d1[0] * rstd * lw1[0] + lb1[0] + bon * bflo(vv.z)) * silu_f(bflo(g.z)), (d1[1] * rstd * lw1[1] + lb1[1] + bon * bfhi(vv.z)) * silu_f(bfhi(g.z)));
            o.w = pk2((d1[2] * rstd * lw1[2] + lb1[2] + bon * bflo(vv.w)) * silu_f(bflo(g.w)), (d1[3] * rstd * lw1[3] + lb1[3] + bon * bfhi(vv.w)) * silu_f(bfhi(g.w)));
            *(u32x4*)(O0 + (size_t)tok * 1024 + 512 + 8 * lane) = o;
        }
    }
}
constexpr int AT_KP = 144, AT_VP = 528, AT_VOFF = 256 * AT_KP;
DI void rope_cs(const float* RT, int pos, float (&cs)[8], float (&sn)[8]) {
    const f32x4* tp = (const f32x4*)(RT + (size_t)pos * 16);
#pragma unroll
    for (int q = 0; q < 4; ++q) { const f32x4 v = tp[q]; cs[2 * q] = v[0]; sn[2 * q] = v[1]; cs[2 * q + 1] = v[2]; sn[2 * q + 1] = v[3]; }
}
DI void p7_attn(const Params& P, LAS unsigned char* lds, int tid, int wave, int lane) {
    const bf16* PROJ1 = (const bf16*)(P.ws + WS_SCR); bf16* O1 = (bf16*)(P.ws + WS_XN); const float* RT = (const float*)(P.ws + WS_ROPE);
    const int m = lane & 31, hi = lane >> 5;
    const int c8 = tid & 7, kpar = (tid >> 3) & 1;
    u32x4 kw[4], vw[4];
    auto uload = [&](int unit) {
        const int qb = unit & 31, kvh = (unit >> 5) & 3, b = unit >> 7;
#pragma unroll
        for (int q = 0; q < 4; ++q) { const int key = (tid >> 3) + 64 * q; const int pos = qb * 128 - 128 + key;
            kw[q] = (u32x4){0u, 0u, 0u, 0u}; vw[q] = (u32x4){0u, 0u, 0u, 0u};
            if (pos >= 0) { const bf16* row = PROJ1 + (size_t)(b * T + pos) * IN1; kw[q] = *(const u32x4*)(row + 1024 + kvh * 64 + 8 * c8); vw[q] = *(const u32x4*)(row + 1280 + kvh * 64 + 8 * c8); } }
    };
    if ((int)blockIdx.x < 512) uload(blockIdx.x);
    struct QG { u32x4 q[4], qo; u32x2 g[8]; };
    auto qgload = [&](int unit, int qq) { QG r; const int qb = unit & 31, kvh = (unit >> 5) & 3, b = unit >> 7; const int h = kvh * 4 + (wave >> 1);
        const int pos = qb * 128 + (wave & 1) * 64 + 32 * qq + m; const bf16* row = PROJ1 + ((size_t)b * T + pos) * IN1;
#pragma unroll
        for (int s = 0; s < 4; ++s) r.q[s] = *(const u32x4*)(row + h * 64 + 16 * s + 8 * hi);
        r.qo = *(const u32x4*)(row + h * 64 + 8 * (hi ^ 1));
#pragma unroll
        for (int db = 0; db < 2; ++db)
#pragma unroll
            for (int gq = 0; gq < 4; ++gq) r.g[4 * db + gq] = *(const u32x2*)(row + 1536 + h * 64 + 32 * db + 8 * gq + 4 * hi);
        return r; };
    QG nxq = qgload((int)blockIdx.x < 512 ? blockIdx.x : 0, 0);
    for (int unit = blockIdx.x; unit < 512; unit += gridDim.x) {
        const int qb = unit & 31, kvh = (unit >> 5) & 3, b = unit >> 7;
#pragma unroll
        for (int q = 0; q < 4; ++q) {
            const int key = (tid >> 3) + 64 * q; const int pos = qb * 128 - 128 + key;
            u32x4 kq = kw[q];
            if (c8 < 2 && pos >= 0) { const bf16* row = PROJ1 + (size_t)(b * T + pos) * IN1;
                const u32x4 ow = *(const u32x4*)(row + 1024 + kvh * 64 + 8 * (c8 ^ 1)); float a[8], o[8], cs[8], sn[8]; unpack8(kq, a); unpack8(ow, o); rope_cs(RT, pos, cs, sn);
                float r[8];
#pragma unroll
                for (int j = 0; j < 8; ++j) r[j] = (c8 == 0) ? (a[j] * cs[j] - o[j] * sn[j]) : (a[j] * cs[j] + o[j] * sn[j]);
                kq.x = pk2(r[0], r[1]); kq.y = pk2(r[2], r[3]); kq.z = pk2(r[4], r[5]); kq.w = pk2(r[6], r[7]); }
            *(LAS u32x4*)(lds + key * AT_KP + c8 * 16) = kq;
            const u32x4 rv = vw[q];
            const unsigned k0 = kpar ? rv[2] : rv[0], k1 = kpar ? rv[3] : rv[1], s0 = kpar ? rv[0] : rv[2], s1 = kpar ? rv[1] : rv[3];
            const unsigned r0 = (unsigned)__builtin_amdgcn_update_dpp(0, (int)s0, 0x128, 0xf, 0xf, true), r1 = (unsigned)__builtin_amdgcn_update_dpp(0, (int)s1, 0x128, 0xf, 0xf, true);
            unsigned o4[4];
            if (kpar == 0) { o4[0] = (k0 & 0xffffu) | (r0 << 16); o4[1] = (k0 >> 16) | (r0 & 0xffff0000u); o4[2] = (k1 & 0xffffu) | (r1 << 16); o4[3] = (k1 >> 16) | (r1 & 0xffff0000u); }
            else           { o4[0] = (r0 & 0xffffu) | (k0 << 16); o4[1] = (r0 >> 16) | (k0 & 0xffff0000u); o4[2] = (r1 & 0xffffu) | (k1 << 16); o4[3] = (r1 >> 16) | (k1 & 0xffff0000u); }
            const int tp = key >> 1, gsw = (tp >> 2) ^ c8;
#pragma unroll
            for (int jj = 0; jj < 4; ++jj) *(LAS unsigned*)(lds + AT_VOFF + (8 * c8 + 4 * kpar + jj) * AT_VP + (4 * gsw + (tp & 3)) * 4) = o4[jj];
        }
        lds_barrier();
        if (unit + (int)gridDim.x < 512) uload(unit + gridDim.x);
        const int g = wave >> 1, h = kvh * 4 + g; const float sink = P.sinks[h];
        for (int qq = 0; qq < 2; ++qq) {
            const int qs = (wave & 1) * 64 + 32 * qq, qi = qs + m, pos = qb * 128 + qi; const size_t tok = (size_t)b * T + pos;
            const QG cq = nxq;
            { const int nu = (qq == 0) ? unit : unit + (int)gridDim.x; if (nu < 512) nxq = qgload(nu, qq ^ 1); }
            bf16x8 Q[4];
#pragma unroll
            for (int s = 0; s < 4; ++s) { const u32x4 w = cq.q[s]; float a[8]; unpack8(w, a);
                if (s == 0) { const u32x4 ow = cq.qo; float o[8], cs[8], sn[8]; unpack8(ow, o); rope_cs(RT, pos, cs, sn);
#pragma unroll
                    for (int j = 0; j < 8; ++j) a[j] = (hi == 0) ? (a[j] * cs[j] - o[j] * sn[j]) : (a[j] * cs[j] + o[j] * sn[j]); }
                u32x4 qw;
#pragma unroll
                for (int e = 0; e < 4; ++e) qw[e] = pk2(a[2 * e] * 0.125f, a[2 * e + 1] * 0.125f);
                Q[s] = __builtin_bit_cast(bf16x8, qw); }
            const int kb0 = qs >> 5;
            f32x16 sc[5];
#pragma unroll
            for (int kbi = 0; kbi < 5; ++kbi) {
#pragma unroll
                for (int i = 0; i < 16; ++i) sc[kbi][i] = 0.f;
#pragma unroll
                for (int s = 0; s < 4; ++s) { const bf16x8 A = *(const LAS bf16x8*)(lds + (32 * (kb0 + kbi) + m) * AT_KP + (16 * s + 8 * hi) * 2); sc[kbi] = MFMA32(A, Q[s], sc[kbi]); }
            }
            float mx = sink;
#pragma unroll
            for (int kbi = 0; kbi < 5; ++kbi)
#pragma unroll
                for (int i = 0; i < 16; ++i) { const int kj = 32 * (kb0 + kbi) + crow(i, hi);
                    const bool band = (kbi == 0) ? (kj >= qi + 1) : ((kbi == 4) ? (kj <= qi + 128) : true); const bool vis = band && (qb > 0 || kj >= 128);
                    sc[kbi][i] = vis ? sc[kbi][i] : -1e30f; mx = fmaxf(mx, sc[kbi][i]); }
            mx = fmaxf(mx, __shfl_xor(mx, 32));
            float sum = 0.f;
#pragma unroll
            for (int kbi = 0; kbi < 5; ++kbi)
#pragma unroll
                for (int i = 0; i < 16; ++i) { const float pv = __expf(sc[kbi][i] - mx); sc[kbi][i] = pv; sum += pv; }
            sum += __shfl_xor(sum, 32);
            const float inv = 1.f / (sum + __expf(sink - mx));
            f32x16 oacc[2];
#pragma unroll
            for (int db = 0; db < 2; ++db) {
#pragma unroll
                for (int i = 0; i < 16; ++i) oacc[db][i] = 0.f;
                const int vrow = 32 * db + m, rsw = (vrow >> 3) & 7;
#pragma unroll
                for (int kbi = 0; kbi < 5; ++kbi)
#pragma unroll
                    for (int s2 = 0; s2 < 2; ++s2) { u32x4 pw;
#pragma unroll
                        for (int e = 0; e < 4; ++e) pw[e] = pk2(sc[kbi][8 * s2 + 2 * e], sc[kbi][8 * s2 + 2 * e + 1]);
                        const int ga = 4 * (kb0 + kbi) + 2 * s2;
                        const LAS unsigned char* vp = lds + AT_VOFF + vrow * AT_VP + 8 * hi;
                        const u32x2 lo = *(const LAS u32x2*)(vp + (ga ^ rsw) * 16), hi2 = *(const LAS u32x2*)(vp + ((ga + 1) ^ rsw) * 16);
                        const u32x4 aw = (u32x4){lo.x, lo.y, hi2.x, hi2.y};
                        oacc[db] = MFMA32(__builtin_bit_cast(bf16x8, aw), __builtin_bit_cast(bf16x8, pw), oacc[db]); }
            }
#pragma unroll
            for (int db = 0; db < 2; ++db)
#pragma unroll
                for (int gq = 0; gq < 4; ++gq) { const int d0 = 32 * db + 8 * gq + 4 * hi; const u32x2 gw = cq.g[4 * db + gq];
                    u32x2 o; o.x = pk2(oacc[db][4 * gq] * inv * silu_f(bflo(gw.x)), oacc[db][4 * gq + 1] * inv * silu_f(bfhi(gw.x)));
                    o.y = pk2(oacc[db][4 * gq + 2] * inv * silu_f(bflo(gw.y)), oacc[db][4 * gq + 3] * inv * silu_f(bfhi(gw.y)));
                    *(u32x2*)(O1 + tok * 1024 + h * 64 + d0) = o; }
        }
        lds_barrier();
    }
}
DI void p9_final(const Params& P, int wave, int lane) {
    const int gw = blockIdx.x * 8 + wave, NGW = gridDim.x * 8;
    const float* slots = (const float*)(P.ws + WS_SLOT2);
    for (int mrow = gw; mrow < M; mrow += NGW) {
        float s = (lane < 16) ? slots[(size_t)mrow * 16 + lane] : 0.f;
        s += __shfl_xor(s, 1); s += __shfl_xor(s, 2); s += __shfl_xor(s, 4); s += __shfl_xor(s, 8);
        s = __shfl(s, 0);
        const float rstd = 1.0f / sqrtf(s * (1.f / 1024.f) + NORM_EPS);
        f32x4* o = (f32x4*)(P.out + (size_t)mrow * D) + lane; const f32x4* w = (const f32x4*)P.final_w + lane;
#pragma unroll
        for (int j = 0; j < 4; ++j) { const f32x4 v = o[64 * j]; o[64 * j] = v * rstd * w[64 * j]; }
    }
}

__global__ void __launch_bounds__(512) fwd_megakernel(Params P) {
    extern __shared__ __attribute__((aligned(16))) unsigned char lds_raw[];
    LAS unsigned char* lds = (LAS unsigned char*)lds_raw;
    cg::grid_group grid = cg::this_grid();
    const int tid = threadIdx.x, lane = tid & 63, wave = __builtin_amdgcn_readfirstlane(tid >> 6);
    const int G = gridDim.x;
    if (tid < 2) ((LAS unsigned*)(lds + LDS_BAR_OFF))[tid] = 0u;
    __syncthreads();
    if (tid == 0) ((unsigned*)(P.ws + WS_XCCTAB))[blockIdx.x] = xb_xcc_id() + 1u;
    const XcdBarrier xbar = xcd_barrier_post((unsigned*)(P.ws + WS_CTL), (volatile LAS unsigned*)(lds + LDS_BAR_OFF));
    bf16* XN = (bf16*)(P.ws + WS_XN);
    p0_prologue(P, lds, wave, lane);
    if (P.ws == nullptr) grid.sync();
    xcd_barrier(xbar);
    { pg8::Gemm g{XN, (const bf16*)(P.ws + WS_W0T), M, N0P, D}; pg8::StaticOrder S; S.init(M, N0P, G, (int)blockIdx.x);
      EpiScaleBf16 E{(bf16*)(P.ws + WS_PROJ0), N0P, nullptr, nullptr, 0};
      pg8::gemm_phase<EpiScaleBf16, pg8::StaticOrder, true, true>(lds, g, S, E); }
    xcd_barrier(xbar);
#pragma unroll 1
    for (int rep = 0; rep < REP_P2R; ++rep) { for (int it = blockIdx.x; it < 512; it += G) rwkv_prep_item(P, it, lds, wave, lane); }
#pragma unroll 1
    for (int rep = 0; rep < REP_P2G; ++rep) { for (int it = blockIdx.x; it < 1024; it += G) gla_prep_item(P, it, lds, wave, lane); }
    xcd_barrier(xbar);
#pragma unroll 1
    for (int rep = 0; rep < REP_P3; ++rep) { p3_seq(P, lds, tid, wave, lane); __syncthreads(); }
    xcd_barrier(xbar);
    p4_finalize(P, wave, lane);
    xcd_barrier(xbar);
    { pg8::Gemm g{XN, (const bf16*)(P.ws + WS_WO0T), M, D, D}; pg8::StaticOrder S; S.init(M, D, G, (int)blockIdx.x);
      EpiResid E{P.x, (bf16*)(P.ws + WS_H1B), (float*)(P.ws + WS_SLOT1)};
      pg8::gemm_phase<EpiResid, pg8::StaticOrder, true, true>(lds, g, S, E); }
    xcd_barrier(xbar);
    { pg8::Gemm g{(const bf16*)(P.ws + WS_H1B), (const bf16*)(P.ws + WS_W1T), M, IN1, D}; pg8::StaticOrder S; S.init(M, IN1, G, (int)blockIdx.x);
      EpiScaleBf16 E{(bf16*)(P.ws + WS_SCR), IN1, (const float*)(P.ws + WS_SLOT1), P.b_in1, 1536};
      pg8::gemm_phase<EpiScaleBf16, pg8::StaticOrder, true, true>(lds, g, S, E); }
    xcd_barrier(xbar);
    p7_attn(P, lds, tid, wave, lane);
    xcd_barrier(xbar);
    { pg8::Gemm g{XN, (const bf16*)(P.ws + WS_WO1T), M, D, D}; pg8::StaticOrder S; S.init(M, D, G, (int)blockIdx.x);
      EpiResidNorm E{(const bf16*)(P.ws + WS_H1B), P.out, P.b_out1, P.final_w, (float*)(P.ws + WS_SLOT2), (unsigned*)(P.ws + WS_PCNT)};
      pg8::gemm_phase<EpiResidNorm, pg8::StaticOrder, false, true>(lds, g, S, E); }
}

extern "C" void kernel_launch(void* const* d_in, const int* in_sizes, int n_in, void* d_out, int out_size, void* d_ws, size_t ws_size, hipStream_t stream) {
    static int grid = 0;
    if (grid == 0) {
        if (n_in != 23 || out_size != M * D || ws_size < WS_END) { fprintf(stderr, "kernel_launch: unexpected sizes n_in %d out %d ws %zu\n", n_in, out_size, ws_size); grid = -1; return; }
        int dev = 0, cus = 0, per_cu = 0;
        hipGetDevice(&dev); hipDeviceGetAttribute(&cus, hipDeviceAttributeMultiprocessorCount, dev);
        hipFuncSetAttribute((const void*)fwd_megakernel, hipFuncAttributeMaxDynamicSharedMemorySize, LDS_BYTES);
        hipOccupancyMaxActiveBlocksPerMultiprocessor(&per_cu, (const void*)fwd_megakernel, 512, LDS_BYTES);
        if (per_cu < 1) { fprintf(stderr, "kernel_launch: occupancy query says %d blocks/CU\n", per_cu); per_cu = 1; }
        grid = cus * 1;
        if (grid != 256) { fprintf(stderr, "kernel_launch: built for a 256-CU device (got %d)\n", cus); grid = -1; return; }
        (void)hipGetLastError();
    }
    if (grid < 0) return;
    Params p{};
    const float** pp = (const float**)&p;
    for (int i = 0; i < 23; ++i) pp[i] = (const float*)d_in[i];
    p.out = (float*)d_out; p.ws = (unsigned char*)d_ws;
    if (hipMemsetAsync((char*)d_ws + WS_CTL, 0, CTL_BYTES, stream) != hipSuccess) { fprintf(stderr, "memset failed\n"); return; }
    void* args[] = {&p};
    hipError_t e = hipLaunchCooperativeKernel((const void*)fwd_megakernel, dim3(grid), dim3(512), args, LDS_BYTES, stream);
    if (e != hipSuccess) fprintf(stderr, "cooperative launch failed: %s (grid %d)\n", hipGetErrorString(e), grid);
}
```

```cpp
#include <hip/hip_runtime.h>
#include <hip/hip_cooperative_groups.h>
#include <cstdio>
#include <cstdint>
namespace cg = cooperative_groups;
#ifndef REP_P2R
#define REP_P2R 1
#endif
#ifndef REP_P2G
#define REP_P2G 1
#endif
#ifndef REP_S2
#define REP_S2 1
#endif
#ifndef REP_P3
#define REP_P3 1
#endif
namespace pg8 {
#define PG8_LAS __attribute__((address_space(3)))
typedef unsigned short bf16_t;
typedef short bf16x8 __attribute__((ext_vector_type(8)));
typedef float f32x4 __attribute__((ext_vector_type(4)));
typedef unsigned u32x4 __attribute__((ext_vector_type(4)));
constexpr int BM = 256, BK = 64, HALF = 128, HTB = HALF * BK * 2  , STAGE_BYTES = 8 * HTB, NXCD = 8, WGM = 8;

__host__ __device__ __forceinline__ int lds_byte(int r, int c) { const int st = (r >> 4) * 2 + (c >> 5), rr = r & 15, cc = c & 31, ob = rr * 64 + cc * 2; return st * 1024 + (ob ^ (((ob >> 9) & 1) << 5)); }
__host__ __device__ __forceinline__ void stage_rc(int b, int& R, int& C) { const int st = b / 1024, sb = b % 1024, swz = sb ^ (((sb >> 9) & 1) << 5); R = (st >> 1) * 16 + swz / 64; C = (st & 1) * 32 + (swz % 64) / 2; }
__host__ __device__ __forceinline__ int perm32(int rho) { const int n = rho >> 4, i = rho & 15; return 8 * (i >> 2) + 4 * n + (i & 3); }

struct Unit { int pm, pn; };
struct Gemm { const bf16_t* A; const bf16_t* Bt; int M, N, K; };

struct StaticOrder {
    int nM, nN, nwg, G, c;
    __host__ __device__ void init(int M, int N, int G_, int c_) { nM = M / BM; nN = N / BM; nwg = nM * nN; G = G_; c = c_; }
    __host__ __device__ bool next(int i, Unit& u) const {
        const long L = (long)i * G + c; if (L >= nwg) return false;
        int wgid = (int)L; { const int q = nwg / NXCD, r = nwg % NXCD, xcd = wgid % NXCD, off = wgid / NXCD; wgid = (xcd < r ? xcd * (q + 1) : r * (q + 1) + (xcd - r) * q) + off; }
        const int nig = WGM * nN, gid = wgid / nig, fm = gid * WGM, gsz = (nM - fm) < WGM ? (nM - fm) : WGM;
        u.pm = fm + ((wgid % nig) % gsz); u.pn = (wgid % nig) / gsz; return true;
    }
    __device__ __forceinline__ void a_ready(const Unit&) const {}
    __device__ __forceinline__ void done(const Unit&) const {}
};

template <class Epi, class Sched, bool ALIGN_EPI = false, bool SP2 = false>
__device__ __forceinline__ void gemm_phase(PG8_LAS unsigned char* lds, const Gemm g, const Sched& S, const Epi& E) {
    const int tid = threadIdx.x, wid = __builtin_amdgcn_readfirstlane(tid >> 6), lane = tid & 63, wr = wid >> 2, wc = wid & 3, fr = lane & 15, fq = lane >> 4;
    const int K = g.K, nt = K / BK;
    unsigned voffA[2], voffB[2];
#pragma unroll
    for (int i = 0; i < 2; ++i) { int R, C; stage_rc(tid * 16 + i * 8192, R, C); const int Rb = Epi::PERM ? ((R & ~31) + perm32(R & 31)) : R;
        voffA[i] = (unsigned)(R * K + C) * 2u; voffB[i] = (unsigned)(Rb * K + C) * 2u; }
    const size_t kstep = (size_t)(BK * 2);
    const size_t hstep = (size_t)HALF * K * 2;
    const size_t tstep = 2 * hstep;
    const unsigned ldsw = (unsigned)wid * 1024u;
    const int aoff = lds_byte(wr * 64 + fr, fq * 8), boff = lds_byte(wc * 32 + fr, fq * 8);
#define PG8_SA(b, h) (((b) * 2 + (h)) * HTB)
#define PG8_SB(b, h) ((4 + (b) * 2 + (h)) * HTB)
#define PG8_STAGE(bufoff, gbase, voff) do { _Pragma("unroll") for (int _i = 0; _i < 2; ++_i) \
        __builtin_amdgcn_global_load_lds((const unsigned*)((const char*)(gbase) + (voff)[_i]), (PG8_LAS unsigned*)(lds + (bufoff) + ldsw + _i * 8192), 16, 0, 0); } while (0)
#define PG8_LDA(dst, b, h) do { _Pragma("unroll") for (int m = 0; m < 4; ++m) _Pragma("unroll") for (int k = 0; k < 2; ++k) dst[m][k] = *(const PG8_LAS bf16x8*)(lds + PG8_SA(b, h) + aoff + m * 2048 + k * 1024); } while (0)
#define PG8_LDB(dst, b, h) do { _Pragma("unroll") for (int n = 0; n < 2; ++n) _Pragma("unroll") for (int k = 0; k < 2; ++k) dst[n][k] = *(const PG8_LAS bf16x8*)(lds + PG8_SB(b, h) + boff + n * 2048 + k * 1024); } while (0)
#define PG8_MMA(ai, bj, At, Bt) do { __builtin_amdgcn_s_setprio(1); _Pragma("unroll") for (int m = 0; m < 4; ++m) _Pragma("unroll") for (int n = 0; n < 2; ++n) _Pragma("unroll") for (int k = 0; k < 2; ++k) \
        acc[ai][bj][m][n] = __builtin_amdgcn_mfma_f32_16x16x32_bf16(Bt[n][k], At[m][k], acc[ai][bj][m][n], 0, 0, 0); __builtin_amdgcn_s_setprio(0); } while (0)
#define PG8_WAIT_V(n) asm volatile("s_waitcnt vmcnt(" #n ")" ::: "memory")
#define PG8_WAIT_L(n) asm volatile("s_waitcnt lgkmcnt(" #n ")" ::: "memory")
#define PG8_BAR __builtin_amdgcn_s_barrier()
#define PG8_SCHED __builtin_amdgcn_sched_barrier(0)
    Unit cur, nxt; int ui = 0;
    if (!S.next(0, cur)) return;
    f32x4 acc[2][2][4][2];
#pragma unroll
    for (int a = 0; a < 2; ++a)
#pragma unroll
        for (int b = 0; b < 2; ++b)
#pragma unroll
            for (int m = 0; m < 4; ++m)
#pragma unroll
                for (int n = 0; n < 2; ++n) acc[a][b][m][n] = (f32x4){0.f, 0.f, 0.f, 0.f};
    bf16x8 At[4][2], B0[2][2], B1[2][2];
    const char* cA = (const char*)g.A + (size_t)cur.pm * tstep; const char* cB = (const char*)g.Bt + (size_t)cur.pn * tstep;
    S.a_ready(cur);
    if constexpr (SP2) {
        PG8_STAGE(PG8_SB(0, 0), cB, voffB); PG8_STAGE(PG8_SB(0, 1), cB + hstep, voffB); PG8_STAGE(PG8_SA(0, 0), cA, voffA); PG8_STAGE(PG8_SA(0, 1), cA + hstep, voffA);
        if (wr == 1) PG8_BAR;
        PG8_WAIT_V(2); PG8_BAR;
        PG8_STAGE(PG8_SB(1, 0), cB + kstep, voffB); PG8_STAGE(PG8_SA(1, 0), cA + kstep, voffA); PG8_STAGE(PG8_SB(1, 1), cB + hstep + kstep, voffB);
        PG8_WAIT_V(6); PG8_BAR;
    } else {
        PG8_STAGE(PG8_SB(0, 0), cB, voffB); PG8_STAGE(PG8_SA(0, 0), cA, voffA); PG8_STAGE(PG8_SB(0, 1), cB + hstep, voffB); PG8_STAGE(PG8_SA(0, 1), cA + hstep, voffA);
        if (wr == 1) PG8_BAR;
        PG8_WAIT_V(4); PG8_BAR;
        PG8_STAGE(PG8_SB(1, 0), cB + kstep, voffB); PG8_STAGE(PG8_SA(1, 0), cA + kstep, voffA); PG8_STAGE(PG8_SB(1, 1), cB + hstep + kstep, voffB);
        PG8_WAIT_V(6); PG8_BAR;
    }
    for (;;) {
        const bool has_next = S.next(ui + 1, nxt);
        const char* nA = has_next ? (const char*)g.A + (size_t)nxt.pm * tstep : cA; const char* nB = has_next ? (const char*)g.Bt + (size_t)nxt.pn * tstep : cB;
        for (int t = 0; t < nt; t += 2) {
            const bool last = (t == nt - 2);
            const char* a1 = cA + (size_t)(t + 1) * kstep;
            const char* a2 = last ? nA : cA + (size_t)(t + 2) * kstep; const char* b2 = last ? nB : cB + (size_t)(t + 2) * kstep;
            const char* a3 = a2 + kstep; const char* b3 = b2 + kstep;
            if (last && has_next) S.a_ready(nxt);
            if constexpr (SP2) {
            PG8_LDB(B0, 0, 0); PG8_LDB(B1, 0, 1); PG8_SCHED; PG8_LDA(At, 0, 0); PG8_STAGE(PG8_SA(1, 1), a1 + hstep, voffA);
            PG8_WAIT_V(8); PG8_WAIT_L(0); PG8_BAR; PG8_MMA(0, 0, At, B0); PG8_MMA(0, 1, At, B1); PG8_BAR; PG8_SCHED;
            PG8_LDA(At, 0, 1); PG8_STAGE(PG8_SB(0, 0), b2, voffB); PG8_STAGE(PG8_SB(0, 1), b2 + hstep, voffB); PG8_STAGE(PG8_SA(0, 0), a2, voffA);
            PG8_WAIT_V(8); PG8_WAIT_L(0); PG8_BAR; PG8_MMA(1, 0, At, B0); PG8_MMA(1, 1, At, B1); PG8_BAR; PG8_SCHED;
            PG8_LDB(B0, 1, 0); PG8_LDB(B1, 1, 1); PG8_SCHED; PG8_LDA(At, 1, 0); PG8_STAGE(PG8_SA(0, 1), a2 + hstep, voffA);
            PG8_WAIT_V(8); PG8_WAIT_L(0); PG8_BAR; PG8_MMA(0, 0, At, B0); PG8_MMA(0, 1, At, B1); PG8_BAR; PG8_SCHED;
            PG8_LDA(At, 1, 1); PG8_STAGE(PG8_SB(1, 0), b3, voffB); PG8_STAGE(PG8_SB(1, 1), b3 + hstep, voffB); PG8_STAGE(PG8_SA(1, 0), a3, voffA);
            PG8_WAIT_V(8); PG8_WAIT_L(0); PG8_BAR; PG8_MMA(1, 0, At, B0); PG8_MMA(1, 1, At, B1); PG8_BAR; PG8_SCHED;
            } else {
            PG8_LDB(B0, 0, 0); PG8_SCHED; PG8_LDA(At, 0, 0); PG8_STAGE(PG8_SA(1, 1), a1 + hstep, voffA);
            PG8_WAIT_L(8); PG8_BAR; PG8_WAIT_L(0); PG8_MMA(0, 0, At, B0); PG8_BAR; PG8_SCHED;
            PG8_LDB(B1, 0, 1); PG8_STAGE(PG8_SB(0, 0), b2, voffB);
            PG8_BAR; PG8_WAIT_L(0); PG8_MMA(0, 1, At, B1); PG8_BAR;
            PG8_LDA(At, 0, 1); PG8_STAGE(PG8_SA(0, 0), a2, voffA);
            PG8_BAR; PG8_WAIT_L(0); PG8_MMA(1, 0, At, B0); PG8_BAR; PG8_SCHED;
            PG8_STAGE(PG8_SB(0, 1), b2 + hstep, voffB);
            PG8_WAIT_V(6); PG8_BAR; PG8_MMA(1, 1, At, B1); PG8_BAR;
            PG8_LDB(B0, 1, 0); PG8_SCHED; PG8_LDA(At, 1, 0); PG8_STAGE(PG8_SA(0, 1), a2 + hstep, voffA);
            PG8_WAIT_L(8); PG8_BAR; PG8_WAIT_L(0); PG8_MMA(0, 0, At, B0); PG8_BAR; PG8_SCHED;
            PG8_LDB(B1, 1, 1); PG8_STAGE(PG8_SB(1, 0), b3, voffB);
            PG8_BAR; PG8_WAIT_L(0); PG8_MMA(0, 1, At, B1); PG8_BAR;
            PG8_LDA(At, 1, 1); PG8_STAGE(PG8_SA(1, 0), a3, voffA);
            PG8_BAR; PG8_WAIT_L(0); PG8_MMA(1, 0, At, B0); PG8_BAR; PG8_SCHED;
            PG8_STAGE(PG8_SB(1, 1), b3 + hstep, voffB);
            PG8_WAIT_V(6); PG8_BAR; PG8_MMA(1, 1, At, B1); PG8_BAR;
            }
        }
        if constexpr (ALIGN_EPI) { if (wr == 0) PG8_BAR; }
        if constexpr (!Epi::AFTER_DRAIN) { E(acc, cur, wr, wc, fr, fq); S.done(cur); }
        if (!has_next) break;
#pragma unroll
        for (int a = 0; a < 2; ++a)
#pragma unroll
            for (int b = 0; b < 2; ++b)
#pragma unroll
                for (int m = 0; m < 4; ++m)
#pragma unroll
                    for (int n = 0; n < 2; ++n) acc[a][b][m][n] = (f32x4){0.f, 0.f, 0.f, 0.f};
        cur = nxt; cA = nA; cB = nB; ++ui;
        if constexpr (ALIGN_EPI) { if (wr == 1) PG8_BAR; }
    }
    PG8_WAIT_V(0);
    if constexpr (!ALIGN_EPI) { if (wr == 0) PG8_BAR; }
    PG8_BAR;
    if constexpr (Epi::AFTER_DRAIN) { E.fused(acc, cur, wr, wc, fr, fq, lds, wid, lane); S.done(cur); }
#undef PG8_SA
#undef PG8_SB
#undef PG8_STAGE
#undef PG8_LDA
#undef PG8_LDB
#undef PG8_MMA
#undef PG8_WAIT_V
#undef PG8_WAIT_L
#undef PG8_BAR
#undef PG8_SCHED
}
}
#define GAS __attribute__((address_space(1)))
#define LAS __attribute__((address_space(3)))
#define AS4 __attribute__((address_space(4)))
#define DI __device__ __forceinline__
typedef unsigned short bf16;
typedef float f32x4 __attribute__((ext_vector_type(4)));
typedef float f32x16 __attribute__((ext_vector_type(16)));
typedef short bf16x8 __attribute__((ext_vector_type(8)));
typedef short s16x4 __attribute__((ext_vector_type(4)));
typedef unsigned u32x4 __attribute__((ext_vector_type(4)));
typedef unsigned u32x2 __attribute__((ext_vector_type(2)));
typedef __bf16 bf2v __attribute__((ext_vector_type(2)));

constexpr int NB = 4, T = 4096, M = NB * T, D = 1024;
constexpr int IN0 = 3728, N0P = 3840, IN1 = 2560;
constexpr int C_GQ = 0, C_GK = 256, C_GV = 512, C_GLOW = 1024, C_RW = 1040, C_GATE0 = 2704;
constexpr int C_RR = C_RW, C_RK = C_RW + 512, C_RV = C_RW + 1024, C_XW = C_RW + 1536, C_XA = C_RW + 1600;
constexpr float NORM_EPS = 1e-5f, RWKV_LN_EPS = 64e-5f;
constexpr size_t MiB = 1u << 20;
constexpr size_t WS_W0T = 0, WS_WO0T = 8 * MiB, WS_W1T = 10 * MiB, WS_WO1T = 15 * MiB;
constexpr size_t WS_SLOT1 = 17 * MiB, WS_SLOT2 = 18 * MiB, WS_BONUS = 19 * MiB, WS_GDEC = 19 * MiB + 512 * 1024;
constexpr size_t WS_CTL = 19 * MiB + 768 * 1024, CTL_BYTES = 40960, WS_PCNT = WS_CTL + 16384;
constexpr size_t WS_XCCTAB = WS_CTL + 32768, WS_PROG = WS_CTL + 33792;
constexpr int LDS_BAR_OFF = 147456 - 64;
constexpr size_t WS_ROPE = 18 * MiB + 512 * 1024;
constexpr size_t WS_WLT = 18 * MiB + 768 * 1024;
constexpr size_t WS_XN = 20 * MiB;
constexpr size_t WS_PROJ0 = 52 * MiB;
constexpr size_t WS_H1B = 116 * MiB;
constexpr size_t WS_SCR = 172 * MiB;
constexpr size_t WS_OARAW = 204 * MiB;
constexpr size_t WS_VP = 236 * MiB;
constexpr size_t WS_END = 252 * MiB;
constexpr int LDS_BYTES = 147456;

struct Params {
    const float *x, *norm_w, *w_in0, *gk_up, *gk_bias, *gla_norm_w, *mu, *w0, *w_up, *a0, *a_up, *k_k, *k_a, *r_k, *ln_w, *ln_b, *w_out0, *w_in1, *b_in1, *sinks, *w_out1, *b_out1, *final_w;
    float* out; unsigned char* ws;
};

typedef float f32x2v __attribute__((ext_vector_type(2)));
DI unsigned pk2(float lo, float hi) { const f32x2v f = {lo, hi}; return __builtin_bit_cast(unsigned, __builtin_convertvector(f, bf2v)); }
DI unsigned f2bf(float f) { return pk2(f, 0.f) & 0xffffu; }
DI float bf2f(unsigned h) { return __builtin_bit_cast(float, h << 16); }
DI float bflo(unsigned w) { return __builtin_bit_cast(float, w << 16); }
DI float bfhi(unsigned w) { return __builtin_bit_cast(float, w & 0xffff0000u); }
DI float wave_sum(float v) {
#pragma unroll
    for (int o = 1; o < 64; o <<= 1) v += __shfl_xor(v, o);
    return v;
}
DI float dpp_sum16(float v) {
    v += __builtin_bit_cast(float, __builtin_amdgcn_update_dpp(0, __builtin_bit_cast(int, v), 0xB1, 0xf, 0xf, true));
    v += __builtin_bit_cast(float, __builtin_amdgcn_update_dpp(0, __builtin_bit_cast(int, v), 0x4E, 0xf, 0xf, true));
    v += __builtin_bit_cast(float, __builtin_amdgcn_update_dpp(0, __builtin_bit_cast(int, v), 0x141, 0xf, 0xf, true));
    v += __builtin_bit_cast(float, __builtin_amdgcn_update_dpp(0, __builtin_bit_cast(int, v), 0x140, 0xf, 0xf, true));
    return v;
}
DI float half_sum32(float v) { v = dpp_sum16(v); return v + __shfl_xor(v, 16); }
DI void unpack8(const u32x4 w, float (&f)[8]) {
#pragma unroll
    for (int e = 0; e < 4; ++e) { f[2 * e] = bflo(w[e]); f[2 * e + 1] = bfhi(w[e]); }
}
DI int crow(int r, int hi) { return (r & 3) + 8 * (r >> 2) + 4 * hi; }
DI int kpos(int k) { const int o16 = k & 15; return (k & ~15) + 8 * ((o16 >> 2) & 1) + 4 * (o16 >> 3) + (o16 & 3); }
#define MFMA32(a, b, c) __builtin_amdgcn_mfma_f32_32x32x16_bf16((a), (b), (c), 0, 0, 0)
#define LDS_WAIT() asm volatile("s_waitcnt lgkmcnt(0)" ::: "memory")
DI void lds_barrier() { asm volatile("s_waitcnt lgkmcnt(0)" ::: "memory"); __builtin_amdgcn_s_barrier(); asm volatile("" ::: "memory"); }

#define XB_TMO      128
#define XB_XCNT(j)  (256  + 64 * (j))
#define XB_XSUB(j)  (1280 + 64 * (j))
#define XB_XGEN(j)  (2304 + 64 * (j))
#define XB_TOP      3328
#define XB_TOPGEN   3392
#define XCD_BAR_WORDS 3456
#define XB_SPIN_CAP (1u << 18)

__device__ __forceinline__ unsigned xb_ld(unsigned* p)              { return __hip_atomic_load(p, __ATOMIC_RELAXED, __HIP_MEMORY_SCOPE_AGENT); }
__device__ __forceinline__ unsigned xb_add(unsigned* p, unsigned v) { return __hip_atomic_fetch_add(p, v, __ATOMIC_RELAXED, __HIP_MEMORY_SCOPE_AGENT); }
__device__ __forceinline__ unsigned xb_xcc_id() { return (unsigned)__builtin_amdgcn_s_getreg((3 << 11) | 20) & 0xFu; }
#define XB_SPIN(cond, bar) do { unsigned _sp = 0; while (cond) { __builtin_amdgcn_s_sleep(1); \
    if ((++_sp & 255u) == 0u) { if (xb_ld(&(bar)[XB_TMO])) break; if (_sp > XB_SPIN_CAP) { atomicAdd(&(bar)[XB_TMO], 1u); break; } } } } while (0)

struct XcdBarrier {
    unsigned* bar; unsigned x;
    volatile LAS unsigned* st;
};

__device__ __forceinline__ XcdBarrier xcd_barrier_post(unsigned* bar, volatile LAS unsigned* st) {
    XcdBarrier b; b.bar = bar; b.x = xb_xcc_id(); b.st = st;
    if (threadIdx.x == 0) (void)xb_add(&bar[XB_XCNT(b.x)], 1u);
    return b;
}
__device__ __forceinline__ void xcd_barrier_complete(unsigned* bar, unsigned x, unsigned& nloc, unsigned& nx) {
    const unsigned G = gridDim.x * gridDim.y * gridDim.z;
    unsigned sum, cnt, mine, sp = 0u;
    for (;;) {
        sum = 0u; cnt = 0u; mine = 0u;
#pragma unroll
        for (unsigned j = 0; j < 16; ++j) { const unsigned c = xb_ld(&bar[XB_XCNT(j)]); sum += c; cnt += (c > 0u) ? 1u : 0u; mine = (j == x) ? c : mine; }
        if (sum == G) break;
        __builtin_amdgcn_s_sleep(1);
        if ((++sp & 255u) == 0u) { if (xb_ld(&bar[XB_TMO])) break; if (sp > XB_SPIN_CAP) { atomicAdd(&bar[XB_TMO], 1u); break; } }
    }
    nloc = mine > 0u ? mine : 1u; nx = cnt > 0u ? cnt : 1u;
}

__device__ __forceinline__ void xcd_barrier(const XcdBarrier& b) {
    asm volatile("s_waitcnt vmcnt(0)" ::: "memory");
    __syncthreads();
    if (threadIdx.x == 0) {
        unsigned* bar = b.bar;
        __builtin_amdgcn_s_waitcnt(0);
        unsigned nloc = b.st[0], nx = b.st[1];
        if (nloc == 0u) { xcd_barrier_complete(bar, b.x, nloc, nx); b.st[0] = nloc; b.st[1] = nx; }
        const unsigned old = xb_add(&bar[XB_XSUB(b.x)], 1u);
        const unsigned gen = old / nloc;
        if (old + 1u == (gen + 1u) * nloc) {
            __builtin_amdgcn_fence(__ATOMIC_RELEASE, "agent");
            asm volatile("s_waitcnt vmcnt(0)" ::: "memory");
            const unsigned og = xb_add(&bar[XB_TOP], 1u);
            const unsigned tg = og / nx;
            if (og + 1u == (tg + 1u) * nx) xb_add(&bar[XB_TOPGEN], 1u);
            else XB_SPIN(xb_ld(&bar[XB_TOPGEN]) == tg, bar);
            __builtin_amdgcn_fence(__ATOMIC_ACQUIRE, "agent");
            xb_add(&bar[XB_XGEN(b.x)], 1u);
            asm volatile("s_waitcnt vmcnt(0)" ::: "memory");
        } else {
            XB_SPIN(xb_ld(&bar[XB_XGEN(b.x)]) == gen, bar);
            __builtin_amdgcn_fence(__ATOMIC_ACQUIRE, "agent");
            asm volatile("s_waitcnt vmcnt(0)" ::: "memory");
        }
    }
    __syncthreads();
}

struct EpiScaleBf16 {
    static constexpr bool PERM = true, AFTER_DRAIN = false;
    bf16* O; int ldc; const float* slots; const float* bias; int bias_n;
    DI void operator()(const pg8::f32x4 (&acc)[2][2][4][2], const pg8::Unit& u, int wr, int wc, int fr, int fq) const {
        const int row0 = u.pm * 256 + wr * 64 + fr, col0 = u.pn * 256 + wc * 32 + 8 * fq;
        const bool hb = bias && (u.pn * 256 < bias_n);
        f32x4 bv[2][2];
#pragma unroll
        for (int bj = 0; bj < 2; ++bj)
#pragma unroll
            for (int n = 0; n < 2; ++n) bv[bj][n] = hb ? *(const f32x4*)(bias + col0 + bj * 128 + 4 * n) : (f32x4){0.f, 0.f, 0.f, 0.f};
#pragma unroll
        for (int ai = 0; ai < 2; ++ai)
#pragma unroll
            for (int m = 0; m < 4; ++m) {
                const int row = row0 + ai * 128 + m * 16; float rs = 1.f;
                if (slots) { const f32x4* sp = (const f32x4*)(slots + (size_t)row * 16); const f32x4 a = sp[0], b = sp[1], c = sp[2], d = sp[3];
                    const float ss = ((a[0] + a[1]) + (a[2] + a[3])) + ((b[0] + b[1]) + (b[2] + b[3])) + ((c[0] + c[1]) + (c[2] + c[3])) + ((d[0] + d[1]) + (d[2] + d[3]));
                    rs = 1.0f / sqrtf(ss * (1.0f / 1024.0f) + NORM_EPS); }
                bf16* rowp = O + (size_t)row * ldc + col0;
#pragma unroll
                for (int bj = 0; bj < 2; ++bj) { const f32x4 v0 = acc[ai][bj][m][0] * rs + bv[bj][0], v1 = acc[ai][bj][m][1] * rs + bv[bj][1];
                    u32x4 w; w.x = pk2(v0[0], v0[1]); w.y = pk2(v0[2], v0[3]); w.z = pk2(v1[0], v1[1]); w.w = pk2(v1[2], v1[3]);
                    *(u32x4*)(rowp + bj * 128) = w; }
            }
    }
};
struct EpiResid {
    static constexpr bool PERM = false, AFTER_DRAIN = false;
    const float* base; bf16* outB; float* slots;
    DI void operator()(const pg8::f32x4 (&acc)[2][2][4][2], const pg8::Unit& u, int wr, int wc, int fr, int fq) const {
        const int col0 = u.pn * 256 + wc * 32 + 4 * fq;
#pragma unroll
        for (int ai = 0; ai < 2; ++ai)
#pragma unroll
            for (int m = 0; m < 4; ++m) {
                const int row = u.pm * 256 + ai * 128 + wr * 64 + m * 16 + fr; const size_t off = (size_t)row * 1024 + col0; float ss = 0.f;
#pragma unroll
                for (int bj = 0; bj < 2; ++bj)
#pragma unroll
                    for (int n = 0; n < 2; ++n) { const f32x4 bs = *(const f32x4*)(base + off + bj * 128 + n * 16); const f32x4 v = bs + acc[ai][bj][m][n];
                        u32x2 w; w.x = pk2(v[0], v[1]); w.y = pk2(v[2], v[3]); *(u32x2*)(outB + off + bj * 128 + n * 16) = w;
                        ss += (v[0] * v[0] + v[1] * v[1]) + (v[2] * v[2] + v[3] * v[3]); }
                ss += __shfl_xor(ss, 16); ss += __shfl_xor(ss, 32);
                if (fq == 0) slots[(size_t)row * 16 + u.pn * 4 + wc] = ss;
            }
    }
};

struct EpiResidNorm {
    static constexpr bool PERM = false, AFTER_DRAIN = true;
    const bf16* base; float* out; const float* bias; const float* w; float* xbuf; unsigned* cnt;
    DI void fused(pg8::f32x4 (&acc)[2][2][4][2], const pg8::Unit& u, int wr, int wc, int fr, int fq, PG8_LAS unsigned char* lds, int wid, int lane) const {
        PG8_LAS float* Pt = (PG8_LAS float*)lds;
        PG8_LAS float* S = (PG8_LAS float*)(lds + 4096);
        const int col0 = u.pn * 256 + wc * 32 + 4 * fq;
#pragma unroll
        for (int ai = 0; ai < 2; ++ai)
#pragma unroll
            for (int m = 0; m < 4; ++m) {
                const int r = ai * 128 + wr * 64 + m * 16 + fr; const size_t off = (size_t)(u.pm * 256 + r) * 1024 + col0; float ss = 0.f;
#pragma unroll
                for (int bj = 0; bj < 2; ++bj)
#pragma unroll
                    for (int n = 0; n < 2; ++n) { const u32x2 bw = *(const u32x2*)(base + off + bj * 128 + n * 16); const f32x4 bs = (f32x4){bflo(bw.x), bfhi(bw.x), bflo(bw.y), bfhi(bw.y)}; const f32x4 bv = *(const f32x4*)(bias + col0 + bj * 128 + n * 16);
                        const f32x4 v = bs + acc[ai][bj][m][n] + bv; acc[ai][bj][m][n] = v; ss += (v[0] * v[0] + v[1] * v[1]) + (v[2] * v[2] + v[3] * v[3]); }
                ss += __shfl_xor(ss, 16); ss += __shfl_xor(ss, 32);
                if (fq == 0) Pt[r * 4 + wc] = ss;
                if (m & 1) asm volatile("" ::: "memory");
            }
        asm volatile("s_waitcnt lgkmcnt(0)" ::: "memory"); __builtin_amdgcn_s_barrier(); asm volatile("" ::: "memory");
        const int row = wid * 32 + (lane & 31);
        if (lane < 32) { const float tot = (Pt[row * 4 + 0] + Pt[row * 4 + 1]) + (Pt[row * 4 + 2] + Pt[row * 4 + 3]);
            __hip_atomic_store(xbuf + (size_t)(u.pm * 256 + row) * 4 + u.pn, tot, __ATOMIC_RELAXED, __HIP_MEMORY_SCOPE_AGENT); }
        asm volatile("s_waitcnt vmcnt(0)" ::: "memory");
        if (lane == 0) __hip_atomic_fetch_add(cnt + 64 * u.pm, 1u, __ATOMIC_RELAXED, __HIP_MEMORY_SCOPE_AGENT);
        if (wid == 0) {
            unsigned spins = 0;
            while ((unsigned)__builtin_amdgcn_readfirstlane(__hip_atomic_load(cnt + 64 * u.pm, __ATOMIC_RELAXED, __HIP_MEMORY_SCOPE_AGENT)) < 32u) { __builtin_amdgcn_s_sleep(2); if (++spins > (1u << 22)) break; }
            __builtin_amdgcn_fence(__ATOMIC_ACQUIRE, "agent");
        }
        asm volatile("s_waitcnt vmcnt(0) lgkmcnt(0)" ::: "memory"); __builtin_amdgcn_s_barrier(); asm volatile("" ::: "memory");
        if (lane < 32) { const float* sl = xbuf + (size_t)(u.pm * 256 + row) * 4; float t = 0.f;
#pragma unroll
            for (int k = 0; k < 4; ++k) t += __hip_atomic_load(sl + k, __ATOMIC_RELAXED, __HIP_MEMORY_SCOPE_AGENT);
            S[row] = 1.0f / sqrtf(t * (1.f / 1024.f) + NORM_EPS); }
        asm volatile("s_waitcnt lgkmcnt(0)" ::: "memory"); __builtin_amdgcn_s_barrier(); asm volatile("" ::: "memory");
        f32x4 wv[2][2];
#pragma unroll
        for (int bj = 0; bj < 2; ++bj)
#pragma unroll
            for (int n = 0; n < 2; ++n) wv[bj][n] = *(const f32x4*)(w + col0 + bj * 128 + n * 16);
#pragma unroll
        for (int ai = 0; ai < 2; ++ai)
#pragma unroll
            for (int m = 0; m < 4; ++m) { const int r = ai * 128 + wr * 64 + m * 16 + fr; const float rs = S[r]; const size_t off = (size_t)(u.pm * 256 + r) * 1024 + col0;
#pragma unroll
                for (int bj = 0; bj < 2; ++bj)
#pragma unroll
                    for (int n = 0; n < 2; ++n) *(f32x4*)(out + off + bj * 128 + n * 16) = acc[ai][bj][m][n] * rs * wv[bj][n]; }
    }
};

DI void transpose_item(const float* W, int N, int Npad, bf16* WT, const float* kscale, LAS float* scr, int item, int lane) {
    const int nblk = Npad / 32, kb = item / nblk, nb = item % nblk, k0 = 64 * kb, n0 = 32 * nb;
    const int n = n0 + (lane & 31);
#pragma unroll 8
    for (int i = 0; i < 32; ++i) { const int kk = 2 * i + (lane >> 5); float v = (n < N) ? W[(size_t)(k0 + kk) * N + n] : 0.f; if (kscale) v *= kscale[k0 + kk]; scr[kk * 33 + (lane & 31)] = v; }
    LDS_WAIT(); asm volatile("" ::: "memory");
    const int c = lane & 7;
#pragma unroll
    for (int j = 0; j < 4; ++j) { const int nn = (lane >> 3) + 8 * j; const LAS float* s = scr + (8 * c) * 33 + nn;
        u32x4 o; o.x = pk2(s[0 * 33], s[1 * 33]); o.y = pk2(s[2 * 33], s[3 * 33]); o.z = pk2(s[4 * 33], s[5 * 33]); o.w = pk2(s[6 * 33], s[7 * 33]);
        *(u32x4*)(WT + (size_t)(n0 + nn) * 1024 + k0 + 8 * c) = o; }
    LDS_WAIT(); asm volatile("" ::: "memory");
}
DI void p0_prologue(const Params& P, LAS unsigned char* lds, int wave, int lane) {
    LAS float* scr = (LAS float*)(lds + wave * 16384);
    const int gw = blockIdx.x * 8 + wave, NGW = gridDim.x * 8;
    bf16* W0T = (bf16*)(P.ws + WS_W0T); bf16* WO0T = (bf16*)(P.ws + WS_WO0T); bf16* W1T = (bf16*)(P.ws + WS_W1T); bf16* WO1T = (bf16*)(P.ws + WS_WO1T);
    constexpr int I0 = 16 * (N0P / 32), I1 = 16 * 32, I2 = 16 * (IN1 / 32), I3 = 16 * 32;
    for (int it = gw; it < I0 + I1 + I2 + I3; it += NGW) {
        int r = it;
        if (r < I0) { transpose_item(P.w_in0, IN0, N0P, W0T, nullptr, scr, r, lane); continue; } r -= I0;
        if (r < I1) { transpose_item(P.w_out0, 1024, 1024, WO0T, nullptr, scr, r, lane); continue; } r -= I1;
        if (r < I2) { transpose_item(P.w_in1, IN1, IN1, W1T, P.norm_w + 1024, scr, r, lane); continue; } r -= I2;
        transpose_item(P.w_out1, 1024, 1024, WO1T, nullptr, scr, r, lane);
    }
    {
        float* RT = (float*)(P.ws + WS_ROPE);
        for (int e = gw * 64 + lane; e < T * 8; e += NGW * 64) { const int pos = e >> 3, j = e & 7;
            const float invf = __expf(-(float)j * 0.125f * 13.122363377404328f); const float ang = (float)pos * invf; const float nrev = rintf(ang * 0.15915494309189535f);
            float r = fmaf(-nrev, 6.2831854820251465f, ang); r = fmaf(-nrev, -1.7484555e-07f, r);
            RT[2 * e] = __cosf(r); RT[2 * e + 1] = __sinf(r); }
    }
    {
        u32x4* WLT = (u32x4*)(P.ws + WS_WLT);
        for (int e = gw * 64 + lane; e < 8 * 2 * 4 * 2 * 64; e += NGW * 64) { const int ln = e & 63, db = (e >> 6) & 1, s = (e >> 7) & 3, lo = (e >> 9) & 1, h = e >> 10;
            const float* wp = (lo ? P.a_up : P.w_up) + (size_t)(16 * s + 8 * (ln >> 5)) * 512 + h * 64 + 2 * (ln & 31) + db;
            u32x4 o; o.x = pk2(wp[0], wp[512]); o.y = pk2(wp[2 * 512], wp[3 * 512]); o.z = pk2(wp[4 * 512], wp[5 * 512]); o.w = pk2(wp[6 * 512], wp[7 * 512]); WLT[e] = o; }
    }
    bf16* XN = (bf16*)(P.ws + WS_XN);
    {
        const f32x4* wr = (const f32x4*)P.norm_w + lane; const f32x4 w0 = wr[0], w1 = wr[64], w2 = wr[128], w3 = wr[192];
        f32x4 nx[4];
        { const f32x4* xr = (const f32x4*)(P.x + (size_t)(gw < M ? gw : 0) * D) + lane;
#pragma unroll
          for (int j = 0; j < 4; ++j) nx[j] = xr[64 * j]; }
        for (int m = gw; m < M; m += NGW) {
            f32x4 v[4]; float s = 0.f;
#pragma unroll
            for (int j = 0; j < 4; ++j) { v[j] = nx[j]; s += (v[j][0] * v[j][0] + v[j][1] * v[j][1]) + (v[j][2] * v[j][2] + v[j][3] * v[j][3]); }
            if (m + NGW < M) { const f32x4* xr = (const f32x4*)(P.x + (size_t)(m + NGW) * D) + lane;
#pragma unroll
                for (int j = 0; j < 4; ++j) nx[j] = xr[64 * j]; }
            const float rstd = 1.0f / sqrtf(wave_sum(s) * (1.f / D) + NORM_EPS);
            u32x2* o8 = (u32x2*)(XN + (size_t)m * D) + lane;
            { u32x2 o; o.x = pk2(v[0][0] * rstd * w0[0], v[0][1] * rstd * w0[1]); o.y = pk2(v[0][2] * rstd * w0[2], v[0][3] * rstd * w0[3]); o8[0] = o; }
            { u32x2 o; o.x = pk2(v[1][0] * rstd * w1[0], v[1][1] * rstd * w1[1]); o.y = pk2(v[1][2] * rstd * w1[2], v[1][3] * rstd * w1[3]); o8[64] = o; }
            { u32x2 o; o.x = pk2(v[2][0] * rstd * w2[0], v[2][1] * rstd * w2[1]); o.y = pk2(v[2][2] * rstd * w2[2], v[2][3] * rstd * w2[3]); o8[128] = o; }
            { u32x2 o; o.x = pk2(v[3][0] * rstd * w3[0], v[3][1] * rstd * w3[1]); o.y = pk2(v[3][2] * rstd * w3[2], v[3][3] * rstd * w3[3]); o8[192] = o; }
        }
    }
}
DI float softplus_f(float z) { return fmaxf(z, 0.f) + __logf(1.f + __expf(-fabsf(z))); }
DI float tanh_f(float x) { return 1.f - 2.f * __builtin_amdgcn_rcpf(__expf(2.f * x) + 1.f); }

template <int N> DI void dpp_fmac(float& acc, float src, float y) { asm("v_fmac_f32_dpp %0, %1, %2 row_newbcast:%3 row_mask:0xf bank_mask:0xf" : "+v"(acc) : "v"(src), "v"(y), "n"(N)); }
template <int N> DI void dpp_mul_ip(float& y, float src) { asm("v_mul_f32_dpp %0, %1, %0 row_newbcast:%2 row_mask:0xf bank_mask:0xf" : "+v"(y) : "v"(src), "n"(N)); }
template <int N> DI float dpp_mul(float src, float s) { float r; asm("v_mul_f32_dpp %0, %1, %2 row_newbcast:%3 row_mask:0xf bank_mask:0xf" : "=v"(r) : "v"(src), "v"(s), "n"(N)); return r; }
template <int D> struct RStep {
    static DI void dot(const float (&y)[64], const f32x4& X, float& s0, float& s1, float& s2, float& s3) {
        if constexpr (D < 16) { dpp_fmac<D>(s0, X[0], y[D]); dpp_fmac<D>(s1, X[1], y[16 + D]); dpp_fmac<D>(s2, X[2], y[32 + D]); dpp_fmac<D>(s3, X[3], y[48 + D]); RStep<D + 1>::dot(y, X, s0, s1, s2, s3); } }
    static DI void upd(float (&y)[64], const f32x4& Bv, float sa) {
        if constexpr (D < 16) {
            dpp_fmac<D>(y[D], Bv[0], sa); dpp_fmac<D>(y[16 + D], Bv[1], sa); dpp_fmac<D>(y[32 + D], Bv[2], sa); dpp_fmac<D>(y[48 + D], Bv[3], sa);
            RStep<D + 1>::upd(y, Bv, sa); } }
    static DI void scale(float (&y)[64], const f32x4& W) {
        if constexpr (D < 16) {
            dpp_mul_ip<D>(y[D], W[0]); dpp_mul_ip<D>(y[16 + D], W[1]); dpp_mul_ip<D>(y[32 + D], W[2]); dpp_mul_ip<D>(y[48 + D], W[3]);
            RStep<D + 1>::scale(y, W); } }
};
DI void rwkv_rstep(float (&y)[64], const f32x4 (&X)[4], int t, int role, int lane, bf16* mstep) {
    float s0 = 0.f, s1 = 0.f, s2 = 0.f, s3 = 0.f;
    RStep<0>::dot(y, X[0], s0, s1, s2, s3);
    float sa = (s0 + s1) + (s2 + s3);
    if (role == 1) sa = (lane < t) ? sa : 0.f;
    RStep<0>::upd(y, X[2], sa);
    float o0 = 0.f, o1 = 0.f, o2 = 0.f, o3 = 0.f;
    RStep<0>::dot(y, X[3], o0, o1, o2, o3);
    float o = (o0 + o1) + (o2 + o3);
    if (role == 1) o = (lane <= t) ? o : 0.f;
    mstep[t * 64] = (bf16)f2bf(o);
}
DI void rwkv_prep_item(const Params& P, int item, LAS unsigned char* lds, int wave, int lane) {
    const int bh = item >> 4, quad = item & 15, b = bh >> 3, h = bh & 7;
    const int tok0 = b * T + quad * 256;
    const bf16* PROJ0 = (const bf16*)(P.ws + WS_PROJ0);
    float* scr = (float*)(P.ws + WS_SCR + (size_t)blockIdx.x * 262144);
    LAS float* KS = (LAS float*)lds;
    LAS float* TOT = (LAS float*)(lds + 8 * 64 * 65 * 4);
    bf16* VP = (bf16*)(P.ws + WS_VP); float* BON = (float*)(P.ws + WS_BONUS);
    const int hd = h * 64 + lane;
    {
        const int m = lane & 31, hi = lane >> 5;
        const int c = wave >> 1, tb = (wave & 1) * 32;
        const int tokw = tok0 + wave * 32, posw = quad * 256 + wave * 32;
        f32x16 accw[2], acca[2];
#pragma unroll
        for (int i = 0; i < 16; ++i) { accw[0][i] = 0.f; accw[1][i] = 0.f; acca[0][i] = 0.f; acca[1][i] = 0.f; }
        {
            const bf16* rowc = PROJ0 + (size_t)(tokw + m) * N0P; const bool hasprev = (posw + m) > 0;
            const u32x4* WLT = (const u32x4*)(P.ws + WS_WLT) + (size_t)h * 1024 + lane;
            u32x4 cwv[4], cav[4], pwv[4], pav[4], bwv[4][2], bav[4][2];
#pragma unroll
            for (int s = 0; s < 4; ++s) { const int j0 = 16 * s + 8 * hi;
                cwv[s] = *(const u32x4*)(rowc + C_XW + j0); cav[s] = *(const u32x4*)(rowc + C_XA + j0);
                pwv[s] = (u32x4){0u, 0u, 0u, 0u}; pav[s] = (u32x4){0u, 0u, 0u, 0u};
                if (hasprev) { pwv[s] = *(const u32x4*)(rowc - N0P + C_XW + j0); pav[s] = *(const u32x4*)(rowc - N0P + C_XA + j0); }
#pragma unroll
                for (int db = 0; db < 2; ++db) { bwv[s][db] = WLT[((0 * 4 + s) * 2 + db) * 64]; bav[s][db] = WLT[((1 * 4 + s) * 2 + db) * 64]; } }
#pragma unroll
            for (int s = 0; s < 4; ++s) {
                const int j0 = 16 * s + 8 * hi;
                float fcw[8], fpw[8], fca[8], fpa[8]; unpack8(cwv[s], fcw); unpack8(pwv[s], fpw); unpack8(cav[s], fca); unpack8(pav[s], fpa);
                const f32x4 mw0 = *(const f32x4*)(P.mu + 1536 + j0), mw1 = *(const f32x4*)(P.mu + 1536 + j0 + 4), ma0 = *(const f32x4*)(P.mu + 1600 + j0), ma1 = *(const f32x4*)(P.mu + 1600 + j0 + 4);
                float xw[8], xa[8];
#pragma unroll
                for (int e = 0; e < 8; ++e) { const float muw = e < 4 ? mw0[e & 3] : mw1[e & 3], mua = e < 4 ? ma0[e & 3] : ma1[e & 3];
                    xw[e] = tanh_f(fcw[e] + (fpw[e] - fcw[e]) * muw); xa[e] = fca[e] + (fpa[e] - fca[e]) * mua; }
                u32x4 aw, aa;
#pragma unroll
                for (int e = 0; e < 4; ++e) { aw[e] = pk2(xw[2 * e], xw[2 * e + 1]); aa[e] = pk2(xa[2 * e], xa[2 * e + 1]); }
#pragma unroll
                for (int db = 0; db < 2; ++db) {
                    accw[db] = MFMA32(__builtin_bit_cast(bf16x8, aw), __builtin_bit_cast(bf16x8, bwv[s][db]), accw[db]);
                    acca[db] = MFMA32(__builtin_bit_cast(bf16x8, aa), __builtin_bit_cast(bf16x8, bav[s][db]), acca[db]);
                }
            }
        }
        float kkd[2], kad[2], rkd[2], w0d[2], a0d[2], mur[2], muk[2], muv[2];
#pragma unroll
        for (int db = 0; db < 2; ++db) { const int hd = h * 64 + 2 * m + db; kkd[db] = P.k_k[hd]; kad[db] = P.k_a[hd]; rkd[db] = P.r_k[hd]; w0d[db] = P.w0[hd]; a0d[db] = P.a0[hd];
            mur[db] = P.mu[hd]; muk[db] = P.mu[512 + hd]; muv[db] = P.mu[1024 + hd]; }
        unsigned qr[16], qk[16], qv[16], qpr[4], qpk[4], qpv[4];
#pragma unroll
        for (int i = 0; i < 16; ++i) {
            int io = i; asm volatile("" : "+v"(io));
            const bf16* row = PROJ0 + (size_t)(tokw + crow(io, hi)) * N0P + h * 64 + 2 * m;
            qr[i] = *(const unsigned*)(row + C_RR); qk[i] = *(const unsigned*)(row + C_RK); qv[i] = *(const unsigned*)(row + C_RV);
            if ((i & 3) == 0) {
                qpr[i >> 2] = 0u; qpk[i >> 2] = 0u; qpv[i >> 2] = 0u;
                if (posw + crow(i, hi) > 0) { qpr[i >> 2] = *(const unsigned*)(row - N0P + C_RR); qpk[i >> 2] = *(const unsigned*)(row - N0P + C_RK); qpv[i >> 2] = *(const unsigned*)(row - N0P + C_RV); }
            }
        }
        float ee[2][16], Lc[2][16];
#pragma unroll
        for (int db = 0; db < 2; ++db) {
#pragma unroll
            for (int i = 0; i < 16; ++i) { const float wl = w0d[db] + accw[db][i]; ee[db][i] = 0.60653066f * __builtin_amdgcn_rcpf(1.f + __expf(-wl)); }
            float gt[4], go[4];
#pragma unroll
            for (int g = 0; g < 4; ++g) { Lc[db][4 * g] = ee[db][4 * g]; Lc[db][4 * g + 1] = Lc[db][4 * g] + ee[db][4 * g + 1]; Lc[db][4 * g + 2] = Lc[db][4 * g + 1] + ee[db][4 * g + 2]; Lc[db][4 * g + 3] = Lc[db][4 * g + 2] + ee[db][4 * g + 3];
                gt[g] = Lc[db][4 * g + 3]; go[g] = __shfl_xor(gt[g], 32); }
            float run = 0.f;
#pragma unroll
            for (int g = 0; g < 4; ++g) { const float base = run + (hi ? go[g] : 0.f);
#pragma unroll
                for (int q = 0; q < 4; ++q) Lc[db][4 * g + q] += base;
                run += gt[g] + go[g]; }
            if (!(wave & 1) && hi == 0) TOT[c * 64 + 2 * m + db] = run;
        }
        __syncthreads();
        if (wave & 1) {
#pragma unroll
            for (int db = 0; db < 2; ++db) { const float tp = TOT[c * 64 + 2 * m + db];
#pragma unroll
                for (int i = 0; i < 16; ++i) Lc[db][i] += tp; }
        }
        float Lb[2][4];
#pragma unroll
        for (int db = 0; db < 2; ++db)
#pragma unroll
            for (int g = 0; g < 4; ++g) { Lb[db][g] = Lc[db][4 * g] - ee[db][4 * g]; asm volatile("" : "+v"(Lb[db][g])); }
        {
            float pv0 = 0.f, pv1 = 0.f;
#pragma unroll
            for (int i = 0; i < 16; ++i) {
                int io = i; asm volatile("" : "+v"(io));
                if ((i & 3) == 0) { pv0 = bflo(qpv[i >> 2]); pv1 = bfhi(qpv[i >> 2]); }
                const float c0 = bflo(qv[i]), c1 = bfhi(qv[i]);
                *(unsigned*)(VP + (size_t)(tokw + crow(io, hi)) * 512 + h * 64 + 2 * m) = pk2(c0 + (pv0 - c0) * muv[0], c1 + (pv1 - c1) * muv[1]);
                pv0 = c0; pv1 = c1;
            }
        }
        float pr[2] = {0.f, 0.f}, pk[2] = {0.f, 0.f}, pemL[2] = {1.f, 1.f};
#pragma unroll
        for (int i = 0; i < 16; ++i) {
            int io = i; asm volatile("" : "+v"(io));
            const int tau = crow(io, hi), tok = tokw + tau, t = tb + tau;
            if ((i & 3) == 0) { pr[0] = bflo(qpr[i >> 2]); pr[1] = bfhi(qpr[i >> 2]); pk[0] = bflo(qpk[i >> 2]); pk[1] = bfhi(qpk[i >> 2]); }
            float r[2], k[2], a[2], kk[2];
#pragma unroll
            for (int db = 0; db < 2; ++db) {
                const float cr = db ? bfhi(qr[i]) : bflo(qr[i]), ck = db ? bfhi(qk[i]) : bflo(qk[i]);
                r[db] = cr + (pr[db] - cr) * mur[db]; k[db] = ck + (pk[db] - ck) * muk[db];
                pr[db] = cr; pk[db] = ck;
                const float al = a0d[db] + acca[db][i];
                a[db] = __builtin_amdgcn_rcpf(1.f + __expf(-al));
                kk[db] = k[db] * kkd[db];
            }
            const float inv = __builtin_amdgcn_rsqf(fmaxf(half_sum32(kk[0] * kk[0] + kk[1] * kk[1]), 1e-24f));
            float k2[2];
#pragma unroll
            for (int db = 0; db < 2; ++db) k2[db] = k[db] * (1.f + (a[db] - 1.f) * kad[db]);
            const float bon = half_sum32(r[0] * k2[0] * rkd[0] + r[1] * k2[1] * rkd[1]);
#pragma unroll
            for (int db = 0; db < 2; ++db) {
                const int d = 2 * m + db; const float kkn = kk[db] * inv;
                float* o = scr + (size_t)((c * 64 + t) * 4) * 64 + (d & 15) * 4 + (d >> 4);
                const float eL = __expf(Lc[db][i]), emL = __builtin_amdgcn_rcpf(eL);
                const float wprev = (i & 3) ? pemL[db] : __expf(-Lb[db][i >> 2]); pemL[db] = emL;
                o[0] = -kkn * wprev;
                if (i == 15 && t == 63) o[64] = emL;
                o[128] = kkn * a[db] * eL;
                o[192] = r[db] * emL;
                KS[((2 * c + 1 - (c >> 1)) * 64 + t) * 65 + d] = k2[db] * eL;
            }
            if (m == 0) BON[(size_t)tok * 8 + h] = bon;
        }
    }
    __syncthreads();
    {
        const int c = wave >> 1, role = (wave ^ (wave >> 2)) & 1;
        const f32x4* xb = (const f32x4*)(scr + (size_t)c * 64 * 256) + (lane & 15);
        const LAS float* ksw = KS + wave * 64 * 65;
        float y[64];
        const int n = quad * 4 + c;
        bf16* mats = (bf16*)P.out + (size_t)(bh * 64 + n) * 4 * 4096;
        bf16* mstep = mats + role * 4096 + (role ? lane : kpos(lane));
#pragma unroll 1
        for (int rep2 = 0; rep2 < REP_S2; ++rep2) {
            int ln = lane; asm volatile("" : "+v"(ln));
#pragma unroll
            for (int d = 0; d < 64; ++d) y[d] = (role == 0) ? ((d == ln) ? 1.f : 0.f) : ksw[ln * 65 + d];
            f32x4 XA[4], XB[4];
#pragma unroll
            for (int v = 0; v < 4; ++v) XA[v] = xb[v * 16];
            for (int t = 0; t < 64; t += 2) {
#pragma unroll
                for (int v = 0; v < 4; ++v) XB[v] = xb[(t + 1) * 64 + v * 16];
                rwkv_rstep(y, XA, t, role, lane, mstep);
                if (t + 2 < 64) {
#pragma unroll
                    for (int v = 0; v < 4; ++v) XA[v] = xb[(t + 2) * 64 + v * 16];
                }
                rwkv_rstep(y, XB, t + 1, role, lane, mstep);
            }
            RStep<0>::scale(y, XB[1]);
        }
        bf16* mend = mats + (role ? 2 : 3) * 4096 + (role ? lane : kpos(lane));
        LAS float* myr = KS + (wave * 64 + lane) * 65;
#pragma unroll
        for (int d = 0; d < 64; ++d) myr[d] = y[d];
#pragma unroll 1
        for (int d = 0; d < 64; ++d) mend[d * 64] = (bf16)f2bf(myr[d]);
    }
    __syncthreads();
}

DI void gla_prep_item(const Params& P, int item, LAS unsigned char* lds, int wave, int lane) {
    const int bh = item >> 6, n = item & 63, b = bh >> 2, h = bh & 3;
    const int tok0 = b * T + n * 64, hd = h * 64 + lane;
    const bf16* PROJ0 = (const bf16*)(P.ws + WS_PROJ0);
    LAS float* WT = (LAS float*)lds;
    LAS bf16* QEb = (LAS bf16*)(WT + 1024);
    LAS bf16* KEb = QEb + 64 * 72;
    LAS float* KL = (LAS float*)(KEb + 64 * 72);
    bf16* mats = (bf16*)(P.ws + WS_XN) + (size_t)(bh * 64 + n) * 3 * 4096;
    float* GDEC = (float*)(P.ws + WS_GDEC) + (size_t)(bh * 64 + n) * 64;
    float q8[8], k8[8]; u32x4 gl0[8], gl1[8];
#pragma unroll
    for (int i = 0; i < 8; ++i) { const bf16* row = PROJ0 + (size_t)(tok0 + wave * 8 + i) * N0P; q8[i] = bf2f(row[C_GQ + hd]) * 0.125f; k8[i] = bf2f(row[C_GK + hd]);
        gl0[i] = *(const u32x4*)(row + C_GLOW); gl1[i] = *(const u32x4*)(row + C_GLOW + 8); }
    float up[16];
#pragma unroll
    for (int r = 0; r < 16; ++r) up[r] = P.gk_up[r * 256 + hd];
    const float bias = P.gk_bias[hd];
    float bt[8]; float acc = 0.f;
#pragma unroll
    for (int i = 0; i < 8; ++i) { float xg = bias;
#pragma unroll
        for (int r = 0; r < 4; ++r) { xg = fmaf(bflo(gl0[i][r]), up[2 * r], xg); xg = fmaf(bfhi(gl0[i][r]), up[2 * r + 1], xg); }
#pragma unroll
        for (int r = 0; r < 4; ++r) { xg = fmaf(bflo(gl1[i][r]), up[8 + 2 * r], xg); xg = fmaf(bfhi(gl1[i][r]), up[8 + 2 * r + 1], xg); }
        acc += -softplus_f(-xg) * (1.f / 16.f); bt[i] = acc; }
    WT[wave * 64 + lane] = acc;
    if (wave == 4) WT[512 + lane] = bt[0];
    __syncthreads();
    float off = 0.f, off4 = 0.f, total = 0.f;
#pragma unroll
    for (int w2 = 0; w2 < 8; ++w2) { const float tv = WT[w2 * 64 + lane]; if (w2 < wave) off += tv; if (w2 < 4) off4 += tv; total += tv; }
    const float bref = off4 + WT[512 + lane], blast = total;
#pragma unroll
    for (int i = 0; i < 8; ++i) { const int t = wave * 8 + i; const float b_t = bt[i] + off;
        QEb[t * 72 + lane] = (bf16)f2bf(q8[i] * __expf(b_t - bref)); KEb[t * 72 + lane] = (bf16)f2bf(k8[i] * __expf(bref - b_t)); KL[t * 65 + lane] = k8[i] * __expf(blast - b_t);
        mats[t * 64 + kpos(lane)] = (bf16)f2bf(q8[i] * __expf(b_t)); }
    if (wave == 0) GDEC[lane] = __expf(blast);
    __syncthreads();
    if (wave < 4) {
        const int m = lane & 31, hi = lane >> 5, tb = wave >> 1, jb = wave & 1;
        f32x16 c;
#pragma unroll
        for (int r = 0; r < 16; ++r) c[r] = 0.f;
#pragma unroll
        for (int s = 0; s < 4; ++s) { const bf16x8 A = *(const LAS bf16x8*)(KEb + (32 * jb + m) * 72 + 16 * s + 8 * hi), Bq = *(const LAS bf16x8*)(QEb + (32 * tb + m) * 72 + 16 * s + 8 * hi); c = MFMA32(A, Bq, c); }
        const int t = 32 * tb + m;
#pragma unroll
        for (int g = 0; g < 4; ++g) { const int j0 = 32 * jb + 8 * g + 4 * hi; u32x2 w;
            w.x = pk2(j0 <= t ? c[4 * g] : 0.f, j0 + 1 <= t ? c[4 * g + 1] : 0.f); w.y = pk2(j0 + 2 <= t ? c[4 * g + 2] : 0.f, j0 + 3 <= t ? c[4 * g + 3] : 0.f);
            *(u32x2*)(mats + 4096 + t * 64 + j0) = w; }
    } else {
#pragma unroll
        for (int r = 0; r < 16; ++r) { const int d = (wave - 4) * 16 + r; mats[8192 + d * 64 + lane] = (bf16)f2bf(KL[lane * 65 + d]); }
    }
    __syncthreads();
}

constexpr int SQ_PITCH = 144, SQ_MAT = 64 * SQ_PITCH, SQ_VT = 4 * SQ_MAT, SQ_DEC = SQ_VT + 128 * SQ_PITCH, SQ_BUF = 57344;
template <bool DIAG>
DI void seq_pass(unsigned* prog, const bf16* mats, int nmat, const bf16* vsrc, int vpitch, const float* dec, bf16* outp, LAS unsigned char* lds, int tid, int wave, int lane) {
    const int m = lane & 31, hi = lane >> 5;
    f32x16 sacc[2];
#pragma unroll
    for (int i = 0; i < 16; ++i) { sacc[0][i] = 0.f; sacc[1][i] = 0.f; }
    const int st = tid - 256;
    struct StSet { u32x4 rm[8]; u32x4 rv[2]; float rdec; };
    const int v8 = st & 7, par = (st >> 3) & 1;
    constexpr int NMAT = DIAG ? 3 : 4;
    auto gload = [&](int n, StSet& S) {
        const bf16* mp = mats + (size_t)n * NMAT * 4096;
#pragma unroll
        for (int q = 0; q < 2 * NMAT; ++q) S.rm[q] = *(const u32x4*)(mp + (size_t)(st + 256 * q) * 8);
#pragma unroll
        for (int q = 0; q < 2; ++q) S.rv[q] = *(const u32x4*)(vsrc + (size_t)(n * 64 + (st >> 3) + 32 * q) * vpitch + 8 * v8);
        if (DIAG) S.rdec = dec[n * 64 + (st & 63)];
    };
    auto lstore = [&](int n, const StSet& S) {
        LAS unsigned char* B = lds + (n & 1) * SQ_BUF;
#pragma unroll
        for (int q = 0; q < 2 * NMAT; ++q) { const int idx = (st + 256 * q) & 511; *(LAS u32x4*)(B + (q >> 1) * SQ_MAT + (idx >> 3) * SQ_PITCH + (idx & 7) * 16) = S.rm[q]; }
#pragma unroll
        for (int q = 0; q < 2; ++q) {
            const int vt = (st >> 3) + 32 * q;
            const unsigned k0 = par ? S.rv[q][2] : S.rv[q][0], k1 = par ? S.rv[q][3] : S.rv[q][1], s0 = par ? S.rv[q][0] : S.rv[q][2], s1 = par ? S.rv[q][1] : S.rv[q][3];
            const unsigned r0 = (unsigned)__builtin_amdgcn_update_dpp(0, (int)s0, 0x128, 0xf, 0xf, true), r1 = (unsigned)__builtin_amdgcn_update_dpp(0, (int)s1, 0x128, 0xf, 0xf, true);
            unsigned o[4];
            if (par == 0) { o[0] = (k0 & 0xffffu) | (r0 << 16); o[1] = (k0 >> 16) | (r0 & 0xffff0000u); o[2] = (k1 & 0xffffu) | (r1 << 16); o[3] = (k1 >> 16) | (r1 & 0xffff0000u); }
            else          { o[0] = (r0 & 0xffffu) | (k0 << 16); o[1] = (r0 >> 16) | (k0 & 0xffff0000u); o[2] = (r1 & 0xffffu) | (k1 << 16); o[3] = (r1 >> 16) | (k1 & 0xffff0000u); }
            const int tp = vt >> 1, gsw = ((tp >> 2) ^ v8) & 7;
#pragma unroll
            for (int jj = 0; jj < 4; ++jj) *(LAS unsigned*)(B + SQ_VT + (8 * v8 + 4 * par + jj) * SQ_PITCH + (4 * gsw + (tp & 3)) * 4) = o[jj];
        }
        if (DIAG && st < 64) *(LAS float*)(B + SQ_DEC + st * 4) = S.rdec;
    };
    f32x16 o0, o1;
    bf16x8 sBp[2][2];
#pragma unroll
    for (int kb = 0; kb < 2; ++kb)
#pragma unroll
        for (int s = 0; s < 2; ++s) sBp[kb][s] = (bf16x8){0, 0, 0, 0, 0, 0, 0, 0};
    LAS unsigned char* SBX = lds + 2 * SQ_BUF;
    if (wave >= 2 && wave < 4) {
#pragma unroll
        for (int q = 0; q < 4; ++q) *(LAS bf16x8*)(SBX + (0 * 2 + (wave & 1)) * 4096 + lane * 64 + 16 * q) = sBp[q >> 1][q & 1];
    }
    auto compute = [&](int n, int bufi) {
        if (wave < 4) {
            const int vb = wave & 1; const bool upd = wave >= 2;
            const LAS unsigned char* B = lds + bufi * SQ_BUF;
            const int vrow = 32 * vb + m;
            const LAS unsigned char* Vr = B + SQ_VT + vrow * SQ_PITCH;
            const LAS unsigned char* Ar = B + m * SQ_PITCH + 16 * hi;
            bf16x8 Fa[2], Fb[2], Va, Vb;
#define SQ_LD(F, VB, k, MS, MV) do { if ((k) < 4) { const int co_ = (32 * ((k) >> 1) + 16 * ((k) & 1)) * 2; \
            F[0] = *(const LAS bf16x8*)(Ar + (MS) * SQ_MAT + co_); F[1] = *(const LAS bf16x8*)(Ar + (MS) * SQ_MAT + 32 * SQ_PITCH + co_); } \
        else { const int S4_ = (k) - 4, co_ = 32 * S4_; VB = *(const LAS bf16x8*)(Vr + (((2 * S4_ + hi) ^ (vrow >> 3)) & 7) * 16); \
            F[0] = *(const LAS bf16x8*)(Ar + (MV) * SQ_MAT + co_); F[1] = *(const LAS bf16x8*)(Ar + (MV) * SQ_MAT + 32 * SQ_PITCH + co_); } } while (0)
            if (!upd) {
                bf16x8 sB[2][2];
#pragma unroll
                for (int q = 0; q < 4; ++q) sB[q >> 1][q & 1] = *(const LAS bf16x8*)(SBX + ((n & 1) * 2 + vb) * 4096 + lane * 64 + 16 * q);
#pragma unroll
                for (int i = 0; i < 16; ++i) { o0[i] = 0.f; o1[i] = 0.f; }
#define SQ_MM(F, VB, k) do { const bf16x8 Bq_ = ((k) < 4) ? sB[(k) >> 1][(k) & 1] : VB; o0 = MFMA32(Bq_, F[0], o0); o1 = MFMA32(Bq_, F[1], o1); } while (0)
                SQ_LD(Fa, Va, 0, 0, 1); SQ_LD(Fb, Vb, 1, 0, 1);
                __builtin_amdgcn_sched_barrier(0);
                SQ_MM(Fa, Va, 0); SQ_LD(Fa, Va, 2, 0, 1); __builtin_amdgcn_sched_barrier(0);
                SQ_MM(Fb, Vb, 1); SQ_LD(Fb, Vb, 3, 0, 1); __builtin_amdgcn_sched_barrier(0);
                SQ_MM(Fa, Va, 2); SQ_LD(Fa, Va, 4, 0, 1); __builtin_amdgcn_sched_barrier(0);
                SQ_MM(Fb, Vb, 3); SQ_LD(Fb, Vb, 5, 0, 1); __builtin_amdgcn_sched_barrier(0);
                SQ_MM(Fa, Va, 4); SQ_LD(Fa, Va, 6, 0, 1); __builtin_amdgcn_sched_barrier(0);
                SQ_MM(Fb, Vb, 5); SQ_LD(Fb, Vb, 7, 0, 1); __builtin_amdgcn_sched_barrier(0);
                SQ_MM(Fa, Va, 6); SQ_MM(Fb, Vb, 7);
#undef SQ_MM
            } else {
                f32x16 n0, n1;
#pragma unroll
                for (int i = 0; i < 16; ++i) {
                    if (DIAG) { n0[i] = sacc[0][i] * *(const LAS float*)(B + SQ_DEC + crow(i, hi) * 4); n1[i] = sacc[1][i] * *(const LAS float*)(B + SQ_DEC + (32 + crow(i, hi)) * 4); }
                    else { n0[i] = 0.f; n1[i] = 0.f; } }
#define SQ_MM(F, VB, k) do { const bf16x8 Bq_ = ((k) < 4) ? sBp[(k) >> 1][(k) & 1] : VB; n0 = MFMA32(F[0], Bq_, n0); n1 = MFMA32(F[1], Bq_, n1); } while (0)
                if (!DIAG) {
                    SQ_LD(Fa, Va, 0, 3, 2); SQ_LD(Fb, Vb, 1, 3, 2);
                    __builtin_amdgcn_sched_barrier(0);
                    SQ_MM(Fa, Va, 0); SQ_LD(Fa, Va, 2, 3, 2); __builtin_amdgcn_sched_barrier(0);
                    SQ_MM(Fb, Vb, 1); SQ_LD(Fb, Vb, 3, 3, 2); __builtin_amdgcn_sched_barrier(0);
                    SQ_MM(Fa, Va, 2); SQ_LD(Fa, Va, 4, 3, 2); __builtin_amdgcn_sched_barrier(0);
                    SQ_MM(Fb, Vb, 3); SQ_LD(Fb, Vb, 5, 3, 2); __builtin_amdgcn_sched_barrier(0);
                } else {
                    SQ_LD(Fa, Va, 4, 3, 2); SQ_LD(Fb, Vb, 5, 3, 2);
                    __builtin_amdgcn_sched_barrier(0);
                }
                SQ_MM(Fa, Va, 4); SQ_LD(Fa, Va, 6, 3, 2); __builtin_amdgcn_sched_barrier(0);
                SQ_MM(Fb, Vb, 5); SQ_LD(Fb, Vb, 7, 3, 2); __builtin_amdgcn_sched_barrier(0);
                SQ_MM(Fa, Va, 6); SQ_MM(Fb, Vb, 7);
#undef SQ_MM
                sacc[0] = n0; sacc[1] = n1;
#pragma unroll
                for (int kb = 0; kb < 2; ++kb)
#pragma unroll
                    for (int s = 0; s < 2; ++s) { u32x4 w;
#pragma unroll
                        for (int e = 0; e < 4; ++e) w[e] = pk2(sacc[kb][8 * s + 2 * e], sacc[kb][8 * s + 2 * e + 1]);
                        sBp[kb][s] = __builtin_bit_cast(bf16x8, w);
                        *(LAS bf16x8*)(SBX + (((n + 1) & 1) * 2 + vb) * 4096 + lane * 64 + 16 * (2 * kb + s)) = sBp[kb][s]; }
            }
#undef SQ_LD
        }
    };
    auto store_out = [&](int n) {
        if (wave < 2) {
#pragma unroll
            for (int g = 0; g < 4; ++g) { bf16* op_ = outp + (size_t)(n * 64 + m) * 512 + 32 * wave + 8 * g + 4 * hi;
                u32x2 w0, w1; w0.x = pk2(o0[4 * g], o0[4 * g + 1]); w0.y = pk2(o0[4 * g + 2], o0[4 * g + 3]); w1.x = pk2(o1[4 * g], o1[4 * g + 1]); w1.y = pk2(o1[4 * g + 2], o1[4 * g + 3]);
                *(u32x2*)op_ = w0; *(u32x2*)(op_ + 32 * 512) = w1; }
        }
    };
    if (wave < 4) {
        lds_barrier();
#pragma unroll 1
        for (int n = 0; n < 64; ++n) { compute(n, n & 1); store_out(n); lds_barrier(); }
    } else {
        StSet A, Bs, C;
        gload(0, A); gload(1, Bs); gload(2, C);
        lstore(0, A); gload(3, A);
        lds_barrier();
#pragma unroll 1
        for (int k = 0; k < 60; k += 3) {
            if (st == 0) __hip_atomic_store(prog, (unsigned)(k + 4), __ATOMIC_RELAXED, __HIP_MEMORY_SCOPE_AGENT);
            lstore(k + 1, Bs); gload(k + 4, Bs); lds_barrier();
            lstore(k + 2, C); gload(k + 5, C); lds_barrier();
            lstore(k + 3, A); gload(k + 6, A); lds_barrier();
        }
        lstore(61, Bs); lds_barrier();
        lstore(62, C); lds_barrier();
        lstore(63, A); lds_barrier();
        lds_barrier();
    }
}
struct P3Src { const bf16* mats; int nmat; const bf16* vsrc; int vpitch; const float* dec; bf16* outp; };
DI P3Src p3_src(const Params& P, int bx) {
    P3Src s;
    if (bx < 32) { const int b = bx >> 3, h = bx & 7;
        s.mats = (const bf16*)P.out + (size_t)bx * 64 * 4 * 4096; s.nmat = 4; s.vsrc = (const bf16*)(P.ws + WS_VP) + (size_t)b * T * 512 + h * 64; s.vpitch = 512; s.dec = nullptr;
        s.outp = (bf16*)(P.ws + WS_SCR) + (size_t)b * T * 512 + h * 64; }
    else { const int g = bx - 32, bh = (g & 7) | ((g >> 4) << 3), vh = (g >> 3) & 1, b = bh >> 2, h = bh & 3;
        s.mats = (const bf16*)(P.ws + WS_XN) + (size_t)bh * 64 * 3 * 4096; s.nmat = 3; s.vsrc = (const bf16*)(P.ws + WS_PROJ0) + (size_t)b * T * N0P + C_GV + h * 128 + 64 * vh; s.vpitch = N0P;
        s.dec = (const float*)(P.ws + WS_GDEC) + (size_t)bh * 64 * 64; s.outp = (bf16*)(P.ws + WS_OARAW) + (size_t)b * T * 512 + h * 128 + 64 * vh; }
    return s;
}
DI void p3_seq(const Params& P, LAS unsigned char* lds, int tid, int wave, int lane) {
    const int bx = blockIdx.x;
    unsigned* progw = (unsigned*)(P.ws + WS_PROG);
    if (bx < 64) {
        const P3Src s = p3_src(P, bx);
        if (bx < 32) seq_pass<false>(progw + 16 * bx, s.mats, 4, s.vsrc, s.vpitch, nullptr, s.outp, lds, tid, wave, lane);
        else         seq_pass<true>(progw + 16 * bx, s.mats, 3, s.vsrc, s.vpitch, s.dec, s.outp, lds, tid, wave, lane);
    } else {
        const unsigned* xt = (const unsigned*)(P.ws + WS_XCCTAB);
        LAS unsigned* hs = (LAS unsigned*)lds;
        if (tid < 4) hs[tid] = 0u;
        __syncthreads();
        const unsigned myx = xt[bx];
        if (tid < 192) { const unsigned o = xt[64 + tid]; if (o == myx) { __hip_atomic_fetch_add(&hs[2], 1u, __ATOMIC_RELAXED, __HIP_MEMORY_SCOPE_WORKGROUP); if (64 + tid < bx) __hip_atomic_fetch_add(&hs[0], 1u, __ATOMIC_RELAXED, __HIP_MEMORY_SCOPE_WORKGROUP); } }
        if (tid >= 192 && tid < 256) { if (xt[tid - 192] == myx) { const unsigned slot = __hip_atomic_fetch_add(&hs[1], 1u, __ATOMIC_RELAXED, __HIP_MEMORY_SCOPE_WORKGROUP); hs[8 + slot] = (unsigned)(tid - 192); } }
        __syncthreads();
        const int rank = (int)hs[0], np = (int)hs[1], nh = (int)hs[2];
        unsigned pf0 = 0u;
        if (np > 0) {
            const int tgt = (int)hs[8 + (rank % np)];
            const int sub = rank / np, cnt = (nh - (rank % np) + np - 1) / np;
            const P3Src s = p3_src(P, tgt);
            const unsigned* pw = progw + 16 * tgt;
            const int nlm = s.nmat * 64;
            int pc = sub; unsigned spins = 0;
            while (pc < 64) {
                const int p = (int)__builtin_amdgcn_readfirstlane((int)__hip_atomic_load(pw, __ATOMIC_RELAXED, __HIP_MEMORY_SCOPE_AGENT));
                if (pc <= p + 8) {
                    const char* a = nullptr;
                    if (tid < nlm) a = (const char*)(s.mats + (size_t)pc * s.nmat * 4096) + (size_t)tid * 128;
                    else if (tid < nlm + 64) a = (const char*)(s.vsrc + (size_t)(pc * 64 + (tid - nlm)) * s.vpitch);
                    if (a) asm volatile("global_load_dword %0, %1, off" : "+v"(pf0) : "v"(a) : "memory");
                    pc += cnt;
                } else { __builtin_amdgcn_s_sleep(8); if (++spins > (1u << 16)) break; }
            }
        }
        asm volatile("s_waitcnt vmcnt(0)" : "+v"(pf0) :: "memory");
        __syncthreads();
    }
}

DI float silu_f(float g) { return g * __builtin_amdgcn_rcpf(1.f + __expf(-g)); }
DI void p4_finalize(const Params& P, int wave, int lane) {
    const int gw = blockIdx.x * 8 + wave, NGW = gridDim.x * 8;
    const bf16* OB = (const bf16*)(P.ws + WS_SCR); const bf16* OA = (const bf16*)(P.ws + WS_OARAW);
    const bf16* PROJ0 = (const bf16*)(P.ws + WS_PROJ0); const bf16* VP = (const bf16*)(P.ws + WS_VP); const float* BON = (const float*)(P.ws + WS_BONUS);
    bf16* O0 = (bf16*)(P.ws + WS_XN);
    const int cv = (8 * lane) & 127;
    const f32x4 gw0 = *(const f32x4*)(P.gla_norm_w + cv), gw1 = *(const f32x4*)(P.gla_norm_w + cv + 4);
    const f32x4 lw0 = *(const f32x4*)(P.ln_w + 8 * lane), lw1 = *(const f32x4*)(P.ln_w + 8 * lane + 4), lb0 = *(const f32x4*)(P.ln_b + 8 * lane), lb1 = *(const f32x4*)(P.ln_b + 8 * lane + 4);
    struct Ld { f32x4 a0, a1, b0, b1; u32x4 ga, gb, vv; float bon; };
    auto load = [&](int tok) { Ld L; const bf16* row = PROJ0 + (size_t)tok * N0P + C_GATE0;
        { const u32x4 wa = *(const u32x4*)(OA + (size_t)tok * 512 + 8 * lane), wb = *(const u32x4*)(OB + (size_t)tok * 512 + 8 * lane);
          L.a0 = (f32x4){bflo(wa.x), bfhi(wa.x), bflo(wa.y), bfhi(wa.y)}; L.a1 = (f32x4){bflo(wa.z), bfhi(wa.z), bflo(wa.w), bfhi(wa.w)};
          L.b0 = (f32x4){bflo(wb.x), bfhi(wb.x), bflo(wb.y), bfhi(wb.y)}; L.b1 = (f32x4){bflo(wb.z), bfhi(wb.z), bflo(wb.w), bfhi(wb.w)}; }
        L.ga = *(const u32x4*)(row + 8 * lane); L.gb = *(const u32x4*)(row + 512 + 8 * lane); L.vv = *(const u32x4*)(VP + (size_t)tok * 512 + 8 * lane); L.bon = BON[(size_t)tok * 8 + (lane >> 3)]; return L; };
    Ld nx = load(gw < M ? gw : 0);
    for (int tok = gw; tok < M; tok += NGW) {
        const Ld L = nx;
        if (tok + NGW < M) nx = load(tok + NGW);
        {
            const f32x4 a0 = L.a0, a1 = L.a1;
            float ss = (a0[0] * a0[0] + a0[1] * a0[1]) + (a0[2] * a0[2] + a0[3] * a0[3]) + (a1[0] * a1[0] + a1[1] * a1[1]) + (a1[2] * a1[2] + a1[3] * a1[3]);
            ss += __shfl_xor(ss, 1); ss += __shfl_xor(ss, 2); ss += __shfl_xor(ss, 4); ss += __shfl_xor(ss, 8);
            const float rstd = 1.0f / sqrtf(ss * (1.f / 128.f) + NORM_EPS);
            const u32x4 g = L.ga;
            u32x4 o;
            o.x = pk2(a0[0] * rstd * gw0[0] * silu_f(bflo(g.x)), a0[1] * rstd * gw0[1] * silu_f(bfhi(g.x)));
            o.y = pk2(a0[2] * rstd * gw0[2] * silu_f(bflo(g.y)), a0[3] * rstd * gw0[3] * silu_f(bfhi(g.y)));
            o.z = pk2(a1[0] * rstd * gw1[0] * silu_f(bflo(g.z)), a1[1] * rstd * gw1[1] * silu_f(bfhi(g.z)));
            o.w = pk2(a1[2] * rstd * gw1[2] * silu_f(bflo(g.w)), a1[3] * rstd * gw1[3] * silu_f(bfhi(g.w)));
            *(u32x4*)(O0 + (size_t)tok * 1024 + 8 * lane) = o;
        }
        {
            const f32x4 a0 = L.b0, a1 = L.b1;
            float s = (a0[0] + a0[1]) + (a0[2] + a0[3]) + (a1[0] + a1[1]) + (a1[2] + a1[3]);
            s += __shfl_xor(s, 1); s += __shfl_xor(s, 2); s += __shfl_xor(s, 4);
            const float mean = s * (1.f / 64.f);
            const f32x4 d0 = a0 - mean, d1 = a1 - mean;
            float q = (d0[0] * d0[0] + d0[1] * d0[1]) + (d0[2] * d0[2] + d0[3] * d0[3]) + (d1[0] * d1[0] + d1[1] * d1[1]) + (d1[2] * d1[2] + d1[3] * d1[3]);
            q += __shfl_xor(q, 1); q += __shfl_xor(q, 2); q += __shfl_xor(q, 4);
            const float rstd = 1.0f / sqrtf(q * (1.f / 64.f) + RWKV_LN_EPS);
            const float bon = L.bon; const u32x4 vv = L.vv, g = L.gb;
            u32x4 o;
            o.x = pk2((d0[0] * rstd * lw0[0] + lb0[0] + bon * bflo(vv.x)) * silu_f(bflo(g.x)), (d0[1] * rstd * lw0[1] + lb0[1] + bon * bfhi(vv.x)) * silu_f(bfhi(g.x)));
            o.y = pk2((d0[2] * rstd * lw0[2] + lb0[2] + bon * bflo(vv.y)) * silu_f(bflo(g.y)), (d0[3] * rstd * lw0[3] + lb0[3] + bon * bfhi(vv.y)) * silu_f(bfhi(g.y)));
            o.z = pk2((d1[0] * rstd * lw1[0] + lb1[0] + bon * bflo(vv.z)) * silu_f(bflo(g.z)), (d1[1] * rstd * lw1[1] + lb1[1] + bon * bfhi(vv.z)) * silu_f(bfhi(g.z)));
            o.w = pk2((d1[2] * rstd * lw1[2] + lb1[2] + bon * bflo(vv.w)) * silu_f(bflo(g.w)), (d1[3] * rstd * lw1[3] + lb1[3] + bon * bfhi(vv.w)) * silu_f(bfhi(g.w)));
            *(u32x4*)(O0 + (size_t)tok * 1024 + 512 + 8 * lane) = o;
        }
    }
}
constexpr int AT_KP = 144, AT_VP = 528, AT_VOFF = 256 * AT_KP;
DI void rope_cs(const float* RT, int pos, float (&cs)[8], float (&sn)[8]) {
    const f32x4* tp = (const f32x4*)(RT + (size_t)pos * 16);
#pragma unroll
    for (int q = 0; q < 4; ++q) { const f32x4 v = tp[q]; cs[2 * q] = v[0]; sn[2 * q] = v[1]; cs[2 * q + 1] = v[2]; sn[2 * q + 1] = v[3]; }
}
DI void p7_attn(const Params& P, LAS unsigned char* lds, int tid, int wave, int lane) {
    const bf16* PROJ1 = (const bf16*)(P.ws + WS_SCR); bf16* O1 = (bf16*)(P.ws + WS_XN); const float* RT = (const float*)(P.ws + WS_ROPE);
    const int m = lane & 31, hi = lane >> 5;
    const int c8 = tid & 7, kpar = (tid >> 3) & 1;
    u32x4 kw[4], vw[4];
    auto uload = [&](int unit) {
        const int qb = unit & 31, kvh = (unit >> 5) & 3, b = unit >> 7;
#pragma unroll
        for (int q = 0; q < 4; ++q) { const int key = (tid >> 3) + 64 * q; const int pos = qb * 128 - 128 + key;
            kw[q] = (u32x4){0u, 0u, 0u, 0u}; vw[q] = (u32x4){0u, 0u, 0u, 0u};
            if (pos >= 0) { const bf16* row = PROJ1 + (size_t)(b * T + pos) * IN1; kw[q] = *(const u32x4*)(row + 1024 + kvh * 64 + 8 * c8); vw[q] = *(const u32x4*)(row + 1280 + kvh * 64 + 8 * c8); } }
    };
    if ((int)blockIdx.x < 512) uload(blockIdx.x);
    struct QG { u32x4 q[4], qo; u32x2 g[8]; };
    auto qgload = [&](int unit, int qq) { QG r; const int qb = unit & 31, kvh = (unit >> 5) & 3, b = unit >> 7; const int h = kvh * 4 + (wave >> 1);
        const int pos = qb * 128 + (wave & 1) * 64 + 32 * qq + m; const bf16* row = PROJ1 + ((size_t)b * T + pos) * IN1;
#pragma unroll
        for (int s = 0; s < 4; ++s) r.q[s] = *(const u32x4*)(row + h * 64 + 16 * s + 8 * hi);
        r.qo = *(const u32x4*)(row + h * 64 + 8 * (hi ^ 1));
#pragma unroll
        for (int db = 0; db < 2; ++db)
#pragma unroll
            for (int gq = 0; gq < 4; ++gq) r.g[4 * db + gq] = *(const u32x2*)(row + 1536 + h * 64 + 32 * db + 8 * gq + 4 * hi);
        return r; };
    QG nxq = qgload((int)blockIdx.x < 512 ? blockIdx.x : 0, 0);
    for (int unit = blockIdx.x; unit < 512; unit += gridDim.x) {
        const int qb = unit & 31, kvh = (unit >> 5) & 3, b = unit >> 7;
#pragma unroll
        for (int q = 0; q < 4; ++q) {
            const int key = (tid >> 3) + 64 * q; const int pos = qb * 128 - 128 + key;
            u32x4 kq = kw[q];
            if (c8 < 2 && pos >= 0) { const bf16* row = PROJ1 + (size_t)(b * T + pos) * IN1;
                const u32x4 ow = *(const u32x4*)(row + 1024 + kvh * 64 + 8 * (c8 ^ 1)); float a[8], o[8], cs[8], sn[8]; unpack8(kq, a); unpack8(ow, o); rope_cs(RT, pos, cs, sn);
                float r[8];
#pragma unroll
                for (int j = 0; j < 8; ++j) r[j] = (c8 == 0) ? (a[j] * cs[j] - o[j] * sn[j]) : (a[j] * cs[j] + o[j] * sn[j]);
                kq.x = pk2(r[0], r[1]); kq.y = pk2(r[2], r[3]); kq.z = pk2(r[4], r[5]); kq.w = pk2(r[6], r[7]); }
            *(LAS u32x4*)(lds + key * AT_KP + c8 * 16) = kq;
            const u32x4 rv = vw[q];
            const unsigned k0 = kpar ? rv[2] : rv[0], k1 = kpar ? rv[3] : rv[1], s0 = kpar ? rv[0] : rv[2], s1 = kpar ? rv[1] : rv[3];
            const unsigned r0 = (unsigned)__builtin_amdgcn_update_dpp(0, (int)s0, 0x128, 0xf, 0xf, true), r1 = (unsigned)__builtin_amdgcn_update_dpp(0, (int)s1, 0x128, 0xf, 0xf, true);
            unsigned o4[4];
            if (kpar == 0) { o4[0] = (k0 & 0xffffu) | (r0 << 16); o4[1] = (k0 >> 16) | (r0 & 0xffff0000u); o4[2] = (k1 & 0xffffu) | (r1 << 16); o4[3] = (k1 >> 16) | (r1 & 0xffff0000u); }
            else           { o4[0] = (r0 & 0xffffu) | (k0 << 16); o4[1] = (r0 >> 16) | (k0 & 0xffff0000u); o4[2] = (r1 & 0xffffu) | (k1 << 16); o4[3] = (r1 >> 16) | (k1 & 0xffff0000u); }
            const int tp = key >> 1, gsw = (tp >> 2) ^ c8;
#pragma unroll
            for (int jj = 0; jj < 4; ++jj) *(LAS unsigned*)(lds + AT_VOFF + (8 * c8 + 4 * kpar + jj) * AT_VP + (4 * gsw + (tp & 3)) * 4) = o4[jj];
        }
        lds_barrier();
        if (unit + (int)gridDim.x < 512) uload(unit + gridDim.x);
        const int g = wave >> 1, h = kvh * 4 + g; const float sink = P.sinks[h];
        for (int qq = 0; qq < 2; ++qq) {
            const int qs = (wave & 1) * 64 + 32 * qq, qi = qs + m, pos = qb * 128 + qi; const size_t tok = (size_t)b * T + pos;
            const QG cq = nxq;
            { const int nu = (qq == 0) ? unit : unit + (int)gridDim.x; if (nu < 512) nxq = qgload(nu, qq ^ 1); }
            bf16x8 Q[4];
#pragma unroll
            for (int s = 0; s < 4; ++s) { const u32x4 w = cq.q[s]; float a[8]; unpack8(w, a);
                if (s == 0) { const u32x4 ow = cq.qo; float o[8], cs[8], sn[8]; unpack8(ow, o); rope_cs(RT, pos, cs, sn);
#pragma unroll
                    for (int j = 0; j < 8; ++j) a[j] = (hi == 0) ? (a[j] * cs[j] - o[j] * sn[j]) : (a[j] * cs[j] + o[j] * sn[j]); }
                u32x4 qw;
#pragma unroll
                for (int e = 0; e < 4; ++e) qw[e] = pk2(a[2 * e] * 0.125f, a[2 * e + 1] * 0.125f);
                Q[s] = __builtin_bit_cast(bf16x8, qw); }
            const int kb0 = qs >> 5;
            f32x16 sc[5];
#pragma unroll
            for (int kbi = 0; kbi < 5; ++kbi) {
#pragma unroll
                for (int i = 0; i < 16; ++i) sc[kbi][i] = 0.f;
#pragma unroll
                for (int s = 0; s < 4; ++s) { const bf16x8 A = *(const LAS bf16x8*)(lds + (32 * (kb0 + kbi) + m) * AT_KP + (16 * s + 8 * hi) * 2); sc[kbi] = MFMA32(A, Q[s], sc[kbi]); }
            }
            float mx = sink;
#pragma unroll
            for (int kbi = 0; kbi < 5; ++kbi)
#pragma unroll
                for (int i = 0; i < 16; ++i) { const int kj = 32 * (kb0 + kbi) + crow(i, hi);
                    const bool band = (kbi == 0) ? (kj >= qi + 1) : ((kbi == 4) ? (kj <= qi + 128) : true); const bool vis = band && (qb > 0 || kj >= 128);
                    sc[kbi][i] = vis ? sc[kbi][i] : -1e30f; mx = fmaxf(mx, sc[kbi][i]); }
            mx = fmaxf(mx, __shfl_xor(mx, 32));
            float sum = 0.f;
#pragma unroll
            for (int kbi = 0; kbi < 5; ++kbi)
#pragma unroll
                for (int i = 0; i < 16; ++i) { const float pv = __expf(sc[kbi][i] - mx); sc[kbi][i] = pv; sum += pv; }
            sum += __shfl_xor(sum, 32);
            const float inv = 1.f / (sum + __expf(sink - mx));
            f32x16 oacc[2];
#pragma unroll
            for (int db = 0; db < 2; ++db) {
#pragma unroll
                for (int i = 0; i < 16; ++i) oacc[db][i] = 0.f;
                const int vrow = 32 * db + m, rsw = (vrow >> 3) & 7;
#pragma unroll
                for (int kbi = 0; kbi < 5; ++kbi)
#pragma unroll
                    for (int s2 = 0; s2 < 2; ++s2) { u32x4 pw;
#pragma unroll
                        for (int e = 0; e < 4; ++e) pw[e] = pk2(sc[kbi][8 * s2 + 2 * e], sc[kbi][8 * s2 + 2 * e + 1]);
                        const int ga = 4 * (kb0 + kbi) + 2 * s2;
                        const LAS unsigned char* vp = lds + AT_VOFF + vrow * AT_VP + 8 * hi;
                        const u32x2 lo = *(const LAS u32x2*)(vp + (ga ^ rsw) * 16), hi2 = *(const LAS u32x2*)(vp + ((ga + 1) ^ rsw) * 16);
                        const u32x4 aw = (u32x4){lo.x, lo.y, hi2.x, hi2.y};
                        oacc[db] = MFMA32(__builtin_bit_cast(bf16x8, aw), __builtin_bit_cast(bf16x8, pw), oacc[db]); }
            }
#pragma unroll
            for (int db = 0; db < 2; ++db)
#pragma unroll
                for (int gq = 0; gq < 4; ++gq) { const int d0 = 32 * db + 8 * gq + 4 * hi; const u32x2 gw = cq.g[4 * db + gq];
                    u32x2 o; o.x = pk2(oacc[db][4 * gq] * inv * silu_f(bflo(gw.x)), oacc[db][4 * gq + 1] * inv * silu_f(bfhi(gw.x)));
                    o.y = pk2(oacc[db][4 * gq + 2] * inv * silu_f(bflo(gw.y)), oacc[db][4 * gq + 3] * inv * silu_f(bfhi(gw.y)));
                    *(u32x2*)(O1 + tok * 1024 + h * 64 + d0) = o; }
        }
        lds_barrier();
    }
}
DI void p9_final(const Params& P, int wave, int lane) {
    const int gw = blockIdx.x * 8 + wave, NGW = gridDim.x * 8;
    const float* slots = (const float*)(P.ws + WS_SLOT2);
    for (int mrow = gw; mrow < M; mrow += NGW) {
        float s = (lane < 16) ? slots[(size_t)mrow * 16 + lane] : 0.f;
        s += __shfl_xor(s, 1); s += __shfl_xor(s, 2); s += __shfl_xor(s, 4); s += __shfl_xor(s, 8);
        s = __shfl(s, 0);
        const float rstd = 1.0f / sqrtf(s * (1.f / 1024.f) + NORM_EPS);
        f32x4* o = (f32x4*)(P.out + (size_t)mrow * D) + lane; const f32x4* w = (const f32x4*)P.final_w + lane;
#pragma unroll
        for (int j = 0; j < 4; ++j) { const f32x4 v = o[64 * j]; o[64 * j] = v * rstd * w[64 * j]; }
    }
}

__global__ void __launch_bounds__(512) fwd_megakernel(Params P) {
    extern __shared__ __attribute__((aligned(16))) unsigned char lds_raw[];
    LAS unsigned char* lds = (LAS unsigned char*)lds_raw;
    cg::grid_group grid = cg::this_grid();
    const int tid = threadIdx.x, lane = tid & 63, wave = __builtin_amdgcn_readfirstlane(tid >> 6);
    const int G = gridDim.x;
    if (tid < 2) ((LAS unsigned*)(lds + LDS_BAR_OFF))[tid] = 0u;
    __syncthreads();
    if (tid == 0) ((unsigned*)(P.ws + WS_XCCTAB))[blockIdx.x] = xb_xcc_id() + 1u;
    const XcdBarrier xbar = xcd_barrier_post((unsigned*)(P.ws + WS_CTL), (volatile LAS unsigned*)(lds + LDS_BAR_OFF));
    bf16* XN = (bf16*)(P.ws + WS_XN);
    p0_prologue(P, lds, wave, lane);
    if (P.ws == nullptr) grid.sync();
    xcd_barrier(xbar);
    { pg8::Gemm g{XN, (const bf16*)(P.ws + WS_W0T), M, N0P, D}; pg8::StaticOrder S; S.init(M, N0P, G, (int)blockIdx.x);
      EpiScaleBf16 E{(bf16*)(P.ws + WS_PROJ0), N0P, nullptr, nullptr, 0};
      pg8::gemm_phase<EpiScaleBf16, pg8::StaticOrder, true, true>(lds, g, S, E); }
    xcd_barrier(xbar);
#pragma unroll 1
    for (int rep = 0; rep < REP_P2R; ++rep) { for (int it = blockIdx.x; it < 512; it += G) rwkv_prep_item(P, it, lds, wave, lane); }
#pragma unroll 1
    for (int rep = 0; rep < REP_P2G; ++rep) { for (int it = blockIdx.x; it < 1024; it += G) gla_prep_item(P, it, lds, wave, lane); }
    xcd_barrier(xbar);
#pragma unroll 1
    for (int rep = 0; rep < REP_P3; ++rep) { p3_seq(P, lds, tid, wave, lane); __syncthreads(); }
    xcd_barrier(xbar);
    p4_finalize(P, wave, lane);
    xcd_barrier(xbar);
    { pg8::Gemm g{XN, (const bf16*)(P.ws + WS_WO0T), M, D, D}; pg8::StaticOrder S; S.init(M, D, G, (int)blockIdx.x);
      EpiResid E{P.x, (bf16*)(P.ws + WS_H1B), (float*)(P.ws + WS_SLOT1)};
      pg8::gemm_phase<EpiResid, pg8::StaticOrder, true, true>(lds, g, S, E); }
    xcd_barrier(xbar);
    { pg8::Gemm g{(const bf16*)(P.ws + WS_H1B), (const bf16*)(P.ws + WS_W1T), M, IN1, D}; pg8::StaticOrder S; S.init(M, IN1, G, (int)blockIdx.x);
      EpiScaleBf16 E{(bf16*)(P.ws + WS_SCR), IN1, (const float*)(P.ws + WS_SLOT1), P.b_in1, 1536};
      pg8::gemm_phase<EpiScaleBf16, pg8::StaticOrder, true, true>(lds, g, S, E); }
    xcd_barrier(xbar);
    p7_attn(P, lds, tid, wave, lane);
    xcd_barrier(xbar);
    { pg8::Gemm g{XN, (const bf16*)(P.ws + WS_WO1T), M, D, D}; pg8::StaticOrder S; S.init(M, D, G, (int)blockIdx.x);
      EpiResidNorm E{(const bf16*)(P.ws + WS_H1B), P.out, P.b_out1, P.final_w, (float*)(P.ws + WS_SLOT2), (unsigned*)(P.ws + WS_PCNT)};
      pg8::gemm_phase<EpiResidNorm, pg8::StaticOrder, false, true>(lds, g, S, E); }
}

extern "C" void kernel_launch(void* const* d_in, const int* in_sizes, int n_in, void* d_out, int out_size, void* d_ws, size_t ws_size, hipStream_t stream) {
    static int grid = 0;
    if (grid == 0) {
        if (n_in != 23 || out_size != M * D || ws_size < WS_END) { fprintf(stderr, "kernel_launch: unexpected sizes n_in %d out %d ws %zu\n", n_in, out_size, ws_size); grid = -1; return; }
        int dev = 0, cus = 0, per_cu = 0;
        hipGetDevice(&dev); hipDeviceGetAttribute(&cus, hipDeviceAttributeMultiprocessorCount, dev);
        hipFuncSetAttribute((const void*)fwd_megakernel, hipFuncAttributeMaxDynamicSharedMemorySize, LDS_BYTES);
        hipOccupancyMaxActiveBlocksPerMultiprocessor(&per_cu, (const void*)fwd_megakernel, 512, LDS_BYTES);
        if (per_cu < 1) { fprintf(stderr, "kernel_launch: occupancy query says %d blocks/CU\n", per_cu); per_cu = 1; }
        grid = cus * 1;
        if (grid != 256) { fprintf(stderr, "kernel_launch: built for a 256-CU device (got %d)\n", cus); grid = -1; return; }
        (void)hipGetLastError();
    }
    if (grid < 0) return;
    Params p{};
    const float** pp = (const float**)&p;
    for (int i = 0; i < 23; ++i) pp[i] = (const float*)d_in[i];
    p.out = (float*)d_out; p.ws = (unsigned char*)d_ws;
    if (hipMemsetAsync((char*)d_ws + WS_CTL, 0, CTL_BYTES, stream) != hipSuccess) { fprintf(stderr, "memset failed\n"); return; }
    void* args[] = {&p};
    hipError_t e = hipLaunchCooperativeKernel((const void*)fwd_megakernel, dim3(grid), dim3(512), args, LDS_BYTES, stream);
    if (e != hipSuccess) fprintf(stderr, "cooperative launch failed: %s (grid %d)\n", hipGetErrorString(e), grid);
}
```

```cpp
#include <hip/hip_runtime.h>
#include <hip/hip_cooperative_groups.h>
#include <cstdio>
#include <cstdint>
namespace cg = cooperative_groups;
#ifndef REP_P2R
#define REP_P2R 1
#endif
#ifndef REP_P2G
#define REP_P2G 1
#endif
#ifndef REP_S2
#define REP_S2 1
#endif
#ifndef REP_P3
#define REP_P3 1
#endif
namespace pg8 {
#define PG8_LAS __attribute__((address_space(3)))
typedef unsigned short bf16_t;
typedef short bf16x8 __attribute__((ext_vector_type(8)));
typedef float f32x4 __attribute__((ext_vector_type(4)));
typedef unsigned u32x4 __attribute__((ext_vector_type(4)));
constexpr int BM = 256, BK = 64, HALF = 128, HTB = HALF * BK * 2  , STAGE_BYTES = 8 * HTB, NXCD = 8, WGM = 8;

__host__ __device__ __forceinline__ int lds_byte(int r, int c) { const int st = (r >> 4) * 2 + (c >> 5), rr = r & 15, cc = c & 31, ob = rr * 64 + cc * 2; return st * 1024 + (ob ^ (((ob >> 9) & 1) << 5)); }
__host__ __device__ __forceinline__ void stage_rc(int b, int& R, int& C) { const int st = b / 1024, sb = b % 1024, swz = sb ^ (((sb >> 9) & 1) << 5); R = (st >> 1) * 16 + swz / 64; C = (st & 1) * 32 + (swz % 64) / 2; }
__host__ __device__ __forceinline__ int perm32(int rho) { const int n = rho >> 4, i = rho & 15; return 8 * (i >> 2) + 4 * n + (i & 3); }

struct Unit { int pm, pn; };
struct Gemm { const bf16_t* A; const bf16_t* Bt; int M, N, K; };

struct StaticOrder {
    int nM, nN, nwg, G, c;
    __host__ __device__ void init(int M, int N, int G_, int c_) { nM = M / BM; nN = N / BM; nwg = nM * nN; G = G_; c = c_; }
    __host__ __device__ bool next(int i, Unit& u) const {
        const long L = (long)i * G + c; if (L >= nwg) return false;
        int wgid = (int)L; { const int q = nwg / NXCD, r = nwg % NXCD, xcd = wgid % NXCD, off = wgid / NXCD; wgid = (xcd < r ? xcd * (q + 1) : r * (q + 1) + (xcd - r) * q) + off; }
        const int nig = WGM * nN, gid = wgid / nig, fm = gid * WGM, gsz = (nM - fm) < WGM ? (nM - fm) : WGM;
        u.pm = fm + ((wgid % nig) % gsz); u.pn = (wgid % nig) / gsz; return true;
    }
    __device__ __forceinline__ void a_ready(const Unit&) const {}
    __device__ __forceinline__ void done(const Unit&) const {}
};

template <class Epi, class Sched, bool ALIGN_EPI = false, bool SP2 = false>
__device__ __forceinline__ void gemm_phase(PG8_LAS unsigned char* lds, const Gemm g, const Sched& S, const Epi& E) {
    const int tid = threadIdx.x, wid = __builtin_amdgcn_readfirstlane(tid >> 6), lane = tid & 63, wr = wid >> 2, wc = wid & 3, fr = lane & 15, fq = lane >> 4;
    const int K = g.K, nt = K / BK;
    unsigned voffA[2], voffB[2];
#pragma unroll
    for (int i = 0; i < 2; ++i) { int R, C; stage_rc(tid * 16 + i * 8192, R, C); const int Rb = Epi::PERM ? ((R & ~31) + perm32(R & 31)) : R;
        voffA[i] = (unsigned)(R * K + C) * 2u; voffB[i] = (unsigned)(Rb * K + C) * 2u; }
    const size_t kstep = (size_t)(BK * 2);
    const size_t hstep = (size_t)HALF * K * 2;
    const size_t tstep = 2 * hstep;
    const unsigned ldsw = (unsigned)wid * 1024u;
    const int aoff = lds_byte(wr * 64 + fr, fq * 8), boff = lds_byte(wc * 32 + fr, fq * 8);
#define PG8_SA(b, h) (((b) * 2 + (h)) * HTB)
#define PG8_SB(b, h) ((4 + (b) * 2 + (h)) * HTB)
#define PG8_STAGE(bufoff, gbase, voff) do { _Pragma("unroll") for (int _i = 0; _i < 2; ++_i) \
        __builtin_amdgcn_global_load_lds((const unsigned*)((const char*)(gbase) + (voff)[_i]), (PG8_LAS unsigned*)(lds + (bufoff) + ldsw + _i * 8192), 16, 0, 0); } while (0)
#define PG8_LDA(dst, b, h) do { _Pragma("unroll") for (int m = 0; m < 4; ++m) _Pragma("unroll") for (int k = 0; k < 2; ++k) dst[m][k] = *(const PG8_LAS bf16x8*)(lds + PG8_SA(b, h) + aoff + m * 2048 + k * 1024); } while (0)
#define PG8_LDB(dst, b, h) do { _Pragma("unroll") for (int n = 0; n < 2; ++n) _Pragma("unroll") for (int k = 0; k < 2; ++k) dst[n][k] = *(const PG8_LAS bf16x8*)(lds + PG8_SB(b, h) + boff + n * 2048 + k * 1024); } while (0)
#define PG8_MMA(ai, bj, At, Bt) do { __builtin_amdgcn_s_setprio(1); _Pragma("unroll") for (int m = 0; m < 4; ++m) _Pragma("unroll") for (int n = 0; n < 2; ++n) _Pragma("unroll") for (int k = 0; k < 2; ++k) \
        acc[ai][bj][m][n] = __builtin_amdgcn_mfma_f32_16x16x32_bf16(Bt[n][k], At[m][k], acc[ai][bj][m][n], 0, 0, 0); __builtin_amdgcn_s_setprio(0); } while (0)
#define PG8_WAIT_V(n) asm volatile("s_waitcnt vmcnt(" #n ")" ::: "memory")
#define PG8_WAIT_L(n) asm volatile("s_waitcnt lgkmcnt(" #n ")" ::: "memory")
#define PG8_BAR __builtin_amdgcn_s_barrier()
#define PG8_SCHED __builtin_amdgcn_sched_barrier(0)
    Unit cur, nxt; int ui = 0;
    if (!S.next(0, cur)) return;
    f32x4 acc[2][2][4][2];
#pragma unroll
    for (int a = 0; a < 2; ++a)
#pragma unroll
        for (int b = 0; b < 2; ++b)
#pragma unroll
            for (int m = 0; m < 4; ++m)
#pragma unroll
                for (int n = 0; n < 2; ++n) acc[a][b][m][n] = (f32x4){0.f, 0.f, 0.f, 0.f};
    bf16x8 At[4][2], B0[2][2], B1[2][2];
    const char* cA = (const char*)g.A + (size_t)cur.pm * tstep; const char* cB = (const char*)g.Bt + (size_t)cur.pn * tstep;
    S.a_ready(cur);
    if constexpr (SP2) {
        PG8_STAGE(PG8_SB(0, 0), cB, voffB); PG8_STAGE(PG8_SB(0, 1), cB + hstep, voffB); PG8_STAGE(PG8_SA(0, 0), cA, voffA); PG8_STAGE(PG8_SA(0, 1), cA + hstep, voffA);
        if (wr == 1) PG8_BAR;
        PG8_WAIT_V(2); PG8_BAR;
        PG8_STAGE(PG8_SB(1, 0), cB + kstep, voffB); PG8_STAGE(PG8_SA(1, 0), cA + kstep, voffA); PG8_STAGE(PG8_SB(1, 1), cB + hstep + kstep, voffB);
        PG8_WAIT_V(6); PG8_BAR;
    } else {
        PG8_STAGE(PG8_SB(0, 0), cB, voffB); PG8_STAGE(PG8_SA(0, 0), cA, voffA); PG8_STAGE(PG8_SB(0, 1), cB + hstep, voffB); PG8_STAGE(PG8_SA(0, 1), cA + hstep, voffA);
        if (wr == 1) PG8_BAR;
        PG8_WAIT_V(4); PG8_BAR;
        PG8_STAGE(PG8_SB(1, 0), cB + kstep, voffB); PG8_STAGE(PG8_SA(1, 0), cA + kstep, voffA); PG8_STAGE(PG8_SB(1, 1), cB + hstep + kstep, voffB);
        PG8_WAIT_V(6); PG8_BAR;
    }
    for (;;) {
        const bool has_next = S.next(ui + 1, nxt);
        const char* nA = has_next ? (const char*)g.A + (size_t)nxt.pm * tstep : cA; const char* nB = has_next ? (const char*)g.Bt + (size_t)nxt.pn * tstep : cB;
        for (int t = 0; t < nt; t += 2) {
            const bool last = (t == nt - 2);
            const char* a1 = cA + (size_t)(t + 1) * kstep;
            const char* a2 = last ? nA : cA + (size_t)(t + 2) * kstep; const char* b2 = last ? nB : cB + (size_t)(t + 2) * kstep;
            const char* a3 = a2 + kstep; const char* b3 = b2 + kstep;
            if (last && has_next) S.a_ready(nxt);
            if constexpr (SP2) {
            PG8_LDB(B0, 0, 0); PG8_LDB(B1, 0, 1); PG8_SCHED; PG8_LDA(At, 0, 0); PG8_STAGE(PG8_SA(1, 1), a1 + hstep, voffA);
            PG8_WAIT_V(8); PG8_WAIT_L(0); PG8_BAR; PG8_MMA(0, 0, At, B0); PG8_MMA(0, 1, At, B1); PG8_BAR; PG8_SCHED;
            PG8_LDA(At, 0, 1); PG8_STAGE(PG8_SB(0, 0), b2, voffB); PG8_STAGE(PG8_SB(0, 1), b2 + hstep, voffB); PG8_STAGE(PG8_SA(0, 0), a2, voffA);
            PG8_WAIT_V(8); PG8_WAIT_L(0); PG8_BAR; PG8_MMA(1, 0, At, B0); PG8_MMA(1, 1, At, B1); PG8_BAR; PG8_SCHED;
            PG8_LDB(B0, 1, 0); PG8_LDB(B1, 1, 1); PG8_SCHED; PG8_LDA(At, 1, 0); PG8_STAGE(PG8_SA(0, 1), a2 + hstep, voffA);
            PG8_WAIT_V(8); PG8_WAIT_L(0); PG8_BAR; PG8_MMA(0, 0, At, B0); PG8_MMA(0, 1, At, B1); PG8_BAR; PG8_SCHED;
            PG8_LDA(At, 1, 1); PG8_STAGE(PG8_SB(1, 0), b3, voffB); PG8_STAGE(PG8_SB(1, 1), b3 + hstep, voffB); PG8_STAGE(PG8_SA(1, 0), a3, voffA);
            PG8_WAIT_V(8); PG8_WAIT_L(0); PG8_BAR; PG8_MMA(1, 0, At, B0); PG8_MMA(1, 1, At, B1); PG8_BAR; PG8_SCHED;
            } else {
            PG8_LDB(B0, 0, 0); PG8_SCHED; PG8_LDA(At, 0, 0); PG8_STAGE(PG8_SA(1, 1), a1 + hstep, voffA);
            PG8_WAIT_L(8); PG8_BAR; PG8_WAIT_L(0); PG8_MMA(0, 0, At, B0); PG8_BAR; PG8_SCHED;
            PG8_LDB(B1, 0, 1); PG8_STAGE(PG8_SB(0, 0), b2, voffB);
            PG8_BAR; PG8_WAIT_L(0); PG8_MMA(0, 1, At, B1); PG8_BAR;
            PG8_LDA(At, 0, 1); PG8_STAGE(PG8_SA(0, 0), a2, voffA);
            PG8_BAR; PG8_WAIT_L(0); PG8_MMA(1, 0, At, B0); PG8_BAR; PG8_SCHED;
            PG8_STAGE(PG8_SB(0, 1), b2 + hstep, voffB);
            PG8_WAIT_V(6); PG8_BAR; PG8_MMA(1, 1, At, B1); PG8_BAR;
            PG8_LDB(B0, 1, 0); PG8_SCHED; PG8_LDA(At, 1, 0); PG8_STAGE(PG8_SA(0, 1), a2 + hstep, voffA);
            PG8_WAIT_L(8); PG8_BAR; PG8_WAIT_L(0); PG8_MMA(0, 0, At, B0); PG8_BAR; PG8_SCHED;
            PG8_LDB(B1, 1, 1); PG8_STAGE(PG8_SB(1, 0), b3, voffB);
            PG8_BAR; PG8_WAIT_L(0); PG8_MMA(0, 1, At, B1); PG8_BAR;
            PG8_LDA(At, 1, 1); PG8_STAGE(PG8_SA(1, 0), a3, voffA);
            PG8_BAR; PG8_WAIT_L(0); PG8_MMA(1, 0, At, B0); PG8_BAR; PG8_SCHED;
            PG8_STAGE(PG8_SB(1, 1), b3 + hstep, voffB);
            PG8_WAIT_V(6); PG8_BAR; PG8_MMA(1, 1, At, B1); PG8_BAR;
            }
        }
        if constexpr (ALIGN_EPI) { if (wr == 0) PG8_BAR; }
        if constexpr (!Epi::AFTER_DRAIN) { E(acc, cur, wr, wc, fr, fq); S.done(cur); }
        if (!has_next) break;
#pragma unroll
        for (int a = 0; a < 2; ++a)
#pragma unroll
            for (int b = 0; b < 2; ++b)
#pragma unroll
                for (int m = 0; m < 4; ++m)
#pragma unroll
                    for (int n = 0; n < 2; ++n) acc[a][b][m][n] = (f32x4){0.f, 0.f, 0.f, 0.f};
        cur = nxt; cA = nA; cB = nB; ++ui;
        if constexpr (ALIGN_EPI) { if (wr == 1) PG8_BAR; }
    }
    PG8_WAIT_V(0);
    if constexpr (!ALIGN_EPI) { if (wr == 0) PG8_BAR; }
    PG8_BAR;
    if constexpr (Epi::AFTER_DRAIN) { E.fused(acc, cur, wr, wc, fr, fq, lds, wid, lane); S.done(cur); }
#undef PG8_SA
#undef PG8_SB
#undef PG8_STAGE
#undef PG8_LDA
#undef PG8_LDB
#undef PG8_MMA
#undef PG8_WAIT_V
#undef PG8_WAIT_L
#undef PG8_BAR
#undef PG8_SCHED
}
}
#define GAS __attribute__((address_space(1)))
#define LAS __attribute__((address_space(3)))
#define AS4 __attribute__((address_space(4)))
#define DI __device__ __forceinline__
typedef unsigned short bf16;
typedef float f32x4 __attribute__((ext_vector_type(4)));
typedef float f32x16 __attribute__((ext_vector_type(16)));
typedef short bf16x8 __attribute__((ext_vector_type(8)));
typedef short s16x4 __attribute__((ext_vector_type(4)));
typedef unsigned u32x4 __attribute__((ext_vector_type(4)));
typedef unsigned u32x2 __attribute__((ext_vector_type(2)));
typedef __bf16 bf2v __attribute__((ext_vector_type(2)));

constexpr int NB = 4, T = 4096, M = NB * T, D = 1024;
constexpr int IN0 = 3728, N0P = 3840, IN1 = 2560;
constexpr int C_GQ = 0, C_GK = 256, C_GV = 512, C_GLOW = 1024, C_RW = 1040, C_GATE0 = 2704;
constexpr int C_RR = C_RW, C_RK = C_RW + 512, C_RV = C_RW + 1024, C_XW = C_RW + 1536, C_XA = C_RW + 1600;
constexpr float NORM_EPS = 1e-5f, RWKV_LN_EPS = 64e-5f;
constexpr size_t MiB = 1u << 20;
constexpr size_t WS_W0T = 0, WS_WO0T = 8 * MiB, WS_W1T = 10 * MiB, WS_WO1T = 15 * MiB;
constexpr size_t WS_SLOT1 = 17 * MiB, WS_SLOT2 = 18 * MiB, WS_BONUS = 19 * MiB, WS_GDEC = 19 * MiB + 512 * 1024;
constexpr size_t WS_CTL = 19 * MiB + 768 * 1024, CTL_BYTES = 40960, WS_PCNT = WS_CTL + 16384;
constexpr size_t WS_XCCTAB = WS_CTL + 32768, WS_PROG = WS_CTL + 33792;
constexpr int LDS_BAR_OFF = 147456 - 64;
constexpr size_t WS_ROPE = 18 * MiB + 512 * 1024;
constexpr size_t WS_WLT = 18 * MiB + 768 * 1024;
constexpr size_t WS_XN = 20 * MiB;
constexpr size_t WS_PROJ0 = 52 * MiB;
constexpr size_t WS_H1B = 116 * MiB;
constexpr size_t WS_SCR = 172 * MiB;
constexpr size_t WS_OARAW = 204 * MiB;
constexpr size_t WS_VP = 236 * MiB;
constexpr size_t WS_END = 252 * MiB;
constexpr int LDS_BYTES = 147456;

struct Params {
    const float *x, *norm_w, *w_in0, *gk_up, *gk_bias, *gla_norm_w, *mu, *w0, *w_up, *a0, *a_up, *k_k, *k_a, *r_k, *ln_w, *ln_b, *w_out0, *w_in1, *b_in1, *sinks, *w_out1, *b_out1, *final_w;
    float* out; unsigned char* ws;
};

typedef float f32x2v __attribute__((ext_vector_type(2)));
DI unsigned pk2(float lo, float hi) { const f32x2v f = {lo, hi}; return __builtin_bit_cast(unsigned, __builtin_convertvector(f, bf2v)); }
DI unsigned f2bf(float f) { return pk2(f, 0.f) & 0xffffu; }
DI float bf2f(unsigned h) { return __builtin_bit_cast(float, h << 16); }
DI float bflo(unsigned w) { return __builtin_bit_cast(float, w << 16); }
DI float bfhi(unsigned w) { return __builtin_bit_cast(float, w & 0xffff0000u); }
DI float wave_sum(float v) {
#pragma unroll
    for (int o = 1; o < 64; o <<= 1) v += __shfl_xor(v, o);
    return v;
}
DI float dpp_sum16(float v) {
    v += __builtin_bit_cast(float, __builtin_amdgcn_update_dpp(0, __builtin_bit_cast(int, v), 0xB1, 0xf, 0xf, true));
    v += __builtin_bit_cast(float, __builtin_amdgcn_update_dpp(0, __builtin_bit_cast(int, v), 0x4E, 0xf, 0xf, true));
    v += __builtin_bit_cast(float, __builtin_amdgcn_update_dpp(0, __builtin_bit_cast(int, v), 0x141, 0xf, 0xf, true));
    v += __builtin_bit_cast(float, __builtin_amdgcn_update_dpp(0, __builtin_bit_cast(int, v), 0x140, 0xf, 0xf, true));
    return v;
}
DI float half_sum32(float v) { v = dpp_sum16(v); return v + __shfl_xor(v, 16); }
DI void unpack8(const u32x4 w, float (&f)[8]) {
#pragma unroll
    for (int e = 0; e < 4; ++e) { f[2 * e] = bflo(w[e]); f[2 * e + 1] = bfhi(w[e]); }
}
DI int crow(int r, int hi) { return (r & 3) + 8 * (r >> 2) + 4 * hi; }
DI int kpos(int k) { const int o16 = k & 15; return (k & ~15) + 8 * ((o16 >> 2) & 1) + 4 * (o16 >> 3) + (o16 & 3); }
#define MFMA32(a, b, c) __builtin_amdgcn_mfma_f32_32x32x16_bf16((a), (b), (c), 0, 0, 0)
#define LDS_WAIT() asm volatile("s_waitcnt lgkmcnt(0)" ::: "memory")
DI void lds_barrier() { asm volatile("s_waitcnt lgkmcnt(0)" ::: "memory"); __builtin_amdgcn_s_barrier(); asm volatile("" ::: "memory"); }

#define XB_TMO      128
#define XB_XCNT(j)  (256  + 64 * (j))
#define XB_XSUB(j)  (1280 + 64 * (j))
#define XB_XGEN(j)  (2304 + 64 * (j))
#define XB_TOP      3328
#define XB_TOPGEN   3392
#define XCD_BAR_WORDS 3456
#define XB_SPIN_CAP (1u << 18)

__device__ __forceinline__ unsigned xb_ld(unsigned* p)              { return __hip_atomic_load(p, __ATOMIC_RELAXED, __HIP_MEMORY_SCOPE_AGENT); }
__device__ __forceinline__ unsigned xb_add(unsigned* p, unsigned v) { return __hip_atomic_fetch_add(p, v, __ATOMIC_RELAXED, __HIP_MEMORY_SCOPE_AGENT); }
__device__ __forceinline__ unsigned xb_xcc_id() { return (unsigned)__builtin_amdgcn_s_getreg((3 << 11) | 20) & 0xFu; }
#define XB_SPIN(cond, bar) do { unsigned _sp = 0; while (cond) { __builtin_amdgcn_s_sleep(1); \
    if ((++_sp & 255u) == 0u) { if (xb_ld(&(bar)[XB_TMO])) break; if (_sp > XB_SPIN_CAP) { atomicAdd(&(bar)[XB_TMO], 1u); break; } } } } while (0)

struct XcdBarrier {
    unsigned* bar; unsigned x;
    volatile LAS unsigned* st;
};

__device__ __forceinline__ XcdBarrier xcd_barrier_post(unsigned* bar, volatile LAS unsigned* st) {
    XcdBarrier b; b.bar = bar; b.x = xb_xcc_id(); b.st = st;
    if (threadIdx.x == 0) (void)xb_add(&bar[XB_XCNT(b.x)], 1u);
    return b;
}
__device__ __forceinline__ void xcd_barrier_complete(unsigned* bar, unsigned x, unsigned& nloc, unsigned& nx) {
    const unsigned G = gridDim.x * gridDim.y * gridDim.z;
    unsigned sum, cnt, mine, sp = 0u;
    for (;;) {
        sum = 0u; cnt = 0u; mine = 0u;
#pragma unroll
        for (unsigned j = 0; j < 16; ++j) { const unsigned c = xb_ld(&bar[XB_XCNT(j)]); sum += c; cnt += (c > 0u) ? 1u : 0u; mine = (j == x) ? c : mine; }
        if (sum == G) break;
        __builtin_amdgcn_s_sleep(1);
        if ((++sp & 255u) == 0u) { if (xb_ld(&bar[XB_TMO])) break; if (sp > XB_SPIN_CAP) { atomicAdd(&bar[XB_TMO], 1u); break; } }
    }
    nloc = mine > 0u ? mine : 1u; nx = cnt > 0u ? cnt : 1u;
}

__device__ __forceinline__ void xcd_barrier(const XcdBarrier& b) {
    asm volatile("s_waitcnt vmcnt(0)" ::: "memory");
    __syncthreads();
    if (threadIdx.x == 0) {
        unsigned* bar = b.bar;
        __builtin_amdgcn_s_waitcnt(0);
        unsigned nloc = b.st[0], nx = b.st[1];
        if (nloc == 0u) { xcd_barrier_complete(bar, b.x, nloc, nx); b.st[0] = nloc; b.st[1] = nx; }
        const unsigned old = xb_add(&bar[XB_XSUB(b.x)], 1u);
        const unsigned gen = old / nloc;
        if (old + 1u == (gen + 1u) * nloc) {
            __builtin_amdgcn_fence(__ATOMIC_RELEASE, "agent");
            asm volatile("s_waitcnt vmcnt(0)" ::: "memory");
            const unsigned og = xb_add(&bar[XB_TOP], 1u);
            const unsigned tg = og / nx;
            if (og + 1u == (tg + 1u) * nx) xb_add(&bar[XB_TOPGEN], 1u);
            else XB_SPIN(xb_ld(&bar[XB_TOPGEN]) == tg, bar);
            __builtin_amdgcn_fence(__ATOMIC_ACQUIRE, "agent");
            xb_add(&bar[XB_XGEN(b.x)], 1u);
            asm volatile("s_waitcnt vmcnt(0)" ::: "memory");
        } else {
            XB_SPIN(xb_ld(&bar[XB_XGEN(b.x)]) == gen, bar);
            __builtin_amdgcn_fence(__ATOMIC_ACQUIRE, "agent");
            asm volatile("s_waitcnt vmcnt(0)" ::: "memory");
        }
    }
    __syncthreads();
}

struct EpiScaleBf16 {
    static constexpr bool PERM = true, AFTER_DRAIN = false;
    bf16* O; int ldc; const float* slots; const float* bias; int bias_n;
    DI void operator()(const pg8::f32x4 (&acc)[2][2][4][2], const pg8::Unit& u, int wr, int wc, int fr, int fq) const {
        const int row0 = u.pm * 256 + wr * 64 + fr, col0 = u.pn * 256 + wc * 32 + 8 * fq;
        const bool hb = bias && (u.pn * 256 < bias_n);
        f32x4 bv[2][2];
#pragma unroll
        for (int bj = 0; bj < 2; ++bj)
#pragma unroll
            for (int n = 0; n < 2; ++n) bv[bj][n] = hb ? *(const f32x4*)(bias + col0 + bj * 128 + 4 * n) : (f32x4){0.f, 0.f, 0.f, 0.f};
#pragma unroll
        for (int ai = 0; ai < 2; ++ai)
#pragma unroll
            for (int m = 0; m < 4; ++m) {
                const int row = row0 + ai * 128 + m * 16; float rs = 1.f;
                if (slots) { const f32x4* sp = (const f32x4*)(slots + (size_t)row * 16); const f32x4 a = sp[0], b = sp[1], c = sp[2], d = sp[3];
                    const float ss = ((a[0] + a[1]) + (a[2] + a[3])) + ((b[0] + b[1]) + (b[2] + b[3])) + ((c[0] + c[1]) + (c[2] + c[3])) + ((d[0] + d[1]) + (d[2] + d[3]));
                    rs = 1.0f / sqrtf(ss * (1.0f / 1024.0f) + NORM_EPS); }
                bf16* rowp = O + (size_t)row * ldc + col0;
#pragma unroll
                for (int bj = 0; bj < 2; ++bj) { const f32x4 v0 = acc[ai][bj][m][0] * rs + bv[bj][0], v1 = acc[ai][bj][m][1] * rs + bv[bj][1];
                    u32x4 w; w.x = pk2(v0[0], v0[1]); w.y = pk2(v0[2], v0[3]); w.z = pk2(v1[0], v1[1]); w.w = pk2(v1[2], v1[3]);
                    *(u32x4*)(rowp + bj * 128) = w; }
            }
    }
};
struct EpiResid {
    static constexpr bool PERM = false, AFTER_DRAIN = false;
    const float* base; bf16* outB; float* slots;
    DI void operator()(const pg8::f32x4 (&acc)[2][2][4][2], const pg8::Unit& u, int wr, int wc, int fr, int fq) const {
        const int col0 = u.pn * 256 + wc * 32 + 4 * fq;
#pragma unroll
        for (int ai = 0; ai < 2; ++ai)
#pragma unroll
            for (int m = 0; m < 4; ++m) {
                const int row = u.pm * 256 + ai * 128 + wr * 64 + m * 16 + fr; const size_t off = (size_t)row * 1024 + col0; float ss = 0.f;
#pragma unroll
                for (int bj = 0; bj < 2; ++bj)
#pragma unroll
                    for (int n = 0; n < 2; ++n) { const f32x4 bs = *(const f32x4*)(base + off + bj * 128 + n * 16); const f32x4 v = bs + acc[ai][bj][m][n];
                        u32x2 w; w.x = pk2(v[0], v[1]); w.y = pk2(v[2], v[3]); *(u32x2*)(outB + off + bj * 128 + n * 16) = w;
                        ss += (v[0] * v[0] + v[1] * v[1]) + (v[2] * v[2] + v[3] * v[3]); }
                ss += __shfl_xor(ss, 16); ss += __shfl_xor(ss, 32);
                if (fq == 0) slots[(size_t)row * 16 + u.pn * 4 + wc] = ss;
            }
    }
};

struct EpiResidNorm {
    static constexpr bool PERM = false, AFTER_DRAIN = true;
    const bf16* base; float* out; const float* bias; const float* w; float* xbuf; unsigned* cnt;
    DI void fused(pg8::f32x4 (&acc)[2][2][4][2], const pg8::Unit& u, int wr, int wc, int fr, int fq, PG8_LAS unsigned char* lds, int wid, int lane) const {
        PG8_LAS float* Pt = (PG8_LAS float*)lds;
        PG8_LAS float* S = (PG8_LAS float*)(lds + 4096);
        const int col0 = u.pn * 256 + wc * 32 + 4 * fq;
#pragma unroll
        for (int ai = 0; ai < 2; ++ai)
#pragma unroll
            for (int m = 0; m < 4; ++m) {
                const int r = ai * 128 + wr * 64 + m * 16 + fr; const size_t off = (size_t)(u.pm * 256 + r) * 1024 + col0; float ss = 0.f;
#pragma unroll
                for (int bj = 0; bj < 2; ++bj)
#pragma unroll
                    for (int n = 0; n < 2; ++n) { const u32x2 bw = *(const u32x2*)(base + off + bj * 128 + n * 16); const f32x4 bs = (f32x4){bflo(bw.x), bfhi(bw.x), bflo(bw.y), bfhi(bw.y)}; const f32x4 bv = *(const f32x4*)(bias + col0 + bj * 128 + n * 16);
                        const f32x4 v = bs + acc[ai][bj][m][n] + bv; acc[ai][bj][m][n] = v; ss += (v[0] * v[0] + v[1] * v[1]) + (v[2] * v[2] + v[3] * v[3]); }
                ss += __shfl_xor(ss, 16); ss += __shfl_xor(ss, 32);
                if (fq == 0) Pt[r * 4 + wc] = ss;
                if (m & 1) asm volatile("" ::: "memory");
            }
        asm volatile("s_waitcnt lgkmcnt(0)" ::: "memory"); __builtin_amdgcn_s_barrier(); asm volatile("" ::: "memory");
        const int row = wid * 32 + (lane & 31);
        if (lane < 32) { const float tot = (Pt[row * 4 + 0] + Pt[row * 4 + 1]) + (Pt[row * 4 + 2] + Pt[row * 4 + 3]);
            __hip_atomic_store(xbuf + (size_t)(u.pm * 256 + row) * 4 + u.pn, tot, __ATOMIC_RELAXED, __HIP_MEMORY_SCOPE_AGENT); }
        asm volatile("s_waitcnt vmcnt(0)" ::: "memory");
        if (lane == 0) __hip_atomic_fetch_add(cnt + 64 * u.pm, 1u, __ATOMIC_RELAXED, __HIP_MEMORY_SCOPE_AGENT);
        if (wid == 0) {
            unsigned spins = 0;
            while ((unsigned)__builtin_amdgcn_readfirstlane(__hip_atomic_load(cnt + 64 * u.pm, __ATOMIC_RELAXED, __HIP_MEMORY_SCOPE_AGENT)) < 32u) { __builtin_amdgcn_s_sleep(2); if (++spins > (1u << 22)) break; }
            __builtin_amdgcn_fence(__ATOMIC_ACQUIRE, "agent");
        }
        asm volatile("s_waitcnt vmcnt(0) lgkmcnt(0)" ::: "memory"); __builtin_amdgcn_s_barrier(); asm volatile("" ::: "memory");
        if (lane < 32) { const float* sl = xbuf + (size_t)(u.pm * 256 + row) * 4; float t = 0.f;
#pragma unroll
            for (int k = 0; k < 4; ++k) t += __hip_atomic_load(sl + k, __ATOMIC_RELAXED, __HIP_MEMORY_SCOPE_AGENT);
            S[row] = 1.0f / sqrtf(t * (1.f / 1024.f) + NORM_EPS); }
        asm volatile("s_waitcnt lgkmcnt(0)" ::: "memory"); __builtin_amdgcn_s_barrier(); asm volatile("" ::: "memory");
        f32x4 wv[2][2];
#pragma unroll
        for (int bj = 0; bj < 2; ++bj)
#pragma unroll
            for (int n = 0; n < 2; ++n) wv[bj][n] = *(const f32x4*)(w + col0 + bj * 128 + n * 16);
#pragma unroll
        for (int ai = 0; ai < 2; ++ai)
#pragma unroll
            for (int m = 0; m < 4; ++m) { const int r = ai * 128 + wr * 64 + m * 16 + fr; const float rs = S[r]; const size_t off = (size_t)(u.pm * 256 + r) * 1024 + col0;
#pragma unroll
                for (int bj = 0; bj < 2; ++bj)
#pragma unroll
                    for (int n = 0; n < 2; ++n) *(f32x4*)(out + off + bj * 128 + n * 16) = acc[ai][bj][m][n] * rs * wv[bj][n]; }
    }
};

DI void transpose_item(const float* W, int N, int Npad, bf16* WT, const float* kscale, LAS float* scr, int item, int lane) {
    const int nblk = Npad / 32, kb = item / nblk, nb = item % nblk, k0 = 64 * kb, n0 = 32 * nb;
    const int n = n0 + (lane & 31);
#pragma unroll 8
    for (int i = 0; i < 32; ++i) { const int kk = 2 * i + (lane >> 5); float v = (n < N) ? W[(size_t)(k0 + kk) * N + n] : 0.f; if (kscale) v *= kscale[k0 + kk]; scr[kk * 33 + (lane & 31)] = v; }
    LDS_WAIT(); asm volatile("" ::: "memory");
    const int c = lane & 7;
#pragma unroll
    for (int j = 0; j < 4; ++j) { const int nn = (lane >> 3) + 8 * j; const LAS float* s = scr + (8 * c) * 33 + nn;
        u32x4 o; o.x = pk2(s[0 * 33], s[1 * 33]); o.y = pk2(s[2 * 33], s[3 * 33]); o.z = pk2(s[4 * 33], s[5 * 33]); o.w = pk2(s[6 * 33], s[7 * 33]);
        *(u32x4*)(WT + (size_t)(n0 + nn) * 1024 + k0 + 8 * c) = o; }
    LDS_WAIT(); asm volatile("" ::: "memory");
}
DI void p0_prologue(const Params& P, LAS unsigned char* lds, int wave, int lane) {
    LAS float* scr = (LAS float*)(lds + wave * 16384);
    const int gw = blockIdx.x * 8 + wave, NGW = gridDim.x * 8;
    bf16* W0T = (bf16*)(P.ws + WS_W0T); bf16* WO0T = (bf16*)(P.ws + WS_WO0T); bf16* W1T = (bf16*)(P.ws + WS_W1T); bf16* WO1T = (bf16*)(P.ws + WS_WO1T);
    constexpr int I0 = 16 * (N0P / 32), I1 = 16 * 32, I2 = 16 * (IN1 / 32), I3 = 16 * 32;
    for (int it = gw; it < I0 + I1 + I2 + I3; it += NGW) {
        int r = it;
        if (r < I0) { transpose_item(P.w_in0, IN0, N0P, W0T, nullptr, scr, r, lane); continue; } r -= I0;
        if (r < I1) { transpose_item(P.w_out0, 1024, 1024, WO0T, nullptr, scr, r, lane); continue; } r -= I1;
        if (r < I2) { transpose_item(P.w_in1, IN1, IN1, W1T, P.norm_w + 1024, scr, r, lane); continue; } r -= I2;
        transpose_item(P.w_out1, 1024, 1024, WO1T, nullptr, scr, r, lane);
    }
    {
        float* RT = (float*)(P.ws + WS_ROPE);
        for (int e = gw * 64 + lane; e < T * 8; e += NGW * 64) { const int pos = e >> 3, j = e & 7;
            const float invf = __expf(-(float)j * 0.125f * 13.122363377404328f); const float ang = (float)pos * invf; const float nrev = rintf(ang * 0.15915494309189535f);
            float r = fmaf(-nrev, 6.2831854820251465f, ang); r = fmaf(-nrev, -1.7484555e-07f, r);
            RT[2 * e] = __cosf(r); RT[2 * e + 1] = __sinf(r); }
    }
    {
        u32x4* WLT = (u32x4*)(P.ws + WS_WLT);
        for (int e = gw * 64 + lane; e < 8 * 2 * 4 * 2 * 64; e += NGW * 64) { const int ln = e & 63, db = (e >> 6) & 1, s = (e >> 7) & 3, lo = (e >> 9) & 1, h = e >> 10;
            const float* wp = (lo ? P.a_up : P.w_up) + (size_t)(16 * s + 8 * (ln >> 5)) * 512 + h * 64 + 2 * (ln & 31) + db;
            u32x4 o; o.x = pk2(wp[0], wp[512]); o.y = pk2(wp[2 * 512], wp[3 * 512]); o.z = pk2(wp[4 * 512], wp[5 * 512]); o.w = pk2(wp[6 * 512], wp[7 * 512]); WLT[e] = o; }
    }
    bf16* XN = (bf16*)(P.ws + WS_XN);
    {
        const f32x4* wr = (const f32x4*)P.norm_w + lane; const f32x4 w0 = wr[0], w1 = wr[64], w2 = wr[128], w3 = wr[192];
        f32x4 nx[4];
        { const f32x4* xr = (const f32x4*)(P.x + (size_t)(gw < M ? gw : 0) * D) + lane;
#pragma unroll
          for (int j = 0; j < 4; ++j) nx[j] = xr[64 * j]; }
        for (int m = gw; m < M; m += NGW) {
            f32x4 v[4]; float s = 0.f;
#pragma unroll
            for (int j = 0; j < 4; ++j) { v[j] = nx[j]; s += (v[j][0] * v[j][0] + v[j][1] * v[j][1]) + (v[j][2] * v[j][2] + v[j][3] * v[j][3]); }
            if (m + NGW < M) { const f32x4* xr = (const f32x4*)(P.x + (size_t)(m + NGW) * D) + lane;
#pragma unroll
                for (int j = 0; j < 4; ++j) nx[j] = xr[64 * j]; }
            const float rstd = 1.0f / sqrtf(wave_sum(s) * (1.f / D) + NORM_EPS);
            u32x2* o8 = (u32x2*)(XN + (size_t)m * D) + lane;
            { u32x2 o; o.x = pk2(v[0][0] * rstd * w0[0], v[0][1] * rstd * w0[1]); o.y = pk2(v[0][2] * rstd * w0[2], v[0][3] * rstd * w0[3]); o8[0] = o; }
            { u32x2 o; o.x = pk2(v[1][0] * rstd * w1[0], v[1][1] * rstd * w1[1]); o.y = pk2(v[1][2] * rstd * w1[2], v[1][3] * rstd * w1[3]); o8[64] = o; }
            { u32x2 o; o.x = pk2(v[2][0] * rstd * w2[0], v[2][1] * rstd * w2[1]); o.y = pk2(v[2][2] * rstd * w2[2], v[2][3] * rstd * w2[3]); o8[128] = o; }
            { u32x2 o; o.x = pk2(v[3][0] * rstd * w3[0], v[3][1] * rstd * w3[1]); o.y = pk2(v[3][2] * rstd * w3[2], v[3][3] * rstd * w3[3]); o8[192] = o; }
        }
    }
}
DI float softplus_f(float z) { return fmaxf(z, 0.f) + __logf(1.f + __expf(-fabsf(z))); }
DI float tanh_f(float x) { return 1.f - 2.f * __builtin_amdgcn_rcpf(__expf(2.f * x) + 1.f); }

template <int N> DI void dpp_fmac(float& acc, float src, float y) { asm("v_fmac_f32_dpp %0, %1, %2 row_newbcast:%3 row_mask:0xf bank_mask:0xf" : "+v"(acc) : "v"(src), "v"(y), "n"(N)); }
template <int N> DI void dpp_mul_ip(float& y, float src) { asm("v_mul_f32_dpp %0, %1, %0 row_newbcast:%2 row_mask:0xf bank_mask:0xf" : "+v"(y) : "v"(src), "n"(N)); }
template <int N> DI float dpp_mul(float src, float s) { float r; asm("v_mul_f32_dpp %0, %1, %2 row_newbcast:%3 row_mask:0xf bank_mask:0xf" : "=v"(r) : "v"(src), "v"(s), "n"(N)); return r; }
template <int D> struct RStep {
    static DI void dot(const float (&y)[64], const f32x4& X, float& s0, float& s1, float& s2, float& s3) {
        if constexpr (D < 16) { dpp_fmac<D>(s0, X[0], y[D]); dpp_fmac<D>(s1, X[1], y[16 + D]); dpp_fmac<D>(s2, X[2], y[32 + D]); dpp_fmac<D>(s3, X[3], y[48 + D]); RStep<D + 1>::dot(y, X, s0, s1, s2, s3); } }
    static DI void upd(float (&y)[64], const f32x4& Bv, float sa) {
        if constexpr (D < 16) {
            dpp_fmac<D>(y[D], Bv[0], sa); dpp_fmac<D>(y[16 + D], Bv[1], sa); dpp_fmac<D>(y[32 + D], Bv[2], sa); dpp_fmac<D>(y[48 + D], Bv[3], sa);
            RStep<D + 1>::upd(y, Bv, sa); } }
    static DI void scale(float (&y)[64], const f32x4& W) {
        if constexpr (D < 16) {
            dpp_mul_ip<D>(y[D], W[0]); dpp_mul_ip<D>(y[16 + D], W[1]); dpp_mul_ip<D>(y[32 + D], W[2]); dpp_mul_ip<D>(y[48 + D], W[3]);
            RStep<D + 1>::scale(y, W); } }
};
DI void rwkv_rstep(float (&y)[64], const f32x4 (&X)[4], int t, int role, int lane, bf16* mstep) {
    float s0 = 0.f, s1 = 0.f, s2 = 0.f, s3 = 0.f;
    RStep<0>::dot(y, X[0], s0, s1, s2, s3);
    float sa = (s0 + s1) + (s2 + s3);
    if (role == 1) sa = (lane < t) ? sa : 0.f;
    RStep<0>::upd(y, X[2], sa);
    float o0 = 0.f, o1 = 0.f, o2 = 0.f, o3 = 0.f;
    RStep<0>::dot(y, X[3], o0, o1, o2, o3);
    float o = (o0 + o1) + (o2 + o3);
    if (role == 1) o = (lane <= t) ? o : 0.f;
    mstep[t * 64] = (bf16)f2bf(o);
}
DI void rwkv_prep_item(const Params& P, int item, LAS unsigned char* lds, int wave, int lane) {
    const int bh = item >> 4, quad = item & 15, b = bh >> 3, h = bh & 7;
    const int tok0 = b * T + quad * 256;
    const bf16* PROJ0 = (const bf16*)(P.ws + WS_PROJ0);
    float* scr = (float*)(P.ws + WS_SCR + (size_t)blockIdx.x * 262144);
    LAS float* KS = (LAS float*)lds;
    LAS float* TOT = (LAS float*)(lds + 8 * 64 * 65 * 4);
    bf16* VP = (bf16*)(P.ws + WS_VP); float* BON = (float*)(P.ws + WS_BONUS);
    const int hd = h * 64 + lane;
    {
        const int m = lane & 31, hi = lane >> 5;
        const int c = wave >> 1, tb = (wave & 1) * 32;
        const int tokw = tok0 + wave * 32, posw = quad * 256 + wave * 32;
        f32x16 accw[2], acca[2];
#pragma unroll
        for (int i = 0; i < 16; ++i) { accw[0][i] = 0.f; accw[1][i] = 0.f; acca[0][i] = 0.f; acca[1][i] = 0.f; }
        {
            const bf16* rowc = PROJ0 + (size_t)(tokw + m) * N0P; const bool hasprev = (posw + m) > 0;
            const u32x4* WLT = (const u32x4*)(P.ws + WS_WLT) + (size_t)h * 1024 + lane;
            u32x4 cwv[4], cav[4], pwv[4], pav[4], bwv[4][2], bav[4][2];
#pragma unroll
            for (int s = 0; s < 4; ++s) { const int j0 = 16 * s + 8 * hi;
                cwv[s] = *(const u32x4*)(rowc + C_XW + j0); cav[s] = *(const u32x4*)(rowc + C_XA + j0);
                pwv[s] = (u32x4){0u, 0u, 0u, 0u}; pav[s] = (u32x4){0u, 0u, 0u, 0u};
                if (hasprev) { pwv[s] = *(const u32x4*)(rowc - N0P + C_XW + j0); pav[s] = *(const u32x4*)(rowc - N0P + C_XA + j0); }
#pragma unroll
                for (int db = 0; db < 2; ++db) { bwv[s][db] = WLT[((0 * 4 + s) * 2 + db) * 64]; bav[s][db] = WLT[((1 * 4 + s) * 2 + db) * 64]; } }
#pragma unroll
            for (int s = 0; s < 4; ++s) {
                const int j0 = 16 * s + 8 * hi;
                float fcw[8], fpw[8], fca[8], fpa[8]; unpack8(cwv[s], fcw); unpack8(pwv[s], fpw); unpack8(cav[s], fca); unpack8(pav[s], fpa);
                const f32x4 mw0 = *(const f32x4*)(P.mu + 1536 + j0), mw1 = *(const f32x4*)(P.mu + 1536 + j0 + 4), ma0 = *(const f32x4*)(P.mu + 1600 + j0), ma1 = *(const f32x4*)(P.mu + 1600 + j0 + 4);
                float xw[8], xa[8];
#pragma unroll
                for (int e = 0; e < 8; ++e) { const float muw = e < 4 ? mw0[e & 3] : mw1[e & 3], mua = e < 4 ? ma0[e & 3] : ma1[e & 3];
                    xw[e] = tanh_f(fcw[e] + (fpw[e] - fcw[e]) * muw); xa[e] = fca[e] + (fpa[e] - fca[e]) * mua; }
                u32x4 aw, aa;
#pragma unroll
                for (int e = 0; e < 4; ++e) { aw[e] = pk2(xw[2 * e], xw[2 * e + 1]); aa[e] = pk2(xa[2 * e], xa[2 * e + 1]); }
#pragma unroll
                for (int db = 0; db < 2; ++db) {
                    accw[db] = MFMA32(__builtin_bit_cast(bf16x8, aw), __builtin_bit_cast(bf16x8, bwv[s][db]), accw[db]);
                    acca[db] = MFMA32(__builtin_bit_cast(bf16x8, aa), __builtin_bit_cast(bf16x8, bav[s][db]), acca[db]);
                }
            }
        }
        float kkd[2], kad[2], rkd[2], w0d[2], a0d[2], mur[2], muk[2], muv[2];
#pragma unroll
        for (int db = 0; db < 2; ++db) { const int hd = h * 64 + 2 * m + db; kkd[db] = P.k_k[hd]; kad[db] = P.k_a[hd]; rkd[db] = P.r_k[hd]; w0d[db] = P.w0[hd]; a0d[db] = P.a0[hd];
            mur[db] = P.mu[hd]; muk[db] = P.mu[512 + hd]; muv[db] = P.mu[1024 + hd]; }
        unsigned qr[16], qk[16], qv[16], qpr[4], qpk[4], qpv[4];
#pragma unroll
        for (int i = 0; i < 16; ++i) {
            int io = i; asm volatile("" : "+v"(io));
            const bf16* row = PROJ0 + (size_t)(tokw + crow(io, hi)) * N0P + h * 64 + 2 * m;
            qr[i] = *(const unsigned*)(row + C_RR); qk[i] = *(const unsigned*)(row + C_RK); qv[i] = *(const unsigned*)(row + C_RV);
            if ((i & 3) == 0) {
                qpr[i >> 2] = 0u; qpk[i >> 2] = 0u; qpv[i >> 2] = 0u;
                if (posw + crow(i, hi) > 0) { qpr[i >> 2] = *(const unsigned*)(row - N0P + C_RR); qpk[i >> 2] = *(const unsigned*)(row - N0P + C_RK); qpv[i >> 2] = *(const unsigned*)(row - N0P + C_RV); }
            }
        }
        float ee[2][16], Lc[2][16];
#pragma unroll
        for (int db = 0; db < 2; ++db) {
#pragma unroll
            for (int i = 0; i < 16; ++i) { const float wl = w0d[db] + accw[db][i]; ee[db][i] = 0.60653066f * __builtin_amdgcn_rcpf(1.f + __expf(-wl)); }
            float gt[4], go[4];
#pragma unroll
            for (int g = 0; g < 4; ++g) { Lc[db][4 * g] = ee[db][4 * g]; Lc[db][4 * g + 1] = Lc[db][4 * g] + ee[db][4 * g + 1]; Lc[db][4 * g + 2] = Lc[db][4 * g + 1] + ee[db][4 * g + 2]; Lc[db][4 * g + 3] = Lc[db][4 * g + 2] + ee[db][4 * g + 3];
                gt[g] = Lc[db][4 * g + 3]; go[g] = __shfl_xor(gt[g], 32); }
            float run = 0.f;
#pragma unroll
            for (int g = 0; g < 4; ++g) { const float base = run + (hi ? go[g] : 0.f);
#pragma unroll
                for (int q = 0; q < 4; ++q) Lc[db][4 * g + q] += base;
                run += gt[g] + go[g]; }
            if (!(wave & 1) && hi == 0) TOT[c * 64 + 2 * m + db] = run;
        }
        __syncthreads();
        if (wave & 1) {
#pragma unroll
            for (int db = 0; db < 2; ++db) { const float tp = TOT[c * 64 + 2 * m + db];
#pragma unroll
                for (int i = 0; i < 16; ++i) Lc[db][i] += tp; }
        }
        float Lb[2][4];
#pragma unroll
        for (int db = 0; db < 2; ++db)
#pragma unroll
            for (int g = 0; g < 4; ++g) { Lb[db][g] = Lc[db][4 * g] - ee[db][4 * g]; asm volatile("" : "+v"(Lb[db][g])); }
        {
            float pv0 = 0.f, pv1 = 0.f;
#pragma unroll
            for (int i = 0; i < 16; ++i) {
                int io = i; asm volatile("" : "+v"(io));
                if ((i & 3) == 0) { pv0 = bflo(qpv[i >> 2]); pv1 = bfhi(qpv[i >> 2]); }
                const float c0 = bflo(qv[i]), c1 = bfhi(qv[i]);
                *(unsigned*)(VP + (size_t)(tokw + crow(io, hi)) * 512 + h * 64 + 2 * m) = pk2(c0 + (pv0 - c0) * muv[0], c1 + (pv1 - c1) * muv[1]);
                pv0 = c0; pv1 = c1;
            }
        }
        float pr[2] = {0.f, 0.f}, pk[2] = {0.f, 0.f}, pemL[2] = {1.f, 1.f};
#pragma unroll
        for (int i = 0; i < 16; ++i) {
            int io = i; asm volatile("" : "+v"(io));
            const int tau = crow(io, hi), tok = tokw + tau, t = tb + tau;
            if ((i & 3) == 0) { pr[0] = bflo(qpr[i >> 2]); pr[1] = bfhi(qpr[i >> 2]); pk[0] = bflo(qpk[i >> 2]); pk[1] = bfhi(qpk[i >> 2]); }
            float r[2], k[2], a[2], kk[2];
#pragma unroll
            for (int db = 0; db < 2; ++db) {
                const float cr = db ? bfhi(qr[i]) : bflo(qr[i]), ck = db ? bfhi(qk[i]) : bflo(qk[i]);
                r[db] = cr + (pr[db] - cr) * mur[db]; k[db] = ck + (pk[db] - ck) * muk[db];
                pr[db] = cr; pk[db] = ck;
                const float al = a0d[db] + acca[db][i];
                a[db] = __builtin_amdgcn_rcpf(1.f + __expf(-al));
                kk[db] = k[db] * kkd[db];
            }
            const float inv = __builtin_amdgcn_rsqf(fmaxf(half_sum32(kk[0] * kk[0] + kk[1] * kk[1]), 1e-24f));
            float k2[2];
#pragma unroll
            for (int db = 0; db < 2; ++db) k2[db] = k[db] * (1.f + (a[db] - 1.f) * kad[db]);
            const float bon = half_sum32(r[0] * k2[0] * rkd[0] + r[1] * k2[1] * rkd[1]);
#pragma unroll
            for (int db = 0; db < 2; ++db) {
                const int d = 2 * m + db; const float kkn = kk[db] * inv;
                float* o = scr + (size_t)((c * 64 + t) * 4) * 64 + (d & 15) * 4 + (d >> 4);
                const float eL = __expf(Lc[db][i]), emL = __builtin_amdgcn_rcpf(eL);
                const float wprev = (i & 3) ? pemL[db] : __expf(-Lb[db][i >> 2]); pemL[db] = emL;
                o[0] = -kkn * wprev;
                if (i == 15 && t == 63) o[64] = emL;
                o[128] = kkn * a[db] * eL;
                o[192] = r[db] * emL;
                KS[((2 * c + 1 - (c >> 1)) * 64 + t) * 65 + d] = k2[db] * eL;
            }
            if (m == 0) BON[(size_t)tok * 8 + h] = bon;
        }
    }
    __syncthreads();
    {
        const int c = wave >> 1, role = (wave ^ (wave >> 2)) & 1;
        const f32x4* xb = (const f32x4*)(scr + (size_t)c * 64 * 256) + (lane & 15);
        const LAS float* ksw = KS + wave * 64 * 65;
        float y[64];
        const int n = quad * 4 + c;
        bf16* mats = (bf16*)P.out + (size_t)(bh * 64 + n) * 4 * 4096;
        bf16* mstep = mats + role * 4096 + (role ? lane : kpos(lane));
#pragma unroll 1
        for (int rep2 = 0; rep2 < REP_S2; ++rep2) {
            int ln = lane; asm volatile("" : "+v"(ln));
#pragma unroll
            for (int d = 0; d < 64; ++d) y[d] = (role == 0) ? ((d == ln) ? 1.f : 0.f) : ksw[ln * 65 + d];
            f32x4 XA[4], XB[4];
#pragma unroll
            for (int v = 0; v < 4; ++v) XA[v] = xb[v * 16];
            for (int t = 0; t < 64; t += 2) {
#pragma unroll
                for (int v = 0; v < 4; ++v) XB[v] = xb[(t + 1) * 64 + v * 16];
                rwkv_rstep(y, XA, t, role, lane, mstep);
                if (t + 2 < 64) {
#pragma unroll
                    for (int v = 0; v < 4; ++v) XA[v] = xb[(t + 2) * 64 + v * 16];
                }
                rwkv_rstep(y, XB, t + 1, role, lane, mstep);
            }
            RStep<0>::scale(y, XB[1]);
        }
        bf16* mend = mats + (role ? 2 : 3) * 4096 + (role ? lane : kpos(lane));
        LAS float* myr = KS + (wave * 64 + lane) * 65;
#pragma unroll
        for (int d = 0; d < 64; ++d) myr[d] = y[d];
#pragma unroll 1
        for (int d = 0; d < 64; ++d) mend[d * 64] = (bf16)f2bf(myr[d]);
    }
    __syncthreads();
}

DI void gla_prep_item(const Params& P, int item, LAS unsigned char* lds, int wave, int lane) {
    const int bh = item >> 6, n = item & 63, b = bh >> 2, h = bh & 3;
    const int tok0 = b * T + n * 64, hd = h * 64 + lane;
    const bf16* PROJ0 = (const bf16*)(P.ws + WS_PROJ0);
    LAS float* WT = (LAS float*)lds;
    LAS bf16* QEb = (LAS bf16*)(WT + 1024);
    LAS bf16* KEb = QEb + 64 * 72;
    LAS float* KL = (LAS float*)(KEb + 64 * 72);
    bf16* mats = (bf16*)(P.ws + WS_XN) + (size_t)(bh * 64 + n) * 3 * 4096;
    float* GDEC = (float*)(P.ws + WS_GDEC) + (size_t)(bh * 64 + n) * 64;
    float q8[8], k8[8]; u32x4 gl0[8], gl1[8];
#pragma unroll
    for (int i = 0; i < 8; ++i) { const bf16* row = PROJ0 + (size_t)(tok0 + wave * 8 + i) * N0P; q8[i] = bf2f(row[C_GQ + hd]) * 0.125f; k8[i] = bf2f(row[C_GK + hd]);
        gl0[i] = *(const u32x4*)(row + C_GLOW); gl1[i] = *(const u32x4*)(row + C_GLOW + 8); }
    float up[16];
#pragma unroll
    for (int r = 0; r < 16; ++r) up[r] = P.gk_up[r * 256 + hd];
    const float bias = P.gk_bias[hd];
    float bt[8]; float acc = 0.f;
#pragma unroll
    for (int i = 0; i < 8; ++i) { float xg = bias;
#pragma unroll
        for (int r = 0; r < 4; ++r) { xg = fmaf(bflo(gl0[i][r]), up[2 * r], xg); xg = fmaf(bfhi(gl0[i][r]), up[2 * r + 1], xg); }
#pragma unroll
        for (int r = 0; r < 4; ++r) { xg = fmaf(bflo(gl1[i][r]), up[8 + 2 * r], xg); xg = fmaf(bfhi(gl1[i][r]), up[8 + 2 * r + 1], xg); }
        acc += -softplus_f(-xg) * (1.f / 16.f); bt[i] = acc; }
    WT[wave * 64 + lane] = acc;
    if (wave == 4) WT[512 + lane] = bt[0];
    __syncthreads();
    float off = 0.f, off4 = 0.f, total = 0.f;
#pragma unroll
    for (int w2 = 0; w2 < 8; ++w2) { const float tv = WT[w2 * 64 + lane]; if (w2 < wave) off += tv; if (w2 < 4) off4 += tv; total += tv; }
    const float bref = off4 + WT[512 + lane], blast = total;
#pragma unroll
    for (int i = 0; i < 8; ++i) { const int t = wave * 8 + i; const float b_t = bt[i] + off;
        QEb[t * 72 + lane] = (bf16)f2bf(q8[i] * __expf(b_t - bref)); KEb[t * 72 + lane] = (bf16)f2bf(k8[i] * __expf(bref - b_t)); KL[t * 65 + lane] = k8[i] * __expf(blast - b_t);
        mats[t * 64 + kpos(lane)] = (bf16)f2bf(q8[i] * __expf(b_t)); }
    if (wave == 0) GDEC[lane] = __expf(blast);
    __syncthreads();
    if (wave < 4) {
        const int m = lane & 31, hi = lane >> 5, tb = wave >> 1, jb = wave & 1;
        f32x16 c;
#pragma unroll
        for (int r = 0; r < 16; ++r) c[r] = 0.f;
#pragma unroll
        for (int s = 0; s < 4; ++s) { const bf16x8 A = *(const LAS bf16x8*)(KEb + (32 * jb + m) * 72 + 16 * s + 8 * hi), Bq = *(const LAS bf16x8*)(QEb + (32 * tb + m) * 72 + 16 * s + 8 * hi); c = MFMA32(A, Bq, c); }
        const int t = 32 * tb + m;
#pragma unroll
        for (int g = 0; g < 4; ++g) { const int j0 = 32 * jb + 8 * g + 4 * hi; u32x2 w;
            w.x = pk2(j0 <= t ? c[4 * g] : 0.f, j0 + 1 <= t ? c[4 * g + 1] : 0.f); w.y = pk2(j0 + 2 <= t ? c[4 * g + 2] : 0.f, j0 + 3 <= t ? c[4 * g + 3] : 0.f);
            *(u32x2*)(mats + 4096 + t * 64 + j0) = w; }
    } else {
#pragma unroll
        for (int r = 0; r < 16; ++r) { const int d = (wave - 4) * 16 + r; mats[8192 + d * 64 + lane] = (bf16)f2bf(KL[lane * 65 + d]); }
    }
    __syncthreads();
}

constexpr int SQ_PITCH = 144, SQ_MAT = 64 * SQ_PITCH, SQ_VT = 4 * SQ_MAT, SQ_DEC = SQ_VT + 128 * SQ_PITCH, SQ_BUF = 57344;
template <bool DIAG>
DI void seq_pass(unsigned* prog, const bf16* mats, int nmat, const bf16* vsrc, int vpitch, const float* dec, bf16* outp, LAS unsigned char* lds, int tid, int wave, int lane) {
    const int m = lane & 31, hi = lane >> 5;
    f32x16 sacc[2];
#pragma unroll
    for (int i = 0; i < 16; ++i) { sacc[0][i] = 0.f; sacc[1][i] = 0.f; }
    const int st = tid - 256;
    struct StSet { u32x4 rm[8]; u32x4 rv[2]; float rdec; };
    const int v8 = st & 7, par = (st >> 3) & 1;
    constexpr int NMAT = DIAG ? 3 : 4;
    auto gload = [&](int n, StSet& S) {
        const bf16* mp = mats + (size_t)n * NMAT * 4096;
#pragma unroll
        for (int q = 0; q < 2 * NMAT; ++q) S.rm[q] = *(const u32x4*)(mp + (size_t)(st + 256 * q) * 8);
#pragma unroll
        for (int q = 0; q < 2; ++q) S.rv[q] = *(const u32x4*)(vsrc + (size_t)(n * 64 + (st >> 3) + 32 * q) * vpitch + 8 * v8);
        if (DIAG) S.rdec = dec[n * 64 + (st & 63)];
    };
    auto lstore = [&](int n, const StSet& S) {
        LAS unsigned char* B = lds + (n & 1) * SQ_BUF;
#pragma unroll
        for (int q = 0; q < 2 * NMAT; ++q) { const int idx = (st + 256 * q) & 511; *(LAS u32x4*)(B + (q >> 1) * SQ_MAT + (idx >> 3) * SQ_PITCH + (idx & 7) * 16) = S.rm[q]; }
#pragma unroll
        for (int q = 0; q < 2; ++q) {
            const int vt = (st >> 3) + 32 * q;
            const unsigned k0 = par ? S.rv[q][2] : S.rv[q][0], k1 = par ? S.rv[q][3] : S.rv[q][1], s0 = par ? S.rv[q][0] : S.rv[q][2], s1 = par ? S.rv[q][1] : S.rv[q][3];
            const unsigned r0 = (unsigned)__builtin_amdgcn_update_dpp(0, (int)s0, 0x128, 0xf, 0xf, true), r1 = (unsigned)__builtin_amdgcn_update_dpp(0, (int)s1, 0x128, 0xf, 0xf, true);
            unsigned o[4];
            if (par == 0) { o[0] = (k0 & 0xffffu) | (r0 << 16); o[1] = (k0 >> 16) | (r0 & 0xffff0000u); o[2] = (k1 & 0xffffu) | (r1 << 16); o[3] = (k1 >> 16) | (r1 & 0xffff0000u); }
            else          { o[0] = (r0 & 0xffffu) | (k0 << 16); o[1] = (r0 >> 16) | (k0 & 0xffff0000u); o[2] = (r1 & 0xffffu) | (k1 << 16); o[3] = (r1 >> 16) | (k1 & 0xffff0000u); }
            const int tp = vt >> 1, gsw = ((tp >> 2) ^ v8) & 7;
#pragma unroll
            for (int jj = 0; jj < 4; ++jj) *(LAS unsigned*)(B + SQ_VT + (8 * v8 + 4 * par + jj) * SQ_PITCH + (4 * gsw + (tp & 3)) * 4) = o[jj];
        }
        if (DIAG && st < 64) *(LAS float*)(B + SQ_DEC + st * 4) = S.rdec;
    };
    f32x16 o0, o1;
    bf16x8 sBp[2][2];
#pragma unroll
    for (int kb = 0; kb < 2; ++kb)
#pragma unroll
        for (int s = 0; s < 2; ++s) sBp[kb][s] = (bf16x8){0, 0, 0, 0, 0, 0, 0, 0};
    LAS unsigned char* SBX = lds + 2 * SQ_BUF;
    if (wave >= 2 && wave < 4) {
#pragma unroll
        for (int q = 0; q < 4; ++q) *(LAS bf16x8*)(SBX + (0 * 2 + (wave & 1)) * 4096 + lane * 64 + 16 * q) = sBp[q >> 1][q & 1];
    }
    auto compute = [&](int n, int bufi) {
        if (wave < 4) {
            const int vb = wave & 1; const bool upd = wave >= 2;
            const LAS unsigned char* B = lds + bufi * SQ_BUF;
            const int vrow = 32 * vb + m;
            const LAS unsigned char* Vr = B + SQ_VT + vrow * SQ_PITCH;
            const LAS unsigned char* Ar = B + m * SQ_PITCH + 16 * hi;
            bf16x8 Fa[2], Fb[2], Va, Vb;
#define SQ_LD(F, VB, k, MS, MV) do { if ((k) < 4) { const int co_ = (32 * ((k) >> 1) + 16 * ((k) & 1)) * 2; \
            F[0] = *(const LAS bf16x8*)(Ar + (MS) * SQ_MAT + co_); F[1] = *(const LAS bf16x8*)(Ar + (MS) * SQ_MAT + 32 * SQ_PITCH + co_); } \
        else { const int S4_ = (k) - 4, co_ = 32 * S4_; VB = *(const LAS bf16x8*)(Vr + (((2 * S4_ + hi) ^ (vrow >> 3)) & 7) * 16); \
            F[0] = *(const LAS bf16x8*)(Ar + (MV) * SQ_MAT + co_); F[1] = *(const LAS bf16x8*)(Ar + (MV) * SQ_MAT + 32 * SQ_PITCH + co_); } } while (0)
            if (!upd) {
                bf16x8 sB[2][2];
#pragma unroll
                for (int q = 0; q < 4; ++q) sB[q >> 1][q & 1] = *(const LAS bf16x8*)(SBX + ((n & 1) * 2 + vb) * 4096 + lane * 64 + 16 * q);
#pragma unroll
                for (int i = 0; i < 16; ++i) { o0[i] = 0.f; o1[i] = 0.f; }
#define SQ_MM(F, VB, k) do { const bf16x8 Bq_ = ((k) < 4) ? sB[(k) >> 1][(k) & 1] : VB; o0 = MFMA32(Bq_, F[0], o0); o1 = MFMA32(Bq_, F[1], o1); } while (0)
                SQ_LD(Fa, Va, 0, 0, 1); SQ_LD(Fb, Vb, 1, 0, 1);
                __builtin_amdgcn_sched_barrier(0);
                SQ_MM(Fa, Va, 0); SQ_LD(Fa, Va, 2, 0, 1); __builtin_amdgcn_sched_barrier(0);
                SQ_MM(Fb, Vb, 1); SQ_LD(Fb, Vb, 3, 0, 1); __builtin_amdgcn_sched_barrier(0);
                SQ_MM(Fa, Va, 2); SQ_LD(Fa, Va, 4, 0, 1); __builtin_amdgcn_sched_barrier(0);
                SQ_MM(Fb, Vb, 3); SQ_LD(Fb, Vb, 5, 0, 1); __builtin_amdgcn_sched_barrier(0);
                SQ_MM(Fa, Va, 4); SQ_LD(Fa, Va, 6, 0, 1); __builtin_amdgcn_sched_barrier(0);
                SQ_MM(Fb, Vb, 5); SQ_LD(Fb, Vb, 7, 0, 1); __builtin_amdgcn_sched_barrier(0);
                SQ_MM(Fa, Va, 6); SQ_MM(Fb, Vb, 7);
#undef SQ_MM
            } else {
                f32x16 n0, n1;
#pragma unroll
                for (int i = 0; i < 16; ++i) {
                    if (DIAG) { n0[i] = sacc[0][i] * *(const LAS float*)(B + SQ_DEC + crow(i, hi) * 4); n1[i] = sacc[1][i] * *(const LAS float*)(B + SQ_DEC + (32 + crow(i, hi)) * 4); }
                    else { n0[i] = 0.f; n1[i] = 0.f; } }
#define SQ_MM(F, VB, k) do { const bf16x8 Bq_ = ((k) < 4) ? sBp[(k) >> 1][(k) & 1] : VB; n0 = MFMA32(F[0], Bq_, n0); n1 = MFMA32(F[1], Bq_, n1); } while (0)
                if (!DIAG) {
                    SQ_LD(Fa, Va, 0, 3, 2); SQ_LD(Fb, Vb, 1, 3, 2);
                    __builtin_amdgcn_sched_barrier(0);
                    SQ_MM(Fa, Va, 0); SQ_LD(Fa, Va, 2, 3, 2); __builtin_amdgcn_sched_barrier(0);
                    SQ_MM(Fb, Vb, 1); SQ_LD(Fb, Vb, 3, 3, 2); __builtin_amdgcn_sched_barrier(0);
                    SQ_MM(Fa, Va, 2); SQ_LD(Fa, Va, 4, 3, 2); __builtin_amdgcn_sched_barrier(0);
                    SQ_MM(Fb, Vb, 3); SQ_LD(Fb, Vb, 5, 3, 2); __builtin_amdgcn_sched_barrier(0);
                } else {
                    SQ_LD(Fa, Va, 4, 3, 2); SQ_LD(Fb, Vb, 5, 3, 2);
                    __builtin_amdgcn_sched_barrier(0);
                }
                SQ_MM(Fa, Va, 4); SQ_LD(Fa, Va, 6, 3, 2); __builtin_amdgcn_sched_barrier(0);
                SQ_MM(Fb, Vb, 5); SQ_LD(Fb, Vb, 7, 3, 2); __builtin_amdgcn_sched_barrier(0);
                SQ_MM(Fa, Va, 6); SQ_MM(Fb, Vb, 7);
#undef SQ_MM
                sacc[0] = n0; sacc[1] = n1;
#pragma unroll
                for (int kb = 0; kb < 2; ++kb)
#pragma unroll
                    for (int s = 0; s < 2; ++s) { u32x4 w;
#pragma unroll
                        for (int e = 0; e < 4; ++e) w[e] = pk2(sacc[kb][8 * s + 2 * e], sacc[kb][8 * s + 2 * e + 1]);
                        sBp[kb][s] = __builtin_bit_cast(bf16x8, w);
                        *(LAS bf16x8*)(SBX + (((n + 1) & 1) * 2 + vb) * 4096 + lane * 64 + 16 * (2 * kb + s)) = sBp[kb][s]; }
            }
#undef SQ_LD
        }
    };
    auto store_out = [&](int n) {
        if (wave < 2) {
#pragma unroll
            for (int g = 0; g < 4; ++g) { bf16* op_ = outp + (size_t)(n * 64 + m) * 512 + 32 * wave + 8 * g + 4 * hi;
                u32x2 w0, w1; w0.x = pk2(o0[4 * g], o0[4 * g + 1]); w0.y = pk2(o0[4 * g + 2], o0[4 * g + 3]); w1.x = pk2(o1[4 * g], o1[4 * g + 1]); w1.y = pk2(o1[4 * g + 2], o1[4 * g + 3]);
                *(u32x2*)op_ = w0; *(u32x2*)(op_ + 32 * 512) = w1; }
        }
    };
    if (wave < 4) {
        lds_barrier();
#pragma unroll 1
        for (int n = 0; n < 64; ++n) { compute(n, n & 1); store_out(n); lds_barrier(); }
    } else {
        StSet A, Bs, C;
        gload(0, A); gload(1, Bs); gload(2, C);
        lstore(0, A); gload(3, A);
        lds_barrier();
#pragma unroll 1
        for (int k = 0; k < 60; k += 3) {
            if (st == 0) __hip_atomic_store(prog, (unsigned)(k + 4), __ATOMIC_RELAXED, __HIP_MEMORY_SCOPE_AGENT);
            lstore(k + 1, Bs); gload(k + 4, Bs); lds_barrier();
            lstore(k + 2, C); gload(k + 5, C); lds_barrier();
            lstore(k + 3, A); gload(k + 6, A); lds_barrier();
        }
        lstore(61, Bs); lds_barrier();
        lstore(62, C); lds_barrier();
        lstore(63, A); lds_barrier();
        lds_barrier();
    }
}
struct P3Src { const bf16* mats; int nmat; const bf16* vsrc; int vpitch; const float* dec; bf16* outp; };
DI P3Src p3_src(const Params& P, int bx) {
    P3Src s;
    if (bx < 32) { const int b = bx >> 3, h = bx & 7;
        s.mats = (const bf16*)P.out + (size_t)bx * 64 * 4 * 4096; s.nmat = 4; s.vsrc = (const bf16*)(P.ws + WS_VP) + (size_t)b * T * 512 + h * 64; s.vpitch = 512; s.dec = nullptr;
        s.outp = (bf16*)(P.ws + WS_SCR) + (size_t)b * T * 512 + h * 64; }
    else { const int g = bx - 32, bh = (g & 7) | ((g >> 4) << 3), vh = (g >> 3) & 1, b = bh >> 2, h = bh & 3;
        s.mats = (const bf16*)(P.ws + WS_XN) + (size_t)bh * 64 * 3 * 4096; s.nmat = 3; s.vsrc = (const bf16*)(P.ws + WS_PROJ0) + (size_t)b * T * N0P + C_GV + h * 128 + 64 * vh; s.vpitch = N0P;
        s.dec = (const float*)(P.ws + WS_GDEC) + (size_t)bh * 64 * 64; s.outp = (bf16*)(P.ws + WS_OARAW) + (size_t)b * T * 512 + h * 128 + 64 * vh; }
    return s;
}
DI void p3_seq(const Params& P, LAS unsigned char* lds, int tid, int wave, int lane) {
    const int bx = blockIdx.x;
    unsigned* progw = (unsigned*)(P.ws + WS_PROG);
    if (bx < 64) {
        const P3Src s = p3_src(P, bx);
        if (bx < 32) seq_pass<false>(progw + 16 * bx, s.mats, 4, s.vsrc, s.vpitch, nullptr, s.outp, lds, tid, wave, lane);
        else         seq_pass<true>(progw + 16 * bx, s.mats, 3, s.vsrc, s.vpitch, s.dec, s.outp, lds, tid, wave, lane);
    } else {
        const unsigned* xt = (const unsigned*)(P.ws + WS_XCCTAB);
        LAS unsigned* hs = (LAS unsigned*)lds;
        if (tid < 4) hs[tid] = 0u;
        __syncthreads();
        const unsigned myx = xt[bx];
        if (tid < 192) { const unsigned o = xt[64 + tid]; if (o == myx) { __hip_atomic_fetch_add(&hs[2], 1u, __ATOMIC_RELAXED, __HIP_MEMORY_SCOPE_WORKGROUP); if (64 + tid < bx) __hip_atomic_fetch_add(&hs[0], 1u, __ATOMIC_RELAXED, __HIP_MEMORY_SCOPE_WORKGROUP); } }
        if (tid >= 192 && tid < 256) { if (xt[tid - 192] == myx) { const unsigned slot = __hip_atomic_fetch_add(&hs[1], 1u, __ATOMIC_RELAXED, __HIP_MEMORY_SCOPE_WORKGROUP); hs[8 + slot] = (unsigned)(tid - 192); } }
        __syncthreads();
        const int rank = (int)hs[0], np = (int)hs[1], nh = (int)hs[2];
        unsigned pf0 = 0u;
        if (np > 0) {
            const int tgt = (int)hs[8 + (rank % np)];
            const int sub = rank / np, cnt = (nh - (rank % np) + np - 1) / np;
            const P3Src s = p3_src(P, tgt);
            const unsigned* pw = progw + 16 * tgt;
            const int nlm = s.nmat * 64;
            int pc = sub; unsigned spins = 0;
            while (pc < 64) {
                const int p = (int)__builtin_amdgcn_readfirstlane((int)__hip_atomic_load(pw, __ATOMIC_RELAXED, __HIP_MEMORY_SCOPE_AGENT));
                if (pc <= p + 8) {
                    const char* a = nullptr;
                    if (tid < nlm) a = (const char*)(s.mats + (size_t)pc * s.nmat * 4096) + (size_t)tid * 128;
                    else if (tid < nlm + 64) a = (const char*)(s.vsrc + (size_t)(pc * 64 + (tid - nlm)) * s.vpitch);
                    if (a) asm volatile("global_load_dword %0, %1, off" : "+v"(pf0) : "v"(a) : "memory");
                    pc += cnt;
                } else { __builtin_amdgcn_s_sleep(8); if (++spins > (1u << 16)) break; }
            }
        }
        asm volatile("s_waitcnt vmcnt(0)" : "+v"(pf0) :: "memory");
        __syncthreads();
    }
}

DI float silu_f(float g) { return g * __builtin_amdgcn_rcpf(1.f + __expf(-g)); }
DI void p4_finalize(const Params& P, int wave, int lane) {
    const int gw = blockIdx.x * 8 + wave, NGW = gridDim.x * 8;
    const bf16* OB = (const bf16*)(P.ws + WS_SCR); const bf16* OA = (const bf16*)(P.ws + WS_OARAW);
    const bf16* PROJ0 = (const bf16*)(P.ws + WS_PROJ0); const bf16* VP = (const bf16*)(P.ws + WS_VP); const float* BON = (const float*)(P.ws + WS_BONUS);
    bf16* O0 = (bf16*)(P.ws + WS_XN);
    const int cv = (8 * lane) & 127;
    const f32x4 gw0 = *(const f32x4*)(P.gla_norm_w + cv), gw1 = *(const f32x4*)(P.gla_norm_w + cv + 4);
    const f32x4 lw0 = *(const f32x4*)(P.ln_w + 8 * lane), lw1 = *(const f32x4*)(P.ln_w + 8 * lane + 4), lb0 = *(const f32x4*)(P.ln_b + 8 * lane), lb1 = *(const f32x4*)(P.ln_b + 8 * lane + 4);
    struct Ld { f32x4 a0, a1, b0, b1; u32x4 ga, gb, vv; float bon; };
    auto load = [&](int tok) { Ld L; const bf16* row = PROJ0 + (size_t)tok * N0P + C_GATE0;
        { const u32x4 wa = *(const u32x4*)(OA + (size_t)tok * 512 + 8 * lane), wb = *(const u32x4*)(OB + (size_t)tok * 512 + 8 * lane);
          L.a0 = (f32x4){bflo(wa.x), bfhi(wa.x), bflo(wa.y), bfhi(wa.y)}; L.a1 = (f32x4){bflo(wa.z), bfhi(wa.z), bflo(wa.w), bfhi(wa.w)};
          L.b0 = (f32x4){bflo(wb.x), bfhi(wb.x), bflo(wb.y), bfhi(wb.y)}; L.b1 = (f32x4){bflo(wb.z), bfhi(wb.z), bflo(wb.w), bfhi(wb.w)}; }
        L.ga = *(const u32x4*)(row + 8 * lane); L.gb = *(const u32x4*)(row + 512 + 8 * lane); L.vv = *(const u32x4*)(VP + (size_t)tok * 512 + 8 * lane); L.bon = BON[(size_t)tok * 8 + (lane >> 3)]; return L; };
    Ld nx = load(gw < M ? gw : 0);
    for (int tok = gw; tok < M; tok += NGW) {
        const Ld L = nx;
        if (tok + NGW < M) nx = load(tok + NGW);
        {
            const f32x4 a0 = L.a0, a1 = L.a1;
            float ss = (a0[0] * a0[0] + a0[1] * a0[1]) + (a0[2] * a0[2] + a0[3] * a0[3]) + (a1[0] * a1[0] + a1[1] * a1[1]) + (a1[2] * a1[2] + a1[3] * a1[3]);
            ss += __shfl_xor(ss, 1); ss += __shfl_xor(ss, 2); ss += __shfl_xor(ss, 4); ss += __shfl_xor(ss, 8);
            const float rstd = 1.0f / sqrtf(ss * (1.f / 128.f) + NORM_EPS);
            const u32x4 g = L.ga;
            u32x4 o;
            o.x = pk2(a0[0] * rstd * gw0[0] * silu_f(bflo(g.x)), a0[1] * rstd * gw0[1] * silu_f(bfhi(g.x)));
            o.y = pk2(a0[2] * rstd * gw0[2] * silu_f(bflo(g.y)), a0[3] * rstd * gw0[3] * silu_f(bfhi(g.y)));
            o.z = pk2(a1[0] * rstd * gw1[0] * silu_f(bflo(g.z)), a1[1] * rstd * gw1[1] * silu_f(bfhi(g.z)));
            o.w = pk2(a1[2] * rstd * gw1[2] * silu_f(bflo(g.w)), a1[3] * rstd * gw1[3] * silu_f(bfhi(g.w)));
            *(u32x4*)(O0 + (size_t)tok * 1024 + 8 * lane) = o;
        }
        {
            const f32x4 a0 = L.b0, a1 = L.b1;
            float s = (a0[0] + a0[1]) + (a0[2] + a0[3]) + (a1[0] + a1[1]) + (a1[2] + a1[3]);
            s += __shfl_xor(s, 1); s += __shfl_xor(s, 2); s += __shfl_xor(s, 4);
            const float mean = s * (1.f / 64.f);
            const f32x4 d0 = a0 - mean, d1 = a1 - mean;
            float q = (d0[0] * d0[0] + d0[1] * d0[1]) + (d0[2] * d0[2] + d0[3] * d0[3]) + (d1[0] * d1[0] + d1[1] * d1[1]) + (d1[2] * d1[2] + d1[3] * d1[3]);
            q += __shfl_xor(q, 1); q += __shfl_xor(q, 2); q += __shfl_xor(q, 4);
            const float rstd = 1.0f / sqrtf(q * (1.f / 64.f) + RWKV_LN_EPS);
            const float bon = L.bon; const u32x4 vv = L.vv, g = L.gb;
            u32x4 o;
            o.x = pk2((d0[0] * rstd * lw0[0] + lb0[0] + bon * bflo(vv.x)) * silu_f(bflo(g.x)), (d0[1] * rstd * lw0[1] + lb0[1] + bon * bfhi(vv.x)) * silu_f(bfhi(g.x)));
            o.y = pk2((d0[2] * rstd * lw0[2] + lb0[2] + bon * bflo(vv.y)) * silu_f(bflo(g.y)), (d0[3] * rstd * lw0[3] + lb0[3] + bon * bfhi(vv.y)) * silu_f(bfhi(g.y)));
            o.z = pk2((d1[0] * rstd * lw1[0] + lb1[0] + bon * bflo(vv.z)) * silu_f(bflo(g.z)), (d1[1] * rstd * lw1[1] + lb1[1] + bon * bfhi(vv.z)) * silu_f(bfhi(g.z)));
            o.w = pk2((d1[2] * rstd * lw1[2] + lb1[2] + bon * bflo(vv.w)) * silu_f(bflo(g.w)), (d1[3] * rstd * lw1[3] + lb1[3] + bon * bfhi(vv.w)) * silu_f(bfhi(g.w)));
            *(u32x4*)(O0 + (size_t)tok * 1024 + 512 + 8 * lane) = o;
        }
    }
}
constexpr int AT_KP = 144, AT_VP = 528, AT_VOFF = 256 * AT_KP;
DI void rope_cs(const float* RT, int pos, float (&cs)[8], float (&sn)[8]) {
    const f32x4* tp = (const f32x4*)(RT + (size_t)pos * 16);
#pragma unroll
    for (int q = 0; q < 4; ++q) { const f32x4 v = tp[q]; cs[2 * q] = v[0]; sn[2 * q] = v[1]; cs[2 * q + 1] = v[2]; sn[2 * q + 1] = v[3]; }
}
DI void p7_attn(const Params& P, LAS unsigned char* lds, int tid, int wave, int lane) {
    const bf16* PROJ1 = (const bf16*)(P.ws + WS_SCR); bf16* O1 = (bf16*)(P.ws + WS_XN); const float* RT = (const float*)(P.ws + WS_ROPE);
    const int m = lane & 31, hi = lane >> 5;
    const int c8 = tid & 7, kpar = (tid >> 3) & 1;
    u32x4 kw[4], vw[4];
    auto uload = [&](int unit) {
        const int qb = unit & 31, kvh = (unit >> 5) & 3, b = unit >> 7;
#pragma unroll
        for (int q = 0; q < 4; ++q) { const int key = (tid >> 3) + 64 * q; const int pos = qb * 128 - 128 + key;
            kw[q] = (u32x4){0u, 0u, 0u, 0u}; vw[q] = (u32x4){0u, 0u, 0u, 0u};
            if (pos >= 0) { const bf16* row = PROJ1 + (size_t)(b * T + pos) * IN1; kw[q] = *(const u32x4*)(row + 1024 + kvh * 64 + 8 * c8); vw[q] = *(const u32x4*)(row + 1280 + kvh * 64 + 8 * c8); } }
    };
    if ((int)blockIdx.x < 512) uload(blockIdx.x);
    struct QG { u32x4 q[4], qo; u32x2 g[8]; };
    auto qgload = [&](int unit, int qq) { QG r; const int qb = unit & 31, kvh = (unit >> 5) & 3, b = unit >> 7; const int h = kvh * 4 + (wave >> 1);
        const int pos = qb * 128 + (wave & 1) * 64 + 32 * qq + m; const bf16* row = PROJ1 + ((size_t)b * T + pos) * IN1;
#pragma unroll
        for (int s = 0; s < 4; ++s) r.q[s] = *(const u32x4*)(row + h * 64 + 16 * s + 8 * hi);
        r.qo = *(const u32x4*)(row + h * 64 + 8 * (hi ^ 1));
#pragma unroll
        for (int db = 0; db < 2; ++db)
#pragma unroll
            for (int gq = 0; gq < 4; ++gq) r.g[4 * db + gq] = *(const u32x2*)(row + 1536 + h * 64 + 32 * db + 8 * gq + 4 * hi);
        return r; };
    QG nxq = qgload((int)blockIdx.x < 512 ? blockIdx.x : 0, 0);
    for (int unit = blockIdx.x; unit < 512; unit += gridDim.x) {
        const int qb = unit & 31, kvh = (unit >> 5) & 3, b = unit >> 7;
#pragma unroll
        for (int q = 0; q < 4; ++q) {
            const int key = (tid >> 3) + 64 * q; const int pos = qb * 128 - 128 + key;
            u32x4 kq = kw[q];
            if (c8 < 2 && pos >= 0) { const bf16* row = PROJ1 + (size_t)(b * T + pos) * IN1;
                const u32x4 ow = *(const u32x4*)(row + 1024 + kvh * 64 + 8 * (c8 ^ 1)); float a[8], o[8], cs[8], sn[8]; unpack8(kq, a); unpack8(ow, o); rope_cs(RT, pos, cs, sn);
                float r[8];
#pragma unroll
                for (int j = 0; j < 8; ++j) r[j] = (c8 == 0) ? (a[j] * cs[j] - o[j] * sn[j]) : (a[j] * cs[j] + o[j] * sn[j]);
                kq.x = pk2(r[0], r[1]); kq.y = pk2(r[2], r[3]); kq.z = pk2(r[4], r[5]); kq.w = pk2(r[6], r[7]); }
            *(LAS u32x4*)(lds + key * AT_KP + c8 * 16) = kq;
            const u32x4 rv = vw[q];
            const unsigned k0 = kpar ? rv[2] : rv[0], k1 = kpar ? rv[3] : rv[1], s0 = kpar ? rv[0] : rv[2], s1 = kpar ? rv[1] : rv[3];
            const unsigned r0 = (unsigned)__builtin_amdgcn_update_dpp(0, (int)s0, 0x128, 0xf, 0xf, true), r1 = (unsigned)__builtin_amdgcn_update_dpp(0, (int)s1, 0x128, 0xf, 0xf, true);
            unsigned o4[4];
            if (kpar == 0) { o4[0] = (k0 & 0xffffu) | (r0 << 16); o4[1] = (k0 >> 16) | (r0 & 0xffff0000u); o4[2] = (k1 & 0xffffu) | (r1 << 16); o4[3] = (k1 >> 16) | (r1 & 0xffff0000u); }
            else           { o4[0] = (r0 & 0xffffu) | (k0 << 16); o4[1] = (r0 >> 16) | (k0 & 0xffff0000u); o4[2] = (r1 & 0xffffu) | (k1 << 16); o4[3] = (r1 >> 16) | (k1 & 0xffff0000u); }
            const int tp = key >> 1, gsw = (tp >> 2) ^ c8;
#pragma unroll
            for (int jj = 0; jj < 4; ++jj) *(LAS unsigned*)(lds + AT_VOFF + (8 * c8 + 4 * kpar + jj) * AT_VP + (4 * gsw + (tp & 3)) * 4) = o4[jj];
        }
        lds_barrier();
        if (unit + (int)gridDim.x < 512) uload(unit + gridDim.x);
        const int g = wave >> 1, h = kvh * 4 + g; const float sink = P.sinks[h] * 1.44269504f;
        for (int qq = 0; qq < 2; ++qq) {
            const int qs = (wave & 1) * 64 + 32 * qq, qi = qs + m, pos = qb * 128 + qi; const size_t tok = (size_t)b * T + pos;
            const QG cq = nxq;
            { const int nu = (qq == 0) ? unit : unit + (int)gridDim.x; if (nu < 512) nxq = qgload(nu, qq ^ 1); }
            bf16x8 Q[4];
#pragma unroll
            for (int s = 0; s < 4; ++s) { const u32x4 w = cq.q[s]; float a[8]; unpack8(w, a);
                if (s == 0) { const u32x4 ow = cq.qo; float o[8], cs[8], sn[8]; unpack8(ow, o); rope_cs(RT, pos, cs, sn);
#pragma unroll
                    for (int j = 0; j < 8; ++j) a[j] = (hi == 0) ? (a[j] * cs[j] - o[j] * sn[j]) : (a[j] * cs[j] + o[j] * sn[j]); }
                u32x4 qw;
#pragma unroll
                for (int e = 0; e < 4; ++e) qw[e] = pk2(a[2 * e] * 0.18033688f, a[2 * e + 1] * 0.18033688f);
                Q[s] = __builtin_bit_cast(bf16x8, qw); }
            const int kb0 = qs >> 5;
            f32x16 sc[5];
#pragma unroll
            for (int kbi = 0; kbi < 5; ++kbi) {
#pragma unroll
                for (int i = 0; i < 16; ++i) sc[kbi][i] = 0.f;
#pragma unroll
                for (int s = 0; s < 4; ++s) { const bf16x8 A = *(const LAS bf16x8*)(lds + (32 * (kb0 + kbi) + m) * AT_KP + (16 * s + 8 * hi) * 2); sc[kbi] = MFMA32(A, Q[s], sc[kbi]); }
            }
            float mx = sink;
#pragma unroll
            for (int kbi = 0; kbi < 5; ++kbi)
#pragma unroll
                for (int i = 0; i < 16; ++i) { const int kj = 32 * (kb0 + kbi) + crow(i, hi);
                    const bool band = (kbi == 0) ? (kj >= qi + 1) : ((kbi == 4) ? (kj <= qi + 128) : true); const bool vis = band && (qb > 0 || kj >= 128);
                    sc[kbi][i] = vis ? sc[kbi][i] : -1e30f; mx = fmaxf(mx, sc[kbi][i]); }
            mx = fmaxf(mx, __shfl_xor(mx, 32));
            float sum = 0.f;
#pragma unroll
            for (int kbi = 0; kbi < 5; ++kbi)
#pragma unroll
                for (int i = 0; i < 16; ++i) { const float pv = __builtin_amdgcn_exp2f(sc[kbi][i] - mx); sc[kbi][i] = pv; sum += pv; }
            sum += __shfl_xor(sum, 32);
            const float inv = __builtin_amdgcn_rcpf(sum + __builtin_amdgcn_exp2f(sink - mx));
            f32x16 oacc[2];
#pragma unroll
            for (int db = 0; db < 2; ++db) {
#pragma unroll
                for (int i = 0; i < 16; ++i) oacc[db][i] = 0.f;
                const int vrow = 32 * db + m, rsw = (vrow >> 3) & 7;
#pragma unroll
                for (int kbi = 0; kbi < 5; ++kbi)
#pragma unroll
                    for (int s2 = 0; s2 < 2; ++s2) { u32x4 pw;
#pragma unroll
                        for (int e = 0; e < 4; ++e) pw[e] = pk2(sc[kbi][8 * s2 + 2 * e], sc[kbi][8 * s2 + 2 * e + 1]);
                        const int ga = 4 * (kb0 + kbi) + 2 * s2;
                        const LAS unsigned char* vp = lds + AT_VOFF + vrow * AT_VP + 8 * hi;
                        const u32x2 lo = *(const LAS u32x2*)(vp + (ga ^ rsw) * 16), hi2 = *(const LAS u32x2*)(vp + ((ga + 1) ^ rsw) * 16);
                        const u32x4 aw = (u32x4){lo.x, lo.y, hi2.x, hi2.y};
                        oacc[db] = MFMA32(__builtin_bit_cast(bf16x8, aw), __builtin_bit_cast(bf16x8, pw), oacc[db]); }
            }
#pragma unroll
            for (int db = 0; db < 2; ++db)
#pragma unroll
                for (int gq = 0; gq < 4; ++gq) { const int d0 = 32 * db + 8 * gq + 4 * hi; const u32x2 gw = cq.g[4 * db + gq];
                    u32x2 o; o.x = pk2(oacc[db][4 * gq] * inv * silu_f(bflo(gw.x)), oacc[db][4 * gq + 1] * inv * silu_f(bfhi(gw.x)));
                    o.y = pk2(oacc[db][4 * gq + 2] * inv * silu_f(bflo(gw.y)), oacc[db][4 * gq + 3] * inv * silu_f(bfhi(gw.y)));
                    *(u32x2*)(O1 + tok * 1024 + h * 64 + d0) = o; }
        }
        lds_barrier();
    }
}
DI void p9_final(const Params& P, int wave, int lane) {
    const int gw = blockIdx.x * 8 + wave, NGW = gridDim.x * 8;
    const float* slots = (const float*)(P.ws + WS_SLOT2);
    for (int mrow = gw; mrow < M; mrow += NGW) {
        float s = (lane < 16) ? slots[(size_t)mrow * 16 + lane] : 0.f;
        s += __shfl_xor(s, 1); s += __shfl_xor(s, 2); s += __shfl_xor(s, 4); s += __shfl_xor(s, 8);
        s = __shfl(s, 0);
        const float rstd = 1.0f / sqrtf(s * (1.f / 1024.f) + NORM_EPS);
        f32x4* o = (f32x4*)(P.out + (size_t)mrow * D) + lane; const f32x4* w = (const f32x4*)P.final_w + lane;
#pragma unroll
        for (int j = 0; j < 4; ++j) { const f32x4 v = o[64 * j]; o[64 * j] = v * rstd * w[64 * j]; }
    }
}

__global__ void __launch_bounds__(512) fwd_megakernel(Params P) {
    extern __shared__ __attribute__((aligned(16))) unsigned char lds_raw[];
    LAS unsigned char* lds = (LAS unsigned char*)lds_raw;
    cg::grid_group grid = cg::this_grid();
    const int tid = threadIdx.x, lane = tid & 63, wave = __builtin_amdgcn_readfirstlane(tid >> 6);
    const int G = gridDim.x;
    if (tid < 2) ((LAS unsigned*)(lds + LDS_BAR_OFF))[tid] = 0u;
    __syncthreads();
    if (tid == 0) ((unsigned*)(P.ws + WS_XCCTAB))[blockIdx.x] = xb_xcc_id() + 1u;
    const XcdBarrier xbar = xcd_barrier_post((unsigned*)(P.ws + WS_CTL), (volatile LAS unsigned*)(lds + LDS_BAR_OFF));
    bf16* XN = (bf16*)(P.ws + WS_XN);
    p0_prologue(P, lds, wave, lane);
    if (P.ws == nullptr) grid.sync();
    xcd_barrier(xbar);
    { pg8::Gemm g{XN, (const bf16*)(P.ws + WS_W0T), M, N0P, D}; pg8::StaticOrder S; S.init(M, N0P, G, (int)blockIdx.x);
      EpiScaleBf16 E{(bf16*)(P.ws + WS_PROJ0), N0P, nullptr, nullptr, 0};
      pg8::gemm_phase<EpiScaleBf16, pg8::StaticOrder, true, true>(lds, g, S, E); }
    xcd_barrier(xbar);
#pragma unroll 1
    for (int rep = 0; rep < REP_P2R; ++rep) { for (int it = blockIdx.x; it < 512; it += G) rwkv_prep_item(P, it, lds, wave, lane); }
#pragma unroll 1
    for (int rep = 0; rep < REP_P2G; ++rep) { for (int it = blockIdx.x; it < 1024; it += G) gla_prep_item(P, it, lds, wave, lane); }
    xcd_barrier(xbar);
#pragma unroll 1
    for (int rep = 0; rep < REP_P3; ++rep) { p3_seq(P, lds, tid, wave, lane); __syncthreads(); }
    xcd_barrier(xbar);
    p4_finalize(P, wave, lane);
    xcd_barrier(xbar);
    { pg8::Gemm g{XN, (const bf16*)(P.ws + WS_WO0T), M, D, D}; pg8::StaticOrder S; S.init(M, D, G, (int)blockIdx.x);
      EpiResid E{P.x, (bf16*)(P.ws + WS_H1B), (float*)(P.ws + WS_SLOT1)};
      pg8::gemm_phase<EpiResid, pg8::StaticOrder, true, true>(lds, g, S, E); }
    xcd_barrier(xbar);
    { pg8::Gemm g{(const bf16*)(P.ws + WS_H1B), (const bf16*)(P.ws + WS_W1T), M, IN1, D}; pg8::StaticOrder S; S.init(M, IN1, G, (int)blockIdx.x);
      EpiScaleBf16 E{(bf16*)(P.ws + WS_SCR), IN1, (const float*)(P.ws + WS_SLOT1), P.b_in1, 1536};
      pg8::gemm_phase<EpiScaleBf16, pg8::StaticOrder, true, true>(lds, g, S, E); }
    xcd_barrier(xbar);
    p7_attn(P, lds, tid, wave, lane);
    xcd_barrier(xbar);
    { pg8::Gemm g{XN, (const bf16*)(P.ws + WS_WO1T), M, D, D}; pg8::StaticOrder S; S.init(M, D, G, (int)blockIdx.x);
      EpiResidNorm E{(const bf16*)(P.ws + WS_H1B), P.out, P.b_out1, P.final_w, (float*)(P.ws + WS_SLOT2), (unsigned*)(P.ws + WS_PCNT)};
      pg8::gemm_phase<EpiResidNorm, pg8::StaticOrder, false, true>(lds, g, S, E); }
}

extern "C" void kernel_launch(void* const* d_in, const int* in_sizes, int n_in, void* d_out, int out_size, void* d_ws, size_t ws_size, hipStream_t stream) {
    static int grid = 0;
    if (grid == 0) {
        if (n_in != 23 || out_size != M * D || ws_size < WS_END) { fprintf(stderr, "kernel_launch: unexpected sizes n_in %d out %d ws %zu\n", n_in, out_size, ws_size); grid = -1; return; }
        int dev = 0, cus = 0, per_cu = 0;
        hipGetDevice(&dev); hipDeviceGetAttribute(&cus, hipDeviceAttributeMultiprocessorCount, dev);
        hipFuncSetAttribute((const void*)fwd_megakernel, hipFuncAttributeMaxDynamicSharedMemorySize, LDS_BYTES);
        hipOccupancyMaxActiveBlocksPerMultiprocessor(&per_cu, (const void*)fwd_megakernel, 512, LDS_BYTES);
        if (per_cu < 1) { fprintf(stderr, "kernel_launch: occupancy query says %d blocks/CU\n", per_cu); per_cu = 1; }
        grid = cus * 1;
        if (grid != 256) { fprintf(stderr, "kernel_launch: built for a 256-CU device (got %d)\n", cus); grid = -1; return; }
        (void)hipGetLastError();
    }
    if (grid < 0) return;
    Params p{};
    const float** pp = (const float**)&p;
    for (int i = 0; i < 23; ++i) pp[i] = (const float*)d_in[i];
    p.out = (float*)d_out; p.ws = (unsigned char*)d_ws;
    if (hipMemsetAsync((char*)d_ws + WS_CTL, 0, CTL_BYTES, stream) != hipSuccess) { fprintf(stderr, "memset failed\n"); return; }
    void* args[] = {&p};
    hipError_t e = hipLaunchCooperativeKernel((const void*)fwd_megakernel, dim3(grid), dim3(512), args, LDS_BYTES, stream);
    if (e != hipSuccess) fprintf(stderr, "cooperative launch failed: %s (grid %d)\n", hipGetErrorString(e), grid);
}
```

```cpp
#include <hip/hip_runtime.h>
#include <hip/hip_cooperative_groups.h>
#include <cstdio>
#include <cstdint>
namespace cg = cooperative_groups;
#ifndef REP_P2R
#define REP_P2R 1
#endif
#ifndef REP_P2G
#define REP_P2G 1
#endif
#ifndef REP_S2
#define REP_S2 1
#endif
#ifndef REP_P3
#define REP_P3 1
#endif
namespace pg8 {
#define PG8_LAS __attribute__((address_space(3)))
typedef unsigned short bf16_t;
typedef short bf16x8 __attribute__((ext_vector_type(8)));
typedef float f32x4 __attribute__((ext_vector_type(4)));
typedef unsigned u32x4 __attribute__((ext_vector_type(4)));
constexpr int BM = 256, BK = 64, HALF = 128, HTB = HALF * BK * 2  , STAGE_BYTES = 8 * HTB, NXCD = 8, WGM = 8;

__host__ __device__ __forceinline__ int lds_byte(int r, int c) { const int st = (r >> 4) * 2 + (c >> 5), rr = r & 15, cc = c & 31, ob = rr * 64 + cc * 2; return st * 1024 + (ob ^ (((ob >> 9) & 1) << 5)); }
__host__ __device__ __forceinline__ void stage_rc(int b, int& R, int& C) { const int st = b / 1024, sb = b % 1024, swz = sb ^ (((sb >> 9) & 1) << 5); R = (st >> 1) * 16 + swz / 64; C = (st & 1) * 32 + (swz % 64) / 2; }
__host__ __device__ __forceinline__ int perm32(int rho) { const int n = rho >> 4, i = rho & 15; return 8 * (i >> 2) + 4 * n + (i & 3); }

struct Unit { int pm, pn; };
struct Gemm { const bf16_t* A; const bf16_t* Bt; int M, N, K; };

struct StaticOrder {
    int nM, nN, nwg, G, c;
    __host__ __device__ void init(int M, int N, int G_, int c_) { nM = M / BM; nN = N / BM; nwg = nM * nN; G = G_; c = c_; }
    __host__ __device__ bool next(int i, Unit& u) const {
        const long L = (long)i * G + c; if (L >= nwg) return false;
        int wgid = (int)L; { const int q = nwg / NXCD, r = nwg % NXCD, xcd = wgid % NXCD, off = wgid / NXCD; wgid = (xcd < r ? xcd * (q + 1) : r * (q + 1) + (xcd - r) * q) + off; }
        const int nig = WGM * nN, gid = wgid / nig, fm = gid * WGM, gsz = (nM - fm) < WGM ? (nM - fm) : WGM;
        u.pm = fm + ((wgid % nig) % gsz); u.pn = (wgid % nig) / gsz; return true;
    }
    __device__ __forceinline__ void a_ready(const Unit&) const {}
    __device__ __forceinline__ void done(const Unit&) const {}
};

template <class Epi, class Sched, bool ALIGN_EPI = false, bool SP2 = false>
__device__ __forceinline__ void gemm_phase(PG8_LAS unsigned char* lds, const Gemm g, const Sched& S, const Epi& E) {
    const int tid = threadIdx.x, wid = __builtin_amdgcn_readfirstlane(tid >> 6), lane = tid & 63, wr = wid >> 2, wc = wid & 3, fr = lane & 15, fq = lane >> 4;
    const int K = g.K, nt = K / BK;
    unsigned voffA[2], voffB[2];
#pragma unroll
    for (int i = 0; i < 2; ++i) { int R, C; stage_rc(tid * 16 + i * 8192, R, C); const int Rb = Epi::PERM ? ((R & ~31) + perm32(R & 31)) : R;
        voffA[i] = (unsigned)(R * K + C) * 2u; voffB[i] = (unsigned)(Rb * K + C) * 2u; }
    const size_t kstep = (size_t)(BK * 2);
    const size_t hstep = (size_t)HALF * K * 2;
    const size_t tstep = 2 * hstep;
    const unsigned ldsw = (unsigned)wid * 1024u;
    const int aoff = lds_byte(wr * 64 + fr, fq * 8), boff = lds_byte(wc * 32 + fr, fq * 8);
#define PG8_SA(b, h) (((b) * 2 + (h)) * HTB)
#define PG8_SB(b, h) ((4 + (b) * 2 + (h)) * HTB)
#define PG8_STAGE(bufoff, gbase, voff) do { _Pragma("unroll") for (int _i = 0; _i < 2; ++_i) \
        __builtin_amdgcn_global_load_lds((const unsigned*)((const char*)(gbase) + (voff)[_i]), (PG8_LAS unsigned*)(lds + (bufoff) + ldsw + _i * 8192), 16, 0, 0); } while (0)
#define PG8_LDA(dst, b, h) do { _Pragma("unroll") for (int m = 0; m < 4; ++m) _Pragma("unroll") for (int k = 0; k < 2; ++k) dst[m][k] = *(const PG8_LAS bf16x8*)(lds + PG8_SA(b, h) + aoff + m * 2048 + k * 1024); } while (0)
#define PG8_LDB(dst, b, h) do { _Pragma("unroll") for (int n = 0; n < 2; ++n) _Pragma("unroll") for (int k = 0; k < 2; ++k) dst[n][k] = *(const PG8_LAS bf16x8*)(lds + PG8_SB(b, h) + boff + n * 2048 + k * 1024); } while (0)
#define PG8_MMA(ai, bj, At, Bt) do { __builtin_amdgcn_s_setprio(1); _Pragma("unroll") for (int m = 0; m < 4; ++m) _Pragma("unroll") for (int n = 0; n < 2; ++n) _Pragma("unroll") for (int k = 0; k < 2; ++k) \
        acc[ai][bj][m][n] = __builtin_amdgcn_mfma_f32_16x16x32_bf16(Bt[n][k], At[m][k], acc[ai][bj][m][n], 0, 0, 0); __builtin_amdgcn_s_setprio(0); } while (0)
#define PG8_WAIT_V(n) asm volatile("s_waitcnt vmcnt(" #n ")" ::: "memory")
#define PG8_WAIT_L(n) asm volatile("s_waitcnt lgkmcnt(" #n ")" ::: "memory")
#define PG8_BAR __builtin_amdgcn_s_barrier()
#define PG8_SCHED __builtin_amdgcn_sched_barrier(0)
    Unit cur, nxt; int ui = 0;
    if (!S.next(0, cur)) return;
    f32x4 acc[2][2][4][2];
#pragma unroll
    for (int a = 0; a < 2; ++a)
#pragma unroll
        for (int b = 0; b < 2; ++b)
#pragma unroll
            for (int m = 0; m < 4; ++m)
#pragma unroll
                for (int n = 0; n < 2; ++n) acc[a][b][m][n] = (f32x4){0.f, 0.f, 0.f, 0.f};
    bf16x8 At[4][2], B0[2][2], B1[2][2];
    const char* cA = (const char*)g.A + (size_t)cur.pm * tstep; const char* cB = (const char*)g.Bt + (size_t)cur.pn * tstep;
    S.a_ready(cur);
    if constexpr (SP2) {
        PG8_STAGE(PG8_SB(0, 0), cB, voffB); PG8_STAGE(PG8_SB(0, 1), cB + hstep, voffB); PG8_STAGE(PG8_SA(0, 0), cA, voffA); PG8_STAGE(PG8_SA(0, 1), cA + hstep, voffA);
        if (wr == 1) PG8_BAR;
        PG8_WAIT_V(2); PG8_BAR;
        PG8_STAGE(PG8_SB(1, 0), cB + kstep, voffB); PG8_STAGE(PG8_SA(1, 0), cA + kstep, voffA); PG8_STAGE(PG8_SB(1, 1), cB + hstep + kstep, voffB);
        PG8_WAIT_V(6); PG8_BAR;
    } else {
        PG8_STAGE(PG8_SB(0, 0), cB, voffB); PG8_STAGE(PG8_SA(0, 0), cA, voffA); PG8_STAGE(PG8_SB(0, 1), cB + hstep, voffB); PG8_STAGE(PG8_SA(0, 1), cA + hstep, voffA);
        if (wr == 1) PG8_BAR;
        PG8_WAIT_V(4); PG8_BAR;
        PG8_STAGE(PG8_SB(1, 0), cB + kstep, voffB); PG8_STAGE(PG8_SA(1, 0), cA + kstep, voffA); PG8_STAGE(PG8_SB(1, 1), cB + hstep + kstep, voffB);
        PG8_WAIT_V(6); PG8_BAR;
    }
    for (;;) {
        const bool has_next = S.next(ui + 1, nxt);
        const char* nA = has_next ? (const char*)g.A + (size_t)nxt.pm * tstep : cA; const char* nB = has_next ? (const char*)g.Bt + (size_t)nxt.pn * tstep : cB;
        for (int t = 0; t < nt; t += 2) {
            const bool last = (t == nt - 2);
            const char* a1 = cA + (size_t)(t + 1) * kstep;
            const char* a2 = last ? nA : cA + (size_t)(t + 2) * kstep; const char* b2 = last ? nB : cB + (size_t)(t + 2) * kstep;
            const char* a3 = a2 + kstep; const char* b3 = b2 + kstep;
            if (last && has_next) S.a_ready(nxt);
            if constexpr (SP2) {
            PG8_LDB(B0, 0, 0); PG8_LDB(B1, 0, 1); PG8_SCHED; PG8_LDA(At, 0, 0); PG8_STAGE(PG8_SA(1, 1), a1 + hstep, voffA);
            PG8_WAIT_V(8); PG8_WAIT_L(0); PG8_BAR; PG8_MMA(0, 0, At, B0); PG8_MMA(0, 1, At, B1); PG8_BAR; PG8_SCHED;
            PG8_LDA(At, 0, 1); PG8_STAGE(PG8_SB(0, 0), b2, voffB); PG8_STAGE(PG8_SB(0, 1), b2 + hstep, voffB); PG8_STAGE(PG8_SA(0, 0), a2, voffA);
            PG8_WAIT_V(8); PG8_WAIT_L(0); PG8_BAR; PG8_MMA(1, 0, At, B0); PG8_MMA(1, 1, At, B1); PG8_BAR; PG8_SCHED;
            PG8_LDB(B0, 1, 0); PG8_LDB(B1, 1, 1); PG8_SCHED; PG8_LDA(At, 1, 0); PG8_STAGE(PG8_SA(0, 1), a2 + hstep, voffA);
            PG8_WAIT_V(8); PG8_WAIT_L(0); PG8_BAR; PG8_MMA(0, 0, At, B0); PG8_MMA(0, 1, At, B1); PG8_BAR; PG8_SCHED;
            PG8_LDA(At, 1, 1); PG8_STAGE(PG8_SB(1, 0), b3, voffB); PG8_STAGE(PG8_SB(1, 1), b3 + hstep, voffB); PG8_STAGE(PG8_SA(1, 0), a3, voffA);
            PG8_WAIT_V(8); PG8_WAIT_L(0); PG8_BAR; PG8_MMA(1, 0, At, B0); PG8_MMA(1, 1, At, B1); PG8_BAR; PG8_SCHED;
            } else {
            PG8_LDB(B0, 0, 0); PG8_SCHED; PG8_LDA(At, 0, 0); PG8_STAGE(PG8_SA(1, 1), a1 + hstep, voffA);
            PG8_WAIT_L(8); PG8_BAR; PG8_WAIT_L(0); PG8_MMA(0, 0, At, B0); PG8_BAR; PG8_SCHED;
            PG8_LDB(B1, 0, 1); PG8_STAGE(PG8_SB(0, 0), b2, voffB);
            PG8_BAR; PG8_WAIT_L(0); PG8_MMA(0, 1, At, B1); PG8_BAR;
            PG8_LDA(At, 0, 1); PG8_STAGE(PG8_SA(0, 0), a2, voffA);
            PG8_BAR; PG8_WAIT_L(0); PG8_MMA(1, 0, At, B0); PG8_BAR; PG8_SCHED;
            PG8_STAGE(PG8_SB(0, 1), b2 + hstep, voffB);
            PG8_WAIT_V(6); PG8_BAR; PG8_MMA(1, 1, At, B1); PG8_BAR;
            PG8_LDB(B0, 1, 0); PG8_SCHED; PG8_LDA(At, 1, 0); PG8_STAGE(PG8_SA(0, 1), a2 + hstep, voffA);
            PG8_WAIT_L(8); PG8_BAR; PG8_WAIT_L(0); PG8_MMA(0, 0, At, B0); PG8_BAR; PG8_SCHED;
            PG8_LDB(B1, 1, 1); PG8_STAGE(PG8_SB(1, 0), b3, voffB);
            PG8_BAR; PG8_WAIT_L(0); PG8_MMA(0, 1, At, B1); PG8_BAR;
            PG8_LDA(At, 1, 1); PG8_STAGE(PG8_SA(1, 0), a3, voffA);
            PG8_BAR; PG8_WAIT_L(0); PG8_MMA(1, 0, At, B0); PG8_BAR; PG8_SCHED;
            PG8_STAGE(PG8_SB(1, 1), b3 + hstep, voffB);
            PG8_WAIT_V(6); PG8_BAR; PG8_MMA(1, 1, At, B1); PG8_BAR;
            }
        }
        if constexpr (ALIGN_EPI) { if (wr == 0) PG8_BAR; }
        if constexpr (!Epi::AFTER_DRAIN) { E(acc, cur, wr, wc, fr, fq); S.done(cur); }
        if (!has_next) break;
#pragma unroll
        for (int a = 0; a < 2; ++a)
#pragma unroll
            for (int b = 0; b < 2; ++b)
#pragma unroll
                for (int m = 0; m < 4; ++m)
#pragma unroll
                    for (int n = 0; n < 2; ++n) acc[a][b][m][n] = (f32x4){0.f, 0.f, 0.f, 0.f};
        cur = nxt; cA = nA; cB = nB; ++ui;
        if constexpr (ALIGN_EPI) { if (wr == 1) PG8_BAR; }
    }
    PG8_WAIT_V(0);
    if constexpr (!ALIGN_EPI) { if (wr == 0) PG8_BAR; }
    PG8_BAR;
    if constexpr (Epi::AFTER_DRAIN) { E.fused(acc, cur, wr, wc, fr, fq, lds, wid, lane); S.done(cur); }
#undef PG8_SA
#undef PG8_SB
#undef PG8_STAGE
#undef PG8_LDA
#undef PG8_LDB
#undef PG8_MMA
#undef PG8_WAIT_V
#undef PG8_WAIT_L
#undef PG8_BAR
#undef PG8_SCHED
}
}
#define GAS __attribute__((address_space(1)))
#define LAS __attribute__((address_space(3)))
#define AS4 __attribute__((address_space(4)))
#define DI __device__ __forceinline__
typedef unsigned short bf16;
typedef float f32x4 __attribute__((ext_vector_type(4)));
typedef float f32x16 __attribute__((ext_vector_type(16)));
typedef short bf16x8 __attribute__((ext_vector_type(8)));
typedef short s16x4 __attribute__((ext_vector_type(4)));
typedef unsigned u32x4 __attribute__((ext_vector_type(4)));
typedef unsigned u32x2 __attribute__((ext_vector_type(2)));
typedef __bf16 bf2v __attribute__((ext_vector_type(2)));

constexpr int NB = 4, T = 4096, M = NB * T, D = 1024;
constexpr int IN0 = 3728, N0P = 3840, IN1 = 2560;
constexpr int C_GQ = 0, C_GK = 256, C_GV = 512, C_GLOW = 1024, C_RW = 1040, C_GATE0 = 2704;
constexpr int C_RR = C_RW, C_RK = C_RW + 512, C_RV = C_RW + 1024, C_XW = C_RW + 1536, C_XA = C_RW + 1600;
constexpr float NORM_EPS = 1e-5f, RWKV_LN_EPS = 64e-5f;
constexpr size_t MiB = 1u << 20;
constexpr size_t WS_W0T = 0, WS_WO0T = 8 * MiB, WS_W1T = 10 * MiB, WS_WO1T = 15 * MiB;
constexpr size_t WS_SLOT1 = 17 * MiB, WS_SLOT2 = 18 * MiB, WS_BONUS = 19 * MiB, WS_GDEC = 19 * MiB + 512 * 1024;
constexpr size_t WS_CTL = 19 * MiB + 768 * 1024, CTL_BYTES = 40960, WS_PCNT = WS_CTL + 16384;
constexpr size_t WS_XCCTAB = WS_CTL + 32768, WS_PROG = WS_CTL + 33792;
constexpr int LDS_BAR_OFF = 147456 - 64;
constexpr size_t WS_ROPE = 18 * MiB + 512 * 1024;
constexpr size_t WS_WLT = 18 * MiB + 768 * 1024;
constexpr size_t WS_XN = 20 * MiB;
constexpr size_t WS_PROJ0 = 52 * MiB;
constexpr size_t WS_H1B = 116 * MiB;
constexpr size_t WS_SCR = 172 * MiB;
constexpr size_t WS_OARAW = 204 * MiB;
constexpr size_t WS_VP = 236 * MiB;
constexpr size_t WS_END = 252 * MiB;
constexpr int LDS_BYTES = 147456;

struct Params {
    const float *x, *norm_w, *w_in0, *gk_up, *gk_bias, *gla_norm_w, *mu, *w0, *w_up, *a0, *a_up, *k_k, *k_a, *r_k, *ln_w, *ln_b, *w_out0, *w_in1, *b_in1, *sinks, *w_out1, *b_out1, *final_w;
    float* out; unsigned char* ws;
};

typedef float f32x2v __attribute__((ext_vector_type(2)));
DI unsigned pk2(float lo, float hi) { const f32x2v f = {lo, hi}; return __builtin_bit_cast(unsigned, __builtin_convertvector(f, bf2v)); }
DI unsigned f2bf(float f) { return pk2(f, 0.f) & 0xffffu; }
DI float bf2f(unsigned h) { return __builtin_bit_cast(float, h << 16); }
DI float bflo(unsigned w) { return __builtin_bit_cast(float, w << 16); }
DI float bfhi(unsigned w) { return __builtin_bit_cast(float, w & 0xffff0000u); }
DI float wave_sum(float v) {
#pragma unroll
    for (int o = 1; o < 64; o <<= 1) v += __shfl_xor(v, o);
    return v;
}
DI float dpp_sum16(float v) {
    v += __builtin_bit_cast(float, __builtin_amdgcn_update_dpp(0, __builtin_bit_cast(int, v), 0xB1, 0xf, 0xf, true));
    v += __builtin_bit_cast(float, __builtin_amdgcn_update_dpp(0, __builtin_bit_cast(int, v), 0x4E, 0xf, 0xf, true));
    v += __builtin_bit_cast(float, __builtin_amdgcn_update_dpp(0, __builtin_bit_cast(int, v), 0x141, 0xf, 0xf, true));
    v += __builtin_bit_cast(float, __builtin_amdgcn_update_dpp(0, __builtin_bit_cast(int, v), 0x140, 0xf, 0xf, true));
    return v;
}
DI float half_sum32(float v) { v = dpp_sum16(v); return v + __shfl_xor(v, 16); }
DI void unpack8(const u32x4 w, float (&f)[8]) {
#pragma unroll
    for (int e = 0; e < 4; ++e) { f[2 * e] = bflo(w[e]); f[2 * e + 1] = bfhi(w[e]); }
}
DI int crow(int r, int hi) { return (r & 3) + 8 * (r >> 2) + 4 * hi; }
DI int kpos(int k) { const int o16 = k & 15; return (k & ~15) + 8 * ((o16 >> 2) & 1) + 4 * (o16 >> 3) + (o16 & 3); }
#define MFMA32(a, b, c) __builtin_amdgcn_mfma_f32_32x32x16_bf16((a), (b), (c), 0, 0, 0)
#define LDS_WAIT() asm volatile("s_waitcnt lgkmcnt(0)" ::: "memory")
DI void lds_barrier() { asm volatile("s_waitcnt lgkmcnt(0)" ::: "memory"); __builtin_amdgcn_s_barrier(); asm volatile("" ::: "memory"); }

#define XB_TMO      128
#define XB_XCNT(j)  (256  + 64 * (j))
#define XB_XSUB(j)  (1280 + 64 * (j))
#define XB_XGEN(j)  (2304 + 64 * (j))
#define XB_TOP      3328
#define XB_TOPGEN   3392
#define XCD_BAR_WORDS 3456
#define XB_SPIN_CAP (1u << 18)

__device__ __forceinline__ unsigned xb_ld(unsigned* p)              { return __hip_atomic_load(p, __ATOMIC_RELAXED, __HIP_MEMORY_SCOPE_AGENT); }
__device__ __forceinline__ unsigned xb_add(unsigned* p, unsigned v) { return __hip_atomic_fetch_add(p, v, __ATOMIC_RELAXED, __HIP_MEMORY_SCOPE_AGENT); }
__device__ __forceinline__ unsigned xb_xcc_id() { return (unsigned)__builtin_amdgcn_s_getreg((3 << 11) | 20) & 0xFu; }
#define XB_SPIN(cond, bar) do { unsigned _sp = 0; while (cond) { __builtin_amdgcn_s_sleep(1); \
    if ((++_sp & 255u) == 0u) { if (xb_ld(&(bar)[XB_TMO])) break; if (_sp > XB_SPIN_CAP) { atomicAdd(&(bar)[XB_TMO], 1u); break; } } } } while (0)

struct XcdBarrier {
    unsigned* bar; unsigned x;
    volatile LAS unsigned* st;
};

__device__ __forceinline__ XcdBarrier xcd_barrier_post(unsigned* bar, volatile LAS unsigned* st) {
    XcdBarrier b; b.bar = bar; b.x = xb_xcc_id(); b.st = st;
    if (threadIdx.x == 0) (void)xb_add(&bar[XB_XCNT(b.x)], 1u);
    return b;
}
__device__ __forceinline__ void xcd_barrier_complete(unsigned* bar, unsigned x, unsigned& nloc, unsigned& nx) {
    const unsigned G = gridDim.x * gridDim.y * gridDim.z;
    unsigned sum, cnt, mine, sp = 0u;
    for (;;) {
        sum = 0u; cnt = 0u; mine = 0u;
#pragma unroll
        for (unsigned j = 0; j < 16; ++j) { const unsigned c = xb_ld(&bar[XB_XCNT(j)]); sum += c; cnt += (c > 0u) ? 1u : 0u; mine = (j == x) ? c : mine; }
        if (sum == G) break;
        __builtin_amdgcn_s_sleep(1);
        if ((++sp & 255u) == 0u) { if (xb_ld(&bar[XB_TMO])) break; if (sp > XB_SPIN_CAP) { atomicAdd(&bar[XB_TMO], 1u); break; } }
    }
    nloc = mine > 0u ? mine : 1u; nx = cnt > 0u ? cnt : 1u;
}

__device__ __forceinline__ void xcd_barrier(const XcdBarrier& b) {
    asm volatile("s_waitcnt vmcnt(0)" ::: "memory");
    __syncthreads();
    if (threadIdx.x == 0) {
        unsigned* bar = b.bar;
        __builtin_amdgcn_s_waitcnt(0);
        unsigned nloc = b.st[0], nx = b.st[1];
        if (nloc == 0u) { xcd_barrier_complete(bar, b.x, nloc, nx); b.st[0] = nloc; b.st[1] = nx; }
        const unsigned old = xb_add(&bar[XB_XSUB(b.x)], 1u);
        const unsigned gen = old / nloc;
        if (old + 1u == (gen + 1u) * nloc) {
            __builtin_amdgcn_fence(__ATOMIC_RELEASE, "agent");
            asm volatile("s_waitcnt vmcnt(0)" ::: "memory");
            const unsigned og = xb_add(&bar[XB_TOP], 1u);
            const unsigned tg = og / nx;
            if (og + 1u == (tg + 1u) * nx) xb_add(&bar[XB_TOPGEN], 1u);
            else XB_SPIN(xb_ld(&bar[XB_TOPGEN]) == tg, bar);
            __builtin_amdgcn_fence(__ATOMIC_ACQUIRE, "agent");
            xb_add(&bar[XB_XGEN(b.x)], 1u);
            asm volatile("s_waitcnt vmcnt(0)" ::: "memory");
        } else {
            XB_SPIN(xb_ld(&bar[XB_XGEN(b.x)]) == gen, bar);
            __builtin_amdgcn_fence(__ATOMIC_ACQUIRE, "agent");
            asm volatile("s_waitcnt vmcnt(0)" ::: "memory");
        }
    }
    __syncthreads();
}

struct EpiScaleBf16 {
    static constexpr bool PERM = true, AFTER_DRAIN = false;
    bf16* O; int ldc; const float* slots; const float* bias; int bias_n;
    DI void operator()(const pg8::f32x4 (&acc)[2][2][4][2], const pg8::Unit& u, int wr, int wc, int fr, int fq) const {
        const int row0 = u.pm * 256 + wr * 64 + fr, col0 = u.pn * 256 + wc * 32 + 8 * fq;
        const bool hb = bias && (u.pn * 256 < bias_n);
        f32x4 bv[2][2];
#pragma unroll
        for (int bj = 0; bj < 2; ++bj)
#pragma unroll
            for (int n = 0; n < 2; ++n) bv[bj][n] = hb ? *(const f32x4*)(bias + col0 + bj * 128 + 4 * n) : (f32x4){0.f, 0.f, 0.f, 0.f};
#pragma unroll
        for (int ai = 0; ai < 2; ++ai)
#pragma unroll
            for (int m = 0; m < 4; ++m) {
                const int row = row0 + ai * 128 + m * 16; float rs = 1.f;
                if (slots) { const f32x4* sp = (const f32x4*)(slots + (size_t)row * 16); const f32x4 a = sp[0], b = sp[1], c = sp[2], d = sp[3];
                    const float ss = ((a[0] + a[1]) + (a[2] + a[3])) + ((b[0] + b[1]) + (b[2] + b[3])) + ((c[0] + c[1]) + (c[2] + c[3])) + ((d[0] + d[1]) + (d[2] + d[3]));
                    rs = 1.0f / sqrtf(ss * (1.0f / 1024.0f) + NORM_EPS); }
                bf16* rowp = O + (size_t)row * ldc + col0;
#pragma unroll
                for (int bj = 0; bj < 2; ++bj) { const f32x4 v0 = acc[ai][bj][m][0] * rs + bv[bj][0], v1 = acc[ai][bj][m][1] * rs + bv[bj][1];
                    u32x4 w; w.x = pk2(v0[0], v0[1]); w.y = pk2(v0[2], v0[3]); w.z = pk2(v1[0], v1[1]); w.w = pk2(v1[2], v1[3]);
                    *(u32x4*)(rowp + bj * 128) = w; }
            }
    }
};
struct EpiResid {
    static constexpr bool PERM = false, AFTER_DRAIN = false;
    const float* base; bf16* outB; float* slots;
    DI void operator()(const pg8::f32x4 (&acc)[2][2][4][2], const pg8::Unit& u, int wr, int wc, int fr, int fq) const {
        const int col0 = u.pn * 256 + wc * 32 + 4 * fq;
#pragma unroll
        for (int ai = 0; ai < 2; ++ai)
#pragma unroll
            for (int m = 0; m < 4; ++m) {
                const int row = u.pm * 256 + ai * 128 + wr * 64 + m * 16 + fr; const size_t off = (size_t)row * 1024 + col0; float ss = 0.f;
#pragma unroll
                for (int bj = 0; bj < 2; ++bj)
#pragma unroll
                    for (int n = 0; n < 2; ++n) { const f32x4 bs = *(const f32x4*)(base + off + bj * 128 + n * 16); const f32x4 v = bs + acc[ai][bj][m][n];
                        u32x2 w; w.x = pk2(v[0], v[1]); w.y = pk2(v[2], v[3]); *(u32x2*)(outB + off + bj * 128 + n * 16) = w;
                        ss += (v[0] * v[0] + v[1] * v[1]) + (v[2] * v[2] + v[3] * v[3]); }
                ss += __shfl_xor(ss, 16); ss += __shfl_xor(ss, 32);
                if (fq == 0) slots[(size_t)row * 16 + u.pn * 4 + wc] = ss;
            }
    }
};

struct EpiResidNorm {
    static constexpr bool PERM = false, AFTER_DRAIN = true;
    const bf16* base; float* out; const float* bias; const float* w; float* xbuf; unsigned* cnt;
    DI void fused(pg8::f32x4 (&acc)[2][2][4][2], const pg8::Unit& u, int wr, int wc, int fr, int fq, PG8_LAS unsigned char* lds, int wid, int lane) const {
        PG8_LAS float* Pt = (PG8_LAS float*)lds;
        PG8_LAS float* S = (PG8_LAS float*)(lds + 4096);
        const int col0 = u.pn * 256 + wc * 32 + 4 * fq;
#pragma unroll
        for (int ai = 0; ai < 2; ++ai)
#pragma unroll
            for (int m = 0; m < 4; ++m) {
                const int r = ai * 128 + wr * 64 + m * 16 + fr; const size_t off = (size_t)(u.pm * 256 + r) * 1024 + col0; float ss = 0.f;
#pragma unroll
                for (int bj = 0; bj < 2; ++bj)
#pragma unroll
                    for (int n = 0; n < 2; ++n) { const u32x2 bw = *(const u32x2*)(base + off + bj * 128 + n * 16); const f32x4 bs = (f32x4){bflo(bw.x), bfhi(bw.x), bflo(bw.y), bfhi(bw.y)}; const f32x4 bv = *(const f32x4*)(bias + col0 + bj * 128 + n * 16);
                        const f32x4 v = bs + acc[ai][bj][m][n] + bv; acc[ai][bj][m][n] = v; ss += (v[0] * v[0] + v[1] * v[1]) + (v[2] * v[2] + v[3] * v[3]); }
                ss += __shfl_xor(ss, 16); ss += __shfl_xor(ss, 32);
                if (fq == 0) Pt[r * 4 + wc] = ss;
                if (m & 1) asm volatile("" ::: "memory");
            }
        asm volatile("s_waitcnt lgkmcnt(0)" ::: "memory"); __builtin_amdgcn_s_barrier(); asm volatile("" ::: "memory");
        const int row = wid * 32 + (lane & 31);
        if (lane < 32) { const float tot = (Pt[row * 4 + 0] + Pt[row * 4 + 1]) + (Pt[row * 4 + 2] + Pt[row * 4 + 3]);
            __hip_atomic_store(xbuf + (size_t)(u.pm * 256 + row) * 4 + u.pn, tot, __ATOMIC_RELAXED, __HIP_MEMORY_SCOPE_AGENT); }
        asm volatile("s_waitcnt vmcnt(0)" ::: "memory");
        if (lane == 0) __hip_atomic_fetch_add(cnt + 64 * u.pm, 1u, __ATOMIC_RELAXED, __HIP_MEMORY_SCOPE_AGENT);
        if (wid == 0) {
            unsigned spins = 0;
            while ((unsigned)__builtin_amdgcn_readfirstlane(__hip_atomic_load(cnt + 64 * u.pm, __ATOMIC_RELAXED, __HIP_MEMORY_SCOPE_AGENT)) < 32u) { __builtin_amdgcn_s_sleep(2); if (++spins > (1u << 22)) break; }
            __builtin_amdgcn_fence(__ATOMIC_ACQUIRE, "agent");
        }
        asm volatile("s_waitcnt vmcnt(0) lgkmcnt(0)" ::: "memory"); __builtin_amdgcn_s_barrier(); asm volatile("" ::: "memory");
        if (lane < 32) { const float* sl = xbuf + (size_t)(u.pm * 256 + row) * 4; float t = 0.f;
#pragma unroll
            for (int k = 0; k < 4; ++k) t += __hip_atomic_load(sl + k, __ATOMIC_RELAXED, __HIP_MEMORY_SCOPE_AGENT);
            S[row] = 1.0f / sqrtf(t * (1.f / 1024.f) + NORM_EPS); }
        asm volatile("s_waitcnt lgkmcnt(0)" ::: "memory"); __builtin_amdgcn_s_barrier(); asm volatile("" ::: "memory");
        f32x4 wv[2][2];
#pragma unroll
        for (int bj = 0; bj < 2; ++bj)
#pragma unroll
            for (int n = 0; n < 2; ++n) wv[bj][n] = *(const f32x4*)(w + col0 + bj * 128 + n * 16);
#pragma unroll
        for (int ai = 0; ai < 2; ++ai)
#pragma unroll
            for (int m = 0; m < 4; ++m) { const int r = ai * 128 + wr * 64 + m * 16 + fr; const float rs = S[r]; const size_t off = (size_t)(u.pm * 256 + r) * 1024 + col0;
#pragma unroll
                for (int bj = 0; bj < 2; ++bj)
#pragma unroll
                    for (int n = 0; n < 2; ++n) *(f32x4*)(out + off + bj * 128 + n * 16) = acc[ai][bj][m][n] * rs * wv[bj][n]; }
    }
};

DI void transpose_item(const float* W, int N, int Npad, bf16* WT, const float* kscale, LAS float* scr, int item, int lane) {
    const int nblk = Npad / 32, kb = item / nblk, nb = item % nblk, k0 = 64 * kb, n0 = 32 * nb;
    const int n = n0 + (lane & 31);
#pragma unroll 8
    for (int i = 0; i < 32; ++i) { const int kk = 2 * i + (lane >> 5); float v = (n < N) ? W[(size_t)(k0 + kk) * N + n] : 0.f; if (kscale) v *= kscale[k0 + kk]; scr[kk * 33 + (lane & 31)] = v; }
    LDS_WAIT(); asm volatile("" ::: "memory");
    const int c = lane & 7;
#pragma unroll
    for (int j = 0; j < 4; ++j) { const int nn = (lane >> 3) + 8 * j; const LAS float* s = scr + (8 * c) * 33 + nn;
        u32x4 o; o.x = pk2(s[0 * 33], s[1 * 33]); o.y = pk2(s[2 * 33], s[3 * 33]); o.z = pk2(s[4 * 33], s[5 * 33]); o.w = pk2(s[6 * 33], s[7 * 33]);
        *(u32x4*)(WT + (size_t)(n0 + nn) * 1024 + k0 + 8 * c) = o; }
    LDS_WAIT(); asm volatile("" ::: "memory");
}
DI void p0_prologue(const Params& P, LAS unsigned char* lds, int wave, int lane) {
    LAS float* scr = (LAS float*)(lds + wave * 16384);
    const int gw = blockIdx.x * 8 + wave, NGW = gridDim.x * 8;
    bf16* W0T = (bf16*)(P.ws + WS_W0T); bf16* WO0T = (bf16*)(P.ws + WS_WO0T); bf16* W1T = (bf16*)(P.ws + WS_W1T); bf16* WO1T = (bf16*)(P.ws + WS_WO1T);
    constexpr int I0 = 16 * (N0P / 32), I1 = 16 * 32, I2 = 16 * (IN1 / 32), I3 = 16 * 32;
    for (int it = gw; it < I0 + I1 + I2 + I3; it += NGW) {
        int r = it;
        if (r < I0) { transpose_item(P.w_in0, IN0, N0P, W0T, nullptr, scr, r, lane); continue; } r -= I0;
        if (r < I1) { transpose_item(P.w_out0, 1024, 1024, WO0T, nullptr, scr, r, lane); continue; } r -= I1;
        if (r < I2) { transpose_item(P.w_in1, IN1, IN1, W1T, P.norm_w + 1024, scr, r, lane); continue; } r -= I2;
        transpose_item(P.w_out1, 1024, 1024, WO1T, nullptr, scr, r, lane);
    }
    {
        float* RT = (float*)(P.ws + WS_ROPE);
        for (int e = gw * 64 + lane; e < T * 8; e += NGW * 64) { const int pos = e >> 3, j = e & 7;
            const float invf = __expf(-(float)j * 0.125f * 13.122363377404328f); const float ang = (float)pos * invf; const float nrev = rintf(ang * 0.15915494309189535f);
            float r = fmaf(-nrev, 6.2831854820251465f, ang); r = fmaf(-nrev, -1.7484555e-07f, r);
            RT[2 * e] = __cosf(r); RT[2 * e + 1] = __sinf(r); }
    }
    {
        u32x4* WLT = (u32x4*)(P.ws + WS_WLT);
        for (int e = gw * 64 + lane; e < 8 * 2 * 4 * 2 * 64; e += NGW * 64) { const int ln = e & 63, db = (e >> 6) & 1, s = (e >> 7) & 3, lo = (e >> 9) & 1, h = e >> 10;
            const float* wp = (lo ? P.a_up : P.w_up) + (size_t)(16 * s + 8 * (ln >> 5)) * 512 + h * 64 + 2 * (ln & 31) + db;
            u32x4 o; o.x = pk2(wp[0], wp[512]); o.y = pk2(wp[2 * 512], wp[3 * 512]); o.z = pk2(wp[4 * 512], wp[5 * 512]); o.w = pk2(wp[6 * 512], wp[7 * 512]); WLT[e] = o; }
    }
    bf16* XN = (bf16*)(P.ws + WS_XN);
    {
        const f32x4* wr = (const f32x4*)P.norm_w + lane; const f32x4 w0 = wr[0], w1 = wr[64], w2 = wr[128], w3 = wr[192];
        f32x4 nx[4];
        { const f32x4* xr = (const f32x4*)(P.x + (size_t)(gw < M ? gw : 0) * D) + lane;
#pragma unroll
          for (int j = 0; j < 4; ++j) nx[j] = xr[64 * j]; }
        for (int m = gw; m < M; m += NGW) {
            f32x4 v[4]; float s = 0.f;
#pragma unroll
            for (int j = 0; j < 4; ++j) { v[j] = nx[j]; s += (v[j][0] * v[j][0] + v[j][1] * v[j][1]) + (v[j][2] * v[j][2] + v[j][3] * v[j][3]); }
            if (m + NGW < M) { const f32x4* xr = (const f32x4*)(P.x + (size_t)(m + NGW) * D) + lane;
#pragma unroll
                for (int j = 0; j < 4; ++j) nx[j] = xr[64 * j]; }
            const float rstd = 1.0f / sqrtf(wave_sum(s) * (1.f / D) + NORM_EPS);
            u32x2* o8 = (u32x2*)(XN + (size_t)m * D) + lane;
            { u32x2 o; o.x = pk2(v[0][0] * rstd * w0[0], v[0][1] * rstd * w0[1]); o.y = pk2(v[0][2] * rstd * w0[2], v[0][3] * rstd * w0[3]); o8[0] = o; }
            { u32x2 o; o.x = pk2(v[1][0] * rstd * w1[0], v[1][1] * rstd * w1[1]); o.y = pk2(v[1][2] * rstd * w1[2], v[1][3] * rstd * w1[3]); o8[64] = o; }
            { u32x2 o; o.x = pk2(v[2][0] * rstd * w2[0], v[2][1] * rstd * w2[1]); o.y = pk2(v[2][2] * rstd * w2[2], v[2][3] * rstd * w2[3]); o8[128] = o; }
            { u32x2 o; o.x = pk2(v[3][0] * rstd * w3[0], v[3][1] * rstd * w3[1]); o.y = pk2(v[3][2] * rstd * w3[2], v[3][3] * rstd * w3[3]); o8[192] = o; }
        }
    }
}
DI float softplus_f(float z) { return fmaxf(z, 0.f) + __logf(1.f + __expf(-fabsf(z))); }
DI float tanh_f(float x) { return 1.f - 2.f * __builtin_amdgcn_rcpf(__expf(2.f * x) + 1.f); }

template <int N> DI void dpp_fmac(float& acc, float src, float y) { asm("v_fmac_f32_dpp %0, %1, %2 row_newbcast:%3 row_mask:0xf bank_mask:0xf" : "+v"(acc) : "v"(src), "v"(y), "n"(N)); }
template <int N> DI void dpp_mul_ip(float& y, float src) { asm("v_mul_f32_dpp %0, %1, %0 row_newbcast:%2 row_mask:0xf bank_mask:0xf" : "+v"(y) : "v"(src), "n"(N)); }
template <int N> DI float dpp_mul(float src, float s) { float r; asm("v_mul_f32_dpp %0, %1, %2 row_newbcast:%3 row_mask:0xf bank_mask:0xf" : "=v"(r) : "v"(src), "v"(s), "n"(N)); return r; }
template <int D> struct RStep {
    static DI void dot(const float (&y)[64], const f32x4& X, float& s0, float& s1, float& s2, float& s3) {
        if constexpr (D < 16) { dpp_fmac<D>(s0, X[0], y[D]); dpp_fmac<D>(s1, X[1], y[16 + D]); dpp_fmac<D>(s2, X[2], y[32 + D]); dpp_fmac<D>(s3, X[3], y[48 + D]); RStep<D + 1>::dot(y, X, s0, s1, s2, s3); } }
    static DI void upd(float (&y)[64], const f32x4& Bv, float sa) {
        if constexpr (D < 16) {
            dpp_fmac<D>(y[D], Bv[0], sa); dpp_fmac<D>(y[16 + D], Bv[1], sa); dpp_fmac<D>(y[32 + D], Bv[2], sa); dpp_fmac<D>(y[48 + D], Bv[3], sa);
            RStep<D + 1>::upd(y, Bv, sa); } }
    static DI void scale(float (&y)[64], const f32x4& W) {
        if constexpr (D < 16) {
            dpp_mul_ip<D>(y[D], W[0]); dpp_mul_ip<D>(y[16 + D], W[1]); dpp_mul_ip<D>(y[32 + D], W[2]); dpp_mul_ip<D>(y[48 + D], W[3]);
            RStep<D + 1>::scale(y, W); } }
};
DI void rwkv_rstep(float (&y)[64], const f32x4 (&X)[4], int t, int role, int lane, bf16* mstep) {
    float s0 = 0.f, s1 = 0.f, s2 = 0.f, s3 = 0.f;
    RStep<0>::dot(y, X[0], s0, s1, s2, s3);
    float sa = (s0 + s1) + (s2 + s3);
    if (role == 1) sa = (lane < t) ? sa : 0.f;
    RStep<0>::upd(y, X[2], sa);
    float o0 = 0.f, o1 = 0.f, o2 = 0.f, o3 = 0.f;
    RStep<0>::dot(y, X[3], o0, o1, o2, o3);
    float o = (o0 + o1) + (o2 + o3);
    if (role == 1) o = (lane <= t) ? o : 0.f;
    mstep[t * 64] = (bf16)f2bf(o);
}
DI void rwkv_prep_item(const Params& P, int item, LAS unsigned char* lds, int wave, int lane) {
    const int bh = item >> 4, quad = item & 15, b = bh >> 3, h = bh & 7;
    const int tok0 = b * T + quad * 256;
    const bf16* PROJ0 = (const bf16*)(P.ws + WS_PROJ0);
    float* scr = (float*)(P.ws + WS_SCR + (size_t)blockIdx.x * 262144);
    LAS float* KS = (LAS float*)lds;
    LAS float* TOT = (LAS float*)(lds + 8 * 64 * 65 * 4);
    bf16* VP = (bf16*)(P.ws + WS_VP); float* BON = (float*)(P.ws + WS_BONUS);
    const int hd = h * 64 + lane;
    {
        const int m = lane & 31, hi = lane >> 5;
        const int c = wave >> 1, tb = (wave & 1) * 32;
        const int tokw = tok0 + wave * 32, posw = quad * 256 + wave * 32;
        f32x16 accw[2], acca[2];
#pragma unroll
        for (int i = 0; i < 16; ++i) { accw[0][i] = 0.f; accw[1][i] = 0.f; acca[0][i] = 0.f; acca[1][i] = 0.f; }
        {
            const bf16* rowc = PROJ0 + (size_t)(tokw + m) * N0P; const bool hasprev = (posw + m) > 0;
            const u32x4* WLT = (const u32x4*)(P.ws + WS_WLT) + (size_t)h * 1024 + lane;
            u32x4 cwv[4], cav[4], pwv[4], pav[4], bwv[4][2], bav[4][2];
#pragma unroll
            for (int s = 0; s < 4; ++s) { const int j0 = 16 * s + 8 * hi;
                cwv[s] = *(const u32x4*)(rowc + C_XW + j0); cav[s] = *(const u32x4*)(rowc + C_XA + j0);
                pwv[s] = (u32x4){0u, 0u, 0u, 0u}; pav[s] = (u32x4){0u, 0u, 0u, 0u};
                if (hasprev) { pwv[s] = *(const u32x4*)(rowc - N0P + C_XW + j0); pav[s] = *(const u32x4*)(rowc - N0P + C_XA + j0); }
#pragma unroll
                for (int db = 0; db < 2; ++db) { bwv[s][db] = WLT[((0 * 4 + s) * 2 + db) * 64]; bav[s][db] = WLT[((1 * 4 + s) * 2 + db) * 64]; } }
#pragma unroll
            for (int s = 0; s < 4; ++s) {
                const int j0 = 16 * s + 8 * hi;
                float fcw[8], fpw[8], fca[8], fpa[8]; unpack8(cwv[s], fcw); unpack8(pwv[s], fpw); unpack8(cav[s], fca); unpack8(pav[s], fpa);
                const f32x4 mw0 = *(const f32x4*)(P.mu + 1536 + j0), mw1 = *(const f32x4*)(P.mu + 1536 + j0 + 4), ma0 = *(const f32x4*)(P.mu + 1600 + j0), ma1 = *(const f32x4*)(P.mu + 1600 + j0 + 4);
                float xw[8], xa[8];
#pragma unroll
                for (int e = 0; e < 8; ++e) { const float muw = e < 4 ? mw0[e & 3] : mw1[e & 3], mua = e < 4 ? ma0[e & 3] : ma1[e & 3];
                    xw[e] = tanh_f(fcw[e] + (fpw[e] - fcw[e]) * muw); xa[e] = fca[e] + (fpa[e] - fca[e]) * mua; }
                u32x4 aw, aa;
#pragma unroll
                for (int e = 0; e < 4; ++e) { aw[e] = pk2(xw[2 * e], xw[2 * e + 1]); aa[e] = pk2(xa[2 * e], xa[2 * e + 1]); }
#pragma unroll
                for (int db = 0; db < 2; ++db) {
                    accw[db] = MFMA32(__builtin_bit_cast(bf16x8, aw), __builtin_bit_cast(bf16x8, bwv[s][db]), accw[db]);
                    acca[db] = MFMA32(__builtin_bit_cast(bf16x8, aa), __builtin_bit_cast(bf16x8, bav[s][db]), acca[db]);
                }
            }
        }
        float kkd[2], kad[2], rkd[2], w0d[2], a0d[2], mur[2], muk[2], muv[2];
#pragma unroll
        for (int db = 0; db < 2; ++db) { const int hd = h * 64 + 2 * m + db; kkd[db] = P.k_k[hd]; kad[db] = P.k_a[hd]; rkd[db] = P.r_k[hd]; w0d[db] = P.w0[hd]; a0d[db] = P.a0[hd];
            mur[db] = P.mu[hd]; muk[db] = P.mu[512 + hd]; muv[db] = P.mu[1024 + hd]; }
        unsigned qr[16], qk[16], qv[16], qpr[4], qpk[4], qpv[4];
#pragma unroll
        for (int i = 0; i < 16; ++i) {
            int io = i; asm volatile("" : "+v"(io));
            const bf16* row = PROJ0 + (size_t)(tokw + crow(io, hi)) * N0P + h * 64 + 2 * m;
            qr[i] = *(const unsigned*)(row + C_RR); qk[i] = *(const unsigned*)(row + C_RK); qv[i] = *(const unsigned*)(row + C_RV);
            if ((i & 3) == 0) {
                qpr[i >> 2] = 0u; qpk[i >> 2] = 0u; qpv[i >> 2] = 0u;
                if (posw + crow(i, hi) > 0) { qpr[i >> 2] = *(const unsigned*)(row - N0P + C_RR); qpk[i >> 2] = *(const unsigned*)(row - N0P + C_RK); qpv[i >> 2] = *(const unsigned*)(row - N0P + C_RV); }
            }
        }
        float ee[2][16], Lc[2][16];
#pragma unroll
        for (int db = 0; db < 2; ++db) {
#pragma unroll
            for (int i = 0; i < 16; ++i) { const float wl = w0d[db] + accw[db][i]; ee[db][i] = 0.60653066f * __builtin_amdgcn_rcpf(1.f + __expf(-wl)); }
            float gt[4], go[4];
#pragma unroll
            for (int g = 0; g < 4; ++g) { Lc[db][4 * g] = ee[db][4 * g]; Lc[db][4 * g + 1] = Lc[db][4 * g] + ee[db][4 * g + 1]; Lc[db][4 * g + 2] = Lc[db][4 * g + 1] + ee[db][4 * g + 2]; Lc[db][4 * g + 3] = Lc[db][4 * g + 2] + ee[db][4 * g + 3];
                gt[g] = Lc[db][4 * g + 3]; go[g] = __shfl_xor(gt[g], 32); }
            float run = 0.f;
#pragma unroll
            for (int g = 0; g < 4; ++g) { const float base = run + (hi ? go[g] : 0.f);
#pragma unroll
                for (int q = 0; q < 4; ++q) Lc[db][4 * g + q] += base;
                run += gt[g] + go[g]; }
            if (!(wave & 1) && hi == 0) TOT[c * 64 + 2 * m + db] = run;
        }
        __syncthreads();
        if (wave & 1) {
#pragma unroll
            for (int db = 0; db < 2; ++db) { const float tp = TOT[c * 64 + 2 * m + db];
#pragma unroll
                for (int i = 0; i < 16; ++i) Lc[db][i] += tp; }
        }
        float Lb[2][4];
#pragma unroll
        for (int db = 0; db < 2; ++db)
#pragma unroll
            for (int g = 0; g < 4; ++g) { Lb[db][g] = Lc[db][4 * g] - ee[db][4 * g]; asm volatile("" : "+v"(Lb[db][g])); }
        {
            float pv0 = 0.f, pv1 = 0.f;
#pragma unroll
            for (int i = 0; i < 16; ++i) {
                int io = i; asm volatile("" : "+v"(io));
                if ((i & 3) == 0) { pv0 = bflo(qpv[i >> 2]); pv1 = bfhi(qpv[i >> 2]); }
                const float c0 = bflo(qv[i]), c1 = bfhi(qv[i]);
                *(unsigned*)(VP + (size_t)(tokw + crow(io, hi)) * 512 + h * 64 + 2 * m) = pk2(c0 + (pv0 - c0) * muv[0], c1 + (pv1 - c1) * muv[1]);
                pv0 = c0; pv1 = c1;
            }
        }
        float pr[2] = {0.f, 0.f}, pk[2] = {0.f, 0.f}, pemL[2] = {1.f, 1.f};
#pragma unroll
        for (int i = 0; i < 16; ++i) {
            int io = i; asm volatile("" : "+v"(io));
            const int tau = crow(io, hi), tok = tokw + tau, t = tb + tau;
            if ((i & 3) == 0) { pr[0] = bflo(qpr[i >> 2]); pr[1] = bfhi(qpr[i >> 2]); pk[0] = bflo(qpk[i >> 2]); pk[1] = bfhi(qpk[i >> 2]); }
            float r[2], k[2], a[2], kk[2];
#pragma unroll
            for (int db = 0; db < 2; ++db) {
                const float cr = db ? bfhi(qr[i]) : bflo(qr[i]), ck = db ? bfhi(qk[i]) : bflo(qk[i]);
                r[db] = cr + (pr[db] - cr) * mur[db]; k[db] = ck + (pk[db] - ck) * muk[db];
                pr[db] = cr; pk[db] = ck;
                const float al = a0d[db] + acca[db][i];
                a[db] = __builtin_amdgcn_rcpf(1.f + __expf(-al));
                kk[db] = k[db] * kkd[db];
            }
            const float inv = __builtin_amdgcn_rsqf(fmaxf(half_sum32(kk[0] * kk[0] + kk[1] * kk[1]), 1e-24f));
            float k2[2];
#pragma unroll
            for (int db = 0; db < 2; ++db) k2[db] = k[db] * (1.f + (a[db] - 1.f) * kad[db]);
            const float bon = half_sum32(r[0] * k2[0] * rkd[0] + r[1] * k2[1] * rkd[1]);
#pragma unroll
            for (int db = 0; db < 2; ++db) {
                const int d = 2 * m + db; const float kkn = kk[db] * inv;
                float* o = scr + (size_t)((c * 64 + t) * 4) * 64 + (d & 15) * 4 + (d >> 4);
                const float eL = __expf(Lc[db][i]), emL = __builtin_amdgcn_rcpf(eL);
                const float wprev = (i & 3) ? pemL[db] : __expf(-Lb[db][i >> 2]); pemL[db] = emL;
                o[0] = -kkn * wprev;
                if (i == 15 && t == 63) o[64] = emL;
                o[128] = kkn * a[db] * eL;
                o[192] = r[db] * emL;
                KS[((2 * c + 1 - (c >> 1)) * 64 + t) * 65 + d] = k2[db] * eL;
            }
            if (m == 0) BON[(size_t)tok * 8 + h] = bon;
        }
    }
    __syncthreads();
    {
        const int c = wave >> 1, role = (wave ^ (wave >> 2)) & 1;
        const f32x4* xb = (const f32x4*)(scr + (size_t)c * 64 * 256) + (lane & 15);
        const LAS float* ksw = KS + wave * 64 * 65;
        float y[64];
        const int n = quad * 4 + c;
        bf16* mats = (bf16*)P.out + (size_t)(bh * 64 + n) * 4 * 4096;
        bf16* mstep = mats + role * 4096 + (role ? lane : kpos(lane));
#pragma unroll 1
        for (int rep2 = 0; rep2 < REP_S2; ++rep2) {
            int ln = lane; asm volatile("" : "+v"(ln));
#pragma unroll
            for (int d = 0; d < 64; ++d) y[d] = (role == 0) ? ((d == ln) ? 1.f : 0.f) : ksw[ln * 65 + d];
            f32x4 XA[4], XB[4];
#pragma unroll
            for (int v = 0; v < 4; ++v) XA[v] = xb[v * 16];
            for (int t = 0; t < 64; t += 2) {
#pragma unroll
                for (int v = 0; v < 4; ++v) XB[v] = xb[(t + 1) * 64 + v * 16];
                rwkv_rstep(y, XA, t, role, lane, mstep);
                if (t + 2 < 64) {
#pragma unroll
                    for (int v = 0; v < 4; ++v) XA[v] = xb[(t + 2) * 64 + v * 16];
                }
                rwkv_rstep(y, XB, t + 1, role, lane, mstep);
            }
            RStep<0>::scale(y, XB[1]);
        }
        bf16* mend = mats + (role ? 2 : 3) * 4096 + (role ? lane : kpos(lane));
        LAS float* myr = KS + (wave * 64 + lane) * 65;
#pragma unroll
        for (int d = 0; d < 64; ++d) myr[d] = y[d];
#pragma unroll 1
        for (int d = 0; d < 64; ++d) mend[d * 64] = (bf16)f2bf(myr[d]);
    }
    __syncthreads();
}

DI void gla_prep_item(const Params& P, int item, LAS unsigned char* lds, int wave, int lane) {
    const int bh = item >> 6, n = item & 63, b = bh >> 2, h = bh & 3;
    const int tok0 = b * T + n * 64, hd = h * 64 + lane;
    const bf16* PROJ0 = (const bf16*)(P.ws + WS_PROJ0);
    LAS float* WT = (LAS float*)lds;
    LAS bf16* QEb = (LAS bf16*)(WT + 1024);
    LAS bf16* KEb = QEb + 64 * 72;
    LAS float* KL = (LAS float*)(KEb + 64 * 72);
    bf16* mats = (bf16*)(P.ws + WS_XN) + (size_t)(bh * 64 + n) * 3 * 4096;
    float* GDEC = (float*)(P.ws + WS_GDEC) + (size_t)(bh * 64 + n) * 64;
    float q8[8], k8[8]; u32x4 gl0[8], gl1[8];
#pragma unroll
    for (int i = 0; i < 8; ++i) { const bf16* row = PROJ0 + (size_t)(tok0 + wave * 8 + i) * N0P; q8[i] = bf2f(row[C_GQ + hd]) * 0.125f; k8[i] = bf2f(row[C_GK + hd]);
        gl0[i] = *(const u32x4*)(row + C_GLOW); gl1[i] = *(const u32x4*)(row + C_GLOW + 8); }
    float up[16];
#pragma unroll
    for (int r = 0; r < 16; ++r) up[r] = P.gk_up[r * 256 + hd];
    const float bias = P.gk_bias[hd];
    float bt[8]; float acc = 0.f;
#pragma unroll
    for (int i = 0; i < 8; ++i) { float xg = bias;
#pragma unroll
        for (int r = 0; r < 4; ++r) { xg = fmaf(bflo(gl0[i][r]), up[2 * r], xg); xg = fmaf(bfhi(gl0[i][r]), up[2 * r + 1], xg); }
#pragma unroll
        for (int r = 0; r < 4; ++r) { xg = fmaf(bflo(gl1[i][r]), up[8 + 2 * r], xg); xg = fmaf(bfhi(gl1[i][r]), up[8 + 2 * r + 1], xg); }
        acc += -softplus_f(-xg) * (1.f / 16.f); bt[i] = acc; }
    WT[wave * 64 + lane] = acc;
    if (wave == 4) WT[512 + lane] = bt[0];
    __syncthreads();
    float off = 0.f, off4 = 0.f, total = 0.f;
#pragma unroll
    for (int w2 = 0; w2 < 8; ++w2) { const float tv = WT[w2 * 64 + lane]; if (w2 < wave) off += tv; if (w2 < 4) off4 += tv; total += tv; }
    const float bref = off4 + WT[512 + lane], blast = total;
#pragma unroll
    for (int i = 0; i < 8; ++i) { const int t = wave * 8 + i; const float b_t = bt[i] + off;
        QEb[t * 72 + lane] = (bf16)f2bf(q8[i] * __expf(b_t - bref)); KEb[t * 72 + lane] = (bf16)f2bf(k8[i] * __expf(bref - b_t)); KL[t * 65 + lane] = k8[i] * __expf(blast - b_t);
        mats[t * 64 + kpos(lane)] = (bf16)f2bf(q8[i] * __expf(b_t)); }
    if (wave == 0) GDEC[lane] = __expf(blast);
    __syncthreads();
    if (wave < 4) {
        const int m = lane & 31, hi = lane >> 5, tb = wave >> 1, jb = wave & 1;
        f32x16 c;
#pragma unroll
        for (int r = 0; r < 16; ++r) c[r] = 0.f;
#pragma unroll
        for (int s = 0; s < 4; ++s) { const bf16x8 A = *(const LAS bf16x8*)(KEb + (32 * jb + m) * 72 + 16 * s + 8 * hi), Bq = *(const LAS bf16x8*)(QEb + (32 * tb + m) * 72 + 16 * s + 8 * hi); c = MFMA32(A, Bq, c); }
        const int t = 32 * tb + m;
#pragma unroll
        for (int g = 0; g < 4; ++g) { const int j0 = 32 * jb + 8 * g + 4 * hi; u32x2 w;
            w.x = pk2(j0 <= t ? c[4 * g] : 0.f, j0 + 1 <= t ? c[4 * g + 1] : 0.f); w.y = pk2(j0 + 2 <= t ? c[4 * g + 2] : 0.f, j0 + 3 <= t ? c[4 * g + 3] : 0.f);
            *(u32x2*)(mats + 4096 + t * 64 + j0) = w; }
    } else {
#pragma unroll
        for (int r = 0; r < 16; ++r) { const int d = (wave - 4) * 16 + r; mats[8192 + d * 64 + lane] = (bf16)f2bf(KL[lane * 65 + d]); }
    }
    __syncthreads();
}

constexpr int SQ_PITCH = 144, SQ_MAT = 64 * SQ_PITCH, SQ_VT = 4 * SQ_MAT, SQ_DEC = SQ_VT + 128 * SQ_PITCH, SQ_BUF = 57344;
template <bool DIAG>
DI void seq_pass(unsigned* prog, const bf16* mats, int nmat, const bf16* vsrc, int vpitch, const float* dec, bf16* outp, LAS unsigned char* lds, int tid, int wave, int lane) {
    const int m = lane & 31, hi = lane >> 5;
    f32x16 sacc[2];
#pragma unroll
    for (int i = 0; i < 16; ++i) { sacc[0][i] = 0.f; sacc[1][i] = 0.f; }
    const int st = tid - 256;
    struct StSet { u32x4 rm[8]; u32x4 rv[2]; float rdec; };
    const int v8 = st & 7, par = (st >> 3) & 1;
    constexpr int NMAT = DIAG ? 3 : 4;
    auto gload = [&](int n, StSet& S) {
        const bf16* mp = mats + (size_t)n * NMAT * 4096;
#pragma unroll
        for (int q = 0; q < 2 * NMAT; ++q) S.rm[q] = *(const u32x4*)(mp + (size_t)(st + 256 * q) * 8);
#pragma unroll
        for (int q = 0; q < 2; ++q) S.rv[q] = *(const u32x4*)(vsrc + (size_t)(n * 64 + (st >> 3) + 32 * q) * vpitch + 8 * v8);
        if (DIAG) S.rdec = dec[n * 64 + (st & 63)];
    };
    auto lstore = [&](int n, const StSet& S) {
        LAS unsigned char* B = lds + (n & 1) * SQ_BUF;
#pragma unroll
        for (int q = 0; q < 2 * NMAT; ++q) { const int idx = (st + 256 * q) & 511; *(LAS u32x4*)(B + (q >> 1) * SQ_MAT + (idx >> 3) * SQ_PITCH + (idx & 7) * 16) = S.rm[q]; }
#pragma unroll
        for (int q = 0; q < 2; ++q) {
            const int vt = (st >> 3) + 32 * q;
            const unsigned k0 = par ? S.rv[q][2] : S.rv[q][0], k1 = par ? S.rv[q][3] : S.rv[q][1], s0 = par ? S.rv[q][0] : S.rv[q][2], s1 = par ? S.rv[q][1] : S.rv[q][3];
            const unsigned r0 = (unsigned)__builtin_amdgcn_update_dpp(0, (int)s0, 0x128, 0xf, 0xf, true), r1 = (unsigned)__builtin_amdgcn_update_dpp(0, (int)s1, 0x128, 0xf, 0xf, true);
            unsigned o[4];
            if (par == 0) { o[0] = (k0 & 0xffffu) | (r0 << 16); o[1] = (k0 >> 16) | (r0 & 0xffff0000u); o[2] = (k1 & 0xffffu) | (r1 << 16); o[3] = (k1 >> 16) | (r1 & 0xffff0000u); }
            else          { o[0] = (r0 & 0xffffu) | (k0 << 16); o[1] = (r0 >> 16) | (k0 & 0xffff0000u); o[2] = (r1 & 0xffffu) | (k1 << 16); o[3] = (r1 >> 16) | (k1 & 0xffff0000u); }
            const int tp = vt >> 1, gsw = ((tp >> 2) ^ v8) & 7;
#pragma unroll
            for (int jj = 0; jj < 4; ++jj) *(LAS unsigned*)(B + SQ_VT + (8 * v8 + 4 * par + jj) * SQ_PITCH + (4 * gsw + (tp & 3)) * 4) = o[jj];
        }
        if (DIAG && st < 64) *(LAS float*)(B + SQ_DEC + st * 4) = S.rdec;
    };
    f32x16 o0, o1;
    bf16x8 sBp[2][2];
#pragma unroll
    for (int kb = 0; kb < 2; ++kb)
#pragma unroll
        for (int s = 0; s < 2; ++s) sBp[kb][s] = (bf16x8){0, 0, 0, 0, 0, 0, 0, 0};
    LAS unsigned char* SBX = lds + 2 * SQ_BUF;
    if (wave >= 2 && wave < 4) {
#pragma unroll
        for (int q = 0; q < 4; ++q) *(LAS bf16x8*)(SBX + (0 * 2 + (wave & 1)) * 4096 + lane * 64 + 16 * q) = sBp[q >> 1][q & 1];
    }
    auto compute = [&](int n, int bufi) {
        if (wave < 4) {
            const int vb = wave & 1; const bool upd = wave >= 2;
            const LAS unsigned char* B = lds + bufi * SQ_BUF;
            const int vrow = 32 * vb + m;
            const LAS unsigned char* Vr = B + SQ_VT + vrow * SQ_PITCH;
            const LAS unsigned char* Ar = B + m * SQ_PITCH + 16 * hi;
            bf16x8 Fa[2], Fb[2], Va, Vb;
#define SQ_LD(F, VB, k, MS, MV) do { if ((k) < 4) { const int co_ = (32 * ((k) >> 1) + 16 * ((k) & 1)) * 2; \
            F[0] = *(const LAS bf16x8*)(Ar + (MS) * SQ_MAT + co_); F[1] = *(const LAS bf16x8*)(Ar + (MS) * SQ_MAT + 32 * SQ_PITCH + co_); } \
        else { const int S4_ = (k) - 4, co_ = 32 * S4_; VB = *(const LAS bf16x8*)(Vr + (((2 * S4_ + hi) ^ (vrow >> 3)) & 7) * 16); \
            F[0] = *(const LAS bf16x8*)(Ar + (MV) * SQ_MAT + co_); F[1] = *(const LAS bf16x8*)(Ar + (MV) * SQ_MAT + 32 * SQ_PITCH + co_); } } while (0)
            if (!upd) {
                bf16x8 sB[2][2];
#pragma unroll
                for (int q = 0; q < 4; ++q) sB[q >> 1][q & 1] = *(const LAS bf16x8*)(SBX + ((n & 1) * 2 + vb) * 4096 + lane * 64 + 16 * q);
#pragma unroll
                for (int i = 0; i < 16; ++i) { o0[i] = 0.f; o1[i] = 0.f; }
#define SQ_MM(F, VB, k) do { const bf16x8 Bq_ = ((k) < 4) ? sB[(k) >> 1][(k) & 1] : VB; o0 = MFMA32(Bq_, F[0], o0); o1 = MFMA32(Bq_, F[1], o1); } while (0)
                SQ_LD(Fa, Va, 0, 0, 1); SQ_LD(Fb, Vb, 1, 0, 1);
                __builtin_amdgcn_sched_barrier(0);
                SQ_MM(Fa, Va, 0); SQ_LD(Fa, Va, 2, 0, 1); __builtin_amdgcn_sched_barrier(0);
                SQ_MM(Fb, Vb, 1); SQ_LD(Fb, Vb, 3, 0, 1); __builtin_amdgcn_sched_barrier(0);
                SQ_MM(Fa, Va, 2); SQ_LD(Fa, Va, 4, 0, 1); __builtin_amdgcn_sched_barrier(0);
                SQ_MM(Fb, Vb, 3); SQ_LD(Fb, Vb, 5, 0, 1); __builtin_amdgcn_sched_barrier(0);
                SQ_MM(Fa, Va, 4); SQ_LD(Fa, Va, 6, 0, 1); __builtin_amdgcn_sched_barrier(0);
                SQ_MM(Fb, Vb, 5); SQ_LD(Fb, Vb, 7, 0, 1); __builtin_amdgcn_sched_barrier(0);
                SQ_MM(Fa, Va, 6); SQ_MM(Fb, Vb, 7);
#undef SQ_MM
            } else {
                f32x16 n0, n1;
#pragma unroll
                for (int i = 0; i < 16; ++i) {
                    if (DIAG) { n0[i] = sacc[0][i] * *(const LAS float*)(B + SQ_DEC + crow(i, hi) * 4); n1[i] = sacc[1][i] * *(const LAS float*)(B + SQ_DEC + (32 + crow(i, hi)) * 4); }
                    else { n0[i] = 0.f; n1[i] = 0.f; } }
#define SQ_MM(F, VB, k) do { const bf16x8 Bq_ = ((k) < 4) ? sBp[(k) >> 1][(k) & 1] : VB; n0 = MFMA32(F[0], Bq_, n0); n1 = MFMA32(F[1], Bq_, n1); } while (0)
                if (!DIAG) {
                    SQ_LD(Fa, Va, 0, 3, 2); SQ_LD(Fb, Vb, 1, 3, 2);
                    __builtin_amdgcn_sched_barrier(0);
                    SQ_MM(Fa, Va, 0); SQ_LD(Fa, Va, 2, 3, 2); __builtin_amdgcn_sched_barrier(0);
                    SQ_MM(Fb, Vb, 1); SQ_LD(Fb, Vb, 3, 3, 2); __builtin_amdgcn_sched_barrier(0);
                    SQ_MM(Fa, Va, 2); SQ_LD(Fa, Va, 4, 3, 2); __builtin_amdgcn_sched_barrier(0);
                    SQ_MM(Fb, Vb, 3); SQ_LD(Fb, Vb, 5, 3, 2); __builtin_amdgcn_sched_barrier(0);
                } else {
                    SQ_LD(Fa, Va, 4, 3, 2); SQ_LD(Fb, Vb, 5, 3, 2);
                    __builtin_amdgcn_sched_barrier(0);
                }
                SQ_MM(Fa, Va, 4); SQ_LD(Fa, Va, 6, 3, 2); __builtin_amdgcn_sched_barrier(0);
                SQ_MM(Fb, Vb, 5); SQ_LD(Fb, Vb, 7, 3, 2); __builtin_amdgcn_sched_barrier(0);
                SQ_MM(Fa, Va, 6); SQ_MM(Fb, Vb, 7);
#undef SQ_MM
                sacc[0] = n0; sacc[1] = n1;
#pragma unroll
                for (int kb = 0; kb < 2; ++kb)
#pragma unroll
                    for (int s = 0; s < 2; ++s) { u32x4 w;
#pragma unroll
                        for (int e = 0; e < 4; ++e) w[e] = pk2(sacc[kb][8 * s + 2 * e], sacc[kb][8 * s + 2 * e + 1]);
                        sBp[kb][s] = __builtin_bit_cast(bf16x8, w);
                        *(LAS bf16x8*)(SBX + (((n + 1) & 1) * 2 + vb) * 4096 + lane * 64 + 16 * (2 * kb + s)) = sBp[kb][s]; }
            }
#undef SQ_LD
        }
    };
    auto store_out = [&](int n) {
        if (wave < 2) {
#pragma unroll
            for (int g = 0; g < 4; ++g) { bf16* op_ = outp + (size_t)(n * 64 + m) * 512 + 32 * wave + 8 * g + 4 * hi;
                u32x2 w0, w1; w0.x = pk2(o0[4 * g], o0[4 * g + 1]); w0.y = pk2(o0[4 * g + 2], o0[4 * g + 3]); w1.x = pk2(o1[4 * g], o1[4 * g + 1]); w1.y = pk2(o1[4 * g + 2], o1[4 * g + 3]);
                *(u32x2*)op_ = w0; *(u32x2*)(op_ + 32 * 512) = w1; }
        }
    };
    if (wave < 4) {
        lds_barrier();
#pragma unroll 1
        for (int n = 0; n < 64; ++n) { compute(n, n & 1); store_out(n); lds_barrier(); }
    } else {
        StSet A, Bs, C;
        gload(0, A); gload(1, Bs); gload(2, C);
        lstore(0, A); gload(3, A);
        lds_barrier();
#pragma unroll 1
        for (int k = 0; k < 60; k += 3) {
            if (st == 0) __hip_atomic_store(prog, (unsigned)(k + 4), __ATOMIC_RELAXED, __HIP_MEMORY_SCOPE_AGENT);
            lstore(k + 1, Bs); gload(k + 4, Bs); lds_barrier();
            lstore(k + 2, C); gload(k + 5, C); lds_barrier();
            lstore(k + 3, A); gload(k + 6, A); lds_barrier();
        }
        lstore(61, Bs); lds_barrier();
        lstore(62, C); lds_barrier();
        lstore(63, A); lds_barrier();
        lds_barrier();
    }
}
struct P3Src { const bf16* mats; int nmat; const bf16* vsrc; int vpitch; const float* dec; bf16* outp; };
DI P3Src p3_src(const Params& P, int bx) {
    P3Src s;
    if (bx < 32) { const int b = bx >> 3, h = bx & 7;
        s.mats = (const bf16*)P.out + (size_t)bx * 64 * 4 * 4096; s.nmat = 4; s.vsrc = (const bf16*)(P.ws + WS_VP) + (size_t)b * T * 512 + h * 64; s.vpitch = 512; s.dec = nullptr;
        s.outp = (bf16*)(P.ws + WS_SCR) + (size_t)b * T * 512 + h * 64; }
    else { const int g = bx - 32, bh = (g & 7) | ((g >> 4) << 3), vh = (g >> 3) & 1, b = bh >> 2, h = bh & 3;
        s.mats = (const bf16*)(P.ws + WS_XN) + (size_t)bh * 64 * 3 * 4096; s.nmat = 3; s.vsrc = (const bf16*)(P.ws + WS_PROJ0) + (size_t)b * T * N0P + C_GV + h * 128 + 64 * vh; s.vpitch = N0P;
        s.dec = (const float*)(P.ws + WS_GDEC) + (size_t)bh * 64 * 64; s.outp = (bf16*)(P.ws + WS_OARAW) + (size_t)b * T * 512 + h * 128 + 64 * vh; }
    return s;
}
DI void p3_seq(const Params& P, LAS unsigned char* lds, int tid, int wave, int lane) {
    const int bx = blockIdx.x;
    unsigned* progw = (unsigned*)(P.ws + WS_PROG);
    if (bx < 64) {
        const P3Src s = p3_src(P, bx);
        if (bx < 32) seq_pass<false>(progw + 16 * bx, s.mats, 4, s.vsrc, s.vpitch, nullptr, s.outp, lds, tid, wave, lane);
        else         seq_pass<true>(progw + 16 * bx, s.mats, 3, s.vsrc, s.vpitch, s.dec, s.outp, lds, tid, wave, lane);
    } else {
        const unsigned* xt = (const unsigned*)(P.ws + WS_XCCTAB);
        LAS unsigned* hs = (LAS unsigned*)lds;
        if (tid < 4) hs[tid] = 0u;
        __syncthreads();
        const unsigned myx = xt[bx];
        if (tid < 192) { const unsigned o = xt[64 + tid]; if (o == myx) { __hip_atomic_fetch_add(&hs[2], 1u, __ATOMIC_RELAXED, __HIP_MEMORY_SCOPE_WORKGROUP); if (64 + tid < bx) __hip_atomic_fetch_add(&hs[0], 1u, __ATOMIC_RELAXED, __HIP_MEMORY_SCOPE_WORKGROUP); } }
        if (tid >= 192 && tid < 256) { if (xt[tid - 192] == myx) { const unsigned slot = __hip_atomic_fetch_add(&hs[1], 1u, __ATOMIC_RELAXED, __HIP_MEMORY_SCOPE_WORKGROUP); hs[8 + slot] = (unsigned)(tid - 192); } }
        __syncthreads();
        const int rank = (int)hs[0], np = (int)hs[1], nh = (int)hs[2];
        unsigned pf0 = 0u;
        if (np > 0) {
            const int tgt = (int)hs[8 + (rank % np)];
            const int sub = rank / np, cnt = (nh - (rank % np) + np - 1) / np;
            const P3Src s = p3_src(P, tgt);
            const unsigned* pw = progw + 16 * tgt;
            const int nlm = s.nmat * 64;
            int pc = sub; unsigned spins = 0;
            while (pc < 64) {
                const int p = (int)__builtin_amdgcn_readfirstlane((int)__hip_atomic_load(pw, __ATOMIC_RELAXED, __HIP_MEMORY_SCOPE_AGENT));
                if (pc <= p + 8) {
                    const char* a = nullptr;
                    if (tid < nlm) a = (const char*)(s.mats + (size_t)pc * s.nmat * 4096) + (size_t)tid * 128;
                    else if (tid < nlm + 64) a = (const char*)(s.vsrc + (size_t)(pc * 64 + (tid - nlm)) * s.vpitch);
                    if (a) asm volatile("global_load_dword %0, %1, off" : "+v"(pf0) : "v"(a) : "memory");
                    pc += cnt;
                } else { __builtin_amdgcn_s_sleep(8); if (++spins > (1u << 16)) break; }
            }
        }
        asm volatile("s_waitcnt vmcnt(0)" : "+v"(pf0) :: "memory");
        __syncthreads();
    }
}

DI float silu_f(float g) { return g * __builtin_amdgcn_rcpf(1.f + __expf(-g)); }
DI void p4_finalize(const Params& P, int wave, int lane) {
    const int gw = blockIdx.x * 8 + wave, NGW = gridDim.x * 8;
    const bf16* OB = (const bf16*)(P.ws + WS_SCR); const bf16* OA = (const bf16*)(P.ws + WS_OARAW);
    const bf16* PROJ0 = (const bf16*)(P.ws + WS_PROJ0); const bf16* VP = (const bf16*)(P.ws + WS_VP); const float* BON = (const float*)(P.ws + WS_BONUS);
    bf16* O0 = (bf16*)(P.ws + WS_XN);
    const int cv = (8 * lane) & 127;
    const f32x4 gw0 = *(const f32x4*)(P.gla_norm_w + cv), gw1 = *(const f32x4*)(P.gla_norm_w + cv + 4);
    const f32x4 lw0 = *(const f32x4*)(P.ln_w + 8 * lane), lw1 = *(const f32x4*)(P.ln_w + 8 * lane + 4), lb0 = *(const f32x4*)(P.ln_b + 8 * lane), lb1 = *(const f32x4*)(P.ln_b + 8 * lane + 4);
    struct Ld { f32x4 a0, a1, b0, b1; u32x4 ga, gb, vv; float bon; };
    auto load = [&](int tok) { Ld L; const bf16* row = PROJ0 + (size_t)tok * N0P + C_GATE0;
        { const u32x4 wa = *(const u32x4*)(OA + (size_t)tok * 512 + 8 * lane), wb = *(const u32x4*)(OB + (size_t)tok * 512 + 8 * lane);
          L.a0 = (f32x4){bflo(wa.x), bfhi(wa.x), bflo(wa.y), bfhi(wa.y)}; L.a1 = (f32x4){bflo(wa.z), bfhi(wa.z), bflo(wa.w), bfhi(wa.w)};
          L.b0 = (f32x4){bflo(wb.x), bfhi(wb.x), bflo(wb.y), bfhi(wb.y)}; L.b1 = (f32x4){bflo(wb.z), bfhi(wb.z), bflo(wb.w), bfhi(wb.w)}; }
        L.ga = *(const u32x4*)(row + 8 * lane); L.gb = *(const u32x4*)(row + 512 + 8 * lane); L.vv = *(const u32x4*)(VP + (size_t)tok * 512 + 8 * lane); L.bon = BON[(size_t)tok * 8 + (lane >> 3)]; return L; };
    Ld nx = load(gw < M ? gw : 0);
    for (int tok = gw; tok < M; tok += NGW) {
        const Ld L = nx;
        if (tok + NGW < M) nx = load(tok + NGW);
        {
            const f32x4 a0 = L.a0, a1 = L.a1;
            float ss = (a0[0] * a0[0] + a0[1] * a0[1]) + (a0[2] * a0[2] + a0[3] * a0[3]) + (a1[0] * a1[0] + a1[1] * a1[1]) + (a1[2] * a1[2] + a1[3] * a1[3]);
            ss += __shfl_xor(ss, 1); ss += __shfl_xor(ss, 2); ss += __shfl_xor(ss, 4); ss += __shfl_xor(ss, 8);
            const float rstd = 1.0f / sqrtf(ss * (1.f / 128.f) + NORM_EPS);
            const u32x4 g = L.ga;
            u32x4 o;
            o.x = pk2(a0[0] * rstd * gw0[0] * silu_f(bflo(g.x)), a0[1] * rstd * gw0[1] * silu_f(bfhi(g.x)));
            o.y = pk2(a0[2] * rstd * gw0[2] * silu_f(bflo(g.y)), a0[3] * rstd * gw0[3] * silu_f(bfhi(g.y)));
            o.z = pk2(a1[0] * rstd * gw1[0] * silu_f(bflo(g.z)), a1[1] * rstd * gw1[1] * silu_f(bfhi(g.z)));
            o.w = pk2(a1[2] * rstd * gw1[2] * silu_f(bflo(g.w)), a1[3] * rstd * gw1[3] * silu_f(bfhi(g.w)));
            *(u32x4*)(O0 + (size_t)tok * 1024 + 8 * lane) = o;
        }
        {
            const f32x4 a0 = L.b0, a1 = L.b1;
            float s = (a0[0] + a0[1]) + (a0[2] + a0[3]) + (a1[0] + a1[1]) + (a1[2] + a1[3]);
            s += __shfl_xor(s, 1); s += __shfl_xor(s, 2); s += __shfl_xor(s, 4);
            const float mean = s * (1.f / 64.f);
            const f32x4 d0 = a0 - mean, d1 = a1 - mean;
            float q = (d0[0] * d0[0] + d0[1] * d0[1]) + (d0[2] * d0[2] + d0[3] * d0[3]) + (d1[0] * d1[0] + d1[1] * d1[1]) + (d1[2] * d1[2] + d1[3] * d1[3]);
            q += __shfl_xor(q, 1); q += __shfl_xor(q, 2); q += __shfl_xor(q, 4);
            const float rstd = 1.0f / sqrtf(q * (1.f / 64.f) + RWKV_LN_EPS);
            const float bon = L.bon; const u32x4 vv = L.vv, g = L.gb;
            u32x4 o;
            o.x = pk2((d0[0] * rstd * lw0[0] + lb0[0] + bon * bflo(vv.x)) * silu_f(bflo(g.x)), (d0[1] * rstd * lw0[1] + lb0[1] + bon * bfhi(vv.x)) * silu_f(bfhi(g.x)));
            o.y = pk2((d0[2] * rstd * lw0[2] + lb0[2] + bon * bflo(vv.y)) * silu_f(bflo(g.y)), (d0[3] * rstd * lw0[3] + lb0[3] + bon * bfhi(vv.y)) * silu_f(bfhi(g.y)));
            o.z = pk2((d1[0] * rstd * lw1[0] + lb1[0] + bon * bflo(vv.z)) * silu_f(bflo(g.z)), (d1[1] * rstd * lw1[1] + lb1[1] + bon * bfhi(vv.z)) * silu_f(bfhi(g.z)));
            o.w = pk2((d1[2] * rstd * lw1[2] + lb1[2] + bon * bflo(vv.w)) * silu_f(bflo(g.w)), (d1[3] * rstd * lw1[3] + lb1[3] + bon * bfhi(vv.w)) * silu_f(bfhi(g.w)));
            *(u32x4*)(O0 + (size_t)tok * 1024 + 512 + 8 * lane) = o;
        }
    }
}
constexpr int AT_KP = 144, AT_VP = 528, AT_VOFF = 256 * AT_KP;
DI void rope_cs(const float* RT, int pos, float (&cs)[8], float (&sn)[8]) {
    const f32x4* tp = (const f32x4*)(RT + (size_t)pos * 16);
#pragma unroll
    for (int q = 0; q < 4; ++q) { const f32x4 v = tp[q]; cs[2 * q] = v[0]; sn[2 * q] = v[1]; cs[2 * q + 1] = v[2]; sn[2 * q + 1] = v[3]; }
}
DI void p7_attn(const Params& P, LAS unsigned char* lds, int tid, int wave, int lane) {
    const bf16* PROJ1 = (const bf16*)(P.ws + WS_SCR); bf16* O1 = (bf16*)(P.ws + WS_XN); const float* RT = (const float*)(P.ws + WS_ROPE);
    const int vcu = ((int)blockIdx.x & 7) * ((int)gridDim.x >> 3) + ((int)blockIdx.x >> 3);
    const int m = lane & 31, hi = lane >> 5;
    const int c8 = tid & 7, kpar = (tid >> 3) & 1;
    u32x4 kw[4], vw[4];
    auto uload = [&](int unit) {
        const int qb = unit & 31, kvh = (unit >> 5) & 3, b = unit >> 7;
#pragma unroll
        for (int q = 0; q < 4; ++q) { const int key = (tid >> 3) + 64 * q; const int pos = qb * 128 - 128 + key;
            kw[q] = (u32x4){0u, 0u, 0u, 0u}; vw[q] = (u32x4){0u, 0u, 0u, 0u};
            if (pos >= 0) { const bf16* row = PROJ1 + (size_t)(b * T + pos) * IN1; kw[q] = *(const u32x4*)(row + 1024 + kvh * 64 + 8 * c8); vw[q] = *(const u32x4*)(row + 1280 + kvh * 64 + 8 * c8); } }
    };
    if (vcu < 512) uload(vcu);
    struct QG { u32x4 q[4], qo; u32x2 g[8]; };
    auto qgload = [&](int unit, int qq) { QG r; const int qb = unit & 31, kvh = (unit >> 5) & 3, b = unit >> 7; const int h = kvh * 4 + (wave >> 1);
        const int pos = qb * 128 + (wave & 1) * 64 + 32 * qq + m; const bf16* row = PROJ1 + ((size_t)b * T + pos) * IN1;
#pragma unroll
        for (int s = 0; s < 4; ++s) r.q[s] = *(const u32x4*)(row + h * 64 + 16 * s + 8 * hi);
        r.qo = *(const u32x4*)(row + h * 64 + 8 * (hi ^ 1));
#pragma unroll
        for (int db = 0; db < 2; ++db)
#pragma unroll
            for (int gq = 0; gq < 4; ++gq) r.g[4 * db + gq] = *(const u32x2*)(row + 1536 + h * 64 + 32 * db + 8 * gq + 4 * hi);
        return r; };
    QG nxq = qgload(vcu < 512 ? vcu : 0, 0);
    for (int unit = vcu; unit < 512; unit += gridDim.x) {
        const int qb = unit & 31, kvh = (unit >> 5) & 3, b = unit >> 7;
#pragma unroll
        for (int q = 0; q < 4; ++q) {
            const int key = (tid >> 3) + 64 * q; const int pos = qb * 128 - 128 + key;
            u32x4 kq = kw[q];
            if (c8 < 2 && pos >= 0) { const bf16* row = PROJ1 + (size_t)(b * T + pos) * IN1;
                const u32x4 ow = *(const u32x4*)(row + 1024 + kvh * 64 + 8 * (c8 ^ 1)); float a[8], o[8], cs[8], sn[8]; unpack8(kq, a); unpack8(ow, o); rope_cs(RT, pos, cs, sn);
                float r[8];
#pragma unroll
                for (int j = 0; j < 8; ++j) r[j] = (c8 == 0) ? (a[j] * cs[j] - o[j] * sn[j]) : (a[j] * cs[j] + o[j] * sn[j]);
                kq.x = pk2(r[0], r[1]); kq.y = pk2(r[2], r[3]); kq.z = pk2(r[4], r[5]); kq.w = pk2(r[6], r[7]); }
            *(LAS u32x4*)(lds + key * AT_KP + c8 * 16) = kq;
            const u32x4 rv = vw[q];
            const unsigned k0 = kpar ? rv[2] : rv[0], k1 = kpar ? rv[3] : rv[1], s0 = kpar ? rv[0] : rv[2], s1 = kpar ? rv[1] : rv[3];
            const unsigned r0 = (unsigned)__builtin_amdgcn_update_dpp(0, (int)s0, 0x128, 0xf, 0xf, true), r1 = (unsigned)__builtin_amdgcn_update_dpp(0, (int)s1, 0x128, 0xf, 0xf, true);
            unsigned o4[4];
            if (kpar == 0) { o4[0] = (k0 & 0xffffu) | (r0 << 16); o4[1] = (k0 >> 16) | (r0 & 0xffff0000u); o4[2] = (k1 & 0xffffu) | (r1 << 16); o4[3] = (k1 >> 16) | (r1 & 0xffff0000u); }
            else           { o4[0] = (r0 & 0xffffu) | (k0 << 16); o4[1] = (r0 >> 16) | (k0 & 0xffff0000u); o4[2] = (r1 & 0xffffu) | (k1 << 16); o4[3] = (r1 >> 16) | (k1 & 0xffff0000u); }
            const int tp = key >> 1, gsw = (tp >> 2) ^ c8;
#pragma unroll
            for (int jj = 0; jj < 4; ++jj) *(LAS unsigned*)(lds + AT_VOFF + (8 * c8 + 4 * kpar + jj) * AT_VP + (4 * gsw + (tp & 3)) * 4) = o4[jj];
        }
        lds_barrier();
        if (unit + (int)gridDim.x < 512) uload(unit + gridDim.x);
        const int g = wave >> 1, h = kvh * 4 + g; const float sink = P.sinks[h] * 1.44269504f;
        for (int qq = 0; qq < 2; ++qq) {
            const int qs = (wave & 1) * 64 + 32 * qq, qi = qs + m, pos = qb * 128 + qi; const size_t tok = (size_t)b * T + pos;
            const QG cq = nxq;
            { const int nu = (qq == 0) ? unit : unit + (int)gridDim.x; if (nu < 512) nxq = qgload(nu, qq ^ 1); }
            bf16x8 Q[4];
#pragma unroll
            for (int s = 0; s < 4; ++s) { const u32x4 w = cq.q[s]; float a[8]; unpack8(w, a);
                if (s == 0) { const u32x4 ow = cq.qo; float o[8], cs[8], sn[8]; unpack8(ow, o); rope_cs(RT, pos, cs, sn);
#pragma unroll
                    for (int j = 0; j < 8; ++j) a[j] = (hi == 0) ? (a[j] * cs[j] - o[j] * sn[j]) : (a[j] * cs[j] + o[j] * sn[j]); }
                u32x4 qw;
#pragma unroll
                for (int e = 0; e < 4; ++e) qw[e] = pk2(a[2 * e] * 0.18033688f, a[2 * e + 1] * 0.18033688f);
                Q[s] = __builtin_bit_cast(bf16x8, qw); }
            const int kb0 = qs >> 5;
            f32x16 sc[5];
#pragma unroll
            for (int kbi = 0; kbi < 5; ++kbi) {
#pragma unroll
                for (int i = 0; i < 16; ++i) sc[kbi][i] = 0.f;
#pragma unroll
                for (int s = 0; s < 4; ++s) { const bf16x8 A = *(const LAS bf16x8*)(lds + (32 * (kb0 + kbi) + m) * AT_KP + (16 * s + 8 * hi) * 2); sc[kbi] = MFMA32(A, Q[s], sc[kbi]); }
            }
            float mx = sink;
#pragma unroll
            for (int kbi = 0; kbi < 5; ++kbi)
#pragma unroll
                for (int i = 0; i < 16; ++i) { const int kj = 32 * (kb0 + kbi) + crow(i, hi);
                    const bool band = (kbi == 0) ? (kj >= qi + 1) : ((kbi == 4) ? (kj <= qi + 128) : true); const bool vis = band && (qb > 0 || kj >= 128);
                    sc[kbi][i] = vis ? sc[kbi][i] : -1e30f; mx = fmaxf(mx, sc[kbi][i]); }
            mx = fmaxf(mx, __shfl_xor(mx, 32));
            float sum = 0.f;
#pragma unroll
            for (int kbi = 0; kbi < 5; ++kbi)
#pragma unroll
                for (int i = 0; i < 16; ++i) { const float pv = __builtin_amdgcn_exp2f(sc[kbi][i] - mx); sc[kbi][i] = pv; sum += pv; }
            sum += __shfl_xor(sum, 32);
            const float inv = __builtin_amdgcn_rcpf(sum + __builtin_amdgcn_exp2f(sink - mx));
            f32x16 oacc[2];
#pragma unroll
            for (int db = 0; db < 2; ++db) {
#pragma unroll
                for (int i = 0; i < 16; ++i) oacc[db][i] = 0.f;
                const int vrow = 32 * db + m, rsw = (vrow >> 3) & 7;
#pragma unroll
                for (int kbi = 0; kbi < 5; ++kbi)
#pragma unroll
                    for (int s2 = 0; s2 < 2; ++s2) { u32x4 pw;
#pragma unroll
                        for (int e = 0; e < 4; ++e) pw[e] = pk2(sc[kbi][8 * s2 + 2 * e], sc[kbi][8 * s2 + 2 * e + 1]);
                        const int ga = 4 * (kb0 + kbi) + 2 * s2;
                        const LAS unsigned char* vp = lds + AT_VOFF + vrow * AT_VP + 8 * hi;
                        const u32x2 lo = *(const LAS u32x2*)(vp + (ga ^ rsw) * 16), hi2 = *(const LAS u32x2*)(vp + ((ga + 1) ^ rsw) * 16);
                        const u32x4 aw = (u32x4){lo.x, lo.y, hi2.x, hi2.y};
                        oacc[db] = MFMA32(__builtin_bit_cast(bf16x8, aw), __builtin_bit_cast(bf16x8, pw), oacc[db]); }
            }
#pragma unroll
            for (int db = 0; db < 2; ++db)
#pragma unroll
                for (int gq = 0; gq < 4; ++gq) { const int d0 = 32 * db + 8 * gq + 4 * hi; const u32x2 gw = cq.g[4 * db + gq];
                    u32x2 o; o.x = pk2(oacc[db][4 * gq] * inv * silu_f(bflo(gw.x)), oacc[db][4 * gq + 1] * inv * silu_f(bfhi(gw.x)));
                    o.y = pk2(oacc[db][4 * gq + 2] * inv * silu_f(bflo(gw.y)), oacc[db][4 * gq + 3] * inv * silu_f(bfhi(gw.y)));
                    *(u32x2*)(O1 + tok * 1024 + h * 64 + d0) = o; }
        }
        lds_barrier();
    }
}
DI void p9_final(const Params& P, int wave, int lane) {
    const int gw = blockIdx.x * 8 + wave, NGW = gridDim.x * 8;
    const float* slots = (const float*)(P.ws + WS_SLOT2);
    for (int mrow = gw; mrow < M; mrow += NGW) {
        float s = (lane < 16) ? slots[(size_t)mrow * 16 + lane] : 0.f;
        s += __shfl_xor(s, 1); s += __shfl_xor(s, 2); s += __shfl_xor(s, 4); s += __shfl_xor(s, 8);
        s = __shfl(s, 0);
        const float rstd = 1.0f / sqrtf(s * (1.f / 1024.f) + NORM_EPS);
        f32x4* o = (f32x4*)(P.out + (size_t)mrow * D) + lane; const f32x4* w = (const f32x4*)P.final_w + lane;
#pragma unroll
        for (int j = 0; j < 4; ++j) { const f32x4 v = o[64 * j]; o[64 * j] = v * rstd * w[64 * j]; }
    }
}

__global__ void __launch_bounds__(512) fwd_megakernel(Params P) {
    extern __shared__ __attribute__((aligned(16))) unsigned char lds_raw[];
    LAS unsigned char* lds = (LAS unsigned char*)lds_raw;
    cg::grid_group grid = cg::this_grid();
    const int tid = threadIdx.x, lane = tid & 63, wave = __builtin_amdgcn_readfirstlane(tid >> 6);
    const int G = gridDim.x;
    if (tid < 2) ((LAS unsigned*)(lds + LDS_BAR_OFF))[tid] = 0u;
    __syncthreads();
    if (tid == 0) ((unsigned*)(P.ws + WS_XCCTAB))[blockIdx.x] = xb_xcc_id() + 1u;
    const XcdBarrier xbar = xcd_barrier_post((unsigned*)(P.ws + WS_CTL), (volatile LAS unsigned*)(lds + LDS_BAR_OFF));
    bf16* XN = (bf16*)(P.ws + WS_XN);
    p0_prologue(P, lds, wave, lane);
    if (P.ws == nullptr) grid.sync();
    xcd_barrier(xbar);
    { pg8::Gemm g{XN, (const bf16*)(P.ws + WS_W0T), M, N0P, D}; pg8::StaticOrder S; S.init(M, N0P, G, (int)blockIdx.x);
      EpiScaleBf16 E{(bf16*)(P.ws + WS_PROJ0), N0P, nullptr, nullptr, 0};
      pg8::gemm_phase<EpiScaleBf16, pg8::StaticOrder, true, true>(lds, g, S, E); }
    xcd_barrier(xbar);
#pragma unroll 1
    for (int rep = 0; rep < REP_P2R; ++rep) { for (int it = blockIdx.x; it < 512; it += G) rwkv_prep_item(P, it, lds, wave, lane); }
#pragma unroll 1
    for (int rep = 0; rep < REP_P2G; ++rep) { for (int it = blockIdx.x; it < 1024; it += G) gla_prep_item(P, it, lds, wave, lane); }
    xcd_barrier(xbar);
#pragma unroll 1
    for (int rep = 0; rep < REP_P3; ++rep) { p3_seq(P, lds, tid, wave, lane); __syncthreads(); }
    xcd_barrier(xbar);
    p4_finalize(P, wave, lane);
    xcd_barrier(xbar);
    { pg8::Gemm g{XN, (const bf16*)(P.ws + WS_WO0T), M, D, D}; pg8::StaticOrder S; S.init(M, D, G, (int)blockIdx.x);
      EpiResid E{P.x, (bf16*)(P.ws + WS_H1B), (float*)(P.ws + WS_SLOT1)};
      pg8::gemm_phase<EpiResid, pg8::StaticOrder, true, true>(lds, g, S, E); }
    xcd_barrier(xbar);
    { pg8::Gemm g{(const bf16*)(P.ws + WS_H1B), (const bf16*)(P.ws + WS_W1T), M, IN1, D}; pg8::StaticOrder S; S.init(M, IN1, G, (int)blockIdx.x);
      EpiScaleBf16 E{(bf16*)(P.ws + WS_SCR), IN1, (const float*)(P.ws + WS_SLOT1), P.b_in1, 1536};
      pg8::gemm_phase<EpiScaleBf16, pg8::StaticOrder, true, true>(lds, g, S, E); }
    xcd_barrier(xbar);
    p7_attn(P, lds, tid, wave, lane);
    xcd_barrier(xbar);
    { pg8::Gemm g{XN, (const bf16*)(P.ws + WS_WO1T), M, D, D}; pg8::StaticOrder S; S.init(M, D, G, (int)blockIdx.x);
      EpiResidNorm E{(const bf16*)(P.ws + WS_H1B), P.out, P.b_out1, P.final_w, (float*)(P.ws + WS_SLOT2), (unsigned*)(P.ws + WS_PCNT)};
      pg8::gemm_phase<EpiResidNorm, pg8::StaticOrder, false, true>(lds, g, S, E); }
}

extern "C" void kernel_launch(void* const* d_in, const int* in_sizes, int n_in, void* d_out, int out_size, void* d_ws, size_t ws_size, hipStream_t stream) {
    static int grid = 0;
    if (grid == 0) {
        if (n_in != 23 || out_size != M * D || ws_size < WS_END) { fprintf(stderr, "kernel_launch: unexpected sizes n_in %d out %d ws %zu\n", n_in, out_size, ws_size); grid = -1; return; }
        int dev = 0, cus = 0, per_cu = 0;
        hipGetDevice(&dev); hipDeviceGetAttribute(&cus, hipDeviceAttributeMultiprocessorCount, dev);
        hipFuncSetAttribute((const void*)fwd_megakernel, hipFuncAttributeMaxDynamicSharedMemorySize, LDS_BYTES);
        hipOccupancyMaxActiveBlocksPerMultiprocessor(&per_cu, (const void*)fwd_megakernel, 512, LDS_BYTES);
        if (per_cu < 1) { fprintf(stderr, "kernel_launch: occupancy query says %d blocks/CU\n", per_cu); per_cu = 1; }
        grid = cus * 1;
        if (grid != 256) { fprintf(stderr, "kernel_launch: built for a 256-CU device (got %d)\n", cus); grid = -1; return; }
        (void)hipGetLastError();
    }
    if (grid < 0) return;
    Params p{};
    const float** pp = (const float**)&p;
    for (int i = 0; i < 23; ++i) pp[i] = (const float*)d_in[i];
    p.out = (float*)d_out; p.ws = (unsigned char*)d_ws;
    if (hipMemsetAsync((char*)d_ws + WS_CTL, 0, CTL_BYTES, stream) != hipSuccess) { fprintf(stderr, "memset failed\n"); return; }
    void* args[] = {&p};
    hipError_t e = hipLaunchCooperativeKernel((const void*)fwd_megakernel, dim3(grid), dim3(512), args, LDS_BYTES, stream);
    if (e != hipSuccess) fprintf(stderr, "cooperative launch failed: %s (grid %d)\n", hipGetErrorString(e), grid);
}
```

```cpp
#include <hip/hip_runtime.h>
#include <hip/hip_cooperative_groups.h>
#include <cstdio>
#include <cstdint>
namespace cg = cooperative_groups;
#ifndef REP_P2R
#define REP_P2R 1
#endif
#ifndef REP_P2G
#define REP_P2G 1
#endif
#ifndef REP_S2
#define REP_S2 1
#endif
#ifndef REP_P3
#define REP_P3 1
#endif
namespace pg8 {
#define PG8_LAS __attribute__((address_space(3)))
typedef unsigned short bf16_t;
typedef short bf16x8 __attribute__((ext_vector_type(8)));
typedef float f32x4 __attribute__((ext_vector_type(4)));
typedef unsigned u32x4 __attribute__((ext_vector_type(4)));
constexpr int BM = 256, BK = 64, HALF = 128, HTB = HALF * BK * 2  , STAGE_BYTES = 8 * HTB, NXCD = 8, WGM = 8;

__host__ __device__ __forceinline__ int lds_byte(int r, int c) { const int st = (r >> 4) * 2 + (c >> 5), rr = r & 15, cc = c & 31, ob = rr * 64 + cc * 2; return st * 1024 + (ob ^ (((ob >> 9) & 1) << 5)); }
__host__ __device__ __forceinline__ void stage_rc(int b, int& R, int& C) { const int st = b / 1024, sb = b % 1024, swz = sb ^ (((sb >> 9) & 1) << 5); R = (st >> 1) * 16 + swz / 64; C = (st & 1) * 32 + (swz % 64) / 2; }
__host__ __device__ __forceinline__ int perm32(int rho) { const int n = rho >> 4, i = rho & 15; return 8 * (i >> 2) + 4 * n + (i & 3); }

struct Unit { int pm, pn; };
struct Gemm { const bf16_t* A; const bf16_t* Bt; int M, N, K; };

struct StaticOrder {
    int nM, nN, nwg, G, c;
    __host__ __device__ void init(int M, int N, int G_, int c_) { nM = M / BM; nN = N / BM; nwg = nM * nN; G = G_; c = c_; }
    __host__ __device__ bool next(int i, Unit& u) const {
        const long L = (long)i * G + c; if (L >= nwg) return false;
        int wgid = (int)L; { const int q = nwg / NXCD, r = nwg % NXCD, xcd = wgid % NXCD, off = wgid / NXCD; wgid = (xcd < r ? xcd * (q + 1) : r * (q + 1) + (xcd - r) * q) + off; }
        const int nig = WGM * nN, gid = wgid / nig, fm = gid * WGM, gsz = (nM - fm) < WGM ? (nM - fm) : WGM;
        u.pm = fm + ((wgid % nig) % gsz); u.pn = (wgid % nig) / gsz; return true;
    }
    __device__ __forceinline__ void a_ready(const Unit&) const {}
    __device__ __forceinline__ void done(const Unit&) const {}
};

template <class Epi, class Sched, bool ALIGN_EPI = false, bool SP2 = false>
__device__ __forceinline__ void gemm_phase(PG8_LAS unsigned char* lds, const Gemm g, const Sched& S, const Epi& E) {
    const int tid = threadIdx.x, wid = __builtin_amdgcn_readfirstlane(tid >> 6), lane = tid & 63, wr = wid >> 2, wc = wid & 3, fr = lane & 15, fq = lane >> 4;
    const int K = g.K, nt = K / BK;
    unsigned voffA[2], voffB[2];
#pragma unroll
    for (int i = 0; i < 2; ++i) { int R, C; stage_rc(tid * 16 + i * 8192, R, C); const int Rb = Epi::PERM ? ((R & ~31) + perm32(R & 31)) : R;
        voffA[i] = (unsigned)(R * K + C) * 2u; voffB[i] = (unsigned)(Rb * K + C) * 2u; }
    const size_t kstep = (size_t)(BK * 2);
    const size_t hstep = (size_t)HALF * K * 2;
    const size_t tstep = 2 * hstep;
    const unsigned ldsw = (unsigned)wid * 1024u;
    const int aoff = lds_byte(wr * 64 + fr, fq * 8), boff = lds_byte(wc * 32 + fr, fq * 8);
#define PG8_SA(b, h) (((b) * 2 + (h)) * HTB)
#define PG8_SB(b, h) ((4 + (b) * 2 + (h)) * HTB)
#define PG8_STAGE(bufoff, gbase, voff) do { _Pragma("unroll") for (int _i = 0; _i < 2; ++_i) \
        __builtin_amdgcn_global_load_lds((const unsigned*)((const char*)(gbase) + (voff)[_i]), (PG8_LAS unsigned*)(lds + (bufoff) + ldsw + _i * 8192), 16, 0, 0); } while (0)
#define PG8_LDA(dst, b, h) do { _Pragma("unroll") for (int m = 0; m < 4; ++m) _Pragma("unroll") for (int k = 0; k < 2; ++k) dst[m][k] = *(const PG8_LAS bf16x8*)(lds + PG8_SA(b, h) + aoff + m * 2048 + k * 1024); } while (0)
#define PG8_LDB(dst, b, h) do { _Pragma("unroll") for (int n = 0; n < 2; ++n) _Pragma("unroll") for (int k = 0; k < 2; ++k) dst[n][k] = *(const PG8_LAS bf16x8*)(lds + PG8_SB(b, h) + boff + n * 2048 + k * 1024); } while (0)
#define PG8_MMA(ai, bj, At, Bt) do { __builtin_amdgcn_s_setprio(1); _Pragma("unroll") for (int m = 0; m < 4; ++m) _Pragma("unroll") for (int n = 0; n < 2; ++n) _Pragma("unroll") for (int k = 0; k < 2; ++k) \
        acc[ai][bj][m][n] = __builtin_amdgcn_mfma_f32_16x16x32_bf16(Bt[n][k], At[m][k], acc[ai][bj][m][n], 0, 0, 0); __builtin_amdgcn_s_setprio(0); } while (0)
#define PG8_WAIT_V(n) asm volatile("s_waitcnt vmcnt(" #n ")" ::: "memory")
#define PG8_WAIT_L(n) asm volatile("s_waitcnt lgkmcnt(" #n ")" ::: "memory")
#define PG8_BAR __builtin_amdgcn_s_barrier()
#define PG8_SCHED __builtin_amdgcn_sched_barrier(0)
    Unit cur, nxt; int ui = 0;
    if (!S.next(0, cur)) return;
    f32x4 acc[2][2][4][2];
#pragma unroll
    for (int a = 0; a < 2; ++a)
#pragma unroll
        for (int b = 0; b < 2; ++b)
#pragma unroll
            for (int m = 0; m < 4; ++m)
#pragma unroll
                for (int n = 0; n < 2; ++n) acc[a][b][m][n] = (f32x4){0.f, 0.f, 0.f, 0.f};
    bf16x8 At[4][2], B0[2][2], B1[2][2];
    const char* cA = (const char*)g.A + (size_t)cur.pm * tstep; const char* cB = (const char*)g.Bt + (size_t)cur.pn * tstep;
    S.a_ready(cur);
    if constexpr (SP2) {
        PG8_STAGE(PG8_SB(0, 0), cB, voffB); PG8_STAGE(PG8_SB(0, 1), cB + hstep, voffB); PG8_STAGE(PG8_SA(0, 0), cA, voffA); PG8_STAGE(PG8_SA(0, 1), cA + hstep, voffA);
        if (wr == 1) PG8_BAR;
        PG8_WAIT_V(2); PG8_BAR;
        PG8_STAGE(PG8_SB(1, 0), cB + kstep, voffB); PG8_STAGE(PG8_SA(1, 0), cA + kstep, voffA); PG8_STAGE(PG8_SB(1, 1), cB + hstep + kstep, voffB);
        PG8_WAIT_V(6); PG8_BAR;
    } else {
        PG8_STAGE(PG8_SB(0, 0), cB, voffB); PG8_STAGE(PG8_SA(0, 0), cA, voffA); PG8_STAGE(PG8_SB(0, 1), cB + hstep, voffB); PG8_STAGE(PG8_SA(0, 1), cA + hstep, voffA);
        if (wr == 1) PG8_BAR;
        PG8_WAIT_V(4); PG8_BAR;
        PG8_STAGE(PG8_SB(1, 0), cB + kstep, voffB); PG8_STAGE(PG8_SA(1, 0), cA + kstep, voffA); PG8_STAGE(PG8_SB(1, 1), cB + hstep + kstep, voffB);
        PG8_WAIT_V(6); PG8_BAR;
    }
    for (;;) {
        const bool has_next = S.next(ui + 1, nxt);
        const char* nA = has_next ? (const char*)g.A + (size_t)nxt.pm * tstep : cA; const char* nB = has_next ? (const char*)g.Bt + (size_t)nxt.pn * tstep : cB;
        for (int t = 0; t < nt; t += 2) {
            const bool last = (t == nt - 2);
            const char* a1 = cA + (size_t)(t + 1) * kstep;
            const char* a2 = last ? nA : cA + (size_t)(t + 2) * kstep; const char* b2 = last ? nB : cB + (size_t)(t + 2) * kstep;
            const char* a3 = a2 + kstep; const char* b3 = b2 + kstep;
            if (last && has_next) S.a_ready(nxt);
            if constexpr (SP2) {
            PG8_LDB(B0, 0, 0); PG8_LDB(B1, 0, 1); PG8_SCHED; PG8_LDA(At, 0, 0); PG8_STAGE(PG8_SA(1, 1), a1 + hstep, voffA);
            PG8_WAIT_V(8); PG8_WAIT_L(0); PG8_BAR; PG8_MMA(0, 0, At, B0); PG8_MMA(0, 1, At, B1); PG8_BAR; PG8_SCHED;
            PG8_LDA(At, 0, 1); PG8_STAGE(PG8_SB(0, 0), b2, voffB); PG8_STAGE(PG8_SB(0, 1), b2 + hstep, voffB); PG8_STAGE(PG8_SA(0, 0), a2, voffA);
            PG8_WAIT_V(8); PG8_WAIT_L(0); PG8_BAR; PG8_MMA(1, 0, At, B0); PG8_MMA(1, 1, At, B1); PG8_BAR; PG8_SCHED;
            PG8_LDB(B0, 1, 0); PG8_LDB(B1, 1, 1); PG8_SCHED; PG8_LDA(At, 1, 0); PG8_STAGE(PG8_SA(0, 1), a2 + hstep, voffA);
            PG8_WAIT_V(8); PG8_WAIT_L(0); PG8_BAR; PG8_MMA(0, 0, At, B0); PG8_MMA(0, 1, At, B1); PG8_BAR; PG8_SCHED;
            PG8_LDA(At, 1, 1); PG8_STAGE(PG8_SB(1, 0), b3, voffB); PG8_STAGE(PG8_SB(1, 1), b3 + hstep, voffB); PG8_STAGE(PG8_SA(1, 0), a3, voffA);
            PG8_WAIT_V(8); PG8_WAIT_L(0); PG8_BAR; PG8_MMA(1, 0, At, B0); PG8_MMA(1, 1, At, B1); PG8_BAR; PG8_SCHED;
            } else {
            PG8_LDB(B0, 0, 0); PG8_SCHED; PG8_LDA(At, 0, 0); PG8_STAGE(PG8_SA(1, 1), a1 + hstep, voffA);
            PG8_WAIT_L(8); PG8_BAR; PG8_WAIT_L(0); PG8_MMA(0, 0, At, B0); PG8_BAR; PG8_SCHED;
            PG8_LDB(B1, 0, 1); PG8_STAGE(PG8_SB(0, 0), b2, voffB);
            PG8_BAR; PG8_WAIT_L(0); PG8_MMA(0, 1, At, B1); PG8_BAR;
            PG8_LDA(At, 0, 1); PG8_STAGE(PG8_SA(0, 0), a2, voffA);
            PG8_BAR; PG8_WAIT_L(0); PG8_MMA(1, 0, At, B0); PG8_BAR; PG8_SCHED;
            PG8_STAGE(PG8_SB(0, 1), b2 + hstep, voffB);
            PG8_WAIT_V(6); PG8_BAR; PG8_MMA(1, 1, At, B1); PG8_BAR;
            PG8_LDB(B0, 1, 0); PG8_SCHED; PG8_LDA(At, 1, 0); PG8_STAGE(PG8_SA(0, 1), a2 + hstep, voffA);
            PG8_WAIT_L(8); PG8_BAR; PG8_WAIT_L(0); PG8_MMA(0, 0, At, B0); PG8_BAR; PG8_SCHED;
            PG8_LDB(B1, 1, 1); PG8_STAGE(PG8_SB(1, 0), b3, voffB);
            PG8_BAR; PG8_WAIT_L(0); PG8_MMA(0, 1, At, B1); PG8_BAR;
            PG8_LDA(At, 1, 1); PG8_STAGE(PG8_SA(1, 0), a3, voffA);
            PG8_BAR; PG8_WAIT_L(0); PG8_MMA(1, 0, At, B0); PG8_BAR; PG8_SCHED;
            PG8_STAGE(PG8_SB(1, 1), b3 + hstep, voffB);
            PG8_WAIT_V(6); PG8_BAR; PG8_MMA(1, 1, At, B1); PG8_BAR;
            }
        }
        if constexpr (ALIGN_EPI) { if (wr == 0) PG8_BAR; }
        if constexpr (!Epi::AFTER_DRAIN) { E(acc, cur, wr, wc, fr, fq); S.done(cur); }
        if (!has_next) break;
#pragma unroll
        for (int a = 0; a < 2; ++a)
#pragma unroll
            for (int b = 0; b < 2; ++b)
#pragma unroll
                for (int m = 0; m < 4; ++m)
#pragma unroll
                    for (int n = 0; n < 2; ++n) acc[a][b][m][n] = (f32x4){0.f, 0.f, 0.f, 0.f};
        cur = nxt; cA = nA; cB = nB; ++ui;
        if constexpr (ALIGN_EPI) { if (wr == 1) PG8_BAR; }
    }
    PG8_WAIT_V(0);
    if constexpr (!ALIGN_EPI) { if (wr == 0) PG8_BAR; }
    PG8_BAR;
    if constexpr (Epi::AFTER_DRAIN) { E.fused(acc, cur, wr, wc, fr, fq, lds, wid, lane); S.done(cur); }
#undef PG8_SA
#undef PG8_SB
#undef PG8_STAGE
#undef PG8_LDA
#undef PG8_LDB
#undef PG8_MMA
#undef PG8_WAIT_V
#undef PG8_WAIT_L
#undef PG8_BAR
#undef PG8_SCHED
}
}
#define GAS __attribute__((address_space(1)))
#define LAS __attribute__((address_space(3)))
#define AS4 __attribute__((address_space(4)))
#define DI __device__ __forceinline__
typedef unsigned short bf16;
typedef float f32x4 __attribute__((ext_vector_type(4)));
typedef float f32x16 __attribute__((ext_vector_type(16)));
typedef short bf16x8 __attribute__((ext_vector_type(8)));
typedef short s16x4 __attribute__((ext_vector_type(4)));
typedef unsigned u32x4 __attribute__((ext_vector_type(4)));
typedef unsigned u32x2 __attribute__((ext_vector_type(2)));
typedef __bf16 bf2v __attribute__((ext_vector_type(2)));

constexpr int NB = 4, T = 4096, M = NB * T, D = 1024;
constexpr int IN0 = 3728, N0P = 3840, IN1 = 2560;
constexpr int C_GQ = 0, C_GK = 256, C_GV = 512, C_GLOW = 1024, C_RW = 1040, C_GATE0 = 2704;
constexpr int C_RR = C_RW, C_RK = C_RW + 512, C_RV = C_RW + 1024, C_XW = C_RW + 1536, C_XA = C_RW + 1600;
constexpr float NORM_EPS = 1e-5f, RWKV_LN_EPS = 64e-5f;
constexpr size_t MiB = 1u << 20;
constexpr size_t WS_W0T = 0, WS_WO0T = 8 * MiB, WS_W1T = 10 * MiB, WS_WO1T = 15 * MiB;
constexpr size_t WS_SLOT1 = 17 * MiB, WS_SLOT2 = 18 * MiB, WS_BONUS = 19 * MiB, WS_GDEC = 19 * MiB + 512 * 1024;
constexpr size_t WS_CTL = 19 * MiB + 768 * 1024, CTL_BYTES = 40960, WS_PCNT = WS_CTL + 16384;
constexpr size_t WS_XCCTAB = WS_CTL + 32768, WS_PROG = WS_CTL + 33792;
constexpr int LDS_BAR_OFF = 147456 - 64;
constexpr size_t WS_ROPE = 18 * MiB + 512 * 1024;
constexpr size_t WS_WLT = 18 * MiB + 768 * 1024;
constexpr size_t WS_XN = 20 * MiB;
constexpr size_t WS_PROJ0 = 52 * MiB;
constexpr size_t WS_H1B = 116 * MiB;
constexpr size_t WS_SCR = 172 * MiB;
constexpr size_t WS_OARAW = 204 * MiB;
constexpr size_t WS_VP = 236 * MiB;
constexpr size_t WS_END = 252 * MiB;
constexpr int LDS_BYTES = 147456;

struct Params {
    const float *x, *norm_w, *w_in0, *gk_up, *gk_bias, *gla_norm_w, *mu, *w0, *w_up, *a0, *a_up, *k_k, *k_a, *r_k, *ln_w, *ln_b, *w_out0, *w_in1, *b_in1, *sinks, *w_out1, *b_out1, *final_w;
    float* out; unsigned char* ws;
};

typedef float f32x2v __attribute__((ext_vector_type(2)));
DI unsigned pk2(float lo, float hi) { const f32x2v f = {lo, hi}; return __builtin_bit_cast(unsigned, __builtin_convertvector(f, bf2v)); }
DI unsigned f2bf(float f) { return pk2(f, 0.f) & 0xffffu; }
DI float bf2f(unsigned h) { return __builtin_bit_cast(float, h << 16); }
DI float bflo(unsigned w) { return __builtin_bit_cast(float, w << 16); }
DI float bfhi(unsigned w) { return __builtin_bit_cast(float, w & 0xffff0000u); }
DI float wave_sum(float v) {
#pragma unroll
    for (int o = 1; o < 64; o <<= 1) v += __shfl_xor(v, o);
    return v;
}
DI float dpp_sum16(float v) {
    v += __builtin_bit_cast(float, __builtin_amdgcn_update_dpp(0, __builtin_bit_cast(int, v), 0xB1, 0xf, 0xf, true));
    v += __builtin_bit_cast(float, __builtin_amdgcn_update_dpp(0, __builtin_bit_cast(int, v), 0x4E, 0xf, 0xf, true));
    v += __builtin_bit_cast(float, __builtin_amdgcn_update_dpp(0, __builtin_bit_cast(int, v), 0x141, 0xf, 0xf, true));
    v += __builtin_bit_cast(float, __builtin_amdgcn_update_dpp(0, __builtin_bit_cast(int, v), 0x140, 0xf, 0xf, true));
    return v;
}
DI float half_sum32(float v) { v = dpp_sum16(v); return v + __shfl_xor(v, 16); }
DI void unpack8(const u32x4 w, float (&f)[8]) {
#pragma unroll
    for (int e = 0; e < 4; ++e) { f[2 * e] = bflo(w[e]); f[2 * e + 1] = bfhi(w[e]); }
}
DI int crow(int r, int hi) { return (r & 3) + 8 * (r >> 2) + 4 * hi; }
DI int kpos(int k) { const int o16 = k & 15; return (k & ~15) + 8 * ((o16 >> 2) & 1) + 4 * (o16 >> 3) + (o16 & 3); }
#define MFMA32(a, b, c) __builtin_amdgcn_mfma_f32_32x32x16_bf16((a), (b), (c), 0, 0, 0)
#define LDS_WAIT() asm volatile("s_waitcnt lgkmcnt(0)" ::: "memory")
DI void lds_barrier() { asm volatile("s_waitcnt lgkmcnt(0)" ::: "memory"); __builtin_amdgcn_s_barrier(); asm volatile("" ::: "memory"); }

#define XB_TMO      128
#define XB_XCNT(j)  (256  + 64 * (j))
#define XB_XSUB(j)  (1280 + 64 * (j))
#define XB_XGEN(j)  (2304 + 64 * (j))
#define XB_TOP      3328
#define XB_TOPGEN   3392
#define XCD_BAR_WORDS 3456
#define XB_SPIN_CAP (1u << 18)

__device__ __forceinline__ unsigned xb_ld(unsigned* p)              { return __hip_atomic_load(p, __ATOMIC_RELAXED, __HIP_MEMORY_SCOPE_AGENT); }
__device__ __forceinline__ unsigned xb_add(unsigned* p, unsigned v) { return __hip_atomic_fetch_add(p, v, __ATOMIC_RELAXED, __HIP_MEMORY_SCOPE_AGENT); }
__device__ __forceinline__ unsigned xb_xcc_id() { return (unsigned)__builtin_amdgcn_s_getreg((3 << 11) | 20) & 0xFu; }
#define XB_SPIN(cond, bar) do { unsigned _sp = 0; while (cond) { __builtin_amdgcn_s_sleep(1); \
    if ((++_sp & 255u) == 0u) { if (xb_ld(&(bar)[XB_TMO])) break; if (_sp > XB_SPIN_CAP) { atomicAdd(&(bar)[XB_TMO], 1u); break; } } } } while (0)

struct XcdBarrier {
    unsigned* bar; unsigned x;
    volatile LAS unsigned* st;
};

__device__ __forceinline__ XcdBarrier xcd_barrier_post(unsigned* bar, volatile LAS unsigned* st) {
    XcdBarrier b; b.bar = bar; b.x = xb_xcc_id(); b.st = st;
    if (threadIdx.x == 0) (void)xb_add(&bar[XB_XCNT(b.x)], 1u);
    return b;
}
__device__ __forceinline__ void xcd_barrier_complete(unsigned* bar, unsigned x, unsigned& nloc, unsigned& nx) {
    const unsigned G = gridDim.x * gridDim.y * gridDim.z;
    unsigned sum, cnt, mine, sp = 0u;
    for (;;) {
        sum = 0u; cnt = 0u; mine = 0u;
#pragma unroll
        for (unsigned j = 0; j < 16; ++j) { const unsigned c = xb_ld(&bar[XB_XCNT(j)]); sum += c; cnt += (c > 0u) ? 1u : 0u; mine = (j == x) ? c : mine; }
        if (sum == G) break;
        __builtin_amdgcn_s_sleep(1);
        if ((++sp & 255u) == 0u) { if (xb_ld(&bar[XB_TMO])) break; if (sp > XB_SPIN_CAP) { atomicAdd(&bar[XB_TMO], 1u); break; } }
    }
    nloc = mine > 0u ? mine : 1u; nx = cnt > 0u ? cnt : 1u;
}

__device__ __forceinline__ void xcd_barrier(const XcdBarrier& b) {
    asm volatile("s_waitcnt vmcnt(0)" ::: "memory");
    __syncthreads();
    if (threadIdx.x == 0) {
        unsigned* bar = b.bar;
        __builtin_amdgcn_s_waitcnt(0);
        unsigned nloc = b.st[0], nx = b.st[1];
        if (nloc == 0u) { xcd_barrier_complete(bar, b.x, nloc, nx); b.st[0] = nloc; b.st[1] = nx; }
        const unsigned old = xb_add(&bar[XB_XSUB(b.x)], 1u);
        const unsigned gen = old / nloc;
        if (old + 1u == (gen + 1u) * nloc) {
            __builtin_amdgcn_fence(__ATOMIC_RELEASE, "agent");
            asm volatile("s_waitcnt vmcnt(0)" ::: "memory");
            const unsigned og = xb_add(&bar[XB_TOP], 1u);
            const unsigned tg = og / nx;
            if (og + 1u == (tg + 1u) * nx) xb_add(&bar[XB_TOPGEN], 1u);
            else XB_SPIN(xb_ld(&bar[XB_TOPGEN]) == tg, bar);
            __builtin_amdgcn_fence(__ATOMIC_ACQUIRE, "agent");
            xb_add(&bar[XB_XGEN(b.x)], 1u);
            asm volatile("s_waitcnt vmcnt(0)" ::: "memory");
        } else {
            XB_SPIN(xb_ld(&bar[XB_XGEN(b.x)]) == gen, bar);
            __builtin_amdgcn_fence(__ATOMIC_ACQUIRE, "agent");
            asm volatile("s_waitcnt vmcnt(0)" ::: "memory");
        }
    }
    __syncthreads();
}

struct EpiScaleBf16 {
    static constexpr bool PERM = true, AFTER_DRAIN = false;
    bf16* O; int ldc; const float* slots; const float* bias; int bias_n;
    DI void operator()(const pg8::f32x4 (&acc)[2][2][4][2], const pg8::Unit& u, int wr, int wc, int fr, int fq) const {
        const int row0 = u.pm * 256 + wr * 64 + fr, col0 = u.pn * 256 + wc * 32 + 8 * fq;
        const bool hb = bias && (u.pn * 256 < bias_n);
        f32x4 bv[2][2];
#pragma unroll
        for (int bj = 0; bj < 2; ++bj)
#pragma unroll
            for (int n = 0; n < 2; ++n) bv[bj][n] = hb ? *(const f32x4*)(bias + col0 + bj * 128 + 4 * n) : (f32x4){0.f, 0.f, 0.f, 0.f};
#pragma unroll
        for (int ai = 0; ai < 2; ++ai)
#pragma unroll
            for (int m = 0; m < 4; ++m) {
                const int row = row0 + ai * 128 + m * 16; float rs = 1.f;
                if (slots) { const f32x4* sp = (const f32x4*)(slots + (size_t)row * 16); const f32x4 a = sp[0], b = sp[1], c = sp[2], d = sp[3];
                    const float ss = ((a[0] + a[1]) + (a[2] + a[3])) + ((b[0] + b[1]) + (b[2] + b[3])) + ((c[0] + c[1]) + (c[2] + c[3])) + ((d[0] + d[1]) + (d[2] + d[3]));
                    rs = 1.0f / sqrtf(ss * (1.0f / 1024.0f) + NORM_EPS); }
                bf16* rowp = O + (size_t)row * ldc + col0;
#pragma unroll
                for (int bj = 0; bj < 2; ++bj) { const f32x4 v0 = acc[ai][bj][m][0] * rs + bv[bj][0], v1 = acc[ai][bj][m][1] * rs + bv[bj][1];
                    u32x4 w; w.x = pk2(v0[0], v0[1]); w.y = pk2(v0[2], v0[3]); w.z = pk2(v1[0], v1[1]); w.w = pk2(v1[2], v1[3]);
                    *(u32x4*)(rowp + bj * 128) = w; }
            }
    }
};
struct EpiResid {
    static constexpr bool PERM = false, AFTER_DRAIN = false;
    const float* base; bf16* outB; float* slots;
    DI void operator()(const pg8::f32x4 (&acc)[2][2][4][2], const pg8::Unit& u, int wr, int wc, int fr, int fq) const {
        const int col0 = u.pn * 256 + wc * 32 + 4 * fq;
#pragma unroll
        for (int ai = 0; ai < 2; ++ai)
#pragma unroll
            for (int m = 0; m < 4; ++m) {
                const int row = u.pm * 256 + ai * 128 + wr * 64 + m * 16 + fr; const size_t off = (size_t)row * 1024 + col0; float ss = 0.f;
#pragma unroll
                for (int bj = 0; bj < 2; ++bj)
#pragma unroll
                    for (int n = 0; n < 2; ++n) { const f32x4 bs = *(const f32x4*)(base + off + bj * 128 + n * 16); const f32x4 v = bs + acc[ai][bj][m][n];
                        u32x2 w; w.x = pk2(v[0], v[1]); w.y = pk2(v[2], v[3]); *(u32x2*)(outB + off + bj * 128 + n * 16) = w;
                        ss += (v[0] * v[0] + v[1] * v[1]) + (v[2] * v[2] + v[3] * v[3]); }
                ss += __shfl_xor(ss, 16); ss += __shfl_xor(ss, 32);
                if (fq == 0) slots[(size_t)row * 16 + u.pn * 4 + wc] = ss;
            }
    }
};

struct EpiResidNorm {
    static constexpr bool PERM = false, AFTER_DRAIN = true;
    const bf16* base; float* out; const float* bias; const float* w; float* xbuf; unsigned* cnt;
    DI void fused(pg8::f32x4 (&acc)[2][2][4][2], const pg8::Unit& u, int wr, int wc, int fr, int fq, PG8_LAS unsigned char* lds, int wid, int lane) const {
        PG8_LAS float* Pt = (PG8_LAS float*)lds;
        PG8_LAS float* S = (PG8_LAS float*)(lds + 4096);
        const int col0 = u.pn * 256 + wc * 32 + 4 * fq;
#pragma unroll
        for (int ai = 0; ai < 2; ++ai)
#pragma unroll
            for (int m = 0; m < 4; ++m) {
                const int r = ai * 128 + wr * 64 + m * 16 + fr; const size_t off = (size_t)(u.pm * 256 + r) * 1024 + col0; float ss = 0.f;
#pragma unroll
                for (int bj = 0; bj < 2; ++bj)
#pragma unroll
                    for (int n = 0; n < 2; ++n) { const u32x2 bw = *(const u32x2*)(base + off + bj * 128 + n * 16); const f32x4 bs = (f32x4){bflo(bw.x), bfhi(bw.x), bflo(bw.y), bfhi(bw.y)}; const f32x4 bv = *(const f32x4*)(bias + col0 + bj * 128 + n * 16);
                        const f32x4 v = bs + acc[ai][bj][m][n] + bv; acc[ai][bj][m][n] = v; ss += (v[0] * v[0] + v[1] * v[1]) + (v[2] * v[2] + v[3] * v[3]); }
                ss += __shfl_xor(ss, 16); ss += __shfl_xor(ss, 32);
                if (fq == 0) Pt[r * 4 + wc] = ss;
                if (m & 1) asm volatile("" ::: "memory");
            }
        asm volatile("s_waitcnt lgkmcnt(0)" ::: "memory"); __builtin_amdgcn_s_barrier(); asm volatile("" ::: "memory");
        const int row = wid * 32 + (lane & 31);
        if (lane < 32) { const float tot = (Pt[row * 4 + 0] + Pt[row * 4 + 1]) + (Pt[row * 4 + 2] + Pt[row * 4 + 3]);
            __hip_atomic_store(xbuf + (size_t)(u.pm * 256 + row) * 4 + u.pn, tot, __ATOMIC_RELAXED, __HIP_MEMORY_SCOPE_AGENT); }
        asm volatile("s_waitcnt vmcnt(0)" ::: "memory");
        if (lane == 0) __hip_atomic_fetch_add(cnt + 64 * u.pm, 1u, __ATOMIC_RELAXED, __HIP_MEMORY_SCOPE_AGENT);
        if (wid == 0) {
            unsigned spins = 0;
            while ((unsigned)__builtin_amdgcn_readfirstlane(__hip_atomic_load(cnt + 64 * u.pm, __ATOMIC_RELAXED, __HIP_MEMORY_SCOPE_AGENT)) < 32u) { __builtin_amdgcn_s_sleep(2); if (++spins > (1u << 22)) break; }
            __builtin_amdgcn_fence(__ATOMIC_ACQUIRE, "agent");
        }
        asm volatile("s_waitcnt vmcnt(0) lgkmcnt(0)" ::: "memory"); __builtin_amdgcn_s_barrier(); asm volatile("" ::: "memory");
        if (lane < 32) { const float* sl = xbuf + (size_t)(u.pm * 256 + row) * 4; float t = 0.f;
#pragma unroll
            for (int k = 0; k < 4; ++k) t += __hip_atomic_load(sl + k, __ATOMIC_RELAXED, __HIP_MEMORY_SCOPE_AGENT);
            S[row] = 1.0f / sqrtf(t * (1.f / 1024.f) + NORM_EPS); }
        asm volatile("s_waitcnt lgkmcnt(0)" ::: "memory"); __builtin_amdgcn_s_barrier(); asm volatile("" ::: "memory");
        f32x4 wv[2][2];
#pragma unroll
        for (int bj = 0; bj < 2; ++bj)
#pragma unroll
            for (int n = 0; n < 2; ++n) wv[bj][n] = *(const f32x4*)(w + col0 + bj * 128 + n * 16);
#pragma unroll
        for (int ai = 0; ai < 2; ++ai)
#pragma unroll
            for (int m = 0; m < 4; ++m) { const int r = ai * 128 + wr * 64 + m * 16 + fr; const float rs = S[r]; const size_t off = (size_t)(u.pm * 256 + r) * 1024 + col0;
#pragma unroll
                for (int bj = 0; bj < 2; ++bj)
#pragma unroll
                    for (int n = 0; n < 2; ++n) *(f32x4*)(out + off + bj * 128 + n * 16) = acc[ai][bj][m][n] * rs * wv[bj][n]; }
    }
};

DI void transpose_item(const float* W, int N, int Npad, bf16* WT, const float* kscale, LAS float* scr, int item, int lane) {
    const int nblk = Npad / 32, kb = item / nblk, nb = item % nblk, k0 = 64 * kb, n0 = 32 * nb;
    const int n = n0 + (lane & 31);
#pragma unroll 8
    for (int i = 0; i < 32; ++i) { const int kk = 2 * i + (lane >> 5); float v = (n < N) ? W[(size_t)(k0 + kk) * N + n] : 0.f; if (kscale) v *= kscale[k0 + kk]; scr[kk * 33 + (lane & 31)] = v; }
    LDS_WAIT(); asm volatile("" ::: "memory");
    const int c = lane & 7;
#pragma unroll
    for (int j = 0; j < 4; ++j) { const int nn = (lane >> 3) + 8 * j; const LAS float* s = scr + (8 * c) * 33 + nn;
        u32x4 o; o.x = pk2(s[0 * 33], s[1 * 33]); o.y = pk2(s[2 * 33], s[3 * 33]); o.z = pk2(s[4 * 33], s[5 * 33]); o.w = pk2(s[6 * 33], s[7 * 33]);
        *(u32x4*)(WT + (size_t)(n0 + nn) * 1024 + k0 + 8 * c) = o; }
    LDS_WAIT(); asm volatile("" ::: "memory");
}
DI void p0_prologue(const Params& P, LAS unsigned char* lds, int wave, int lane) {
    LAS float* scr = (LAS float*)(lds + wave * 16384);
    const int gw = blockIdx.x * 8 + wave, NGW = gridDim.x * 8;
    bf16* W0T = (bf16*)(P.ws + WS_W0T); bf16* WO0T = (bf16*)(P.ws + WS_WO0T); bf16* W1T = (bf16*)(P.ws + WS_W1T); bf16* WO1T = (bf16*)(P.ws + WS_WO1T);
    constexpr int I0 = 16 * (N0P / 32), I1 = 16 * 32, I2 = 16 * (IN1 / 32), I3 = 16 * 32;
    for (int it = gw; it < I0 + I1 + I2 + I3; it += NGW) {
        int r = it;
        if (r < I0) { transpose_item(P.w_in0, IN0, N0P, W0T, nullptr, scr, r, lane); continue; } r -= I0;
        if (r < I1) { transpose_item(P.w_out0, 1024, 1024, WO0T, nullptr, scr, r, lane); continue; } r -= I1;
        if (r < I2) { transpose_item(P.w_in1, IN1, IN1, W1T, P.norm_w + 1024, scr, r, lane); continue; } r -= I2;
        transpose_item(P.w_out1, 1024, 1024, WO1T, nullptr, scr, r, lane);
    }
    {
        float* RT = (float*)(P.ws + WS_ROPE);
        for (int e = gw * 64 + lane; e < T * 8; e += NGW * 64) { const int pos = e >> 3, j = e & 7;
            const float invf = __expf(-(float)j * 0.125f * 13.122363377404328f); const float ang = (float)pos * invf; const float nrev = rintf(ang * 0.15915494309189535f);
            float r = fmaf(-nrev, 6.2831854820251465f, ang); r = fmaf(-nrev, -1.7484555e-07f, r);
            RT[2 * e] = __cosf(r); RT[2 * e + 1] = __sinf(r); }
    }
    {
        u32x4* WLT = (u32x4*)(P.ws + WS_WLT);
        for (int e = gw * 64 + lane; e < 8 * 2 * 4 * 2 * 64; e += NGW * 64) { const int ln = e & 63, db = (e >> 6) & 1, s = (e >> 7) & 3, lo = (e >> 9) & 1, h = e >> 10;
            const float* wp = (lo ? P.a_up : P.w_up) + (size_t)(16 * s + 8 * (ln >> 5)) * 512 + h * 64 + 2 * (ln & 31) + db;
            u32x4 o; o.x = pk2(wp[0], wp[512]); o.y = pk2(wp[2 * 512], wp[3 * 512]); o.z = pk2(wp[4 * 512], wp[5 * 512]); o.w = pk2(wp[6 * 512], wp[7 * 512]); WLT[e] = o; }
    }
    bf16* XN = (bf16*)(P.ws + WS_XN);
    {
        const f32x4* wr = (const f32x4*)P.norm_w + lane; const f32x4 w0 = wr[0], w1 = wr[64], w2 = wr[128], w3 = wr[192];
        f32x4 nx[4];
        { const f32x4* xr = (const f32x4*)(P.x + (size_t)(gw < M ? gw : 0) * D) + lane;
#pragma unroll
          for (int j = 0; j < 4; ++j) nx[j] = xr[64 * j]; }
        for (int m = gw; m < M; m += NGW) {
            f32x4 v[4]; float s = 0.f;
#pragma unroll
            for (int j = 0; j < 4; ++j) { v[j] = nx[j]; s += (v[j][0] * v[j][0] + v[j][1] * v[j][1]) + (v[j][2] * v[j][2] + v[j][3] * v[j][3]); }
            if (m + NGW < M) { const f32x4* xr = (const f32x4*)(P.x + (size_t)(m + NGW) * D) + lane;
#pragma unroll
                for (int j = 0; j < 4; ++j) nx[j] = xr[64 * j]; }
            const float rstd = 1.0f / sqrtf(wave_sum(s) * (1.f / D) + NORM_EPS);
            u32x2* o8 = (u32x2*)(XN + (size_t)m * D) + lane;
            { u32x2 o; o.x = pk2(v[0][0] * rstd * w0[0], v[0][1] * rstd * w0[1]); o.y = pk2(v[0][2] * rstd * w0[2], v[0][3] * rstd * w0[3]); o8[0] = o; }
            { u32x2 o; o.x = pk2(v[1][0] * rstd * w1[0], v[1][1] * rstd * w1[1]); o.y = pk2(v[1][2] * rstd * w1[2], v[1][3] * rstd * w1[3]); o8[64] = o; }
            { u32x2 o; o.x = pk2(v[2][0] * rstd * w2[0], v[2][1] * rstd * w2[1]); o.y = pk2(v[2][2] * rstd * w2[2], v[2][3] * rstd * w2[3]); o8[128] = o; }
            { u32x2 o; o.x = pk2(v[3][0] * rstd * w3[0], v[3][1] * rstd * w3[1]); o.y = pk2(v[3][2] * rstd * w3[2], v[3][3] * rstd * w3[3]); o8[192] = o; }
        }
    }
}
DI float softplus_f(float z) { return fmaxf(z, 0.f) + __logf(1.f + __expf(-fabsf(z))); }
DI float tanh_f(float x) { return 1.f - 2.f * __builtin_amdgcn_rcpf(__expf(2.f * x) + 1.f); }

template <int N> DI void dpp_fmac(float& acc, float src, float y) { asm("v_fmac_f32_dpp %0, %1, %2 row_newbcast:%3 row_mask:0xf bank_mask:0xf" : "+v"(acc) : "v"(src), "v"(y), "n"(N)); }
template <int N> DI void dpp_mul_ip(float& y, float src) { asm("v_mul_f32_dpp %0, %1, %0 row_newbcast:%2 row_mask:0xf bank_mask:0xf" : "+v"(y) : "v"(src), "n"(N)); }
template <int N> DI float dpp_mul(float src, float s) { float r; asm("v_mul_f32_dpp %0, %1, %2 row_newbcast:%3 row_mask:0xf bank_mask:0xf" : "=v"(r) : "v"(src), "v"(s), "n"(N)); return r; }
template <int D> struct RStep {
    static DI void dot(const float (&y)[64], const f32x4& X, float& s0, float& s1, float& s2, float& s3) {
        if constexpr (D < 16) { dpp_fmac<D>(s0, X[0], y[4 * D]); dpp_fmac<D>(s1, X[1], y[4 * D + 1]); dpp_fmac<D>(s2, X[2], y[4 * D + 2]); dpp_fmac<D>(s3, X[3], y[4 * D + 3]); RStep<D + 1>::dot(y, X, s0, s1, s2, s3); } }
    static DI void upd(float (&y)[64], const f32x4& Bv, float sa) {
        if constexpr (D < 16) {
            dpp_fmac<D>(y[4 * D], Bv[0], sa); dpp_fmac<D>(y[4 * D + 1], Bv[1], sa); dpp_fmac<D>(y[4 * D + 2], Bv[2], sa); dpp_fmac<D>(y[4 * D + 3], Bv[3], sa);
            RStep<D + 1>::upd(y, Bv, sa); } }
    static DI void scale(float (&y)[64], const f32x4& W) {
        if constexpr (D < 16) {
            dpp_mul_ip<D>(y[4 * D], W[0]); dpp_mul_ip<D>(y[4 * D + 1], W[1]); dpp_mul_ip<D>(y[4 * D + 2], W[2]); dpp_mul_ip<D>(y[4 * D + 3], W[3]);
            RStep<D + 1>::scale(y, W); } }
};
DI void rwkv_rstep(float (&y)[64], const f32x4 (&X)[4], int t, int role, int lane, bf16* mstep) {
    float s0 = 0.f, s1 = 0.f, s2 = 0.f, s3 = 0.f;
    RStep<0>::dot(y, X[0], s0, s1, s2, s3);
    float sa = (s0 + s1) + (s2 + s3);
    if (role == 1) sa = (lane < t) ? sa : 0.f;
    RStep<0>::upd(y, X[2], sa);
    float o0 = 0.f, o1 = 0.f, o2 = 0.f, o3 = 0.f;
    RStep<0>::dot(y, X[3], o0, o1, o2, o3);
    float o = (o0 + o1) + (o2 + o3);
    if (role == 1) o = (lane <= t) ? o : 0.f;
    mstep[t * 64] = (bf16)f2bf(o);
}
DI void rwkv_prep_item(const Params& P, int item, LAS unsigned char* lds, int wave, int lane) {
    const int bh = item >> 4, quad = item & 15, b = bh >> 3, h = bh & 7;
    const int tok0 = b * T + quad * 256;
    const bf16* PROJ0 = (const bf16*)(P.ws + WS_PROJ0);
    float* scr = (float*)(P.ws + WS_SCR + (size_t)blockIdx.x * 262144);
    LAS float* KS = (LAS float*)lds;
    LAS float* TOT = (LAS float*)(lds + 8 * 64 * 65 * 4);
    bf16* VP = (bf16*)(P.ws + WS_VP); float* BON = (float*)(P.ws + WS_BONUS);
    const int hd = h * 64 + lane;
    {
        const int m = lane & 31, hi = lane >> 5;
        const int c = wave >> 1, tb = (wave & 1) * 32;
        const int tokw = tok0 + wave * 32, posw = quad * 256 + wave * 32;
        f32x16 accw[2], acca[2];
#pragma unroll
        for (int i = 0; i < 16; ++i) { accw[0][i] = 0.f; accw[1][i] = 0.f; acca[0][i] = 0.f; acca[1][i] = 0.f; }
        {
            const bf16* rowc = PROJ0 + (size_t)(tokw + m) * N0P; const bool hasprev = (posw + m) > 0;
            const u32x4* WLT = (const u32x4*)(P.ws + WS_WLT) + (size_t)h * 1024 + lane;
            u32x4 cwv[4], cav[4], pwv[4], pav[4], bwv[4][2], bav[4][2];
#pragma unroll
            for (int s = 0; s < 4; ++s) { const int j0 = 16 * s + 8 * hi;
                cwv[s] = *(const u32x4*)(rowc + C_XW + j0); cav[s] = *(const u32x4*)(rowc + C_XA + j0);
                pwv[s] = (u32x4){0u, 0u, 0u, 0u}; pav[s] = (u32x4){0u, 0u, 0u, 0u};
                if (hasprev) { pwv[s] = *(const u32x4*)(rowc - N0P + C_XW + j0); pav[s] = *(const u32x4*)(rowc - N0P + C_XA + j0); }
#pragma unroll
                for (int db = 0; db < 2; ++db) { bwv[s][db] = WLT[((0 * 4 + s) * 2 + db) * 64]; bav[s][db] = WLT[((1 * 4 + s) * 2 + db) * 64]; } }
#pragma unroll
            for (int s = 0; s < 4; ++s) {
                const int j0 = 16 * s + 8 * hi;
                float fcw[8], fpw[8], fca[8], fpa[8]; unpack8(cwv[s], fcw); unpack8(pwv[s], fpw); unpack8(cav[s], fca); unpack8(pav[s], fpa);
                const f32x4 mw0 = *(const f32x4*)(P.mu + 1536 + j0), mw1 = *(const f32x4*)(P.mu + 1536 + j0 + 4), ma0 = *(const f32x4*)(P.mu + 1600 + j0), ma1 = *(const f32x4*)(P.mu + 1600 + j0 + 4);
                float xw[8], xa[8];
#pragma unroll
                for (int e = 0; e < 8; ++e) { const float muw = e < 4 ? mw0[e & 3] : mw1[e & 3], mua = e < 4 ? ma0[e & 3] : ma1[e & 3];
                    xw[e] = tanh_f(fcw[e] + (fpw[e] - fcw[e]) * muw); xa[e] = fca[e] + (fpa[e] - fca[e]) * mua; }
                u32x4 aw, aa;
#pragma unroll
                for (int e = 0; e < 4; ++e) { aw[e] = pk2(xw[2 * e], xw[2 * e + 1]); aa[e] = pk2(xa[2 * e], xa[2 * e + 1]); }
#pragma unroll
                for (int db = 0; db < 2; ++db) {
                    accw[db] = MFMA32(__builtin_bit_cast(bf16x8, aw), __builtin_bit_cast(bf16x8, bwv[s][db]), accw[db]);
                    acca[db] = MFMA32(__builtin_bit_cast(bf16x8, aa), __builtin_bit_cast(bf16x8, bav[s][db]), acca[db]);
                }
            }
        }
        float kkd[2], kad[2], rkd[2], w0d[2], a0d[2], mur[2], muk[2], muv[2];
#pragma unroll
        for (int db = 0; db < 2; ++db) { const int hd = h * 64 + 2 * m + db; kkd[db] = P.k_k[hd]; kad[db] = P.k_a[hd]; rkd[db] = P.r_k[hd]; w0d[db] = P.w0[hd]; a0d[db] = P.a0[hd];
            mur[db] = P.mu[hd]; muk[db] = P.mu[512 + hd]; muv[db] = P.mu[1024 + hd]; }
        unsigned qr[16], qk[16], qv[16], qpr[4], qpk[4], qpv[4];
#pragma unroll
        for (int i = 0; i < 16; ++i) {
            int io = i; asm volatile("" : "+v"(io));
            const bf16* row = PROJ0 + (size_t)(tokw + crow(io, hi)) * N0P + h * 64 + 2 * m;
            qr[i] = *(const unsigned*)(row + C_RR); qk[i] = *(const unsigned*)(row + C_RK); qv[i] = *(const unsigned*)(row + C_RV);
            if ((i & 3) == 0) {
                qpr[i >> 2] = 0u; qpk[i >> 2] = 0u; qpv[i >> 2] = 0u;
                if (posw + crow(i, hi) > 0) { qpr[i >> 2] = *(const unsigned*)(row - N0P + C_RR); qpk[i >> 2] = *(const unsigned*)(row - N0P + C_RK); qpv[i >> 2] = *(const unsigned*)(row - N0P + C_RV); }
            }
        }
        float ee[2][16], Lc[2][16];
#pragma unroll
        for (int db = 0; db < 2; ++db) {
#pragma unroll
            for (int i = 0; i < 16; ++i) { const float wl = w0d[db] + accw[db][i]; ee[db][i] = 0.60653066f * __builtin_amdgcn_rcpf(1.f + __expf(-wl)); }
            float gt[4], go[4];
#pragma unroll
            for (int g = 0; g < 4; ++g) { Lc[db][4 * g] = ee[db][4 * g]; Lc[db][4 * g + 1] = Lc[db][4 * g] + ee[db][4 * g + 1]; Lc[db][4 * g + 2] = Lc[db][4 * g + 1] + ee[db][4 * g + 2]; Lc[db][4 * g + 3] = Lc[db][4 * g + 2] + ee[db][4 * g + 3];
                gt[g] = Lc[db][4 * g + 3]; go[g] = __shfl_xor(gt[g], 32); }
            float run = 0.f;
#pragma unroll
            for (int g = 0; g < 4; ++g) { const float base = run + (hi ? go[g] : 0.f);
#pragma unroll
                for (int q = 0; q < 4; ++q) Lc[db][4 * g + q] += base;
                run += gt[g] + go[g]; }
            if (!(wave & 1) && hi == 0) TOT[c * 64 + 2 * m + db] = run;
        }
        __syncthreads();
        if (wave & 1) {
#pragma unroll
            for (int db = 0; db < 2; ++db) { const float tp = TOT[c * 64 + 2 * m + db];
#pragma unroll
                for (int i = 0; i < 16; ++i) Lc[db][i] += tp; }
        }
        float Lb[2][4];
#pragma unroll
        for (int db = 0; db < 2; ++db)
#pragma unroll
            for (int g = 0; g < 4; ++g) { Lb[db][g] = Lc[db][4 * g] - ee[db][4 * g]; asm volatile("" : "+v"(Lb[db][g])); }
        {
            float pv0 = 0.f, pv1 = 0.f;
#pragma unroll
            for (int i = 0; i < 16; ++i) {
                int io = i; asm volatile("" : "+v"(io));
                if ((i & 3) == 0) { pv0 = bflo(qpv[i >> 2]); pv1 = bfhi(qpv[i >> 2]); }
                const float c0 = bflo(qv[i]), c1 = bfhi(qv[i]);
                *(unsigned*)(VP + (size_t)(tokw + crow(io, hi)) * 512 + h * 64 + 2 * m) = pk2(c0 + (pv0 - c0) * muv[0], c1 + (pv1 - c1) * muv[1]);
                pv0 = c0; pv1 = c1;
            }
        }
        float pr[2] = {0.f, 0.f}, pk[2] = {0.f, 0.f}, pemL[2] = {1.f, 1.f};
#pragma unroll
        for (int i = 0; i < 16; ++i) {
            int io = i; asm volatile("" : "+v"(io));
            const int tau = crow(io, hi), tok = tokw + tau, t = tb + tau;
            if ((i & 3) == 0) { pr[0] = bflo(qpr[i >> 2]); pr[1] = bfhi(qpr[i >> 2]); pk[0] = bflo(qpk[i >> 2]); pk[1] = bfhi(qpk[i >> 2]); }
            float r[2], k[2], a[2], kk[2];
#pragma unroll
            for (int db = 0; db < 2; ++db) {
                const float cr = db ? bfhi(qr[i]) : bflo(qr[i]), ck = db ? bfhi(qk[i]) : bflo(qk[i]);
                r[db] = cr + (pr[db] - cr) * mur[db]; k[db] = ck + (pk[db] - ck) * muk[db];
                pr[db] = cr; pk[db] = ck;
                const float al = a0d[db] + acca[db][i];
                a[db] = __builtin_amdgcn_rcpf(1.f + __expf(-al));
                kk[db] = k[db] * kkd[db];
            }
            const float inv = __builtin_amdgcn_rsqf(fmaxf(half_sum32(kk[0] * kk[0] + kk[1] * kk[1]), 1e-24f));
            float k2[2];
#pragma unroll
            for (int db = 0; db < 2; ++db) k2[db] = k[db] * (1.f + (a[db] - 1.f) * kad[db]);
            const float bon = half_sum32(r[0] * k2[0] * rkd[0] + r[1] * k2[1] * rkd[1]);
            f32x2v sa_, sb_, sr_; float we_[2];
#pragma unroll
            for (int db = 0; db < 2; ++db) {
                const int d = 2 * m + db; const float kkn = kk[db] * inv;
                const float eL = __expf(Lc[db][i]), emL = __builtin_amdgcn_rcpf(eL);
                const float wprev = (i & 3) ? pemL[db] : __expf(-Lb[db][i >> 2]); pemL[db] = emL;
                sa_[db] = -kkn * wprev;
                sb_[db] = kkn * a[db] * eL;
                sr_[db] = r[db] * emL;
                we_[db] = emL;
                KS[((2 * c + 1 - (c >> 1)) * 64 + t) * 65 + d] = k2[db] * eL;
            }
            {
                float* o = scr + (size_t)((c * 64 + t) * 4) * 64 + 2 * m;
                *(f32x2v*)o = sa_; *(f32x2v*)(o + 128) = sb_; *(f32x2v*)(o + 192) = sr_;
                if (i == 15 && t == 63) *(f32x2v*)(o + 64) = (f32x2v){we_[0], we_[1]};
            }
            if (m == 0) BON[(size_t)tok * 8 + h] = bon;
        }
    }
    __syncthreads();
    {
        const int c = wave >> 1, role = (wave ^ (wave >> 2)) & 1;
        const f32x4* xb = (const f32x4*)(scr + (size_t)c * 64 * 256) + (lane & 15);
        const LAS float* ksw = KS + wave * 64 * 65;
        float y[64];
        const int n = quad * 4 + c;
        bf16* mats = (bf16*)P.out + (size_t)(bh * 64 + n) * 4 * 4096;
        bf16* mstep = mats + role * 4096 + (role ? lane : kpos(lane));
#pragma unroll 1
        for (int rep2 = 0; rep2 < REP_S2; ++rep2) {
            int ln = lane; asm volatile("" : "+v"(ln));
#pragma unroll
            for (int d = 0; d < 64; ++d) y[d] = (role == 0) ? ((d == ln) ? 1.f : 0.f) : ksw[ln * 65 + d];
            f32x4 XA[4], XB[4];
#pragma unroll
            for (int v = 0; v < 4; ++v) XA[v] = xb[v * 16];
            for (int t = 0; t < 64; t += 2) {
#pragma unroll
                for (int v = 0; v < 4; ++v) XB[v] = xb[(t + 1) * 64 + v * 16];
                rwkv_rstep(y, XA, t, role, lane, mstep);
                if (t + 2 < 64) {
#pragma unroll
                    for (int v = 0; v < 4; ++v) XA[v] = xb[(t + 2) * 64 + v * 16];
                }
                rwkv_rstep(y, XB, t + 1, role, lane, mstep);
            }
            RStep<0>::scale(y, XB[1]);
        }
        bf16* mend = mats + (role ? 2 : 3) * 4096 + (role ? lane : kpos(lane));
        LAS float* myr = KS + (wave * 64 + lane) * 65;
#pragma unroll
        for (int d = 0; d < 64; ++d) myr[d] = y[d];
#pragma unroll 1
        for (int d = 0; d < 64; ++d) mend[d * 64] = (bf16)f2bf(myr[d]);
    }
    __syncthreads();
}

DI void gla_prep_item(const Params& P, int item, LAS unsigned char* lds, int wave, int lane) {
    const int bh = item >> 6, n = item & 63, b = bh >> 2, h = bh & 3;
    const int tok0 = b * T + n * 64, hd = h * 64 + lane;
    const bf16* PROJ0 = (const bf16*)(P.ws + WS_PROJ0);
    LAS float* WT = (LAS float*)lds;
    LAS bf16* QEb = (LAS bf16*)(WT + 1024);
    LAS bf16* KEb = QEb + 64 * 72;
    LAS float* KL = (LAS float*)(KEb + 64 * 72);
    bf16* mats = (bf16*)(P.ws + WS_XN) + (size_t)(bh * 64 + n) * 3 * 4096;
    float* GDEC = (float*)(P.ws + WS_GDEC) + (size_t)(bh * 64 + n) * 64;
    float q8[8], k8[8]; u32x4 gl0[8], gl1[8];
#pragma unroll
    for (int i = 0; i < 8; ++i) { const bf16* row = PROJ0 + (size_t)(tok0 + wave * 8 + i) * N0P; q8[i] = bf2f(row[C_GQ + hd]) * 0.125f; k8[i] = bf2f(row[C_GK + hd]);
        gl0[i] = *(const u32x4*)(row + C_GLOW); gl1[i] = *(const u32x4*)(row + C_GLOW + 8); }
    float up[16];
#pragma unroll
    for (int r = 0; r < 16; ++r) up[r] = P.gk_up[r * 256 + hd];
    const float bias = P.gk_bias[hd];
    float bt[8]; float acc = 0.f;
#pragma unroll
    for (int i = 0; i < 8; ++i) { float xg = bias;
#pragma unroll
        for (int r = 0; r < 4; ++r) { xg = fmaf(bflo(gl0[i][r]), up[2 * r], xg); xg = fmaf(bfhi(gl0[i][r]), up[2 * r + 1], xg); }
#pragma unroll
        for (int r = 0; r < 4; ++r) { xg = fmaf(bflo(gl1[i][r]), up[8 + 2 * r], xg); xg = fmaf(bfhi(gl1[i][r]), up[8 + 2 * r + 1], xg); }
        acc += -softplus_f(-xg) * (1.f / 16.f); bt[i] = acc; }
    WT[wave * 64 + lane] = acc;
    if (wave == 4) WT[512 + lane] = bt[0];
    __syncthreads();
    float off = 0.f, off4 = 0.f, total = 0.f;
#pragma unroll
    for (int w2 = 0; w2 < 8; ++w2) { const float tv = WT[w2 * 64 + lane]; if (w2 < wave) off += tv; if (w2 < 4) off4 += tv; total += tv; }
    const float bref = off4 + WT[512 + lane], blast = total;
#pragma unroll
    for (int i = 0; i < 8; ++i) { const int t = wave * 8 + i; const float b_t = bt[i] + off;
        QEb[t * 72 + lane] = (bf16)f2bf(q8[i] * __expf(b_t - bref)); KEb[t * 72 + lane] = (bf16)f2bf(k8[i] * __expf(bref - b_t)); KL[t * 65 + lane] = k8[i] * __expf(blast - b_t);
        mats[t * 64 + kpos(lane)] = (bf16)f2bf(q8[i] * __expf(b_t)); }
    if (wave == 0) GDEC[lane] = __expf(blast);
    __syncthreads();
    if (wave < 4) {
        const int m = lane & 31, hi = lane >> 5, tb = wave >> 1, jb = wave & 1;
        f32x16 c;
#pragma unroll
        for (int r = 0; r < 16; ++r) c[r] = 0.f;
#pragma unroll
        for (int s = 0; s < 4; ++s) { const bf16x8 A = *(const LAS bf16x8*)(KEb + (32 * jb + m) * 72 + 16 * s + 8 * hi), Bq = *(const LAS bf16x8*)(QEb + (32 * tb + m) * 72 + 16 * s + 8 * hi); c = MFMA32(A, Bq, c); }
        const int t = 32 * tb + m;
#pragma unroll
        for (int g = 0; g < 4; ++g) { const int j0 = 32 * jb + 8 * g + 4 * hi; u32x2 w;
            w.x = pk2(j0 <= t ? c[4 * g] : 0.f, j0 + 1 <= t ? c[4 * g + 1] : 0.f); w.y = pk2(j0 + 2 <= t ? c[4 * g + 2] : 0.f, j0 + 3 <= t ? c[4 * g + 3] : 0.f);
            *(u32x2*)(mats + 4096 + t * 64 + j0) = w; }
    } else {
#pragma unroll
        for (int r = 0; r < 16; ++r) { const int d = (wave - 4) * 16 + r; mats[8192 + d * 64 + lane] = (bf16)f2bf(KL[lane * 65 + d]); }
    }
    __syncthreads();
}

constexpr int SQ_PITCH = 144, SQ_MAT = 64 * SQ_PITCH, SQ_VT = 4 * SQ_MAT, SQ_DEC = SQ_VT + 128 * SQ_PITCH, SQ_BUF = 57344;
template <bool DIAG>
DI void seq_pass(unsigned* prog, const bf16* mats, int nmat, const bf16* vsrc, int vpitch, const float* dec, bf16* outp, LAS unsigned char* lds, int tid, int wave, int lane) {
    const int m = lane & 31, hi = lane >> 5;
    f32x16 sacc[2];
#pragma unroll
    for (int i = 0; i < 16; ++i) { sacc[0][i] = 0.f; sacc[1][i] = 0.f; }
    const int st = tid - 256;
    struct StSet { u32x4 rm[8]; u32x4 rv[2]; float rdec; };
    const int v8 = st & 7, par = (st >> 3) & 1;
    constexpr int NMAT = DIAG ? 3 : 4;
    auto gload = [&](int n, StSet& S) {
        const bf16* mp = mats + (size_t)n * NMAT * 4096;
#pragma unroll
        for (int q = 0; q < 2 * NMAT; ++q) S.rm[q] = *(const u32x4*)(mp + (size_t)(st + 256 * q) * 8);
#pragma unroll
        for (int q = 0; q < 2; ++q) S.rv[q] = *(const u32x4*)(vsrc + (size_t)(n * 64 + (st >> 3) + 32 * q) * vpitch + 8 * v8);
        if (DIAG) S.rdec = dec[n * 64 + (st & 63)];
    };
    auto lstore = [&](int n, const StSet& S) {
        LAS unsigned char* B = lds + (n & 1) * SQ_BUF;
#pragma unroll
        for (int q = 0; q < 2 * NMAT; ++q) { const int idx = (st + 256 * q) & 511; *(LAS u32x4*)(B + (q >> 1) * SQ_MAT + (idx >> 3) * SQ_PITCH + (idx & 7) * 16) = S.rm[q]; }
#pragma unroll
        for (int q = 0; q < 2; ++q) {
            const int vt = (st >> 3) + 32 * q;
            const unsigned k0 = par ? S.rv[q][2] : S.rv[q][0], k1 = par ? S.rv[q][3] : S.rv[q][1], s0 = par ? S.rv[q][0] : S.rv[q][2], s1 = par ? S.rv[q][1] : S.rv[q][3];
            const unsigned r0 = (unsigned)__builtin_amdgcn_update_dpp(0, (int)s0, 0x128, 0xf, 0xf, true), r1 = (unsigned)__builtin_amdgcn_update_dpp(0, (int)s1, 0x128, 0xf, 0xf, true);
            unsigned o[4];
            if (par == 0) { o[0] = (k0 & 0xffffu) | (r0 << 16); o[1] = (k0 >> 16) | (r0 & 0xffff0000u); o[2] = (k1 & 0xffffu) | (r1 << 16); o[3] = (k1 >> 16) | (r1 & 0xffff0000u); }
            else          { o[0] = (r0 & 0xffffu) | (k0 << 16); o[1] = (r0 >> 16) | (k0 & 0xffff0000u); o[2] = (r1 & 0xffffu) | (k1 << 16); o[3] = (r1 >> 16) | (k1 & 0xffff0000u); }
            const int tp = vt >> 1, gsw = ((tp >> 2) ^ v8) & 7;
#pragma unroll
            for (int jj = 0; jj < 4; ++jj) *(LAS unsigned*)(B + SQ_VT + (8 * v8 + 4 * par + jj) * SQ_PITCH + (4 * gsw + (tp & 3)) * 4) = o[jj];
        }
        if (DIAG && st < 64) *(LAS float*)(B + SQ_DEC + st * 4) = S.rdec;
    };
    f32x16 o0, o1;
    bf16x8 sBp[2][2];
#pragma unroll
    for (int kb = 0; kb < 2; ++kb)
#pragma unroll
        for (int s = 0; s < 2; ++s) sBp[kb][s] = (bf16x8){0, 0, 0, 0, 0, 0, 0, 0};
    LAS unsigned char* SBX = lds + 2 * SQ_BUF;
    if (wave >= 2 && wave < 4) {
#pragma unroll
        for (int q = 0; q < 4; ++q) *(LAS bf16x8*)(SBX + (0 * 2 + (wave & 1)) * 4096 + lane * 64 + 16 * q) = sBp[q >> 1][q & 1];
    }
    auto compute = [&](int n, int bufi) {
        if (wave < 4) {
            const int vb = wave & 1; const bool upd = wave >= 2;
            const LAS unsigned char* B = lds + bufi * SQ_BUF;
            const int vrow = 32 * vb + m;
            const LAS unsigned char* Vr = B + SQ_VT + vrow * SQ_PITCH;
            const LAS unsigned char* Ar = B + m * SQ_PITCH + 16 * hi;
            bf16x8 Fa[2], Fb[2], Va, Vb;
#define SQ_LD(F, VB, k, MS, MV) do { if ((k) < 4) { const int co_ = (32 * ((k) >> 1) + 16 * ((k) & 1)) * 2; \
            F[0] = *(const LAS bf16x8*)(Ar + (MS) * SQ_MAT + co_); F[1] = *(const LAS bf16x8*)(Ar + (MS) * SQ_MAT + 32 * SQ_PITCH + co_); } \
        else { const int S4_ = (k) - 4, co_ = 32 * S4_; VB = *(const LAS bf16x8*)(Vr + (((2 * S4_ + hi) ^ (vrow >> 3)) & 7) * 16); \
            F[0] = *(const LAS bf16x8*)(Ar + (MV) * SQ_MAT + co_); F[1] = *(const LAS bf16x8*)(Ar + (MV) * SQ_MAT + 32 * SQ_PITCH + co_); } } while (0)
            if (!upd) {
                bf16x8 sB[2][2];
#pragma unroll
                for (int q = 0; q < 4; ++q) sB[q >> 1][q & 1] = *(const LAS bf16x8*)(SBX + ((n & 1) * 2 + vb) * 4096 + lane * 64 + 16 * q);
#pragma unroll
                for (int i = 0; i < 16; ++i) { o0[i] = 0.f; o1[i] = 0.f; }
#define SQ_MM(F, VB, k) do { const bf16x8 Bq_ = ((k) < 4) ? sB[(k) >> 1][(k) & 1] : VB; o0 = MFMA32(Bq_, F[0], o0); o1 = MFMA32(Bq_, F[1], o1); } while (0)
                SQ_LD(Fa, Va, 0, 0, 1); SQ_LD(Fb, Vb, 1, 0, 1);
                __builtin_amdgcn_sched_barrier(0);
                SQ_MM(Fa, Va, 0); SQ_LD(Fa, Va, 2, 0, 1); __builtin_amdgcn_sched_barrier(0);
                SQ_MM(Fb, Vb, 1); SQ_LD(Fb, Vb, 3, 0, 1); __builtin_amdgcn_sched_barrier(0);
                SQ_MM(Fa, Va, 2); SQ_LD(Fa, Va, 4, 0, 1); __builtin_amdgcn_sched_barrier(0);
                SQ_MM(Fb, Vb, 3); SQ_LD(Fb, Vb, 5, 0, 1); __builtin_amdgcn_sched_barrier(0);
                SQ_MM(Fa, Va, 4); SQ_LD(Fa, Va, 6, 0, 1); __builtin_amdgcn_sched_barrier(0);
                SQ_MM(Fb, Vb, 5); SQ_LD(Fb, Vb, 7, 0, 1); __builtin_amdgcn_sched_barrier(0);
                SQ_MM(Fa, Va, 6); SQ_MM(Fb, Vb, 7);
#undef SQ_MM
            } else {
                f32x16 n0, n1;
#pragma unroll
                for (int i = 0; i < 16; ++i) {
                    if (DIAG) { n0[i] = sacc[0][i] * *(const LAS float*)(B + SQ_DEC + crow(i, hi) * 4); n1[i] = sacc[1][i] * *(const LAS float*)(B + SQ_DEC + (32 + crow(i, hi)) * 4); }
                    else { n0[i] = 0.f; n1[i] = 0.f; } }
#define SQ_MM(F, VB, k) do { const bf16x8 Bq_ = ((k) < 4) ? sBp[(k) >> 1][(k) & 1] : VB; n0 = MFMA32(F[0], Bq_, n0); n1 = MFMA32(F[1], Bq_, n1); } while (0)
                if (!DIAG) {
                    SQ_LD(Fa, Va, 0, 3, 2); SQ_LD(Fb, Vb, 1, 3, 2);
                    __builtin_amdgcn_sched_barrier(0);
                    SQ_MM(Fa, Va, 0); SQ_LD(Fa, Va, 2, 3, 2); __builtin_amdgcn_sched_barrier(0);
                    SQ_MM(Fb, Vb, 1); SQ_LD(Fb, Vb, 3, 3, 2); __builtin_amdgcn_sched_barrier(0);
                    SQ_MM(Fa, Va, 2); SQ_LD(Fa, Va, 4, 3, 2); __builtin_amdgcn_sched_barrier(0);
                    SQ_MM(Fb, Vb, 3); SQ_LD(Fb, Vb, 5, 3, 2); __builtin_amdgcn_sched_barrier(0);
                } else {
                    SQ_LD(Fa, Va, 4, 3, 2); SQ_LD(Fb, Vb, 5, 3, 2);
                    __builtin_amdgcn_sched_barrier(0);
                }
                SQ_MM(Fa, Va, 4); SQ_LD(Fa, Va, 6, 3, 2); __builtin_amdgcn_sched_barrier(0);
                SQ_MM(Fb, Vb, 5); SQ_LD(Fb, Vb, 7, 3, 2); __builtin_amdgcn_sched_barrier(0);
                SQ_MM(Fa, Va, 6); SQ_MM(Fb, Vb, 7);
#undef SQ_MM
                sacc[0] = n0; sacc[1] = n1;
#pragma unroll
                for (int kb = 0; kb < 2; ++kb)
#pragma unroll
                    for (int s = 0; s < 2; ++s) { u32x4 w;
#pragma unroll
                        for (int e = 0; e < 4; ++e) w[e] = pk2(sacc[kb][8 * s + 2 * e], sacc[kb][8 * s + 2 * e + 1]);
                        sBp[kb][s] = __builtin_bit_cast(bf16x8, w);
                        *(LAS bf16x8*)(SBX + (((n + 1) & 1) * 2 + vb) * 4096 + lane * 64 + 16 * (2 * kb + s)) = sBp[kb][s]; }
            }
#undef SQ_LD
        }
    };
    auto store_out = [&](int n) {
        if (wave < 2) {
#pragma unroll
            for (int g = 0; g < 4; ++g) { bf16* op_ = outp + (size_t)(n * 64 + m) * 512 + 32 * wave + 8 * g + 4 * hi;
                u32x2 w0, w1; w0.x = pk2(o0[4 * g], o0[4 * g + 1]); w0.y = pk2(o0[4 * g + 2], o0[4 * g + 3]); w1.x = pk2(o1[4 * g], o1[4 * g + 1]); w1.y = pk2(o1[4 * g + 2], o1[4 * g + 3]);
                *(u32x2*)op_ = w0; *(u32x2*)(op_ + 32 * 512) = w1; }
        }
    };
    if (wave < 4) {
        lds_barrier();
#pragma unroll 1
        for (int n = 0; n < 64; ++n) { compute(n, n & 1); store_out(n); lds_barrier(); }
    } else {
        StSet A, Bs, C;
        gload(0, A); gload(1, Bs); gload(2, C);
        lstore(0, A); gload(3, A);
        lds_barrier();
#pragma unroll 1
        for (int k = 0; k < 60; k += 3) {
            if (st == 0) __hip_atomic_store(prog, (unsigned)(k + 4), __ATOMIC_RELAXED, __HIP_MEMORY_SCOPE_AGENT);
            lstore(k + 1, Bs); gload(k + 4, Bs); lds_barrier();
            lstore(k + 2, C); gload(k + 5, C); lds_barrier();
            lstore(k + 3, A); gload(k + 6, A); lds_barrier();
        }
        lstore(61, Bs); lds_barrier();
        lstore(62, C); lds_barrier();
        lstore(63, A); lds_barrier();
        lds_barrier();
    }
}
struct P3Src { const bf16* mats; int nmat; const bf16* vsrc; int vpitch; const float* dec; bf16* outp; };
DI P3Src p3_src(const Params& P, int bx) {
    P3Src s;
    if (bx < 32) { const int b = bx >> 3, h = bx & 7;
        s.mats = (const bf16*)P.out + (size_t)bx * 64 * 4 * 4096; s.nmat = 4; s.vsrc = (const bf16*)(P.ws + WS_VP) + (size_t)b * T * 512 + h * 64; s.vpitch = 512; s.dec = nullptr;
        s.outp = (bf16*)(P.ws + WS_SCR) + (size_t)b * T * 512 + h * 64; }
    else { const int g = bx - 32, bh = (g & 7) | ((g >> 4) << 3), vh = (g >> 3) & 1, b = bh >> 2, h = bh & 3;
        s.mats = (const bf16*)(P.ws + WS_XN) + (size_t)bh * 64 * 3 * 4096; s.nmat = 3; s.vsrc = (const bf16*)(P.ws + WS_PROJ0) + (size_t)b * T * N0P + C_GV + h * 128 + 64 * vh; s.vpitch = N0P;
        s.dec = (const float*)(P.ws + WS_GDEC) + (size_t)bh * 64 * 64; s.outp = (bf16*)(P.ws + WS_OARAW) + (size_t)b * T * 512 + h * 128 + 64 * vh; }
    return s;
}
DI void p3_seq(const Params& P, LAS unsigned char* lds, int tid, int wave, int lane) {
    const int bx = blockIdx.x;
    unsigned* progw = (unsigned*)(P.ws + WS_PROG);
    if (bx < 64) {
        const P3Src s = p3_src(P, bx);
        if (bx < 32) seq_pass<false>(progw + 16 * bx, s.mats, 4, s.vsrc, s.vpitch, nullptr, s.outp, lds, tid, wave, lane);
        else         seq_pass<true>(progw + 16 * bx, s.mats, 3, s.vsrc, s.vpitch, s.dec, s.outp, lds, tid, wave, lane);
    } else {
        const unsigned* xt = (const unsigned*)(P.ws + WS_XCCTAB);
        LAS unsigned* hs = (LAS unsigned*)lds;
        if (tid < 4) hs[tid] = 0u;
        __syncthreads();
        const unsigned myx = xt[bx];
        if (tid < 192) { const unsigned o = xt[64 + tid]; if (o == myx) { __hip_atomic_fetch_add(&hs[2], 1u, __ATOMIC_RELAXED, __HIP_MEMORY_SCOPE_WORKGROUP); if (64 + tid < bx) __hip_atomic_fetch_add(&hs[0], 1u, __ATOMIC_RELAXED, __HIP_MEMORY_SCOPE_WORKGROUP); } }
        if (tid >= 192 && tid < 256) { if (xt[tid - 192] == myx) { const unsigned slot = __hip_atomic_fetch_add(&hs[1], 1u, __ATOMIC_RELAXED, __HIP_MEMORY_SCOPE_WORKGROUP); hs[8 + slot] = (unsigned)(tid - 192); } }
        __syncthreads();
        const int rank = (int)hs[0], np = (int)hs[1], nh = (int)hs[2];
        unsigned pf0 = 0u;
        if (np > 0) {
            const int tgt = (int)hs[8 + (rank % np)];
            const int sub = rank / np, cnt = (nh - (rank % np) + np - 1) / np;
            const P3Src s = p3_src(P, tgt);
            const unsigned* pw = progw + 16 * tgt;
            const int nlm = s.nmat * 64;
            int pc = sub; unsigned spins = 0;
            while (pc < 64) {
                const int p = (int)__builtin_amdgcn_readfirstlane((int)__hip_atomic_load(pw, __ATOMIC_RELAXED, __HIP_MEMORY_SCOPE_AGENT));
                if (pc <= p + 8) {
                    const char* a = nullptr;
                    if (tid < nlm) a = (const char*)(s.mats + (size_t)pc * s.nmat * 4096) + (size_t)tid * 128;
                    else if (tid < nlm + 64) a = (const char*)(s.vsrc + (size_t)(pc * 64 + (tid - nlm)) * s.vpitch);
                    if (a) asm volatile("global_load_dword %0, %1, off" : "+v"(pf0) : "v"(a) : "memory");
                    pc += cnt;
                } else { __builtin_amdgcn_s_sleep(8); if (++spins > (1u << 16)) break; }
            }
        }
        asm volatile("s_waitcnt vmcnt(0)" : "+v"(pf0) :: "memory");
        __syncthreads();
    }
}

DI float silu_f(float g) { return g * __builtin_amdgcn_rcpf(1.f + __expf(-g)); }
DI void p4_finalize(const Params& P, int wave, int lane) {
    const int gw = blockIdx.x * 8 + wave, NGW = gridDim.x * 8;
    const bf16* OB = (const bf16*)(P.ws + WS_SCR); const bf16* OA = (const bf16*)(P.ws + WS_OARAW);
    const bf16* PROJ0 = (const bf16*)(P.ws + WS_PROJ0); const bf16* VP = (const bf16*)(P.ws + WS_VP); const float* BON = (const float*)(P.ws + WS_BONUS);
    bf16* O0 = (bf16*)(P.ws + WS_XN);
    const int cv = (8 * lane) & 127;
    const f32x4 gw0 = *(const f32x4*)(P.gla_norm_w + cv), gw1 = *(const f32x4*)(P.gla_norm_w + cv + 4);
    const f32x4 lw0 = *(const f32x4*)(P.ln_w + 8 * lane), lw1 = *(const f32x4*)(P.ln_w + 8 * lane + 4), lb0 = *(const f32x4*)(P.ln_b + 8 * lane), lb1 = *(const f32x4*)(P.ln_b + 8 * lane + 4);
    struct Ld { f32x4 a0, a1, b0, b1; u32x4 ga, gb, vv; float bon; };
    auto load = [&](int tok) { Ld L; const bf16* row = PROJ0 + (size_t)tok * N0P + C_GATE0;
        { const u32x4 wa = *(const u32x4*)(OA + (size_t)tok * 512 + 8 * lane), wb = *(const u32x4*)(OB + (size_t)tok * 512 + 8 * lane);
          L.a0 = (f32x4){bflo(wa.x), bfhi(wa.x), bflo(wa.y), bfhi(wa.y)}; L.a1 = (f32x4){bflo(wa.z), bfhi(wa.z), bflo(wa.w), bfhi(wa.w)};
          L.b0 = (f32x4){bflo(wb.x), bfhi(wb.x), bflo(wb.y), bfhi(wb.y)}; L.b1 = (f32x4){bflo(wb.z), bfhi(wb.z), bflo(wb.w), bfhi(wb.w)}; }
        L.ga = *(const u32x4*)(row + 8 * lane); L.gb = *(const u32x4*)(row + 512 + 8 * lane); L.vv = *(const u32x4*)(VP + (size_t)tok * 512 + 8 * lane); L.bon = BON[(size_t)tok * 8 + (lane >> 3)]; return L; };
    Ld nx = load(gw < M ? gw : 0);
    for (int tok = gw; tok < M; tok += NGW) {
        const Ld L = nx;
        if (tok + NGW < M) nx = load(tok + NGW);
        {
            const f32x4 a0 = L.a0, a1 = L.a1;
            float ss = (a0[0] * a0[0] + a0[1] * a0[1]) + (a0[2] * a0[2] + a0[3] * a0[3]) + (a1[0] * a1[0] + a1[1] * a1[1]) + (a1[2] * a1[2] + a1[3] * a1[3]);
            ss += __shfl_xor(ss, 1); ss += __shfl_xor(ss, 2); ss += __shfl_xor(ss, 4); ss += __shfl_xor(ss, 8);
            const float rstd = 1.0f / sqrtf(ss * (1.f / 128.f) + NORM_EPS);
            const u32x4 g = L.ga;
            u32x4 o;
            o.x = pk2(a0[0] * rstd * gw0[0] * silu_f(bflo(g.x)), a0[1] * rstd * gw0[1] * silu_f(bfhi(g.x)));
            o.y = pk2(a0[2] * rstd * gw0[2] * silu_f(bflo(g.y)), a0[3] * rstd * gw0[3] * silu_f(bfhi(g.y)));
            o.z = pk2(a1[0] * rstd * gw1[0] * silu_f(bflo(g.z)), a1[1] * rstd * gw1[1] * silu_f(bfhi(g.z)));
            o.w = pk2(a1[2] * rstd * gw1[2] * silu_f(bflo(g.w)), a1[3] * rstd * gw1[3] * silu_f(bfhi(g.w)));
            *(u32x4*)(O0 + (size_t)tok * 1024 + 8 * lane) = o;
        }
        {
            const f32x4 a0 = L.b0, a1 = L.b1;
            float s = (a0[0] + a0[1]) + (a0[2] + a0[3]) + (a1[0] + a1[1]) + (a1[2] + a1[3]);
            s += __shfl_xor(s, 1); s += __shfl_xor(s, 2); s += __shfl_xor(s, 4);
            const float mean = s * (1.f / 64.f);
            const f32x4 d0 = a0 - mean, d1 = a1 - mean;
            float q = (d0[0] * d0[0] + d0[1] * d0[1]) + (d0[2] * d0[2] + d0[3] * d0[3]) + (d1[0] * d1[0] + d1[1] * d1[1]) + (d1[2] * d1[2] + d1[3] * d1[3]);
            q += __shfl_xor(q, 1); q += __shfl_xor(q, 2); q += __shfl_xor(q, 4);
            const float rstd = 1.0f / sqrtf(q * (1.f / 64.f) + RWKV_LN_EPS);
            const float bon = L.bon; const u32x4 vv = L.vv, g = L.gb;
            u32x4 o;
            o.x = pk2((d0[0] * rstd * lw0[0] + lb0[0] + bon * bflo(vv.x)) * silu_f(bflo(g.x)), (d0[1] * rstd * lw0[1] + lb0[1] + bon * bfhi(vv.x)) * silu_f(bfhi(g.x)));
            o.y = pk2((d0[2] * rstd * lw0[2] + lb0[2] + bon * bflo(vv.y)) * silu_f(bflo(g.y)), (d0[3] * rstd * lw0[3] + lb0[3] + bon * bfhi(vv.y)) * silu_f(bfhi(g.y)));
            o.z = pk2((d1[0] * rstd * lw1[0] + lb1[0] + bon * bflo(vv.z)) * silu_f(bflo(g.z)), (d1[1] * rstd * lw1[1] + lb1[1] + bon * bfhi(vv.z)) * silu_f(bfhi(g.z)));
            o.w = pk2((d1[2] * rstd * lw1[2] + lb1[2] + bon * bflo(vv.w)) * silu_f(bflo(g.w)), (d1[3] * rstd * lw1[3] + lb1[3] + bon * bfhi(vv.w)) * silu_f(bfhi(g.w)));
            *(u32x4*)(O0 + (size_t)tok * 1024 + 512 + 8 * lane) = o;
        }
    }
}
constexpr int AT_KP = 144, AT_VP = 528, AT_VOFF = 256 * AT_KP;
DI void rope_cs(const float* RT, int pos, float (&cs)[8], float (&sn)[8]) {
    const f32x4* tp = (const f32x4*)(RT + (size_t)pos * 16);
#pragma unroll
    for (int q = 0; q < 4; ++q) { const f32x4 v = tp[q]; cs[2 * q] = v[0]; sn[2 * q] = v[1]; cs[2 * q + 1] = v[2]; sn[2 * q + 1] = v[3]; }
}
DI void p7_attn(const Params& P, LAS unsigned char* lds, int tid, int wave, int lane) {
    const bf16* PROJ1 = (const bf16*)(P.ws + WS_SCR); bf16* O1 = (bf16*)(P.ws + WS_XN); const float* RT = (const float*)(P.ws + WS_ROPE);
    const int vcu = ((int)blockIdx.x & 7) * ((int)gridDim.x >> 3) + ((int)blockIdx.x >> 3);
    const int m = lane & 31, hi = lane >> 5;
    const int c8 = tid & 7, kpar = (tid >> 3) & 1;
    u32x4 kw[4], vw[4];
    auto uload = [&](int unit) {
        const int qb = unit & 31, kvh = (unit >> 5) & 3, b = unit >> 7;
#pragma unroll
        for (int q = 0; q < 4; ++q) { const int key = (tid >> 3) + 64 * q; const int pos = qb * 128 - 128 + key;
            kw[q] = (u32x4){0u, 0u, 0u, 0u}; vw[q] = (u32x4){0u, 0u, 0u, 0u};
            if (pos >= 0) { const bf16* row = PROJ1 + (size_t)(b * T + pos) * IN1; kw[q] = *(const u32x4*)(row + 1024 + kvh * 64 + 8 * c8); vw[q] = *(const u32x4*)(row + 1280 + kvh * 64 + 8 * c8); } }
    };
    if (vcu < 512) uload(vcu);
    struct QG { u32x4 q[4], qo; u32x2 g[8]; };
    auto qgload = [&](int unit, int qq) { QG r; const int qb = unit & 31, kvh = (unit >> 5) & 3, b = unit >> 7; const int h = kvh * 4 + (wave >> 1);
        const int pos = qb * 128 + (wave & 1) * 64 + 32 * qq + m; const bf16* row = PROJ1 + ((size_t)b * T + pos) * IN1;
#pragma unroll
        for (int s = 0; s < 4; ++s) r.q[s] = *(const u32x4*)(row + h * 64 + 16 * s + 8 * hi);
        r.qo = *(const u32x4*)(row + h * 64 + 8 * (hi ^ 1));
#pragma unroll
        for (int db = 0; db < 2; ++db)
#pragma unroll
            for (int gq = 0; gq < 4; ++gq) r.g[4 * db + gq] = *(const u32x2*)(row + 1536 + h * 64 + 32 * db + 8 * gq + 4 * hi);
        return r; };
    QG nxq = qgload(vcu < 512 ? vcu : 0, 0);
    for (int unit = vcu; unit < 512; unit += gridDim.x) {
        const int qb = unit & 31, kvh = (unit >> 5) & 3, b = unit >> 7;
#pragma unroll
        for (int q = 0; q < 4; ++q) {
            const int key = (tid >> 3) + 64 * q; const int pos = qb * 128 - 128 + key;
            u32x4 kq = kw[q];
            if (c8 < 2 && pos >= 0) { const bf16* row = PROJ1 + (size_t)(b * T + pos) * IN1;
                const u32x4 ow = *(const u32x4*)(row + 1024 + kvh * 64 + 8 * (c8 ^ 1)); float a[8], o[8], cs[8], sn[8]; unpack8(kq, a); unpack8(ow, o); rope_cs(RT, pos, cs, sn);
                float r[8];
#pragma unroll
                for (int j = 0; j < 8; ++j) r[j] = (c8 == 0) ? (a[j] * cs[j] - o[j] * sn[j]) : (a[j] * cs[j] + o[j] * sn[j]);
                kq.x = pk2(r[0], r[1]); kq.y = pk2(r[2], r[3]); kq.z = pk2(r[4], r[5]); kq.w = pk2(r[6], r[7]); }
            *(LAS u32x4*)(lds + key * AT_KP + c8 * 16) = kq;
            const u32x4 rv = vw[q];
            const unsigned k0 = kpar ? rv[2] : rv[0], k1 = kpar ? rv[3] : rv[1], s0 = kpar ? rv[0] : rv[2], s1 = kpar ? rv[1] : rv[3];
            const unsigned r0 = (unsigned)__builtin_amdgcn_update_dpp(0, (int)s0, 0x128, 0xf, 0xf, true), r1 = (unsigned)__builtin_amdgcn_update_dpp(0, (int)s1, 0x128, 0xf, 0xf, true);
            unsigned o4[4];
            if (kpar == 0) { o4[0] = (k0 & 0xffffu) | (r0 << 16); o4[1] = (k0 >> 16) | (r0 & 0xffff0000u); o4[2] = (k1 & 0xffffu) | (r1 << 16); o4[3] = (k1 >> 16) | (r1 & 0xffff0000u); }
            else           { o4[0] = (r0 & 0xffffu) | (k0 << 16); o4[1] = (r0 >> 16) | (k0 & 0xffff0000u); o4[2] = (r1 & 0xffffu) | (k1 << 16); o4[3] = (r1 >> 16) | (k1 & 0xffff0000u); }
            const int tp = key >> 1, gsw = (tp >> 2) ^ c8;
#pragma unroll
            for (int jj = 0; jj < 4; ++jj) *(LAS unsigned*)(lds + AT_VOFF + (8 * c8 + 4 * kpar + jj) * AT_VP + (4 * gsw + (tp & 3)) * 4) = o4[jj];
        }
        lds_barrier();
        if (unit + (int)gridDim.x < 512) uload(unit + gridDim.x);
        const int g = wave >> 1, h = kvh * 4 + g; const float sink = P.sinks[h] * 1.44269504f;
        for (int qq = 0; qq < 2; ++qq) {
            const int qs = (wave & 1) * 64 + 32 * qq, qi = qs + m, pos = qb * 128 + qi; const size_t tok = (size_t)b * T + pos;
            const QG cq = nxq;
            { const int nu = (qq == 0) ? unit : unit + (int)gridDim.x; if (nu < 512) nxq = qgload(nu, qq ^ 1); }
            bf16x8 Q[4];
#pragma unroll
            for (int s = 0; s < 4; ++s) { const u32x4 w = cq.q[s]; float a[8]; unpack8(w, a);
                if (s == 0) { const u32x4 ow = cq.qo; float o[8], cs[8], sn[8]; unpack8(ow, o); rope_cs(RT, pos, cs, sn);
#pragma unroll
                    for (int j = 0; j < 8; ++j) a[j] = (hi == 0) ? (a[j] * cs[j] - o[j] * sn[j]) : (a[j] * cs[j] + o[j] * sn[j]); }
                u32x4 qw;
#pragma unroll
                for (int e = 0; e < 4; ++e) qw[e] = pk2(a[2 * e] * 0.18033688f, a[2 * e + 1] * 0.18033688f);
                Q[s] = __builtin_bit_cast(bf16x8, qw); }
            const int kb0 = qs >> 5;
            f32x16 sc[5];
#pragma unroll
            for (int kbi = 0; kbi < 5; ++kbi) {
#pragma unroll
                for (int i = 0; i < 16; ++i) sc[kbi][i] = 0.f;
#pragma unroll
                for (int s = 0; s < 4; ++s) { const bf16x8 A = *(const LAS bf16x8*)(lds + (32 * (kb0 + kbi) + m) * AT_KP + (16 * s + 8 * hi) * 2); sc[kbi] = MFMA32(A, Q[s], sc[kbi]); }
            }
            float mx = sink;
#pragma unroll
            for (int kbi = 0; kbi < 5; ++kbi)
#pragma unroll
                for (int i = 0; i < 16; ++i) { const int kj = 32 * (kb0 + kbi) + crow(i, hi);
                    const bool band = (kbi == 0) ? (kj >= qi + 1) : ((kbi == 4) ? (kj <= qi + 128) : true); const bool vis = band && (qb > 0 || kj >= 128);
                    sc[kbi][i] = vis ? sc[kbi][i] : -1e30f; mx = fmaxf(mx, sc[kbi][i]); }
            mx = fmaxf(mx, __shfl_xor(mx, 32));
            float sum = 0.f;
#pragma unroll
            for (int kbi = 0; kbi < 5; ++kbi)
#pragma unroll
                for (int i = 0; i < 16; ++i) { const float pv = __builtin_amdgcn_exp2f(sc[kbi][i] - mx); sc[kbi][i] = pv; sum += pv; }
            sum += __shfl_xor(sum, 32);
            const float inv = __builtin_amdgcn_rcpf(sum + __builtin_amdgcn_exp2f(sink - mx));
            f32x16 oacc[2];
#pragma unroll
            for (int db = 0; db < 2; ++db) {
#pragma unroll
                for (int i = 0; i < 16; ++i) oacc[db][i] = 0.f;
                const int vrow = 32 * db + m, rsw = (vrow >> 3) & 7;
#pragma unroll
                for (int kbi = 0; kbi < 5; ++kbi)
#pragma unroll
                    for (int s2 = 0; s2 < 2; ++s2) { u32x4 pw;
#pragma unroll
                        for (int e = 0; e < 4; ++e) pw[e] = pk2(sc[kbi][8 * s2 + 2 * e], sc[kbi][8 * s2 + 2 * e + 1]);
                        const int ga = 4 * (kb0 + kbi) + 2 * s2;
                        const LAS unsigned char* vp = lds + AT_VOFF + vrow * AT_VP + 8 * hi;
                        const u32x2 lo = *(const LAS u32x2*)(vp + (ga ^ rsw) * 16), hi2 = *(const LAS u32x2*)(vp + ((ga + 1) ^ rsw) * 16);
                        const u32x4 aw = (u32x4){lo.x, lo.y, hi2.x, hi2.y};
                        oacc[db] = MFMA32(__builtin_bit_cast(bf16x8, aw), __builtin_bit_cast(bf16x8, pw), oacc[db]); }
            }
#pragma unroll
            for (int db = 0; db < 2; ++db)
#pragma unroll
                for (int gq = 0; gq < 4; ++gq) { const int d0 = 32 * db + 8 * gq + 4 * hi; const u32x2 gw = cq.g[4 * db + gq];
                    u32x2 o; o.x = pk2(oacc[db][4 * gq] * inv * silu_f(bflo(gw.x)), oacc[db][4 * gq + 1] * inv * silu_f(bfhi(gw.x)));
                    o.y = pk2(oacc[db][4 * gq + 2] * inv * silu_f(bflo(gw.y)), oacc[db][4 * gq + 3] * inv * silu_f(bfhi(gw.y)));
                    *(u32x2*)(O1 + tok * 1024 + h * 64 + d0) = o; }
        }
        lds_barrier();
    }
}
DI void p9_final(const Params& P, int wave, int lane) {
    const int gw = blockIdx.x * 8 + wave, NGW = gridDim.x * 8;
    const float* slots = (const float*)(P.ws + WS_SLOT2);
    for (int mrow = gw; mrow < M; mrow += NGW) {
        float s = (lane < 16) ? slots[(size_t)mrow * 16 + lane] : 0.f;
        s += __shfl_xor(s, 1); s += __shfl_xor(s, 2); s += __shfl_xor(s, 4); s += __shfl_xor(s, 8);
        s = __shfl(s, 0);
        const float rstd = 1.0f / sqrtf(s * (1.f / 1024.f) + NORM_EPS);
        f32x4* o = (f32x4*)(P.out + (size_t)mrow * D) + lane; const f32x4* w = (const f32x4*)P.final_w + lane;
#pragma unroll
        for (int j = 0; j < 4; ++j) { const f32x4 v = o[64 * j]; o[64 * j] = v * rstd * w[64 * j]; }
    }
}

__global__ void __launch_bounds__(512) fwd_megakernel(Params P) {
    extern __shared__ __attribute__((aligned(16))) unsigned char lds_raw[];
    LAS unsigned char* lds = (LAS unsigned char*)lds_raw;
    cg::grid_group grid = cg::this_grid();
    const int tid = threadIdx.x, lane = tid & 63, wave = __builtin_amdgcn_readfirstlane(tid >> 6);
    const int G = gridDim.x;
    if (tid < 2) ((LAS unsigned*)(lds + LDS_BAR_OFF))[tid] = 0u;
    __syncthreads();
    if (tid == 0) ((unsigned*)(P.ws + WS_XCCTAB))[blockIdx.x] = xb_xcc_id() + 1u;
    const XcdBarrier xbar = xcd_barrier_post((unsigned*)(P.ws + WS_CTL), (volatile LAS unsigned*)(lds + LDS_BAR_OFF));
    bf16* XN = (bf16*)(P.ws + WS_XN);
    p0_prologue(P, lds, wave, lane);
    if (P.ws == nullptr) grid.sync();
    xcd_barrier(xbar);
    { pg8::Gemm g{XN, (const bf16*)(P.ws + WS_W0T), M, N0P, D}; pg8::StaticOrder S; S.init(M, N0P, G, (int)blockIdx.x);
      EpiScaleBf16 E{(bf16*)(P.ws + WS_PROJ0), N0P, nullptr, nullptr, 0};
      pg8::gemm_phase<EpiScaleBf16, pg8::StaticOrder, true, true>(lds, g, S, E); }
    xcd_barrier(xbar);
#pragma unroll 1
    for (int rep = 0; rep < REP_P2R; ++rep) { for (int it = blockIdx.x; it < 512; it += G) rwkv_prep_item(P, it, lds, wave, lane); }
#pragma unroll 1
    for (int rep = 0; rep < REP_P2G; ++rep) { for (int it = blockIdx.x; it < 1024; it += G) gla_prep_item(P, it, lds, wave, lane); }
    xcd_barrier(xbar);
#pragma unroll 1
    for (int rep = 0; rep < REP_P3; ++rep) { p3_seq(P, lds, tid, wave, lane); __syncthreads(); }
    xcd_barrier(xbar);
    p4_finalize(P, wave, lane);
    xcd_barrier(xbar);
    { pg8::Gemm g{XN, (const bf16*)(P.ws + WS_WO0T), M, D, D}; pg8::StaticOrder S; S.init(M, D, G, (int)blockIdx.x);
      EpiResid E{P.x, (bf16*)(P.ws + WS_H1B), (float*)(P.ws + WS_SLOT1)};
      pg8::gemm_phase<EpiResid, pg8::StaticOrder, true, true>(lds, g, S, E); }
    xcd_barrier(xbar);
    { pg8::Gemm g{(const bf16*)(P.ws + WS_H1B), (const bf16*)(P.ws + WS_W1T), M, IN1, D}; pg8::StaticOrder S; S.init(M, IN1, G, (int)blockIdx.x);
      EpiScaleBf16 E{(bf16*)(P.ws + WS_SCR), IN1, (const float*)(P.ws + WS_SLOT1), P.b_in1, 1536};
      pg8::gemm_phase<EpiScaleBf16, pg8::StaticOrder, true, true>(lds, g, S, E); }
    xcd_barrier(xbar);
    p7_attn(P, lds, tid, wave, lane);
    xcd_barrier(xbar);
    { pg8::Gemm g{XN, (const bf16*)(P.ws + WS_WO1T), M, D, D}; pg8::StaticOrder S; S.init(M, D, G, (int)blockIdx.x);
      EpiResidNorm E{(const bf16*)(P.ws + WS_H1B), P.out, P.b_out1, P.final_w, (float*)(P.ws + WS_SLOT2), (unsigned*)(P.ws + WS_PCNT)};
      pg8::gemm_phase<EpiResidNorm, pg8::StaticOrder, false, true>(lds, g, S, E); }
}

extern "C" void kernel_launch(void* const* d_in, const int* in_sizes, int n_in, void* d_out, int out_size, void* d_ws, size_t ws_size, hipStream_t stream) {
    static int grid = 0;
    if (grid == 0) {
        if (n_in != 23 || out_size != M * D || ws_size < WS_END) { fprintf(stderr, "kernel_launch: unexpected sizes n_in %d out %d ws %zu\n", n_in, out_size, ws_size); grid = -1; return; }
        int dev = 0, cus = 0, per_cu = 0;
        hipGetDevice(&dev); hipDeviceGetAttribute(&cus, hipDeviceAttributeMultiprocessorCount, dev);
        hipFuncSetAttribute((const void*)fwd_megakernel, hipFuncAttributeMaxDynamicSharedMemorySize, LDS_BYTES);
        hipOccupancyMaxActiveBlocksPerMultiprocessor(&per_cu, (const void*)fwd_megakernel, 512, LDS_BYTES);
        if (per_cu < 1) { fprintf(stderr, "kernel_launch: occupancy query says %d blocks/CU\n", per_cu); per_cu = 1; }
        grid = cus * 1;
        if (grid != 256) { fprintf(stderr, "kernel_launch: built for a 256-CU device (got %d)\n", cus); grid = -1; return; }
        (void)hipGetLastError();
    }
    if (grid < 0) return;
    Params p{};
    const float** pp = (const float**)&p;
    for (int i = 0; i < 23; ++i) pp[i] = (const float*)d_in[i];
    p.out = (float*)d_out; p.ws = (unsigned char*)d_ws;
    if (hipMemsetAsync((char*)d_ws + WS_CTL, 0, CTL_BYTES, stream) != hipSuccess) { fprintf(stderr, "memset failed\n"); return; }
    void* args[] = {&p};
    hipError_t e = hipLaunchCooperativeKernel((const void*)fwd_megakernel, dim3(grid), dim3(512), args, LDS_BYTES, stream);
    if (e != hipSuccess) fprintf(stderr, "cooperative launch failed: %s (grid %d)\n", hipGetErrorString(e), grid);
}
```

```cpp
#include <hip/hip_runtime.h>
#include <hip/hip_cooperative_groups.h>
#include <cstdio>
#include <cstdint>
namespace cg = cooperative_groups;
#ifndef REP_P2R
#define REP_P2R 1
#endif
#ifndef REP_P2G
#define REP_P2G 1
#endif
#ifndef REP_S2
#define REP_S2 1
#endif
#ifndef REP_P3
#define REP_P3 1
#endif
namespace pg8 {
#define PG8_LAS __attribute__((address_space(3)))
typedef unsigned short bf16_t;
typedef short bf16x8 __attribute__((ext_vector_type(8)));
typedef float f32x4 __attribute__((ext_vector_type(4)));
typedef unsigned u32x4 __attribute__((ext_vector_type(4)));
constexpr int BM = 256, BK = 64, HALF = 128, HTB = HALF * BK * 2  , STAGE_BYTES = 8 * HTB, NXCD = 8, WGM = 8;

__host__ __device__ __forceinline__ int lds_byte(int r, int c) { const int st = (r >> 4) * 2 + (c >> 5), rr = r & 15, cc = c & 31, ob = rr * 64 + cc * 2; return st * 1024 + (ob ^ (((ob >> 9) & 1) << 5)); }
__host__ __device__ __forceinline__ void stage_rc(int b, int& R, int& C) { const int st = b / 1024, sb = b % 1024, swz = sb ^ (((sb >> 9) & 1) << 5); R = (st >> 1) * 16 + swz / 64; C = (st & 1) * 32 + (swz % 64) / 2; }
__host__ __device__ __forceinline__ int perm32(int rho) { const int n = rho >> 4, i = rho & 15; return 8 * (i >> 2) + 4 * n + (i & 3); }

struct Unit { int pm, pn; };
struct Gemm { const bf16_t* A; const bf16_t* Bt; int M, N, K; };

struct StaticOrder {
    int nM, nN, nwg, G, c;
    __host__ __device__ void init(int M, int N, int G_, int c_) { nM = M / BM; nN = N / BM; nwg = nM * nN; G = G_; c = c_; }
    __host__ __device__ bool next(int i, Unit& u) const {
        const long L = (long)i * G + c; if (L >= nwg) return false;
        int wgid = (int)L; { const int q = nwg / NXCD, r = nwg % NXCD, xcd = wgid % NXCD, off = wgid / NXCD; wgid = (xcd < r ? xcd * (q + 1) : r * (q + 1) + (xcd - r) * q) + off; }
        const int nig = WGM * nN, gid = wgid / nig, fm = gid * WGM, gsz = (nM - fm) < WGM ? (nM - fm) : WGM;
        u.pm = fm + ((wgid % nig) % gsz); u.pn = (wgid % nig) / gsz; return true;
    }
    __device__ __forceinline__ void a_ready(const Unit&) const {}
    __device__ __forceinline__ void done(const Unit&) const {}
};

template <class Epi, class Sched, bool ALIGN_EPI = false, bool SP2 = false>
__device__ __forceinline__ void gemm_phase(PG8_LAS unsigned char* lds, const Gemm g, const Sched& S, const Epi& E) {
    const int tid = threadIdx.x, wid = __builtin_amdgcn_readfirstlane(tid >> 6), lane = tid & 63, wr = wid >> 2, wc = wid & 3, fr = lane & 15, fq = lane >> 4;
    const int K = g.K, nt = K / BK;
    unsigned voffA[2], voffB[2];
#pragma unroll
    for (int i = 0; i < 2; ++i) { int R, C; stage_rc(tid * 16 + i * 8192, R, C); const int Rb = Epi::PERM ? ((R & ~31) + perm32(R & 31)) : R;
        voffA[i] = (unsigned)(R * K + C) * 2u; voffB[i] = (unsigned)(Rb * K + C) * 2u; }
    const size_t kstep = (size_t)(BK * 2);
    const size_t hstep = (size_t)HALF * K * 2;
    const size_t tstep = 2 * hstep;
    const unsigned ldsw = (unsigned)wid * 1024u;
    const int aoff = lds_byte(wr * 64 + fr, fq * 8), boff = lds_byte(wc * 32 + fr, fq * 8);
#define PG8_SA(b, h) (((b) * 2 + (h)) * HTB)
#define PG8_SB(b, h) ((4 + (b) * 2 + (h)) * HTB)
#define PG8_STAGE(bufoff, gbase, voff) do { _Pragma("unroll") for (int _i = 0; _i < 2; ++_i) \
        __builtin_amdgcn_global_load_lds((const unsigned*)((const char*)(gbase) + (voff)[_i]), (PG8_LAS unsigned*)(lds + (bufoff) + ldsw + _i * 8192), 16, 0, 0); } while (0)
#define PG8_LDA(dst, b, h) do { _Pragma("unroll") for (int m = 0; m < 4; ++m) _Pragma("unroll") for (int k = 0; k < 2; ++k) dst[m][k] = *(const PG8_LAS bf16x8*)(lds + PG8_SA(b, h) + aoff + m * 2048 + k * 1024); } while (0)
#define PG8_LDB(dst, b, h) do { _Pragma("unroll") for (int n = 0; n < 2; ++n) _Pragma("unroll") for (int k = 0; k < 2; ++k) dst[n][k] = *(const PG8_LAS bf16x8*)(lds + PG8_SB(b, h) + boff + n * 2048 + k * 1024); } while (0)
#define PG8_MMA(ai, bj, At, Bt) do { __builtin_amdgcn_s_setprio(1); _Pragma("unroll") for (int m = 0; m < 4; ++m) _Pragma("unroll") for (int n = 0; n < 2; ++n) _Pragma("unroll") for (int k = 0; k < 2; ++k) \
        acc[ai][bj][m][n] = __builtin_amdgcn_mfma_f32_16x16x32_bf16(Bt[n][k], At[m][k], acc[ai][bj][m][n], 0, 0, 0); __builtin_amdgcn_s_setprio(0); } while (0)
#define PG8_WAIT_V(n) asm volatile("s_waitcnt vmcnt(" #n ")" ::: "memory")
#define PG8_WAIT_L(n) asm volatile("s_waitcnt lgkmcnt(" #n ")" ::: "memory")
#define PG8_BAR __builtin_amdgcn_s_barrier()
#define PG8_SCHED __builtin_amdgcn_sched_barrier(0)
    Unit cur, nxt; int ui = 0;
    if (!S.next(0, cur)) return;
    f32x4 acc[2][2][4][2];
#pragma unroll
    for (int a = 0; a < 2; ++a)
#pragma unroll
        for (int b = 0; b < 2; ++b)
#pragma unroll
            for (int m = 0; m < 4; ++m)
#pragma unroll
                for (int n = 0; n < 2; ++n) acc[a][b][m][n] = (f32x4){0.f, 0.f, 0.f, 0.f};
    bf16x8 At[4][2], B0[2][2], B1[2][2];
    const char* cA = (const char*)g.A + (size_t)cur.pm * tstep; const char* cB = (const char*)g.Bt + (size_t)cur.pn * tstep;
    S.a_ready(cur);
    if constexpr (SP2) {
        PG8_STAGE(PG8_SB(0, 0), cB, voffB); PG8_STAGE(PG8_SB(0, 1), cB + hstep, voffB); PG8_STAGE(PG8_SA(0, 0), cA, voffA); PG8_STAGE(PG8_SA(0, 1), cA + hstep, voffA);
        if (wr == 1) PG8_BAR;
        PG8_WAIT_V(2); PG8_BAR;
        PG8_STAGE(PG8_SB(1, 0), cB + kstep, voffB); PG8_STAGE(PG8_SA(1, 0), cA + kstep, voffA); PG8_STAGE(PG8_SB(1, 1), cB + hstep + kstep, voffB);
        PG8_WAIT_V(6); PG8_BAR;
    } else {
        PG8_STAGE(PG8_SB(0, 0), cB, voffB); PG8_STAGE(PG8_SA(0, 0), cA, voffA); PG8_STAGE(PG8_SB(0, 1), cB + hstep, voffB); PG8_STAGE(PG8_SA(0, 1), cA + hstep, voffA);
        if (wr == 1) PG8_BAR;
        PG8_WAIT_V(4); PG8_BAR;
        PG8_STAGE(PG8_SB(1, 0), cB + kstep, voffB); PG8_STAGE(PG8_SA(1, 0), cA + kstep, voffA); PG8_STAGE(PG8_SB(1, 1), cB + hstep + kstep, voffB);
        PG8_WAIT_V(6); PG8_BAR;
    }
    for (;;) {
        const bool has_next = S.next(ui + 1, nxt);
        const char* nA = has_next ? (const char*)g.A + (size_t)nxt.pm * tstep : cA; const char* nB = has_next ? (const char*)g.Bt + (size_t)nxt.pn * tstep : cB;
        for (int t = 0; t < nt; t += 2) {
            const bool last = (t == nt - 2);
            const char* a1 = cA + (size_t)(t + 1) * kstep;
            const char* a2 = last ? nA : cA + (size_t)(t + 2) * kstep; const char* b2 = last ? nB : cB + (size_t)(t + 2) * kstep;
            const char* a3 = a2 + kstep; const char* b3 = b2 + kstep;
            if (last && has_next) S.a_ready(nxt);
            if constexpr (SP2) {
            PG8_LDB(B0, 0, 0); PG8_LDB(B1, 0, 1); PG8_SCHED; PG8_LDA(At, 0, 0); PG8_STAGE(PG8_SA(1, 1), a1 + hstep, voffA);
            PG8_WAIT_V(8); PG8_WAIT_L(0); PG8_BAR; PG8_MMA(0, 0, At, B0); PG8_MMA(0, 1, At, B1); PG8_BAR; PG8_SCHED;
            PG8_LDA(At, 0, 1); PG8_STAGE(PG8_SB(0, 0), b2, voffB); PG8_STAGE(PG8_SB(0, 1), b2 + hstep, voffB); PG8_STAGE(PG8_SA(0, 0), a2, voffA);
            PG8_WAIT_V(8); PG8_WAIT_L(0); PG8_BAR; PG8_MMA(1, 0, At, B0); PG8_MMA(1, 1, At, B1); PG8_BAR; PG8_SCHED;
            PG8_LDB(B0, 1, 0); PG8_LDB(B1, 1, 1); PG8_SCHED; PG8_LDA(At, 1, 0); PG8_STAGE(PG8_SA(0, 1), a2 + hstep, voffA);
            PG8_WAIT_V(8); PG8_WAIT_L(0); PG8_BAR; PG8_MMA(0, 0, At, B0); PG8_MMA(0, 1, At, B1); PG8_BAR; PG8_SCHED;
            PG8_LDA(At, 1, 1); PG8_STAGE(PG8_SB(1, 0), b3, voffB); PG8_STAGE(PG8_SB(1, 1), b3 + hstep, voffB); PG8_STAGE(PG8_SA(1, 0), a3, voffA);
            PG8_WAIT_V(8); PG8_WAIT_L(0); PG8_BAR; PG8_MMA(1, 0, At, B0); PG8_MMA(1, 1, At, B1); PG8_BAR; PG8_SCHED;
            } else {
            PG8_LDB(B0, 0, 0); PG8_SCHED; PG8_LDA(At, 0, 0); PG8_STAGE(PG8_SA(1, 1), a1 + hstep, voffA);
            PG8_WAIT_L(8); PG8_BAR; PG8_WAIT_L(0); PG8_MMA(0, 0, At, B0); PG8_BAR; PG8_SCHED;
            PG8_LDB(B1, 0, 1); PG8_STAGE(PG8_SB(0, 0), b2, voffB);
            PG8_BAR; PG8_WAIT_L(0); PG8_MMA(0, 1, At, B1); PG8_BAR;
            PG8_LDA(At, 0, 1); PG8_STAGE(PG8_SA(0, 0), a2, voffA);
            PG8_BAR; PG8_WAIT_L(0); PG8_MMA(1, 0, At, B0); PG8_BAR; PG8_SCHED;
            PG8_STAGE(PG8_SB(0, 1), b2 + hstep, voffB);
            PG8_WAIT_V(6); PG8_BAR; PG8_MMA(1, 1, At, B1); PG8_BAR;
            PG8_LDB(B0, 1, 0); PG8_SCHED; PG8_LDA(At, 1, 0); PG8_STAGE(PG8_SA(0, 1), a2 + hstep, voffA);
            PG8_WAIT_L(8); PG8_BAR; PG8_WAIT_L(0); PG8_MMA(0, 0, At, B0); PG8_BAR; PG8_SCHED;
            PG8_LDB(B1, 1, 1); PG8_STAGE(PG8_SB(1, 0), b3, voffB);
            PG8_BAR; PG8_WAIT_L(0); PG8_MMA(0, 1, At, B1); PG8_BAR;
            PG8_LDA(At, 1, 1); PG8_STAGE(PG8_SA(1, 0), a3, voffA);
            PG8_BAR; PG8_WAIT_L(0); PG8_MMA(1, 0, At, B0); PG8_BAR; PG8_SCHED;
            PG8_STAGE(PG8_SB(1, 1), b3 + hstep, voffB);
            PG8_WAIT_V(6); PG8_BAR; PG8_MMA(1, 1, At, B1); PG8_BAR;
            }
        }
        if constexpr (ALIGN_EPI) { if (wr == 0) PG8_BAR; }
        if constexpr (!Epi::AFTER_DRAIN) { E(acc, cur, wr, wc, fr, fq); S.done(cur); }
        if (!has_next) break;
#pragma unroll
        for (int a = 0; a < 2; ++a)
#pragma unroll
            for (int b = 0; b < 2; ++b)
#pragma unroll
                for (int m = 0; m < 4; ++m)
#pragma unroll
                    for (int n = 0; n < 2; ++n) acc[a][b][m][n] = (f32x4){0.f, 0.f, 0.f, 0.f};
        cur = nxt; cA = nA; cB = nB; ++ui;
        if constexpr (ALIGN_EPI) { if (wr == 1) PG8_BAR; }
    }
    PG8_WAIT_V(0);
    if constexpr (!ALIGN_EPI) { if (wr == 0) PG8_BAR; }
    PG8_BAR;
    if constexpr (Epi::AFTER_DRAIN) { E.fused(acc, cur, wr, wc, fr, fq, lds, wid, lane); S.done(cur); }
#undef PG8_SA
#undef PG8_SB
#undef PG8_STAGE
#undef PG8_LDA
#undef PG8_LDB
#undef PG8_MMA
#undef PG8_WAIT_V
#undef PG8_WAIT_L
#undef PG8_BAR
#undef PG8_SCHED
}
}
#define GAS __attribute__((address_space(1)))
#define LAS __attribute__((address_space(3)))
#define AS4 __attribute__((address_space(4)))
#define DI __device__ __forceinline__
typedef unsigned short bf16;
typedef float f32x4 __attribute__((ext_vector_type(4)));
typedef float f32x16 __attribute__((ext_vector_type(16)));
typedef short bf16x8 __attribute__((ext_vector_type(8)));
typedef short s16x4 __attribute__((ext_vector_type(4)));
typedef unsigned u32x4 __attribute__((ext_vector_type(4)));
typedef unsigned u32x2 __attribute__((ext_vector_type(2)));
typedef __bf16 bf2v __attribute__((ext_vector_type(2)));

constexpr int NB = 4, T = 4096, M = NB * T, D = 1024;
constexpr int IN0 = 3728, N0P = 3840, IN1 = 2560;
constexpr int C_GQ = 0, C_GK = 256, C_GV = 512, C_GLOW = 1024, C_RW = 1040, C_GATE0 = 2704;
constexpr int C_RR = C_RW, C_RK = C_RW + 512, C_RV = C_RW + 1024, C_XW = C_RW + 1536, C_XA = C_RW + 1600;
constexpr float NORM_EPS = 1e-5f, RWKV_LN_EPS = 64e-5f;
constexpr size_t MiB = 1u << 20;
constexpr size_t WS_W0T = 0, WS_WO0T = 8 * MiB, WS_W1T = 10 * MiB, WS_WO1T = 15 * MiB;
constexpr size_t WS_SLOT1 = 17 * MiB, WS_SLOT2 = 18 * MiB, WS_BONUS = 19 * MiB, WS_GDEC = 19 * MiB + 512 * 1024;
constexpr size_t WS_CTL = 19 * MiB + 768 * 1024, CTL_BYTES = 40960, WS_PCNT = WS_CTL + 16384;
constexpr size_t WS_XCCTAB = WS_CTL + 32768, WS_PROG = WS_CTL + 33792;
constexpr int LDS_BAR_OFF = 147456 - 64;
constexpr size_t WS_ROPE = 18 * MiB + 512 * 1024;
constexpr size_t WS_WLT = 18 * MiB + 768 * 1024;
constexpr size_t WS_XN = 20 * MiB;
constexpr size_t WS_PROJ0 = 52 * MiB;
constexpr size_t WS_H1B = 116 * MiB;
constexpr size_t WS_SCR = 172 * MiB;
constexpr size_t WS_OARAW = 204 * MiB;
constexpr size_t WS_VP = 236 * MiB;
constexpr size_t WS_END = 252 * MiB;
constexpr int LDS_BYTES = 147456;

struct Params {
    const float *x, *norm_w, *w_in0, *gk_up, *gk_bias, *gla_norm_w, *mu, *w0, *w_up, *a0, *a_up, *k_k, *k_a, *r_k, *ln_w, *ln_b, *w_out0, *w_in1, *b_in1, *sinks, *w_out1, *b_out1, *final_w;
    float* out; unsigned char* ws;
};

typedef float f32x2v __attribute__((ext_vector_type(2)));
DI unsigned pk2(float lo, float hi) { const f32x2v f = {lo, hi}; return __builtin_bit_cast(unsigned, __builtin_convertvector(f, bf2v)); }
DI unsigned f2bf(float f) { return pk2(f, 0.f) & 0xffffu; }
DI float bf2f(unsigned h) { return __builtin_bit_cast(float, h << 16); }
DI float bflo(unsigned w) { return __builtin_bit_cast(float, w << 16); }
DI float bfhi(unsigned w) { return __builtin_bit_cast(float, w & 0xffff0000u); }
DI float wave_sum(float v) {
#pragma unroll
    for (int o = 1; o < 64; o <<= 1) v += __shfl_xor(v, o);
    return v;
}
DI float dpp_sum16(float v) {
    v += __builtin_bit_cast(float, __builtin_amdgcn_update_dpp(0, __builtin_bit_cast(int, v), 0xB1, 0xf, 0xf, true));
    v += __builtin_bit_cast(float, __builtin_amdgcn_update_dpp(0, __builtin_bit_cast(int, v), 0x4E, 0xf, 0xf, true));
    v += __builtin_bit_cast(float, __builtin_amdgcn_update_dpp(0, __builtin_bit_cast(int, v), 0x141, 0xf, 0xf, true));
    v += __builtin_bit_cast(float, __builtin_amdgcn_update_dpp(0, __builtin_bit_cast(int, v), 0x140, 0xf, 0xf, true));
    return v;
}
DI float half_sum32(float v) { v = dpp_sum16(v); return v + __shfl_xor(v, 16); }
DI void unpack8(const u32x4 w, float (&f)[8]) {
#pragma unroll
    for (int e = 0; e < 4; ++e) { f[2 * e] = bflo(w[e]); f[2 * e + 1] = bfhi(w[e]); }
}
DI int crow(int r, int hi) { return (r & 3) + 8 * (r >> 2) + 4 * hi; }
DI int kpos(int k) { const int o16 = k & 15; return (k & ~15) + 8 * ((o16 >> 2) & 1) + 4 * (o16 >> 3) + (o16 & 3); }
#define MFMA32(a, b, c) __builtin_amdgcn_mfma_f32_32x32x16_bf16((a), (b), (c), 0, 0, 0)
#define LDS_WAIT() asm volatile("s_waitcnt lgkmcnt(0)" ::: "memory")
DI void lds_barrier() { asm volatile("s_waitcnt lgkmcnt(0)" ::: "memory"); __builtin_amdgcn_s_barrier(); asm volatile("" ::: "memory"); }

#define XB_TMO      128
#define XB_XCNT(j)  (256  + 64 * (j))
#define XB_XSUB(j)  (1280 + 64 * (j))
#define XB_XGEN(j)  (2304 + 64 * (j))
#define XB_TOP      3328
#define XB_TOPGEN   3392
#define XCD_BAR_WORDS 3456
#define XB_SPIN_CAP (1u << 18)

__device__ __forceinline__ unsigned xb_ld(unsigned* p)              { return __hip_atomic_load(p, __ATOMIC_RELAXED, __HIP_MEMORY_SCOPE_AGENT); }
__device__ __forceinline__ unsigned xb_add(unsigned* p, unsigned v) { return __hip_atomic_fetch_add(p, v, __ATOMIC_RELAXED, __HIP_MEMORY_SCOPE_AGENT); }
__device__ __forceinline__ unsigned xb_xcc_id() { return (unsigned)__builtin_amdgcn_s_getreg((3 << 11) | 20) & 0xFu; }
#define XB_SPIN(cond, bar) do { unsigned _sp = 0; while (cond) { __builtin_amdgcn_s_sleep(1); \
    if ((++_sp & 255u) == 0u) { if (xb_ld(&(bar)[XB_TMO])) break; if (_sp > XB_SPIN_CAP) { atomicAdd(&(bar)[XB_TMO], 1u); break; } } } } while (0)

struct XcdBarrier {
    unsigned* bar; unsigned x;
    volatile LAS unsigned* st;
};

__device__ __forceinline__ XcdBarrier xcd_barrier_post(unsigned* bar, volatile LAS unsigned* st) {
    XcdBarrier b; b.bar = bar; b.x = xb_xcc_id(); b.st = st;
    if (threadIdx.x == 0) (void)xb_add(&bar[XB_XCNT(b.x)], 1u);
    return b;
}
__device__ __forceinline__ void xcd_barrier_complete(unsigned* bar, unsigned x, unsigned& nloc, unsigned& nx) {
    const unsigned G = gridDim.x * gridDim.y * gridDim.z;
    unsigned sum, cnt, mine, sp = 0u;
    for (;;) {
        sum = 0u; cnt = 0u; mine = 0u;
#pragma unroll
        for (unsigned j = 0; j < 16; ++j) { const unsigned c = xb_ld(&bar[XB_XCNT(j)]); sum += c; cnt += (c > 0u) ? 1u : 0u; mine = (j == x) ? c : mine; }
        if (sum == G) break;
        __builtin_amdgcn_s_sleep(1);
        if ((++sp & 255u) == 0u) { if (xb_ld(&bar[XB_TMO])) break; if (sp > XB_SPIN_CAP) { atomicAdd(&bar[XB_TMO], 1u); break; } }
    }
    nloc = mine > 0u ? mine : 1u; nx = cnt > 0u ? cnt : 1u;
}

__device__ __forceinline__ void xcd_barrier(const XcdBarrier& b) {
    asm volatile("s_waitcnt vmcnt(0)" ::: "memory");
    __syncthreads();
    if (threadIdx.x == 0) {
        unsigned* bar = b.bar;
        __builtin_amdgcn_s_waitcnt(0);
        unsigned nloc = b.st[0], nx = b.st[1];
        if (nloc == 0u) { xcd_barrier_complete(bar, b.x, nloc, nx); b.st[0] = nloc; b.st[1] = nx; }
        const unsigned old = xb_add(&bar[XB_XSUB(b.x)], 1u);
        const unsigned gen = old / nloc;
        if (old + 1u == (gen + 1u) * nloc) {
            __builtin_amdgcn_fence(__ATOMIC_RELEASE, "agent");
            asm volatile("s_waitcnt vmcnt(0)" ::: "memory");
            const unsigned og = xb_add(&bar[XB_TOP], 1u);
            const unsigned tg = og / nx;
            if (og + 1u == (tg + 1u) * nx) xb_add(&bar[XB_TOPGEN], 1u);
            else XB_SPIN(xb_ld(&bar[XB_TOPGEN]) == tg, bar);
            __builtin_amdgcn_fence(__ATOMIC_ACQUIRE, "agent");
            xb_add(&bar[XB_XGEN(b.x)], 1u);
            asm volatile("s_waitcnt vmcnt(0)" ::: "memory");
        } else {
            XB_SPIN(xb_ld(&bar[XB_XGEN(b.x)]) == gen, bar);
            __builtin_amdgcn_fence(__ATOMIC_ACQUIRE, "agent");
            asm volatile("s_waitcnt vmcnt(0)" ::: "memory");
        }
    }
    __syncthreads();
}

struct EpiScaleBf16 {
    static constexpr bool PERM = true, AFTER_DRAIN = false;
    bf16* O; int ldc; const float* slots; const float* bias; int bias_n;
    DI void operator()(const pg8::f32x4 (&acc)[2][2][4][2], const pg8::Unit& u, int wr, int wc, int fr, int fq) const {
        const int row0 = u.pm * 256 + wr * 64 + fr, col0 = u.pn * 256 + wc * 32 + 8 * fq;
        const bool hb = bias && (u.pn * 256 < bias_n);
        f32x4 bv[2][2];
#pragma unroll
        for (int bj = 0; bj < 2; ++bj)
#pragma unroll
            for (int n = 0; n < 2; ++n) bv[bj][n] = hb ? *(const f32x4*)(bias + col0 + bj * 128 + 4 * n) : (f32x4){0.f, 0.f, 0.f, 0.f};
#pragma unroll
        for (int ai = 0; ai < 2; ++ai)
#pragma unroll
            for (int m = 0; m < 4; ++m) {
                const int row = row0 + ai * 128 + m * 16; float rs = 1.f;
                if (slots) { const f32x4* sp = (const f32x4*)(slots + (size_t)row * 16); const f32x4 a = sp[0], b = sp[1], c = sp[2], d = sp[3];
                    const float ss = ((a[0] + a[1]) + (a[2] + a[3])) + ((b[0] + b[1]) + (b[2] + b[3])) + ((c[0] + c[1]) + (c[2] + c[3])) + ((d[0] + d[1]) + (d[2] + d[3]));
                    rs = 1.0f / sqrtf(ss * (1.0f / 1024.0f) + NORM_EPS); }
                bf16* rowp = O + (size_t)row * ldc + col0;
#pragma unroll
                for (int bj = 0; bj < 2; ++bj) { const f32x4 v0 = acc[ai][bj][m][0] * rs + bv[bj][0], v1 = acc[ai][bj][m][1] * rs + bv[bj][1];
                    u32x4 w; w.x = pk2(v0[0], v0[1]); w.y = pk2(v0[2], v0[3]); w.z = pk2(v1[0], v1[1]); w.w = pk2(v1[2], v1[3]);
                    *(u32x4*)(rowp + bj * 128) = w; }
            }
    }
};
struct EpiResid {
    static constexpr bool PERM = false, AFTER_DRAIN = false;
    const float* base; bf16* outB; float* slots;
    DI void operator()(const pg8::f32x4 (&acc)[2][2][4][2], const pg8::Unit& u, int wr, int wc, int fr, int fq) const {
        const int col0 = u.pn * 256 + wc * 32 + 4 * fq;
#pragma unroll
        for (int ai = 0; ai < 2; ++ai)
#pragma unroll
            for (int m = 0; m < 4; ++m) {
                const int row = u.pm * 256 + ai * 128 + wr * 64 + m * 16 + fr; const size_t off = (size_t)row * 1024 + col0; float ss = 0.f;
#pragma unroll
                for (int bj = 0; bj < 2; ++bj)
#pragma unroll
                    for (int n = 0; n < 2; ++n) { const f32x4 bs = *(const f32x4*)(base + off + bj * 128 + n * 16); const f32x4 v = bs + acc[ai][bj][m][n];
                        u32x2 w; w.x = pk2(v[0], v[1]); w.y = pk2(v[2], v[3]); *(u32x2*)(outB + off + bj * 128 + n * 16) = w;
                        ss += (v[0] * v[0] + v[1] * v[1]) + (v[2] * v[2] + v[3] * v[3]); }
                ss += __shfl_xor(ss, 16); ss += __shfl_xor(ss, 32);
                if (fq == 0) slots[(size_t)row * 16 + u.pn * 4 + wc] = ss;
            }
    }
};

struct EpiResidNorm {
    static constexpr bool PERM = false, AFTER_DRAIN = true;
    const bf16* base; float* out; const float* bias; const float* w; float* xbuf; unsigned* cnt;
    DI void fused(pg8::f32x4 (&acc)[2][2][4][2], const pg8::Unit& u, int wr, int wc, int fr, int fq, PG8_LAS unsigned char* lds, int wid, int lane) const {
        PG8_LAS float* Pt = (PG8_LAS float*)lds;
        PG8_LAS float* S = (PG8_LAS float*)(lds + 4096);
        const int col0 = u.pn * 256 + wc * 32 + 4 * fq;
#pragma unroll
        for (int ai = 0; ai < 2; ++ai)
#pragma unroll
            for (int m = 0; m < 4; ++m) {
                const int r = ai * 128 + wr * 64 + m * 16 + fr; const size_t off = (size_t)(u.pm * 256 + r) * 1024 + col0; float ss = 0.f;
#pragma unroll
                for (int bj = 0; bj < 2; ++bj)
#pragma unroll
                    for (int n = 0; n < 2; ++n) { const u32x2 bw = *(const u32x2*)(base + off + bj * 128 + n * 16); const f32x4 bs = (f32x4){bflo(bw.x), bfhi(bw.x), bflo(bw.y), bfhi(bw.y)}; const f32x4 bv = *(const f32x4*)(bias + col0 + bj * 128 + n * 16);
                        const f32x4 v = bs + acc[ai][bj][m][n] + bv; acc[ai][bj][m][n] = v; ss += (v[0] * v[0] + v[1] * v[1]) + (v[2] * v[2] + v[3] * v[3]); }
                ss += __shfl_xor(ss, 16); ss += __shfl_xor(ss, 32);
                if (fq == 0) Pt[r * 4 + wc] = ss;
                if (m & 1) asm volatile("" ::: "memory");
            }
        asm volatile("s_waitcnt lgkmcnt(0)" ::: "memory"); __builtin_amdgcn_s_barrier(); asm volatile("" ::: "memory");
        const int row = wid * 32 + (lane & 31);
        if (lane < 32) { const float tot = (Pt[row * 4 + 0] + Pt[row * 4 + 1]) + (Pt[row * 4 + 2] + Pt[row * 4 + 3]);
            __hip_atomic_store(xbuf + (size_t)(u.pm * 256 + row) * 4 + u.pn, tot, __ATOMIC_RELAXED, __HIP_MEMORY_SCOPE_AGENT); }
        asm volatile("s_waitcnt vmcnt(0)" ::: "memory");
        if (lane == 0) __hip_atomic_fetch_add(cnt + 64 * u.pm, 1u, __ATOMIC_RELAXED, __HIP_MEMORY_SCOPE_AGENT);
        if (wid == 0) {
            unsigned spins = 0;
            while ((unsigned)__builtin_amdgcn_readfirstlane(__hip_atomic_load(cnt + 64 * u.pm, __ATOMIC_RELAXED, __HIP_MEMORY_SCOPE_AGENT)) < 32u) { __builtin_amdgcn_s_sleep(2); if (++spins > (1u << 22)) break; }
            __builtin_amdgcn_fence(__ATOMIC_ACQUIRE, "agent");
        }
        asm volatile("s_waitcnt vmcnt(0) lgkmcnt(0)" ::: "memory"); __builtin_amdgcn_s_barrier(); asm volatile("" ::: "memory");
        if (lane < 32) { const float* sl = xbuf + (size_t)(u.pm * 256 + row) * 4; float t = 0.f;
#pragma unroll
            for (int k = 0; k < 4; ++k) t += __hip_atomic_load(sl + k, __ATOMIC_RELAXED, __HIP_MEMORY_SCOPE_AGENT);
            S[row] = 1.0f / sqrtf(t * (1.f / 1024.f) + NORM_EPS); }
        asm volatile("s_waitcnt lgkmcnt(0)" ::: "memory"); __builtin_amdgcn_s_barrier(); asm volatile("" ::: "memory");
        f32x4 wv[2][2];
#pragma unroll
        for (int bj = 0; bj < 2; ++bj)
#pragma unroll
            for (int n = 0; n < 2; ++n) wv[bj][n] = *(const f32x4*)(w + col0 + bj * 128 + n * 16);
#pragma unroll
        for (int ai = 0; ai < 2; ++ai)
#pragma unroll
            for (int m = 0; m < 4; ++m) { const int r = ai * 128 + wr * 64 + m * 16 + fr; const float rs = S[r]; const size_t off = (size_t)(u.pm * 256 + r) * 1024 + col0;
#pragma unroll
                for (int bj = 0; bj < 2; ++bj)
#pragma unroll
                    for (int n = 0; n < 2; ++n) *(f32x4*)(out + off + bj * 128 + n * 16) = acc[ai][bj][m][n] * rs * wv[bj][n]; }
    }
};

DI void transpose_item(const float* W, int N, int Npad, bf16* WT, const float* kscale, LAS float* scr, int item, int lane) {
    const int nblk = Npad / 32, kb = item / nblk, nb = item % nblk, k0 = 64 * kb, n0 = 32 * nb;
    const int n = n0 + (lane & 31);
#pragma unroll 8
    for (int i = 0; i < 32; ++i) { const int kk = 2 * i + (lane >> 5); float v = (n < N) ? W[(size_t)(k0 + kk) * N + n] : 0.f; if (kscale) v *= kscale[k0 + kk]; scr[kk * 33 + (lane & 31)] = v; }
    LDS_WAIT(); asm volatile("" ::: "memory");
    const int c = lane & 7;
#pragma unroll
    for (int j = 0; j < 4; ++j) { const int nn = (lane >> 3) + 8 * j; const LAS float* s = scr + (8 * c) * 33 + nn;
        u32x4 o; o.x = pk2(s[0 * 33], s[1 * 33]); o.y = pk2(s[2 * 33], s[3 * 33]); o.z = pk2(s[4 * 33], s[5 * 33]); o.w = pk2(s[6 * 33], s[7 * 33]);
        *(u32x4*)(WT + (size_t)(n0 + nn) * 1024 + k0 + 8 * c) = o; }
    LDS_WAIT(); asm volatile("" ::: "memory");
}
DI void p0_prologue(const Params& P, LAS unsigned char* lds, int wave, int lane) {
    LAS float* scr = (LAS float*)(lds + wave * 16384);
    const int gw = blockIdx.x * 8 + wave, NGW = gridDim.x * 8;
    bf16* W0T = (bf16*)(P.ws + WS_W0T); bf16* WO0T = (bf16*)(P.ws + WS_WO0T); bf16* W1T = (bf16*)(P.ws + WS_W1T); bf16* WO1T = (bf16*)(P.ws + WS_WO1T);
    constexpr int I0 = 16 * (N0P / 32), I1 = 16 * 32, I2 = 16 * (IN1 / 32), I3 = 16 * 32;
    for (int it = gw; it < I0 + I1 + I2 + I3; it += NGW) {
        int r = it;
        if (r < I0) { transpose_item(P.w_in0, IN0, N0P, W0T, nullptr, scr, r, lane); continue; } r -= I0;
        if (r < I1) { transpose_item(P.w_out0, 1024, 1024, WO0T, nullptr, scr, r, lane); continue; } r -= I1;
        if (r < I2) { transpose_item(P.w_in1, IN1, IN1, W1T, P.norm_w + 1024, scr, r, lane); continue; } r -= I2;
        transpose_item(P.w_out1, 1024, 1024, WO1T, nullptr, scr, r, lane);
    }
    {
        float* RT = (float*)(P.ws + WS_ROPE);
        for (int e = gw * 64 + lane; e < T * 8; e += NGW * 64) { const int pos = e >> 3, j = e & 7;
            const float invf = __expf(-(float)j * 0.125f * 13.122363377404328f); const float ang = (float)pos * invf; const float nrev = rintf(ang * 0.15915494309189535f);
            float r = fmaf(-nrev, 6.2831854820251465f, ang); r = fmaf(-nrev, -1.7484555e-07f, r);
            RT[2 * e] = __cosf(r); RT[2 * e + 1] = __sinf(r); }
    }
    {
        u32x4* WLT = (u32x4*)(P.ws + WS_WLT);
        for (int e = gw * 64 + lane; e < 8 * 2 * 4 * 2 * 64; e += NGW * 64) { const int ln = e & 63, db = (e >> 6) & 1, s = (e >> 7) & 3, lo = (e >> 9) & 1, h = e >> 10;
            const float* wp = (lo ? P.a_up : P.w_up) + (size_t)(16 * s + 8 * (ln >> 5)) * 512 + h * 64 + 2 * (ln & 31) + db;
            u32x4 o; o.x = pk2(wp[0], wp[512]); o.y = pk2(wp[2 * 512], wp[3 * 512]); o.z = pk2(wp[4 * 512], wp[5 * 512]); o.w = pk2(wp[6 * 512], wp[7 * 512]); WLT[e] = o; }
    }
    bf16* XN = (bf16*)(P.ws + WS_XN);
    {
        const f32x4* wr = (const f32x4*)P.norm_w + lane; const f32x4 w0 = wr[0], w1 = wr[64], w2 = wr[128], w3 = wr[192];
        f32x4 nx[4];
        { const f32x4* xr = (const f32x4*)(P.x + (size_t)(gw < M ? gw : 0) * D) + lane;
#pragma unroll
          for (int j = 0; j < 4; ++j) nx[j] = xr[64 * j]; }
        for (int m = gw; m < M; m += NGW) {
            f32x4 v[4]; float s = 0.f;
#pragma unroll
            for (int j = 0; j < 4; ++j) { v[j] = nx[j]; s += (v[j][0] * v[j][0] + v[j][1] * v[j][1]) + (v[j][2] * v[j][2] + v[j][3] * v[j][3]); }
            if (m + NGW < M) { const f32x4* xr = (const f32x4*)(P.x + (size_t)(m + NGW) * D) + lane;
#pragma unroll
                for (int j = 0; j < 4; ++j) nx[j] = xr[64 * j]; }
            const float rstd = 1.0f / sqrtf(wave_sum(s) * (1.f / D) + NORM_EPS);
            u32x2* o8 = (u32x2*)(XN + (size_t)m * D) + lane;
            { u32x2 o; o.x = pk2(v[0][0] * rstd * w0[0], v[0][1] * rstd * w0[1]); o.y = pk2(v[0][2] * rstd * w0[2], v[0][3] * rstd * w0[3]); o8[0] = o; }
            { u32x2 o; o.x = pk2(v[1][0] * rstd * w1[0], v[1][1] * rstd * w1[1]); o.y = pk2(v[1][2] * rstd * w1[2], v[1][3] * rstd * w1[3]); o8[64] = o; }
            { u32x2 o; o.x = pk2(v[2][0] * rstd * w2[0], v[2][1] * rstd * w2[1]); o.y = pk2(v[2][2] * rstd * w2[2], v[2][3] * rstd * w2[3]); o8[128] = o; }
            { u32x2 o; o.x = pk2(v[3][0] * rstd * w3[0], v[3][1] * rstd * w3[1]); o.y = pk2(v[3][2] * rstd * w3[2], v[3][3] * rstd * w3[3]); o8[192] = o; }
        }
    }
}
DI float softplus_f(float z) { return fmaxf(z, 0.f) + __logf(1.f + __expf(-fabsf(z))); }
DI float tanh_f(float x) { return 1.f - 2.f * __builtin_amdgcn_rcpf(__expf(2.f * x) + 1.f); }

template <int N> DI void dpp_fmac(float& acc, float src, float y) { asm("v_fmac_f32_dpp %0, %1, %2 row_newbcast:%3 row_mask:0xf bank_mask:0xf" : "+v"(acc) : "v"(src), "v"(y), "n"(N)); }
template <int N> DI void dpp_mul_ip(float& y, float src) { asm("v_mul_f32_dpp %0, %1, %0 row_newbcast:%2 row_mask:0xf bank_mask:0xf" : "+v"(y) : "v"(src), "n"(N)); }
template <int N> DI float dpp_mul(float src, float s) { float r; asm("v_mul_f32_dpp %0, %1, %2 row_newbcast:%3 row_mask:0xf bank_mask:0xf" : "=v"(r) : "v"(src), "v"(s), "n"(N)); return r; }
template <int D> struct RStep {
    static DI void dot(const float (&y)[64], const f32x4& X, float& s0, float& s1, float& s2, float& s3) {
        if constexpr (D < 16) { dpp_fmac<D>(s0, X[0], y[4 * D]); dpp_fmac<D>(s1, X[1], y[4 * D + 1]); dpp_fmac<D>(s2, X[2], y[4 * D + 2]); dpp_fmac<D>(s3, X[3], y[4 * D + 3]); RStep<D + 1>::dot(y, X, s0, s1, s2, s3); } }
    static DI void upd(float (&y)[64], const f32x4& Bv, float sa) {
        if constexpr (D < 16) {
            dpp_fmac<D>(y[4 * D], Bv[0], sa); dpp_fmac<D>(y[4 * D + 1], Bv[1], sa); dpp_fmac<D>(y[4 * D + 2], Bv[2], sa); dpp_fmac<D>(y[4 * D + 3], Bv[3], sa);
            RStep<D + 1>::upd(y, Bv, sa); } }
    static DI void scale(float (&y)[64], const f32x4& W) {
        if constexpr (D < 16) {
            dpp_mul_ip<D>(y[4 * D], W[0]); dpp_mul_ip<D>(y[4 * D + 1], W[1]); dpp_mul_ip<D>(y[4 * D + 2], W[2]); dpp_mul_ip<D>(y[4 * D + 3], W[3]);
            RStep<D + 1>::scale(y, W); } }
};
DI void rwkv_rstep(float (&y)[64], const f32x4 (&X)[4], int t, int role, int lane, bf16* mstep) {
    float s0 = 0.f, s1 = 0.f, s2 = 0.f, s3 = 0.f;
    RStep<0>::dot(y, X[0], s0, s1, s2, s3);
    float sa = (s0 + s1) + (s2 + s3);
    if (role == 1) sa = (lane < t) ? sa : 0.f;
    RStep<0>::upd(y, X[2], sa);
    float o0 = 0.f, o1 = 0.f, o2 = 0.f, o3 = 0.f;
    RStep<0>::dot(y, X[3], o0, o1, o2, o3);
    float o = (o0 + o1) + (o2 + o3);
    if (role == 1) o = (lane <= t) ? o : 0.f;
    mstep[t * 64] = (bf16)f2bf(o);
}
DI void rwkv_prep_item(const Params& P, int item, LAS unsigned char* lds, int wave, int lane) {
    const int bh = item >> 4, quad = item & 15, b = bh >> 3, h = bh & 7;
    const int tok0 = b * T + quad * 256;
    const bf16* PROJ0 = (const bf16*)(P.ws + WS_PROJ0);
    float* scr = (float*)(P.ws + WS_SCR + (size_t)blockIdx.x * 262144);
    LAS float* KS = (LAS float*)lds;
    LAS float* TOT = (LAS float*)(lds + 8 * 64 * 65 * 4);
    bf16* VP = (bf16*)(P.ws + WS_VP); float* BON = (float*)(P.ws + WS_BONUS);
    const int hd = h * 64 + lane;
    {
        const int m = lane & 31, hi = lane >> 5;
        const int c = wave >> 1, tb = (wave & 1) * 32;
        const int tokw = tok0 + wave * 32, posw = quad * 256 + wave * 32;
        f32x16 accw[2], acca[2];
#pragma unroll
        for (int i = 0; i < 16; ++i) { accw[0][i] = 0.f; accw[1][i] = 0.f; acca[0][i] = 0.f; acca[1][i] = 0.f; }
        {
            const bf16* rowc = PROJ0 + (size_t)(tokw + m) * N0P; const bool hasprev = (posw + m) > 0;
            const u32x4* WLT = (const u32x4*)(P.ws + WS_WLT) + (size_t)h * 1024 + lane;
            u32x4 cwv[4], cav[4], pwv[4], pav[4], bwv[4][2], bav[4][2];
#pragma unroll
            for (int s = 0; s < 4; ++s) { const int j0 = 16 * s + 8 * hi;
                cwv[s] = *(const u32x4*)(rowc + C_XW + j0); cav[s] = *(const u32x4*)(rowc + C_XA + j0);
                pwv[s] = (u32x4){0u, 0u, 0u, 0u}; pav[s] = (u32x4){0u, 0u, 0u, 0u};
                if (hasprev) { pwv[s] = *(const u32x4*)(rowc - N0P + C_XW + j0); pav[s] = *(const u32x4*)(rowc - N0P + C_XA + j0); }
#pragma unroll
                for (int db = 0; db < 2; ++db) { bwv[s][db] = WLT[((0 * 4 + s) * 2 + db) * 64]; bav[s][db] = WLT[((1 * 4 + s) * 2 + db) * 64]; } }
#pragma unroll
            for (int s = 0; s < 4; ++s) {
                const int j0 = 16 * s + 8 * hi;
                float fcw[8], fpw[8], fca[8], fpa[8]; unpack8(cwv[s], fcw); unpack8(pwv[s], fpw); unpack8(cav[s], fca); unpack8(pav[s], fpa);
                const f32x4 mw0 = *(const f32x4*)(P.mu + 1536 + j0), mw1 = *(const f32x4*)(P.mu + 1536 + j0 + 4), ma0 = *(const f32x4*)(P.mu + 1600 + j0), ma1 = *(const f32x4*)(P.mu + 1600 + j0 + 4);
                float xw[8], xa[8];
#pragma unroll
                for (int e = 0; e < 8; ++e) { const float muw = e < 4 ? mw0[e & 3] : mw1[e & 3], mua = e < 4 ? ma0[e & 3] : ma1[e & 3];
                    xw[e] = tanh_f(fcw[e] + (fpw[e] - fcw[e]) * muw); xa[e] = fca[e] + (fpa[e] - fca[e]) * mua; }
                u32x4 aw, aa;
#pragma unroll
                for (int e = 0; e < 4; ++e) { aw[e] = pk2(xw[2 * e], xw[2 * e + 1]); aa[e] = pk2(xa[2 * e], xa[2 * e + 1]); }
#pragma unroll
                for (int db = 0; db < 2; ++db) {
                    accw[db] = MFMA32(__builtin_bit_cast(bf16x8, aw), __builtin_bit_cast(bf16x8, bwv[s][db]), accw[db]);
                    acca[db] = MFMA32(__builtin_bit_cast(bf16x8, aa), __builtin_bit_cast(bf16x8, bav[s][db]), acca[db]);
                }
            }
        }
        float kkd[2], kad[2], rkd[2], w0d[2], a0d[2], mur[2], muk[2], muv[2];
#pragma unroll
        for (int db = 0; db < 2; ++db) { const int hd = h * 64 + 2 * m + db; kkd[db] = P.k_k[hd]; kad[db] = P.k_a[hd]; rkd[db] = P.r_k[hd]; w0d[db] = P.w0[hd]; a0d[db] = P.a0[hd];
            mur[db] = P.mu[hd]; muk[db] = P.mu[512 + hd]; muv[db] = P.mu[1024 + hd]; }
        unsigned qr[16], qk[16], qv[16], qpr[4], qpk[4], qpv[4];
#pragma unroll
        for (int i = 0; i < 16; ++i) {
            int io = i; asm volatile("" : "+v"(io));
            const bf16* row = PROJ0 + (size_t)(tokw + crow(io, hi)) * N0P + h * 64 + 2 * m;
            qr[i] = *(const unsigned*)(row + C_RR); qk[i] = *(const unsigned*)(row + C_RK); qv[i] = *(const unsigned*)(row + C_RV);
            if ((i & 3) == 0) {
                qpr[i >> 2] = 0u; qpk[i >> 2] = 0u; qpv[i >> 2] = 0u;
                if (posw + crow(i, hi) > 0) { qpr[i >> 2] = *(const unsigned*)(row - N0P + C_RR); qpk[i >> 2] = *(const unsigned*)(row - N0P + C_RK); qpv[i >> 2] = *(const unsigned*)(row - N0P + C_RV); }
            }
        }
        float ee[2][16], Lc[2][16];
#pragma unroll
        for (int db = 0; db < 2; ++db) {
#pragma unroll
            for (int i = 0; i < 16; ++i) { const float wl = w0d[db] + accw[db][i]; ee[db][i] = 0.60653066f * __builtin_amdgcn_rcpf(1.f + __expf(-wl)); }
            float gt[4], go[4];
#pragma unroll
            for (int g = 0; g < 4; ++g) { Lc[db][4 * g] = ee[db][4 * g]; Lc[db][4 * g + 1] = Lc[db][4 * g] + ee[db][4 * g + 1]; Lc[db][4 * g + 2] = Lc[db][4 * g + 1] + ee[db][4 * g + 2]; Lc[db][4 * g + 3] = Lc[db][4 * g + 2] + ee[db][4 * g + 3];
                gt[g] = Lc[db][4 * g + 3]; go[g] = __shfl_xor(gt[g], 32); }
            float run = 0.f;
#pragma unroll
            for (int g = 0; g < 4; ++g) { const float base = run + (hi ? go[g] : 0.f);
#pragma unroll
                for (int q = 0; q < 4; ++q) Lc[db][4 * g + q] += base;
                run += gt[g] + go[g]; }
            if (!(wave & 1) && hi == 0) TOT[c * 64 + 2 * m + db] = run;
        }
        __syncthreads();
        if (wave & 1) {
#pragma unroll
            for (int db = 0; db < 2; ++db) { const float tp = TOT[c * 64 + 2 * m + db];
#pragma unroll
                for (int i = 0; i < 16; ++i) Lc[db][i] += tp; }
        }
        float Lb[2][4];
#pragma unroll
        for (int db = 0; db < 2; ++db)
#pragma unroll
            for (int g = 0; g < 4; ++g) { Lb[db][g] = Lc[db][4 * g] - ee[db][4 * g]; asm volatile("" : "+v"(Lb[db][g])); }
        {
            float pv0 = 0.f, pv1 = 0.f;
#pragma unroll
            for (int i = 0; i < 16; ++i) {
                int io = i; asm volatile("" : "+v"(io));
                if ((i & 3) == 0) { pv0 = bflo(qpv[i >> 2]); pv1 = bfhi(qpv[i >> 2]); }
                const float c0 = bflo(qv[i]), c1 = bfhi(qv[i]);
                *(unsigned*)(VP + (size_t)(tokw + crow(io, hi)) * 512 + h * 64 + 2 * m) = pk2(c0 + (pv0 - c0) * muv[0], c1 + (pv1 - c1) * muv[1]);
                pv0 = c0; pv1 = c1;
            }
        }
        float pr[2] = {0.f, 0.f}, pk[2] = {0.f, 0.f}, pemL[2] = {1.f, 1.f};
#pragma unroll
        for (int i = 0; i < 16; ++i) {
            int io = i; asm volatile("" : "+v"(io));
            const int tau = crow(io, hi), tok = tokw + tau, t = tb + tau;
            if ((i & 3) == 0) { pr[0] = bflo(qpr[i >> 2]); pr[1] = bfhi(qpr[i >> 2]); pk[0] = bflo(qpk[i >> 2]); pk[1] = bfhi(qpk[i >> 2]); }
            float r[2], k[2], a[2], kk[2];
#pragma unroll
            for (int db = 0; db < 2; ++db) {
                const float cr = db ? bfhi(qr[i]) : bflo(qr[i]), ck = db ? bfhi(qk[i]) : bflo(qk[i]);
                r[db] = cr + (pr[db] - cr) * mur[db]; k[db] = ck + (pk[db] - ck) * muk[db];
                pr[db] = cr; pk[db] = ck;
                const float al = a0d[db] + acca[db][i];
                a[db] = __builtin_amdgcn_rcpf(1.f + __expf(-al));
                kk[db] = k[db] * kkd[db];
            }
            const float inv = __builtin_amdgcn_rsqf(fmaxf(half_sum32(kk[0] * kk[0] + kk[1] * kk[1]), 1e-24f));
            float k2[2];
#pragma unroll
            for (int db = 0; db < 2; ++db) k2[db] = k[db] * (1.f + (a[db] - 1.f) * kad[db]);
            const float bon = half_sum32(r[0] * k2[0] * rkd[0] + r[1] * k2[1] * rkd[1]);
            f32x2v sa_, sb_, sr_; float we_[2];
#pragma unroll
            for (int db = 0; db < 2; ++db) {
                const int d = 2 * m + db; const float kkn = kk[db] * inv;
                const float eL = __expf(Lc[db][i]), emL = __builtin_amdgcn_rcpf(eL);
                const float wprev = (i & 3) ? pemL[db] : __expf(-Lb[db][i >> 2]); pemL[db] = emL;
                sa_[db] = -kkn * wprev;
                sb_[db] = kkn * a[db] * eL;
                sr_[db] = r[db] * emL;
                we_[db] = emL;
                KS[((2 * c + 1 - (c >> 1)) * 64 + t) * 65 + d] = k2[db] * eL;
            }
            {
                float* o = scr + (size_t)((c * 64 + t) * 4) * 64 + 2 * m;
                *(f32x2v*)o = sa_; *(f32x2v*)(o + 128) = sb_; *(f32x2v*)(o + 192) = sr_;
                if (i == 15 && t == 63) *(f32x2v*)(o + 64) = (f32x2v){we_[0], we_[1]};
            }
            if (m == 0) BON[(size_t)tok * 8 + h] = bon;
        }
    }
    __syncthreads();
    {
        const int c = wave >> 1, role = (wave ^ (wave >> 2)) & 1;
        const f32x4* xb = (const f32x4*)(scr + (size_t)c * 64 * 256) + (lane & 15);
        const LAS float* ksw = KS + wave * 64 * 65;
        float y[64];
        const int n = quad * 4 + c;
        bf16* mats = (bf16*)P.out + (size_t)(bh * 64 + n) * 4 * 4096;
        bf16* mstep = mats + role * 4096 + (role ? lane : kpos(lane));
#pragma unroll 1
        for (int rep2 = 0; rep2 < REP_S2; ++rep2) {
            int ln = lane; asm volatile("" : "+v"(ln));
#pragma unroll
            for (int d = 0; d < 64; ++d) y[d] = (role == 0) ? ((d == ln) ? 1.f : 0.f) : ksw[ln * 65 + d];
            f32x4 XA[4], XB[4];
#pragma unroll
            for (int v = 0; v < 4; ++v) XA[v] = xb[v * 16];
            for (int t = 0; t < 64; t += 2) {
#pragma unroll
                for (int v = 0; v < 4; ++v) XB[v] = xb[(t + 1) * 64 + v * 16];
                rwkv_rstep(y, XA, t, role, lane, mstep);
                if (t + 2 < 64) {
#pragma unroll
                    for (int v = 0; v < 4; ++v) XA[v] = xb[(t + 2) * 64 + v * 16];
                }
                rwkv_rstep(y, XB, t + 1, role, lane, mstep);
            }
            RStep<0>::scale(y, XB[1]);
        }
        bf16* mend = mats + (role ? 2 : 3) * 4096 + (role ? lane : kpos(lane));
        LAS float* myr = KS + (wave * 64 + lane) * 65;
#pragma unroll
        for (int d = 0; d < 64; ++d) myr[d] = y[d];
#pragma unroll 8
        for (int d = 0; d < 64; ++d) mend[d * 64] = (bf16)f2bf(myr[d]);
    }
    __syncthreads();
}

DI void gla_prep_item(const Params& P, int item, LAS unsigned char* lds, int wave, int lane) {
    const int bh = item >> 6, n = item & 63, b = bh >> 2, h = bh & 3;
    const int tok0 = b * T + n * 64, hd = h * 64 + lane;
    const bf16* PROJ0 = (const bf16*)(P.ws + WS_PROJ0);
    LAS float* WT = (LAS float*)lds;
    LAS bf16* QEb = (LAS bf16*)(WT + 1024);
    LAS bf16* KEb = QEb + 64 * 72;
    LAS float* KL = (LAS float*)(KEb + 64 * 72);
    bf16* mats = (bf16*)(P.ws + WS_XN) + (size_t)(bh * 64 + n) * 3 * 4096;
    float* GDEC = (float*)(P.ws + WS_GDEC) + (size_t)(bh * 64 + n) * 64;
    float q8[8], k8[8]; u32x4 gl0[8], gl1[8];
#pragma unroll
    for (int i = 0; i < 8; ++i) { const bf16* row = PROJ0 + (size_t)(tok0 + wave * 8 + i) * N0P; q8[i] = bf2f(row[C_GQ + hd]) * 0.125f; k8[i] = bf2f(row[C_GK + hd]);
        gl0[i] = *(const u32x4*)(row + C_GLOW); gl1[i] = *(const u32x4*)(row + C_GLOW + 8); }
    float up[16];
#pragma unroll
    for (int r = 0; r < 16; ++r) up[r] = P.gk_up[r * 256 + hd];
    const float bias = P.gk_bias[hd];
    float bt[8]; float acc = 0.f;
#pragma unroll
    for (int i = 0; i < 8; ++i) { float xg = bias;
#pragma unroll
        for (int r = 0; r < 4; ++r) { xg = fmaf(bflo(gl0[i][r]), up[2 * r], xg); xg = fmaf(bfhi(gl0[i][r]), up[2 * r + 1], xg); }
#pragma unroll
        for (int r = 0; r < 4; ++r) { xg = fmaf(bflo(gl1[i][r]), up[8 + 2 * r], xg); xg = fmaf(bfhi(gl1[i][r]), up[8 + 2 * r + 1], xg); }
        acc += -softplus_f(-xg) * (1.f / 16.f); bt[i] = acc; }
    WT[wave * 64 + lane] = acc;
    if (wave == 4) WT[512 + lane] = bt[0];
    __syncthreads();
    float off = 0.f, off4 = 0.f, total = 0.f;
#pragma unroll
    for (int w2 = 0; w2 < 8; ++w2) { const float tv = WT[w2 * 64 + lane]; if (w2 < wave) off += tv; if (w2 < 4) off4 += tv; total += tv; }
    const float bref = off4 + WT[512 + lane], blast = total;
#pragma unroll
    for (int i = 0; i < 8; ++i) { const int t = wave * 8 + i; const float b_t = bt[i] + off;
        QEb[t * 72 + lane] = (bf16)f2bf(q8[i] * __expf(b_t - bref)); KEb[t * 72 + lane] = (bf16)f2bf(k8[i] * __expf(bref - b_t)); KL[t * 65 + lane] = k8[i] * __expf(blast - b_t);
        mats[t * 64 + kpos(lane)] = (bf16)f2bf(q8[i] * __expf(b_t)); }
    if (wave == 0) GDEC[lane] = __expf(blast);
    __syncthreads();
    if (wave < 4) {
        const int m = lane & 31, hi = lane >> 5, tb = wave >> 1, jb = wave & 1;
        f32x16 c;
#pragma unroll
        for (int r = 0; r < 16; ++r) c[r] = 0.f;
#pragma unroll
        for (int s = 0; s < 4; ++s) { const bf16x8 A = *(const LAS bf16x8*)(KEb + (32 * jb + m) * 72 + 16 * s + 8 * hi), Bq = *(const LAS bf16x8*)(QEb + (32 * tb + m) * 72 + 16 * s + 8 * hi); c = MFMA32(A, Bq, c); }
        const int t = 32 * tb + m;
#pragma unroll
        for (int g = 0; g < 4; ++g) { const int j0 = 32 * jb + 8 * g + 4 * hi; u32x2 w;
            w.x = pk2(j0 <= t ? c[4 * g] : 0.f, j0 + 1 <= t ? c[4 * g + 1] : 0.f); w.y = pk2(j0 + 2 <= t ? c[4 * g + 2] : 0.f, j0 + 3 <= t ? c[4 * g + 3] : 0.f);
            *(u32x2*)(mats + 4096 + t * 64 + j0) = w; }
    } else {
#pragma unroll
        for (int r = 0; r < 16; ++r) { const int d = (wave - 4) * 16 + r; mats[8192 + d * 64 + lane] = (bf16)f2bf(KL[lane * 65 + d]); }
    }
    __syncthreads();
}

constexpr int SQ_PITCH = 144, SQ_MAT = 64 * SQ_PITCH, SQ_VT = 4 * SQ_MAT, SQ_DEC = SQ_VT + 128 * SQ_PITCH, SQ_BUF = 57344;
template <bool DIAG>
DI void seq_pass(unsigned* prog, const bf16* mats, int nmat, const bf16* vsrc, int vpitch, const float* dec, bf16* outp, LAS unsigned char* lds, int tid, int wave, int lane) {
    const int m = lane & 31, hi = lane >> 5;
    f32x16 sacc[2];
#pragma unroll
    for (int i = 0; i < 16; ++i) { sacc[0][i] = 0.f; sacc[1][i] = 0.f; }
    const int st = tid - 256;
    struct StSet { u32x4 rm[8]; u32x4 rv[2]; float rdec; };
    const int v8 = st & 7, par = (st >> 3) & 1;
    constexpr int NMAT = DIAG ? 3 : 4;
    auto gload = [&](int n, StSet& S) {
        const bf16* mp = mats + (size_t)n * NMAT * 4096;
#pragma unroll
        for (int q = 0; q < 2 * NMAT; ++q) S.rm[q] = *(const u32x4*)(mp + (size_t)(st + 256 * q) * 8);
#pragma unroll
        for (int q = 0; q < 2; ++q) S.rv[q] = *(const u32x4*)(vsrc + (size_t)(n * 64 + (st >> 3) + 32 * q) * vpitch + 8 * v8);
        if (DIAG) S.rdec = dec[n * 64 + (st & 63)];
    };
    auto lstore = [&](int n, const StSet& S) {
        LAS unsigned char* B = lds + (n & 1) * SQ_BUF;
#pragma unroll
        for (int q = 0; q < 2 * NMAT; ++q) { const int idx = (st + 256 * q) & 511; *(LAS u32x4*)(B + (q >> 1) * SQ_MAT + (idx >> 3) * SQ_PITCH + (idx & 7) * 16) = S.rm[q]; }
#pragma unroll
        for (int q = 0; q < 2; ++q) {
            const int vt = (st >> 3) + 32 * q;
            const unsigned k0 = par ? S.rv[q][2] : S.rv[q][0], k1 = par ? S.rv[q][3] : S.rv[q][1], s0 = par ? S.rv[q][0] : S.rv[q][2], s1 = par ? S.rv[q][1] : S.rv[q][3];
            const unsigned r0 = (unsigned)__builtin_amdgcn_update_dpp(0, (int)s0, 0x128, 0xf, 0xf, true), r1 = (unsigned)__builtin_amdgcn_update_dpp(0, (int)s1, 0x128, 0xf, 0xf, true);
            unsigned o[4];
            if (par == 0) { o[0] = (k0 & 0xffffu) | (r0 << 16); o[1] = (k0 >> 16) | (r0 & 0xffff0000u); o[2] = (k1 & 0xffffu) | (r1 << 16); o[3] = (k1 >> 16) | (r1 & 0xffff0000u); }
            else          { o[0] = (r0 & 0xffffu) | (k0 << 16); o[1] = (r0 >> 16) | (k0 & 0xffff0000u); o[2] = (r1 & 0xffffu) | (k1 << 16); o[3] = (r1 >> 16) | (k1 & 0xffff0000u); }
            const int tp = vt >> 1, gsw = ((tp >> 2) ^ v8) & 7;
#pragma unroll
            for (int jj = 0; jj < 4; ++jj) *(LAS unsigned*)(B + SQ_VT + (8 * v8 + 4 * par + jj) * SQ_PITCH + (4 * gsw + (tp & 3)) * 4) = o[jj];
        }
        if (DIAG && st < 64) *(LAS float*)(B + SQ_DEC + st * 4) = S.rdec;
    };
    f32x16 o0, o1;
    bf16x8 sBp[2][2];
#pragma unroll
    for (int kb = 0; kb < 2; ++kb)
#pragma unroll
        for (int s = 0; s < 2; ++s) sBp[kb][s] = (bf16x8){0, 0, 0, 0, 0, 0, 0, 0};
    LAS unsigned char* SBX = lds + 2 * SQ_BUF;
    if (wave >= 2 && wave < 4) {
#pragma unroll
        for (int q = 0; q < 4; ++q) *(LAS bf16x8*)(SBX + (0 * 2 + (wave & 1)) * 4096 + lane * 64 + 16 * q) = sBp[q >> 1][q & 1];
    }
    auto compute = [&](int n, int bufi) {
        if (wave < 4) {
            const int vb = wave & 1; const bool upd = wave >= 2;
            const LAS unsigned char* B = lds + bufi * SQ_BUF;
            const int vrow = 32 * vb + m;
            const LAS unsigned char* Vr = B + SQ_VT + vrow * SQ_PITCH;
            const LAS unsigned char* Ar = B + m * SQ_PITCH + 16 * hi;
            bf16x8 Fa[2], Fb[2], Va, Vb;
#define SQ_LD(F, VB, k, MS, MV) do { if ((k) < 4) { const int co_ = (32 * ((k) >> 1) + 16 * ((k) & 1)) * 2; \
            F[0] = *(const LAS bf16x8*)(Ar + (MS) * SQ_MAT + co_); F[1] = *(const LAS bf16x8*)(Ar + (MS) * SQ_MAT + 32 * SQ_PITCH + co_); } \
        else { const int S4_ = (k) - 4, co_ = 32 * S4_; VB = *(const LAS bf16x8*)(Vr + (((2 * S4_ + hi) ^ (vrow >> 3)) & 7) * 16); \
            F[0] = *(const LAS bf16x8*)(Ar + (MV) * SQ_MAT + co_); F[1] = *(const LAS bf16x8*)(Ar + (MV) * SQ_MAT + 32 * SQ_PITCH + co_); } } while (0)
            if (!upd) {
                bf16x8 sB[2][2];
#pragma unroll
                for (int q = 0; q < 4; ++q) sB[q >> 1][q & 1] = *(const LAS bf16x8*)(SBX + ((n & 1) * 2 + vb) * 4096 + lane * 64 + 16 * q);
#pragma unroll
                for (int i = 0; i < 16; ++i) { o0[i] = 0.f; o1[i] = 0.f; }
#define SQ_MM(F, VB, k) do { const bf16x8 Bq_ = ((k) < 4) ? sB[(k) >> 1][(k) & 1] : VB; o0 = MFMA32(Bq_, F[0], o0); o1 = MFMA32(Bq_, F[1], o1); } while (0)
                SQ_LD(Fa, Va, 0, 0, 1); SQ_LD(Fb, Vb, 1, 0, 1);
                __builtin_amdgcn_sched_barrier(0);
                SQ_MM(Fa, Va, 0); SQ_LD(Fa, Va, 2, 0, 1); __builtin_amdgcn_sched_barrier(0);
                SQ_MM(Fb, Vb, 1); SQ_LD(Fb, Vb, 3, 0, 1); __builtin_amdgcn_sched_barrier(0);
                SQ_MM(Fa, Va, 2); SQ_LD(Fa, Va, 4, 0, 1); __builtin_amdgcn_sched_barrier(0);
                SQ_MM(Fb, Vb, 3); SQ_LD(Fb, Vb, 5, 0, 1); __builtin_amdgcn_sched_barrier(0);
                SQ_MM(Fa, Va, 4); SQ_LD(Fa, Va, 6, 0, 1); __builtin_amdgcn_sched_barrier(0);
                SQ_MM(Fb, Vb, 5); SQ_LD(Fb, Vb, 7, 0, 1); __builtin_amdgcn_sched_barrier(0);
                SQ_MM(Fa, Va, 6); SQ_MM(Fb, Vb, 7);
#undef SQ_MM
            } else {
                f32x16 n0, n1;
#pragma unroll
                for (int i = 0; i < 16; ++i) {
                    if (DIAG) { n0[i] = sacc[0][i] * *(const LAS float*)(B + SQ_DEC + crow(i, hi) * 4); n1[i] = sacc[1][i] * *(const LAS float*)(B + SQ_DEC + (32 + crow(i, hi)) * 4); }
                    else { n0[i] = 0.f; n1[i] = 0.f; } }
#define SQ_MM(F, VB, k) do { const bf16x8 Bq_ = ((k) < 4) ? sBp[(k) >> 1][(k) & 1] : VB; n0 = MFMA32(F[0], Bq_, n0); n1 = MFMA32(F[1], Bq_, n1); } while (0)
                if (!DIAG) {
                    SQ_LD(Fa, Va, 0, 3, 2); SQ_LD(Fb, Vb, 1, 3, 2);
                    __builtin_amdgcn_sched_barrier(0);
                    SQ_MM(Fa, Va, 0); SQ_LD(Fa, Va, 2, 3, 2); __builtin_amdgcn_sched_barrier(0);
                    SQ_MM(Fb, Vb, 1); SQ_LD(Fb, Vb, 3, 3, 2); __builtin_amdgcn_sched_barrier(0);
                    SQ_MM(Fa, Va, 2); SQ_LD(Fa, Va, 4, 3, 2); __builtin_amdgcn_sched_barrier(0);
                    SQ_MM(Fb, Vb, 3); SQ_LD(Fb, Vb, 5, 3, 2); __builtin_amdgcn_sched_barrier(0);
                } else {
                    SQ_LD(Fa, Va, 4, 3, 2); SQ_LD(Fb, Vb, 5, 3, 2);
                    __builtin_amdgcn_sched_barrier(0);
                }
                SQ_MM(Fa, Va, 4); SQ_LD(Fa, Va, 6, 3, 2); __builtin_amdgcn_sched_barrier(0);
                SQ_MM(Fb, Vb, 5); SQ_LD(Fb, Vb, 7, 3, 2); __builtin_amdgcn_sched_barrier(0);
                SQ_MM(Fa, Va, 6); SQ_MM(Fb, Vb, 7);
#undef SQ_MM
                sacc[0] = n0; sacc[1] = n1;
#pragma unroll
                for (int kb = 0; kb < 2; ++kb)
#pragma unroll
                    for (int s = 0; s < 2; ++s) { u32x4 w;
#pragma unroll
                        for (int e = 0; e < 4; ++e) w[e] = pk2(sacc[kb][8 * s + 2 * e], sacc[kb][8 * s + 2 * e + 1]);
                        sBp[kb][s] = __builtin_bit_cast(bf16x8, w);
                        *(LAS bf16x8*)(SBX + (((n + 1) & 1) * 2 + vb) * 4096 + lane * 64 + 16 * (2 * kb + s)) = sBp[kb][s]; }
            }
#undef SQ_LD
        }
    };
    auto store_out = [&](int n) {
        if (wave < 2) {
#pragma unroll
            for (int g = 0; g < 4; ++g) { bf16* op_ = outp + (size_t)(n * 64 + m) * 512 + 32 * wave + 8 * g + 4 * hi;
                u32x2 w0, w1; w0.x = pk2(o0[4 * g], o0[4 * g + 1]); w0.y = pk2(o0[4 * g + 2], o0[4 * g + 3]); w1.x = pk2(o1[4 * g], o1[4 * g + 1]); w1.y = pk2(o1[4 * g + 2], o1[4 * g + 3]);
                *(u32x2*)op_ = w0; *(u32x2*)(op_ + 32 * 512) = w1; }
        }
    };
    if (wave < 4) {
        lds_barrier();
#pragma unroll 1
        for (int n = 0; n < 64; ++n) { compute(n, n & 1); store_out(n); lds_barrier(); }
    } else {
        StSet A, Bs, C;
        gload(0, A); gload(1, Bs); gload(2, C);
        lstore(0, A); gload(3, A);
        lds_barrier();
#pragma unroll 1
        for (int k = 0; k < 60; k += 3) {
            if (st == 0) __hip_atomic_store(prog, (unsigned)(k + 4), __ATOMIC_RELAXED, __HIP_MEMORY_SCOPE_AGENT);
            lstore(k + 1, Bs); gload(k + 4, Bs); lds_barrier();
            lstore(k + 2, C); gload(k + 5, C); lds_barrier();
            lstore(k + 3, A); gload(k + 6, A); lds_barrier();
        }
        lstore(61, Bs); lds_barrier();
        lstore(62, C); lds_barrier();
        lstore(63, A); lds_barrier();
        lds_barrier();
    }
}
struct P3Src { const bf16* mats; int nmat; const bf16* vsrc; int vpitch; const float* dec; bf16* outp; };
DI P3Src p3_src(const Params& P, int bx) {
    P3Src s;
    if (bx < 32) { const int b = bx >> 3, h = bx & 7;
        s.mats = (const bf16*)P.out + (size_t)bx * 64 * 4 * 4096; s.nmat = 4; s.vsrc = (const bf16*)(P.ws + WS_VP) + (size_t)b * T * 512 + h * 64; s.vpitch = 512; s.dec = nullptr;
        s.outp = (bf16*)(P.ws + WS_SCR) + (size_t)b * T * 512 + h * 64; }
    else { const int g = bx - 32, bh = (g & 7) | ((g >> 4) << 3), vh = (g >> 3) & 1, b = bh >> 2, h = bh & 3;
        s.mats = (const bf16*)(P.ws + WS_XN) + (size_t)bh * 64 * 3 * 4096; s.nmat = 3; s.vsrc = (const bf16*)(P.ws + WS_PROJ0) + (size_t)b * T * N0P + C_GV + h * 128 + 64 * vh; s.vpitch = N0P;
        s.dec = (const float*)(P.ws + WS_GDEC) + (size_t)bh * 64 * 64; s.outp = (bf16*)(P.ws + WS_OARAW) + (size_t)b * T * 512 + h * 128 + 64 * vh; }
    return s;
}
DI void p3_seq(const Params& P, LAS unsigned char* lds, int tid, int wave, int lane) {
    const int bx = blockIdx.x;
    unsigned* progw = (unsigned*)(P.ws + WS_PROG);
    if (bx < 64) {
        const P3Src s = p3_src(P, bx);
        if (bx < 32) seq_pass<false>(progw + 16 * bx, s.mats, 4, s.vsrc, s.vpitch, nullptr, s.outp, lds, tid, wave, lane);
        else         seq_pass<true>(progw + 16 * bx, s.mats, 3, s.vsrc, s.vpitch, s.dec, s.outp, lds, tid, wave, lane);
    } else {
        const unsigned* xt = (const unsigned*)(P.ws + WS_XCCTAB);
        LAS unsigned* hs = (LAS unsigned*)lds;
        if (tid < 4) hs[tid] = 0u;
        __syncthreads();
        const unsigned myx = xt[bx];
        if (tid < 192) { const unsigned o = xt[64 + tid]; if (o == myx) { __hip_atomic_fetch_add(&hs[2], 1u, __ATOMIC_RELAXED, __HIP_MEMORY_SCOPE_WORKGROUP); if (64 + tid < bx) __hip_atomic_fetch_add(&hs[0], 1u, __ATOMIC_RELAXED, __HIP_MEMORY_SCOPE_WORKGROUP); } }
        if (tid >= 192 && tid < 256) { if (xt[tid - 192] == myx) { const unsigned slot = __hip_atomic_fetch_add(&hs[1], 1u, __ATOMIC_RELAXED, __HIP_MEMORY_SCOPE_WORKGROUP); hs[8 + slot] = (unsigned)(tid - 192); } }
        __syncthreads();
        const int rank = (int)hs[0], np = (int)hs[1], nh = (int)hs[2];
        unsigned pf0 = 0u;
        if (np > 0) {
            const int tgt = (int)hs[8 + (rank % np)];
            const int sub = rank / np, cnt = (nh - (rank % np) + np - 1) / np;
            const P3Src s = p3_src(P, tgt);
            const unsigned* pw = progw + 16 * tgt;
            const int nlm = s.nmat * 64;
            int pc = sub; unsigned spins = 0;
            while (pc < 64) {
                const int p = (int)__builtin_amdgcn_readfirstlane((int)__hip_atomic_load(pw, __ATOMIC_RELAXED, __HIP_MEMORY_SCOPE_AGENT));
                if (pc <= p + 8) {
                    const char* a = nullptr;
                    if (tid < nlm) a = (const char*)(s.mats + (size_t)pc * s.nmat * 4096) + (size_t)tid * 128;
                    else if (tid < nlm + 64) a = (const char*)(s.vsrc + (size_t)(pc * 64 + (tid - nlm)) * s.vpitch);
                    if (a) asm volatile("global_load_dword %0, %1, off" : "+v"(pf0) : "v"(a) : "memory");
                    pc += cnt;
                } else { __builtin_amdgcn_s_sleep(8); if (++spins > (1u << 16)) break; }
            }
        }
        asm volatile("s_waitcnt vmcnt(0)" : "+v"(pf0) :: "memory");
        __syncthreads();
    }
}

DI float silu_f(float g) { return g * __builtin_amdgcn_rcpf(1.f + __expf(-g)); }
DI void p4_finalize(const Params& P, int wave, int lane) {
    const int gw = blockIdx.x * 8 + wave, NGW = gridDim.x * 8;
    const bf16* OB = (const bf16*)(P.ws + WS_SCR); const bf16* OA = (const bf16*)(P.ws + WS_OARAW);
    const bf16* PROJ0 = (const bf16*)(P.ws + WS_PROJ0); const bf16* VP = (const bf16*)(P.ws + WS_VP); const float* BON = (const float*)(P.ws + WS_BONUS);
    bf16* O0 = (bf16*)(P.ws + WS_XN);
    const int cv = (8 * lane) & 127;
    const f32x4 gw0 = *(const f32x4*)(P.gla_norm_w + cv), gw1 = *(const f32x4*)(P.gla_norm_w + cv + 4);
    const f32x4 lw0 = *(const f32x4*)(P.ln_w + 8 * lane), lw1 = *(const f32x4*)(P.ln_w + 8 * lane + 4), lb0 = *(const f32x4*)(P.ln_b + 8 * lane), lb1 = *(const f32x4*)(P.ln_b + 8 * lane + 4);
    struct Ld { f32x4 a0, a1, b0, b1; u32x4 ga, gb, vv; float bon; };
    auto load = [&](int tok) { Ld L; const bf16* row = PROJ0 + (size_t)tok * N0P + C_GATE0;
        { const u32x4 wa = *(const u32x4*)(OA + (size_t)tok * 512 + 8 * lane), wb = *(const u32x4*)(OB + (size_t)tok * 512 + 8 * lane);
          L.a0 = (f32x4){bflo(wa.x), bfhi(wa.x), bflo(wa.y), bfhi(wa.y)}; L.a1 = (f32x4){bflo(wa.z), bfhi(wa.z), bflo(wa.w), bfhi(wa.w)};
          L.b0 = (f32x4){bflo(wb.x), bfhi(wb.x), bflo(wb.y), bfhi(wb.y)}; L.b1 = (f32x4){bflo(wb.z), bfhi(wb.z), bflo(wb.w), bfhi(wb.w)}; }
        L.ga = *(const u32x4*)(row + 8 * lane); L.gb = *(const u32x4*)(row + 512 + 8 * lane); L.vv = *(const u32x4*)(VP + (size_t)tok * 512 + 8 * lane); L.bon = BON[(size_t)tok * 8 + (lane >> 3)]; return L; };
    Ld nx = load(gw < M ? gw : 0);
    for (int tok = gw; tok < M; tok += NGW) {
        const Ld L = nx;
        if (tok + NGW < M) nx = load(tok + NGW);
        {
            const f32x4 a0 = L.a0, a1 = L.a1;
            float ss = (a0[0] * a0[0] + a0[1] * a0[1]) + (a0[2] * a0[2] + a0[3] * a0[3]) + (a1[0] * a1[0] + a1[1] * a1[1]) + (a1[2] * a1[2] + a1[3] * a1[3]);
            ss += __shfl_xor(ss, 1); ss += __shfl_xor(ss, 2); ss += __shfl_xor(ss, 4); ss += __shfl_xor(ss, 8);
            const float rstd = 1.0f / sqrtf(ss * (1.f / 128.f) + NORM_EPS);
            const u32x4 g = L.ga;
            u32x4 o;
            o.x = pk2(a0[0] * rstd * gw0[0] * silu_f(bflo(g.x)), a0[1] * rstd * gw0[1] * silu_f(bfhi(g.x)));
            o.y = pk2(a0[2] * rstd * gw0[2] * silu_f(bflo(g.y)), a0[3] * rstd * gw0[3] * silu_f(bfhi(g.y)));
            o.z = pk2(a1[0] * rstd * gw1[0] * silu_f(bflo(g.z)), a1[1] * rstd * gw1[1] * silu_f(bfhi(g.z)));
            o.w = pk2(a1[2] * rstd * gw1[2] * silu_f(bflo(g.w)), a1[3] * rstd * gw1[3] * silu_f(bfhi(g.w)));
            *(u32x4*)(O0 + (size_t)tok * 1024 + 8 * lane) = o;
        }
        {
            const f32x4 a0 = L.b0, a1 = L.b1;
            float s = (a0[0] + a0[1]) + (a0[2] + a0[3]) + (a1[0] + a1[1]) + (a1[2] + a1[3]);
            s += __shfl_xor(s, 1); s += __shfl_xor(s, 2); s += __shfl_xor(s, 4);
            const float mean = s * (1.f / 64.f);
            const f32x4 d0 = a0 - mean, d1 = a1 - mean;
            float q = (d0[0] * d0[0] + d0[1] * d0[1]) + (d0[2] * d0[2] + d0[3] * d0[3]) + (d1[0] * d1[0] + d1[1] * d1[1]) + (d1[2] * d1[2] + d1[3] * d1[3]);
            q += __shfl_xor(q, 1); q += __shfl_xor(q, 2); q += __shfl_xor(q, 4);
            const float rstd = 1.0f / sqrtf(q * (1.f / 64.f) + RWKV_LN_EPS);
            const float bon = L.bon; const u32x4 vv = L.vv, g = L.gb;
            u32x4 o;
            o.x = pk2((d0[0] * rstd * lw0[0] + lb0[0] + bon * bflo(vv.x)) * silu_f(bflo(g.x)), (d0[1] * rstd * lw0[1] + lb0[1] + bon * bfhi(vv.x)) * silu_f(bfhi(g.x)));
            o.y = pk2((d0[2] * rstd * lw0[2] + lb0[2] + bon * bflo(vv.y)) * silu_f(bflo(g.y)), (d0[3] * rstd * lw0[3] + lb0[3] + bon * bfhi(vv.y)) * silu_f(bfhi(g.y)));
            o.z = pk2((d1[0] * rstd * lw1[0] + lb1[0] + bon * bflo(vv.z)) * silu_f(bflo(g.z)), (d1[1] * rstd * lw1[1] + lb1[1] + bon * bfhi(vv.z)) * silu_f(bfhi(g.z)));
            o.w = pk2((d1[2] * rstd * lw1[2] + lb1[2] + bon * bflo(vv.w)) * silu_f(bflo(g.w)), (d1[3] * rstd * lw1[3] + lb1[3] + bon * bfhi(vv.w)) * silu_f(bfhi(g.w)));
            *(u32x4*)(O0 + (size_t)tok * 1024 + 512 + 8 * lane) = o;
        }
    }
}
constexpr int AT_KP = 144, AT_VP = 528, AT_VOFF = 256 * AT_KP;
DI void rope_cs(const float* RT, int pos, float (&cs)[8], float (&sn)[8]) {
    const f32x4* tp = (const f32x4*)(RT + (size_t)pos * 16);
#pragma unroll
    for (int q = 0; q < 4; ++q) { const f32x4 v = tp[q]; cs[2 * q] = v[0]; sn[2 * q] = v[1]; cs[2 * q + 1] = v[2]; sn[2 * q + 1] = v[3]; }
}
DI void p7_attn(const Params& P, LAS unsigned char* lds, int tid, int wave, int lane) {
    const bf16* PROJ1 = (const bf16*)(P.ws + WS_SCR); bf16* O1 = (bf16*)(P.ws + WS_XN); const float* RT = (const float*)(P.ws + WS_ROPE);
    const int vcu = ((int)blockIdx.x & 7) * ((int)gridDim.x >> 3) + ((int)blockIdx.x >> 3);
    const int m = lane & 31, hi = lane >> 5;
    const int c8 = tid & 7, kpar = (tid >> 3) & 1;
    u32x4 kw[4], vw[4];
    auto uload = [&](int unit) {
        const int qb = unit & 31, kvh = (unit >> 5) & 3, b = unit >> 7;
#pragma unroll
        for (int q = 0; q < 4; ++q) { const int key = (tid >> 3) + 64 * q; const int pos = qb * 128 - 128 + key;
            kw[q] = (u32x4){0u, 0u, 0u, 0u}; vw[q] = (u32x4){0u, 0u, 0u, 0u};
            if (pos >= 0) { const bf16* row = PROJ1 + (size_t)(b * T + pos) * IN1; kw[q] = *(const u32x4*)(row + 1024 + kvh * 64 + 8 * c8); vw[q] = *(const u32x4*)(row + 1280 + kvh * 64 + 8 * c8); } }
    };
    if (vcu < 512) uload(vcu);
    struct QG { u32x4 q[4], qo; u32x2 g[8]; };
    auto qgload = [&](int unit, int qq) { QG r; const int qb = unit & 31, kvh = (unit >> 5) & 3, b = unit >> 7; const int h = kvh * 4 + (wave >> 1);
        const int pos = qb * 128 + (wave & 1) * 64 + 32 * qq + m; const bf16* row = PROJ1 + ((size_t)b * T + pos) * IN1;
#pragma unroll
        for (int s = 0; s < 4; ++s) r.q[s] = *(const u32x4*)(row + h * 64 + 16 * s + 8 * hi);
        r.qo = *(const u32x4*)(row + h * 64 + 8 * (hi ^ 1));
#pragma unroll
        for (int db = 0; db < 2; ++db)
#pragma unroll
            for (int gq = 0; gq < 4; ++gq) r.g[4 * db + gq] = *(const u32x2*)(row + 1536 + h * 64 + 32 * db + 8 * gq + 4 * hi);
        return r; };
    QG nxq = qgload(vcu < 512 ? vcu : 0, 0);
    for (int unit = vcu; unit < 512; unit += gridDim.x) {
        const int qb = unit & 31, kvh = (unit >> 5) & 3, b = unit >> 7;
#pragma unroll
        for (int q = 0; q < 4; ++q) {
            const int key = (tid >> 3) + 64 * q; const int pos = qb * 128 - 128 + key;
            u32x4 kq = kw[q];
            if (c8 < 2 && pos >= 0) { const bf16* row = PROJ1 + (size_t)(b * T + pos) * IN1;
                const u32x4 ow = *(const u32x4*)(row + 1024 + kvh * 64 + 8 * (c8 ^ 1)); float a[8], o[8], cs[8], sn[8]; unpack8(kq, a); unpack8(ow, o); rope_cs(RT, pos, cs, sn);
                float r[8];
#pragma unroll
                for (int j = 0; j < 8; ++j) r[j] = (c8 == 0) ? (a[j] * cs[j] - o[j] * sn[j]) : (a[j] * cs[j] + o[j] * sn[j]);
                kq.x = pk2(r[0], r[1]); kq.y = pk2(r[2], r[3]); kq.z = pk2(r[4], r[5]); kq.w = pk2(r[6], r[7]); }
            *(LAS u32x4*)(lds + key * AT_KP + c8 * 16) = kq;
            const u32x4 rv = vw[q];
            const unsigned k0 = kpar ? rv[2] : rv[0], k1 = kpar ? rv[3] : rv[1], s0 = kpar ? rv[0] : rv[2], s1 = kpar ? rv[1] : rv[3];
            const unsigned r0 = (unsigned)__builtin_amdgcn_update_dpp(0, (int)s0, 0x128, 0xf, 0xf, true), r1 = (unsigned)__builtin_amdgcn_update_dpp(0, (int)s1, 0x128, 0xf, 0xf, true);
            unsigned o4[4];
            if (kpar == 0) { o4[0] = (k0 & 0xffffu) | (r0 << 16); o4[1] = (k0 >> 16) | (r0 & 0xffff0000u); o4[2] = (k1 & 0xffffu) | (r1 << 16); o4[3] = (k1 >> 16) | (r1 & 0xffff0000u); }
            else           { o4[0] = (r0 & 0xffffu) | (k0 << 16); o4[1] = (r0 >> 16) | (k0 & 0xffff0000u); o4[2] = (r1 & 0xffffu) | (k1 << 16); o4[3] = (r1 >> 16) | (k1 & 0xffff0000u); }
            const int tp = key >> 1, gsw = (tp >> 2) ^ c8;
#pragma unroll
            for (int jj = 0; jj < 4; ++jj) *(LAS unsigned*)(lds + AT_VOFF + (8 * c8 + 4 * kpar + jj) * AT_VP + (4 * gsw + (tp & 3)) * 4) = o4[jj];
        }
        lds_barrier();
        if (unit + (int)gridDim.x < 512) uload(unit + gridDim.x);
        const int g = wave >> 1, h = kvh * 4 + g; const float sink = P.sinks[h] * 1.44269504f;
        for (int qq = 0; qq < 2; ++qq) {
            const int qs = (wave & 1) * 64 + 32 * qq, qi = qs + m, pos = qb * 128 + qi; const size_t tok = (size_t)b * T + pos;
            const QG cq = nxq;
            { const int nu = (qq == 0) ? unit : unit + (int)gridDim.x; if (nu < 512) nxq = qgload(nu, qq ^ 1); }
            bf16x8 Q[4];
#pragma unroll
            for (int s = 0; s < 4; ++s) { const u32x4 w = cq.q[s]; float a[8]; unpack8(w, a);
                if (s == 0) { const u32x4 ow = cq.qo; float o[8], cs[8], sn[8]; unpack8(ow, o); rope_cs(RT, pos, cs, sn);
#pragma unroll
                    for (int j = 0; j < 8; ++j) a[j] = (hi == 0) ? (a[j] * cs[j] - o[j] * sn[j]) : (a[j] * cs[j] + o[j] * sn[j]); }
                u32x4 qw;
#pragma unroll
                for (int e = 0; e < 4; ++e) qw[e] = pk2(a[2 * e] * 0.18033688f, a[2 * e + 1] * 0.18033688f);
                Q[s] = __builtin_bit_cast(bf16x8, qw); }
            const int kb0 = qs >> 5;
            f32x16 sc[5];
#pragma unroll
            for (int kbi = 0; kbi < 5; ++kbi) {
#pragma unroll
                for (int i = 0; i < 16; ++i) sc[kbi][i] = 0.f;
#pragma unroll
                for (int s = 0; s < 4; ++s) { const bf16x8 A = *(const LAS bf16x8*)(lds + (32 * (kb0 + kbi) + m) * AT_KP + (16 * s + 8 * hi) * 2); sc[kbi] = MFMA32(A, Q[s], sc[kbi]); }
            }
            float mx = sink;
#pragma unroll
            for (int kbi = 0; kbi < 5; ++kbi)
#pragma unroll
                for (int i = 0; i < 16; ++i) { const int kj = 32 * (kb0 + kbi) + crow(i, hi);
                    const bool band = (kbi == 0) ? (kj >= qi + 1) : ((kbi == 4) ? (kj <= qi + 128) : true); const bool vis = band && (qb > 0 || kj >= 128);
                    sc[kbi][i] = vis ? sc[kbi][i] : -1e30f; mx = fmaxf(mx, sc[kbi][i]); }
            mx = fmaxf(mx, __shfl_xor(mx, 32));
            float sum = 0.f;
#pragma unroll
            for (int kbi = 0; kbi < 5; ++kbi)
#pragma unroll
                for (int i = 0; i < 16; ++i) { const float pv = __builtin_amdgcn_exp2f(sc[kbi][i] - mx); sc[kbi][i] = pv; sum += pv; }
            sum += __shfl_xor(sum, 32);
            const float inv = __builtin_amdgcn_rcpf(sum + __builtin_amdgcn_exp2f(sink - mx));
            f32x16 oacc[2];
#pragma unroll
            for (int db = 0; db < 2; ++db) {
#pragma unroll
                for (int i = 0; i < 16; ++i) oacc[db][i] = 0.f;
                const int vrow = 32 * db + m, rsw = (vrow >> 3) & 7;
#pragma unroll
                for (int kbi = 0; kbi < 5; ++kbi)
#pragma unroll
                    for (int s2 = 0; s2 < 2; ++s2) { u32x4 pw;
#pragma unroll
                        for (int e = 0; e < 4; ++e) pw[e] = pk2(sc[kbi][8 * s2 + 2 * e], sc[kbi][8 * s2 + 2 * e + 1]);
                        const int ga = 4 * (kb0 + kbi) + 2 * s2;
                        const LAS unsigned char* vp = lds + AT_VOFF + vrow * AT_VP + 8 * hi;
                        const u32x2 lo = *(const LAS u32x2*)(vp + (ga ^ rsw) * 16), hi2 = *(const LAS u32x2*)(vp + ((ga + 1) ^ rsw) * 16);
                        const u32x4 aw = (u32x4){lo.x, lo.y, hi2.x, hi2.y};
                        oacc[db] = MFMA32(__builtin_bit_cast(bf16x8, aw), __builtin_bit_cast(bf16x8, pw), oacc[db]); }
            }
#pragma unroll
            for (int db = 0; db < 2; ++db)
#pragma unroll
                for (int gq = 0; gq < 4; ++gq) { const int d0 = 32 * db + 8 * gq + 4 * hi; const u32x2 gw = cq.g[4 * db + gq];
                    u32x2 o; o.x = pk2(oacc[db][4 * gq] * inv * silu_f(bflo(gw.x)), oacc[db][4 * gq + 1] * inv * silu_f(bfhi(gw.x)));
                    o.y = pk2(oacc[db][4 * gq + 2] * inv * silu_f(bflo(gw.y)), oacc[db][4 * gq + 3] * inv * silu_f(bfhi(gw.y)));
                    *(u32x2*)(O1 + tok * 1024 + h * 64 + d0) = o; }
        }
        lds_barrier();
    }
}
DI void p9_final(const Params& P, int wave, int lane) {
    const int gw = blockIdx.x * 8 + wave, NGW = gridDim.x * 8;
    const float* slots = (const float*)(P.ws + WS_SLOT2);
    for (int mrow = gw; mrow < M; mrow += NGW) {
        float s = (lane < 16) ? slots[(size_t)mrow * 16 + lane] : 0.f;
        s += __shfl_xor(s, 1); s += __shfl_xor(s, 2); s += __shfl_xor(s, 4); s += __shfl_xor(s, 8);
        s = __shfl(s, 0);
        const float rstd = 1.0f / sqrtf(s * (1.f / 1024.f) + NORM_EPS);
        f32x4* o = (f32x4*)(P.out + (size_t)mrow * D) + lane; const f32x4* w = (const f32x4*)P.final_w + lane;
#pragma unroll
        for (int j = 0; j < 4; ++j) { const f32x4 v = o[64 * j]; o[64 * j] = v * rstd * w[64 * j]; }
    }
}

__global__ void __launch_bounds__(512) fwd_megakernel(Params P) {
    extern __shared__ __attribute__((aligned(16))) unsigned char lds_raw[];
    LAS unsigned char* lds = (LAS unsigned char*)lds_raw;
    cg::grid_group grid = cg::this_grid();
    const int tid = threadIdx.x, lane = tid & 63, wave = __builtin_amdgcn_readfirstlane(tid >> 6);
    const int G = gridDim.x;
    if (tid < 2) ((LAS unsigned*)(lds + LDS_BAR_OFF))[tid] = 0u;
    __syncthreads();
    if (tid == 0) ((unsigned*)(P.ws + WS_XCCTAB))[blockIdx.x] = xb_xcc_id() + 1u;
    const XcdBarrier xbar = xcd_barrier_post((unsigned*)(P.ws + WS_CTL), (volatile LAS unsigned*)(lds + LDS_BAR_OFF));
    bf16* XN = (bf16*)(P.ws + WS_XN);
    p0_prologue(P, lds, wave, lane);
    if (P.ws == nullptr) grid.sync();
    xcd_barrier(xbar);
    { pg8::Gemm g{XN, (const bf16*)(P.ws + WS_W0T), M, N0P, D}; pg8::StaticOrder S; S.init(M, N0P, G, (int)blockIdx.x);
      EpiScaleBf16 E{(bf16*)(P.ws + WS_PROJ0), N0P, nullptr, nullptr, 0};
      pg8::gemm_phase<EpiScaleBf16, pg8::StaticOrder, true, true>(lds, g, S, E); }
    xcd_barrier(xbar);
#pragma unroll 1
    for (int rep = 0; rep < REP_P2R; ++rep) { for (int it = blockIdx.x; it < 512; it += G) rwkv_prep_item(P, it, lds, wave, lane); }
#pragma unroll 1
    for (int rep = 0; rep < REP_P2G; ++rep) { for (int it = blockIdx.x; it < 1024; it += G) gla_prep_item(P, it, lds, wave, lane); }
    xcd_barrier(xbar);
#pragma unroll 1
    for (int rep = 0; rep < REP_P3; ++rep) { p3_seq(P, lds, tid, wave, lane); __syncthreads(); }
    xcd_barrier(xbar);
    p4_finalize(P, wave, lane);
    xcd_barrier(xbar);
    { pg8::Gemm g{XN, (const bf16*)(P.ws + WS_WO0T), M, D, D}; pg8::StaticOrder S; S.init(M, D, G, (int)blockIdx.x);
      EpiResid E{P.x, (bf16*)(P.ws + WS_H1B), (float*)(P.ws + WS_SLOT1)};
      pg8::gemm_phase<EpiResid, pg8::StaticOrder, true, true>(lds, g, S, E); }
    xcd_barrier(xbar);
    { pg8::Gemm g{(const bf16*)(P.ws + WS_H1B), (const bf16*)(P.ws + WS_W1T), M, IN1, D}; pg8::StaticOrder S; S.init(M, IN1, G, (int)blockIdx.x);
      EpiScaleBf16 E{(bf16*)(P.ws + WS_SCR), IN1, (const float*)(P.ws + WS_SLOT1), P.b_in1, 1536};
      pg8::gemm_phase<EpiScaleBf16, pg8::StaticOrder, true, true>(lds, g, S, E); }
    xcd_barrier(xbar);
    p7_attn(P, lds, tid, wave, lane);
    xcd_barrier(xbar);
    { pg8::Gemm g{XN, (const bf16*)(P.ws + WS_WO1T), M, D, D}; pg8::StaticOrder S; S.init(M, D, G, (int)blockIdx.x);
      EpiResidNorm E{(const bf16*)(P.ws + WS_H1B), P.out, P.b_out1, P.final_w, (float*)(P.ws + WS_SLOT2), (unsigned*)(P.ws + WS_PCNT)};
      pg8::gemm_phase<EpiResidNorm, pg8::StaticOrder, false, true>(lds, g, S, E); }
}

extern "C" void kernel_launch(void* const* d_in, const int* in_sizes, int n_in, void* d_out, int out_size, void* d_ws, size_t ws_size, hipStream_t stream) {
    static int grid = 0;
    if (grid == 0) {
        if (n_in != 23 || out_size != M * D || ws_size < WS_END) { fprintf(stderr, "kernel_launch: unexpected sizes n_in %d out %d ws %zu\n", n_in, out_size, ws_size); grid = -1; return; }
        int dev = 0, cus = 0, per_cu = 0;
        hipGetDevice(&dev); hipDeviceGetAttribute(&cus, hipDeviceAttributeMultiprocessorCount, dev);
        hipFuncSetAttribute((const void*)fwd_megakernel, hipFuncAttributeMaxDynamicSharedMemorySize, LDS_BYTES);
        hipOccupancyMaxActiveBlocksPerMultiprocessor(&per_cu, (const void*)fwd_megakernel, 512, LDS_BYTES);
        if (per_cu < 1) { fprintf(stderr, "kernel_launch: occupancy query says %d blocks/CU\n", per_cu); per_cu = 1; }
        grid = cus * 1;
        if (grid != 256) { fprintf(stderr, "kernel_launch: built for a 256-CU device (got %d)\n", cus); grid = -1; return; }
        (void)hipGetLastError();
    }
    if (grid < 0) return;
    Params p{};
    const float** pp = (const float**)&p;
    for (int i = 0; i < 23; ++i) pp[i] = (const float*)d_in[i];
    p.out = (float*)d_out; p.ws = (unsigned char*)d_ws;
    if (hipMemsetAsync((char*)d_ws + WS_CTL, 0, CTL_BYTES, stream) != hipSuccess) { fprintf(stderr, "memset failed\n"); return; }
    void* args[] = {&p};
    hipError_t e = hipLaunchCooperativeKernel((const void*)fwd_megakernel, dim3(grid), dim3(512), args, LDS_BYTES, stream);
    if (e != hipSuccess) fprintf(stderr, "cooperative launch failed: %s (grid %d)\n", hipGetErrorString(e), grid);
}
```
